# Optimizing an MI355X kernel written in HIP

```python
import math
import jax, jax.numpy as jnp
from jax import lax
import numpy as np

D_MODEL = 1024
BATCH = 2
SEQ = 8192
DEPTH = 1

N_META = 16
RET_HEADS = 4
RET_QK_HEAD = 128
RET_V_HEAD = 256
RET_CHUNK = 128
ROPE_BASE = 10000.0
HY_WIDTH = D_MODEL
HY_SHORT_CONV = 3
HY_EMB_DIM = 33
HY_FILTER_ORDER = 64
HY_FAST_DECAY_PCT = 0.3
HY_SLOW_DECAY_PCT = 1.5
HY_DECAY_TARGET = 1e-2
N_EXPERTS = 16
EC_CAPACITY = 2
D_FF_EXPERT = 2 * D_MODEL
RMS_EPS = 1e-6

RET_QK_W = RET_HEADS * RET_QK_HEAD
RET_V_W = RET_HEADS * RET_V_HEAD
IN_SPLITS = (RET_QK_W, RET_QK_W, RET_V_W, RET_V_W, 3 * HY_WIDTH, D_MODEL, D_MODEL)
IN_PROJ_W = sum(IN_SPLITS)

kernel_name = 'hybrid_retention_hyena_ecmoe_encoder'


def rms_norm(x, g):
    xf = x.astype(jnp.float32)
    y = xf * lax.rsqrt(jnp.mean(xf * xf, axis=-1, keepdims=True) + RMS_EPS)
    return (y * g.astype(jnp.float32)).astype(x.dtype)


def rotary(x, pos):
    half = x.shape[-1] // 2
    inv = ROPE_BASE ** (-jnp.arange(half, dtype=jnp.float32) / half)
    ang = pos[:, None] * inv[None, :]
    cos = jnp.cos(ang)[:, None, :].astype(x.dtype)
    sin = jnp.sin(ang)[:, None, :].astype(x.dtype)
    x1, x2 = x[..., :half], x[..., half:]
    return jnp.concatenate([x1 * cos - x2 * sin, x1 * sin + x2 * cos], axis=-1)


def bidir_retention(q, k, v, log_gf, log_gb):
    B, T, H, _ = q.shape
    dt = q.dtype
    C = RET_CHUNK
    pad = (-T) % C
    n = (T + pad) // C

    def to_chunks(a):
        a = jnp.pad(a, ((0, 0), (pad, 0), (0, 0), (0, 0)))
        return a.reshape(B, n, C, H, a.shape[-1]).transpose(0, 3, 1, 2, 4)

    qc, kc, vc = to_chunks(q), to_chunks(k), to_chunks(v)
    i = jnp.arange(C, dtype=jnp.float32)
    diff = i[:, None] - i[None, :]
    lf = log_gf[:, None, None]
    lb = log_gb[:, None, None]
    mask = jnp.exp(jnp.where(diff >= 0, lf * diff, -lb * diff)).astype(dt)
    scores = jnp.einsum('bhncd,bhned->bhnce', qc, kc) * mask[None, :, None]
    intra = jnp.einsum('bhnce,bhned->bhncd', scores, vc)

    w_end = jnp.exp(log_gf[:, None] * (C - 1 - i)[None, :]).astype(dt)
    w_start = jnp.exp(log_gb[:, None] * i[None, :]).astype(dt)
    a_f = jnp.einsum('bhncd,hc,bhnce->nbhde', kc, w_end, vc)
    a_b = jnp.einsum('bhncd,hc,bhnce->nbhde', kc, w_start, vc)
    dec_f = jnp.exp(log_gf * C).astype(dt)
    dec_b = jnp.exp(log_gb * C).astype(dt)

    def states(a, dec, reverse):
        def step(s, a_n):
            return s * dec[None, :, None, None] + a_n, s
        _, ss = lax.scan(step, jnp.zeros_like(a[0]), a, reverse=reverse)
        return ss

    s_f = states(a_f, dec_f, False)
    s_b = states(a_b, dec_b, True)
    qw_f = jnp.exp(log_gf[:, None] * (i + 1.0)[None, :]).astype(dt)
    qw_b = jnp.exp(log_gb[:, None] * (C - i)[None, :]).astype(dt)
    cross = (jnp.einsum('bhncd,hc,nbhde->bhnce', qc, qw_f, s_f)
             + jnp.einsum('bhncd,hc,nbhde->bhnce', qc, qw_b, s_b))
    o = (intra + cross).transpose(0, 2, 3, 1, 4).reshape(B, n * C, H, -1)
    return o[:, pad:]


def head_rms_norm(o, g):
    of = o.astype(jnp.float32)
    y = of * lax.rsqrt(jnp.mean(of * of, axis=-1, keepdims=True) + RMS_EPS)
    return (y * g.astype(jnp.float32).reshape(o.shape[2], o.shape[3])).astype(o.dtype)


def short_conv_centred(u, w, b):
    T = u.shape[1]
    half = HY_SHORT_CONV // 2
    up = jnp.pad(u, ((0, 0), (half, half), (0, 0)))
    return sum(up[:, j:j + T] * w[j] for j in range(HY_SHORT_CONV)) + b


def hyena_filters(T, w1, b1, w2, b2, w3, b3, freq, w4):
    f32 = jnp.float32
    t = jnp.arange(T, dtype=f32)
    t_norm = t / (T - 1)
    bands = (HY_EMB_DIM - 1) // 2
    fr = jnp.linspace(1e-4, bands - 1, bands, dtype=f32)
    ang = (2.0 * math.pi * t / T)[:, None] * fr[None, :]
    feat = jnp.concatenate([t_norm[:, None], jnp.cos(ang), -jnp.sin(ang)], axis=-1)
    fq = freq.astype(f32)
    hdn = jnp.sin(fq * (feat @ w1.astype(f32) + b1.astype(f32)))
    hdn = jnp.sin(fq * (hdn @ w2.astype(f32) + b2.astype(f32)))
    hdn = jnp.sin(fq * (hdn @ w3.astype(f32) + b3.astype(f32)))
    filt = (hdn @ w4.astype(f32)).reshape(T, 2, HY_WIDTH)
    max_decay = math.log(HY_DECAY_TARGET) / HY_FAST_DECAY_PCT
    min_decay = math.log(HY_DECAY_TARGET) / HY_SLOW_DECAY_PCT
    deltas = jnp.linspace(min_decay, max_decay, HY_WIDTH, dtype=f32)
    window = jnp.exp(-t_norm[:, None] * jnp.abs(deltas)[None, :])
    filt = filt * window[:, None, :]
    return filt[:, 0], filt[:, 1]


def bidir_fftconv(z, h_f, h_b):
    T = z.shape[1]
    n = 2 * T
    g = jnp.concatenate([h_f, jnp.zeros((1, h_f.shape[1]), jnp.float32), h_b[:0:-1]], axis=0)
    zf = jnp.fft.rfft(z.astype(jnp.float32), n=n, axis=1)
    gf = jnp.fft.rfft(g, n=n, axis=0)
    y = jnp.fft.irfft(zf * gf[None], n=n, axis=1)[:, :T]
    return y.astype(z.dtype)


def expert_choice_moe(xn, w_router, w_gate, w_up, w_down):
    B, T, _ = xn.shape
    cap = EC_CAPACITY * T // N_EXPERTS
    logits = jnp.einsum('btd,de->bte', xn, w_router).astype(jnp.float32)
    aff = jax.nn.softmax(logits, axis=-1)
    gate, idx = lax.top_k(jnp.swapaxes(aff, 1, 2), cap)
    bidx = jnp.arange(B)[:, None, None]
    xe = xn[bidx, idx]
    hid = jax.nn.silu(jnp.einsum('becd,edf->becf', xe, w_gate)) * jnp.einsum('becd,edf->becf', xe, w_up)
    ye = jnp.einsum('becf,efd->becd', hid, w_down) * gate[..., None].astype(xn.dtype)
    return jnp.zeros_like(xn).at[bidx, idx].add(ye)


def setup_inputs(seed: int = 0) -> dict:
    key = jax.random.key(seed)
    ks = iter(jax.random.split(key, 40))
    f32 = jnp.float32
    L = DEPTH

    def nrm(shape, scale):
        return jax.random.normal(next(ks), shape, f32) * scale

    hh = jnp.arange(RET_HEADS, dtype=f32)
    decay_base = jnp.log(2.0 ** (5.0 + hh) - 1.0)
    return {
        'x': nrm((BATCH, SEQ, D_MODEL), 1.0),
        'meta_tokens': nrm((N_META, D_MODEL), 1.0),
        'norm1_g': 1.0 + nrm((L, D_MODEL), 0.01),
        'w_in': nrm((L, D_MODEL, IN_PROJ_W), D_MODEL ** -0.5),
        'ret_decay_fwd': decay_base[None] + nrm((L, RET_HEADS), 0.1),
        'ret_decay_bwd': decay_base[None] + nrm((L, RET_HEADS), 0.1),
        'ret_head_norm_g': 1.0 + nrm((L, RET_V_W), 0.01),
        'w_ret_out': nrm((L, RET_V_W, D_MODEL), RET_V_W ** -0.5),
        'hy_conv_w': nrm((L, HY_SHORT_CONV, 3 * HY_WIDTH), HY_SHORT_CONV ** -0.5),
        'hy_conv_b': nrm((L, 3 * HY_WIDTH), 0.01),
        'hy_filt_w1': nrm((L, HY_EMB_DIM, HY_FILTER_ORDER), HY_EMB_DIM ** -0.5),
        'hy_filt_b1': nrm((L, HY_FILTER_ORDER), 0.01),
        'hy_filt_w2': nrm((L, HY_FILTER_ORDER, HY_FILTER_ORDER), HY_FILTER_ORDER ** -0.5),
        'hy_filt_b2': nrm((L, HY_FILTER_ORDER), 0.01),
        'hy_filt_w3': nrm((L, HY_FILTER_ORDER, HY_FILTER_ORDER), HY_FILTER_ORDER ** -0.5),
        'hy_filt_b3': nrm((L, HY_FILTER_ORDER), 0.01),
        'hy_filt_freq': 1.0 + nrm((L, HY_FILTER_ORDER), 0.01),
        'hy_filt_w4': nrm((L, HY_FILTER_ORDER, 2 * HY_WIDTH), 0.1 * HY_FILTER_ORDER ** -0.5),
        'hy_skip': nrm((L, HY_WIDTH), 1.0),
        'w_hy_out': nrm((L, HY_WIDTH, D_MODEL), HY_WIDTH ** -0.5),
        'w_o': nrm((L, D_MODEL, D_MODEL), D_MODEL ** -0.5),
        'norm2_g': 1.0 + nrm((L, D_MODEL), 0.01),
        'w_router': nrm((L, D_MODEL, N_EXPERTS), D_MODEL ** -0.5),
        'w_exp_gate': nrm((L, N_EXPERTS, D_MODEL, D_FF_EXPERT), D_MODEL ** -0.5),
        'w_exp_up': nrm((L, N_EXPERTS, D_MODEL, D_FF_EXPERT), D_MODEL ** -0.5),
        'w_exp_down': nrm((L, N_EXPERTS, D_FF_EXPERT, D_MODEL), D_FF_EXPERT ** -0.5),
        'final_norm_g': 1.0 + nrm((D_MODEL,), 0.01),
    }


def reference(x, meta_tokens, norm1_g, w_in, ret_decay_fwd, ret_decay_bwd, ret_head_norm_g, w_ret_out,
              hy_conv_w, hy_conv_b, hy_filt_w1, hy_filt_b1, hy_filt_w2, hy_filt_b2, hy_filt_w3, hy_filt_b3,
              hy_filt_freq, hy_filt_w4, hy_skip, w_hy_out, w_o, norm2_g, w_router, w_exp_gate, w_exp_up,
              w_exp_down, final_norm_g):
    B = x.shape[0]
    meta = jnp.broadcast_to(meta_tokens[None].astype(x.dtype), (B, N_META, D_MODEL))
    h = jnp.concatenate([meta, x], axis=1)
    T = h.shape[1]
    pos = jnp.arange(T, dtype=jnp.float32)
    offs = np.cumsum(IN_SPLITS)[:-1].tolist()
    for l in range(DEPTH):
        xn = rms_norm(h, norm1_g[l])
        proj = xn @ w_in[l]
        q, k, v, g_ret, u_hy, gate_a, gate_b = jnp.split(proj, offs, axis=-1)

        q = rotary(q.reshape(B, T, RET_HEADS, RET_QK_HEAD), pos)
        k = rotary(k.reshape(B, T, RET_HEADS, RET_QK_HEAD), pos) * (RET_QK_HEAD ** -0.5)
        v = v.reshape(B, T, RET_HEADS, RET_V_HEAD)
        o = bidir_retention(q, k, v,
                            jax.nn.log_sigmoid(ret_decay_fwd[l].astype(jnp.float32)),
                            jax.nn.log_sigmoid(ret_decay_bwd[l].astype(jnp.float32)))
        o = head_rms_norm(o, ret_head_norm_g[l]).reshape(B, T, RET_V_W)
        y_a = (jax.nn.silu(g_ret) * o) @ w_ret_out[l]

        uc = short_conv_centred(u_hy, hy_conv_w[l], hy_conv_b[l])
        x0, x1, vh = jnp.split(uc, 3, axis=-1)
        h_f, h_b = hyena_filters(T, hy_filt_w1[l], hy_filt_b1[l], hy_filt_w2[l], hy_filt_b2[l],
                                 hy_filt_w3[l], hy_filt_b3[l], hy_filt_freq[l], hy_filt_w4[l])
        z = x1 * vh
        y_b = (x0 * (bidir_fftconv(z, h_f, h_b) + z * hy_skip[l])) @ w_hy_out[l]

        mixed = jax.nn.sigmoid(gate_a) * y_a + jax.nn.sigmoid(gate_b) * y_b
        h = h + mixed @ w_o[l]

        h = h + expert_choice_moe(rms_norm(h, norm2_g[l]), w_router[l], w_exp_gate[l],
                                  w_exp_up[l], w_exp_down[l])
    return rms_norm(h, final_norm_g)[:, N_META:]
```

```cpp
#include <hip/hip_runtime.h>
#include <stdint.h>
#include <cstdio>

typedef unsigned short bf16_t;
__device__ __forceinline__ float bf2f(bf16_t v) { return __uint_as_float(((unsigned)v) << 16); }
__device__ __forceinline__ bf16_t f2bf(float f) { unsigned u = __float_as_uint(f); u += 0x7fffu + ((u >> 16) & 1u); return (bf16_t)(u >> 16); }

constexpr int NB = 2, SEQ = 8192, DM = 1024, NMETA = 16, TT = 8208;
constexpr int MX = 16384, MROWS = 16416, MP = 16640;
constexpr int NPROJ = 8192;
constexpr int C_Q = 0, C_K = 512, C_V = 1024, C_G = 2048, C_U = 3072, C_GA = 6144, C_GB = 7168;
constexpr int NE = 16, CAP = 1026, ER = 2304, FF = 2048;
constexpr int NCH = 65;
constexpr int GL = 16640;
constexpr int ZL = 8320;
constexpr float RMS_EPS = 1e-6f;

constexpr size_t MiB = 1u << 20;
constexpr size_t WS_CTL = 0;
constexpr size_t WS_WRET = 1 * MiB, WS_WHY = 3 * MiB, WS_WO = 5 * MiB;
constexpr size_t WS_MISC = 7 * MiB;
constexpr size_t WS_XN = 12 * MiB;
constexpr size_t WS_PROJ = 48 * MiB;
constexpr size_t WS_S = 308 * MiB;
constexpr size_t WS_ZT = 374 * MiB;
constexpr size_t WS_G = 407 * MiB;
constexpr size_t WS_ARET = 440 * MiB;
constexpr size_t WS_WGU = 48 * MiB;
constexpr size_t WS_WD = 176 * MiB;
constexpr size_t WS_XE = 240 * MiB;
constexpr size_t WS_HID = 312 * MiB;
constexpr size_t WS_END = 456 * MiB;
constexpr size_t DO_WIN = 0;
constexpr size_t DO_ROPE = 16 * MiB;
constexpr size_t DO_HDN = 22 * MiB;
constexpr size_t DO_YCT = 0;
constexpr size_t MI_AFF = 0;
constexpr size_t MI_IDX = 1 * MiB + 64 * 1024;
constexpr size_t MI_GATE = 1 * MiB + 256 * 1024;
constexpr size_t MI_INV = 2 * MiB;
constexpr size_t MI_H2M = 3 * MiB + 256 * 1024;

__device__ __forceinline__ int row_of(int b, int t) { return t < NMETA ? MX + b * NMETA + t : b * SEQ + (t - NMETA); }
__device__ __forceinline__ void bt_of(int m, int& b, int& t) { if (m < MX) { b = m >> 13; t = (m & 8191) + NMETA; } else { b = (m - MX) >> 4; t = (m - MX) & 15; } }

__global__ void k_wconv(const float* __restrict__ W0, const float* __restrict__ W1, int K, int N, int Nd, bf16_t* __restrict__ WT, int mode, size_t src_bstride, size_t dst_bstride) {
    __shared__ float tile[32][33];
    const int tx = threadIdx.x, ty = threadIdx.y;
    const int k0 = blockIdx.x * 32, r0 = blockIdx.y * 32, e = blockIdx.z;
    const int r = r0 + tx;
    const float* src = W0 + (size_t)e * src_bstride; int col = r;
    if (mode == 1) { if (r < 1024) { const int sec = r >> 7, rl = r & 127, g = rl >> 3, j = rl & 7; col = sec * 128 + (j < 4 ? 4 * g + j : 64 + 4 * g + (j - 4)); } }
    else if (mode == 2) { const int g = r >> 3, j = r & 7; if (j < 4) { col = 4 * g + j; } else { col = 4 * g + j - 4; src = W1 + (size_t)e * src_bstride; } }
    for (int i = 0; i < 4; ++i) { const int k = k0 + ty + 8 * i; tile[ty + 8 * i][tx] = src[(size_t)k * N + col]; }
    __syncthreads();
    bf16_t* dst = WT + (size_t)e * dst_bstride;
    for (int i = 0; i < 4; ++i) { const int rr = r0 + ty + 8 * i; dst[(size_t)rr * K + k0 + tx] = f2bf(tile[tx][ty + 8 * i]); }
}

__device__ __forceinline__ float block_sum256(float v, float* red) {
    for (int o = 32; o > 0; o >>= 1) v += __shfl_xor(v, o);
    const int w = threadIdx.x >> 6;
    __syncthreads();
    if ((threadIdx.x & 63) == 0) red[w] = v;
    __syncthreads();
    return red[0] + red[1] + red[2] + red[3];
}

__global__ void k_xn1(const float* __restrict__ x, const float* __restrict__ meta, const float* __restrict__ g, bf16_t* __restrict__ XN) {
    __shared__ float red[4];
    const int m = blockIdx.x;
    const float* src = m < MX ? x + (size_t)m * DM : meta + (size_t)((m - MX) & 15) * DM;
    float v[4]; float s = 0.f;
    for (int i = 0; i < 4; ++i) { v[i] = src[threadIdx.x + 256 * i]; s += v[i] * v[i]; }
    s = block_sum256(s, red);
    const float r = rsqrtf(s * (1.f / DM) + RMS_EPS);
    for (int i = 0; i < 4; ++i) XN[(size_t)m * DM + threadIdx.x + 256 * i] = f2bf(v[i] * r * g[threadIdx.x + 256 * i]);
}

__global__ void k_rope(float* __restrict__ ROPE) {
    const int t = blockIdx.x, i = threadIdx.x;
    const float inv = powf(10000.0f, -(float)i / 64.0f);
    const float ang = (float)t * inv;
    ROPE[(size_t)t * 128 + i] = cosf(ang);
    ROPE[(size_t)t * 128 + 64 + i] = sinf(ang);
}

__global__ void k_filt_hidden(const float* __restrict__ w1, const float* __restrict__ b1, const float* __restrict__ w2, const float* __restrict__ b2,
                              const float* __restrict__ w3, const float* __restrict__ b3, const float* __restrict__ fq, float* __restrict__ HDN) {
    __shared__ float feat[33]; __shared__ float ha[64]; __shared__ float hb[64];
    const int t = blockIdx.x, j = threadIdx.x;
    if (j == 0) feat[0] = (float)t / (float)(TT - 1);
    if (j < 16) {
        const float fr = 1e-4f + (float)j * ((15.0f - 1e-4f) / 15.0f);
        const float ang = (2.0f * 3.14159265358979323846f * (float)t / (float)TT) * fr;
        feat[1 + j] = cosf(ang); feat[17 + j] = -sinf(ang);
    }
    __syncthreads();
    const float f = fq[j];
    float a = b1[j];
    for (int i = 0; i < 33; ++i) a += feat[i] * w1[i * 64 + j];
    ha[j] = sinf(f * a);
    __syncthreads();
    a = b2[j];
    for (int i = 0; i < 64; ++i) a += ha[i] * w2[i * 64 + j];
    hb[j] = sinf(f * a);
    __syncthreads();
    a = b3[j];
    for (int i = 0; i < 64; ++i) a += hb[i] * w3[i * 64 + j];
    HDN[(size_t)t * 64 + j] = sinf(f * a);
}

__global__ void k_filt_out(const float* __restrict__ HDN, const float* __restrict__ w4, bf16_t* __restrict__ G) {
    const int c = blockIdx.x * 256 + threadIdx.x, t = blockIdx.y;
    __shared__ float h[64];
    if (threadIdx.x < 64) h[threadIdx.x] = HDN[(size_t)t * 64 + threadIdx.x];
    __syncthreads();
    float ff = 0.f, fb = 0.f;
    for (int j = 0; j < 64; ++j) { ff += h[j] * w4[j * 2048 + c]; fb += h[j] * w4[j * 2048 + 1024 + c]; }
    const float mind = logf(1e-2f) / 1.5f, maxd = logf(1e-2f) / 0.3f;
    const float delta = mind + (float)c * ((maxd - mind) / 1023.0f);
    const float tn = (float)t / (float)(TT - 1);
    const float win = expf(-tn * fabsf(delta));
    G[(size_t)c * GL + TT + t] = f2bf(ff * win);
    if (t >= 1) G[(size_t)c * GL + TT - t] = f2bf(fb * win);
    if (t == 0) { G[(size_t)c * GL] = 0; for (int i = 2 * TT; i < GL; ++i) G[(size_t)c * GL + i] = 0; }
}

struct EpiArgs {
    bf16_t* PROJ; const float* ROPE;
    float* TMP; bf16_t* MIXED;
    const float* x; const float* meta; float* H2; float* H2M;
    bf16_t* HID; bf16_t* YE; const float* GATEV;
};
__device__ __forceinline__ void epi8(int mode, const EpiArgs& E, int e, int m, int c0, const float* acc) {
    if (mode == 1) {
        bf16_t* dst = E.PROJ + (size_t)m * NPROJ + c0;
        if (c0 < C_V) {
            int b, t; bt_of(m, b, t);
            const int i0 = ((c0 & 127) >> 3) * 4;
            const float sc = c0 >= C_K ? 0.08838834764831845f : 1.0f;
            for (int j = 0; j < 4; ++j) {
                const float cs = E.ROPE[(size_t)t * 128 + i0 + j], sn = E.ROPE[(size_t)t * 128 + 64 + i0 + j];
                const float x1 = acc[j], x2 = acc[4 + j];
                dst[j] = f2bf((x1 * cs - x2 * sn) * sc); dst[4 + j] = f2bf((x1 * sn + x2 * cs) * sc);
            }
        } else if (c0 < C_G || (c0 >= C_U && c0 < C_GA)) { for (int j = 0; j < 8; ++j) dst[j] = f2bf(acc[j]); }
        else if (c0 < C_U) { for (int j = 0; j < 8; ++j) dst[j] = f2bf(acc[j] / (1.f + expf(-acc[j]))); }
        else { for (int j = 0; j < 8; ++j) dst[j] = f2bf(1.f / (1.f + expf(-acc[j]))); }
    } else if (mode == 2) {
        for (int j = 0; j < 8; ++j) E.TMP[(size_t)m * DM + c0 + j] = bf2f(E.PROJ[(size_t)m * NPROJ + C_GA + c0 + j]) * acc[j];
    } else if (mode == 3) {
        for (int j = 0; j < 8; ++j) E.MIXED[(size_t)m * DM + c0 + j] = f2bf(E.TMP[(size_t)m * DM + c0 + j] + bf2f(E.PROJ[(size_t)m * NPROJ + C_GB + c0 + j]) * acc[j]);
    } else if (mode == 4) {
        if (m < MX) { for (int j = 0; j < 8; ++j) E.H2[(size_t)m * DM + c0 + j] = E.x[(size_t)m * DM + c0 + j] + acc[j]; }
        else { for (int j = 0; j < 8; ++j) E.H2M[(size_t)(m - MX) * DM + c0 + j] = E.meta[(size_t)((m - MX) & 15) * DM + c0 + j] + acc[j]; }
    } else if (mode == 5) {
        bf16_t* dst = E.HID + ((size_t)e * ER + m) * FF + (c0 >> 1);
        for (int j = 0; j < 4; ++j) { const float g = acc[j], u = acc[4 + j]; dst[j] = f2bf(g / (1.f + expf(-g)) * u); }
    } else {
        const float gt = m < 2 * CAP ? E.GATEV[((size_t)(m / CAP) * NE + e) * CAP + (m % CAP)] : 0.f;
        bf16_t* dst = E.YE + ((size_t)e * ER + m) * DM + c0;
        for (int j = 0; j < 8; ++j) dst[j] = f2bf(gt * acc[j]);
    }
}

__global__ void __launch_bounds__(256) k_gemm(const bf16_t* __restrict__ A, const bf16_t* __restrict__ Bt, int M, int N, int K, size_t a_bstride, size_t b_bstride, int mode, EpiArgs E) {
    __shared__ float As[32][128 + 4];
    __shared__ float Bs[32][64 + 4];
    const int tid = threadIdx.x, e = blockIdx.z;
    const int m0 = blockIdx.y * 128, n0 = blockIdx.x * 64;
    A += (size_t)e * a_bstride; Bt += (size_t)e * b_bstride;
    const int ty = tid >> 3, tx = tid & 7;
    float acc[4][8];
    for (int i = 0; i < 4; ++i) for (int j = 0; j < 8; ++j) acc[i][j] = 0.f;
    const int ar = tid >> 1, ak = (tid & 1) * 16;
    const int br = tid >> 2, bk = (tid & 3) * 8;
    for (int k0 = 0; k0 < K; k0 += 32) {
        {
            const int m = m0 + ar;
            if (m < M) { const uint4* p = (const uint4*)(A + (size_t)m * K + k0 + ak); const uint4 v0 = p[0], v1 = p[1];
                const unsigned w[8] = {v0.x, v0.y, v0.z, v0.w, v1.x, v1.y, v1.z, v1.w};
                for (int q = 0; q < 8; ++q) { As[ak + 2 * q][ar] = __uint_as_float(w[q] << 16); As[ak + 2 * q + 1][ar] = __uint_as_float(w[q] & 0xffff0000u); } }
            else { for (int q = 0; q < 16; ++q) As[ak + q][ar] = 0.f; }
            const uint4 v = *(const uint4*)(Bt + (size_t)(n0 + br) * K + k0 + bk);
            const unsigned w[4] = {v.x, v.y, v.z, v.w};
            for (int q = 0; q < 4; ++q) { Bs[bk + 2 * q][br] = __uint_as_float(w[q] << 16); Bs[bk + 2 * q + 1][br] = __uint_as_float(w[q] & 0xffff0000u); }
        }
        __syncthreads();
#pragma unroll 8
        for (int k = 0; k < 32; ++k) {
            float a[4], b[8];
            for (int i = 0; i < 4; ++i) a[i] = As[k][ty + 32 * i];
            for (int j = 0; j < 8; ++j) b[j] = Bs[k][tx * 8 + j];
            for (int i = 0; i < 4; ++i) for (int j = 0; j < 8; ++j) acc[i][j] += a[i] * b[j];
        }
        __syncthreads();
    }
    for (int i = 0; i < 4; ++i) { const int m = m0 + ty + 32 * i; if (m < M) epi8(mode, E, e, m, n0 + tx * 8, acc[i]); }
}

__device__ __forceinline__ float log_sigmoid(float x) { return -log1pf(expf(-x)); }
__device__ __forceinline__ int chunk_row(int b, int n, int c) { return n == 0 ? (c >= 112 ? MX + b * 16 + (c - 112) : -1) : b * SEQ + 128 * (n - 1) + c; }

__global__ void __launch_bounds__(256) k_ret_state(const bf16_t* __restrict__ PROJ, const float* __restrict__ dec_f, const float* __restrict__ dec_b, bf16_t* __restrict__ S) {
    __shared__ bf16_t Ks[128][128];
    __shared__ float Vs[128][32];
    const int sl = blockIdx.x, bh = blockIdx.y, dir = blockIdx.z, b = bh >> 2, h = bh & 3, tid = threadIdx.x;
    const float lg = log_sigmoid(dir == 0 ? dec_f[h] : dec_b[h]);
    const float dec = expf(lg * 128.f);
    const int dk = tid & 127, hf = tid >> 7;
    float st[16]; for (int j = 0; j < 16; ++j) st[j] = 0.f;
    for (int step = 0; step < NCH; ++step) {
        const int n = dir == 0 ? step : NCH - 1 - step;
        bf16_t* dst = S + ((((size_t)dir * 8 + bh) * NCH + n) * 128 + dk) * 256 + sl * 32 + hf * 16;
        for (int j = 0; j < 16; ++j) dst[j] = f2bf(st[j]);
        __syncthreads();
        for (int i = tid; i < 128 * 128; i += 256) { const int c = i >> 7, d = i & 127; const int r = chunk_row(b, n, c); Ks[c][d] = r < 0 ? (bf16_t)0 : PROJ[(size_t)r * NPROJ + C_K + h * 128 + d]; }
        for (int i = tid; i < 128 * 32; i += 256) { const int c = i >> 5, d = i & 31; const int r = chunk_row(b, n, c);
            const float w = dir == 0 ? expf(lg * (float)(127 - c)) : expf(lg * (float)c);
            Vs[c][d] = r < 0 ? 0.f : bf2f(PROJ[(size_t)r * NPROJ + C_V + h * 256 + sl * 32 + d]) * w; }
        __syncthreads();
        float a[16]; for (int j = 0; j < 16; ++j) a[j] = 0.f;
        for (int c = 0; c < 128; ++c) { const float kv = bf2f(Ks[c][dk]); for (int j = 0; j < 16; ++j) a[j] += kv * Vs[c][hf * 16 + j]; }
        for (int j = 0; j < 16; ++j) st[j] = st[j] * dec + a[j];
    }
}

constexpr int QS_STRIDE = 130;
constexpr int R2_LDS = 2 * 128 * QS_STRIDE * 2 + 128 * 128 * 4 + 64 * 4;
__global__ void __launch_bounds__(256) k_ret_out(const bf16_t* __restrict__ PROJ, const bf16_t* __restrict__ S, const float* __restrict__ dec_f, const float* __restrict__ dec_b,
                                                const float* __restrict__ hg, bf16_t* __restrict__ ARET) {
    extern __shared__ __attribute__((aligned(16))) unsigned char smem[];
    bf16_t* Qs = (bf16_t*)smem; bf16_t* Ks = Qs + 128 * QS_STRIDE; float* SC = (float*)(Ks + 128 * QS_STRIDE); float* red = SC + 128 * 128;
    const int n = blockIdx.x, bh = blockIdx.y, b = bh >> 2, h = bh & 3, tid = threadIdx.x;
    const float lf = log_sigmoid(dec_f[h]), lb = log_sigmoid(dec_b[h]);
    for (int i = tid; i < 128 * 128; i += 256) { const int c = i >> 7, d = i & 127; const int r = chunk_row(b, n, c);
        Qs[c * QS_STRIDE + d] = r < 0 ? (bf16_t)0 : PROJ[(size_t)r * NPROJ + C_Q + h * 128 + d];
        Ks[c * QS_STRIDE + d] = r < 0 ? (bf16_t)0 : PROJ[(size_t)r * NPROJ + C_K + h * 128 + d]; }
    __syncthreads();
    {
        const int j = tid & 127, ib = (tid >> 7) * 64;
        for (int i = ib; i < ib + 64; ++i) {
            float s = 0.f;
            for (int d = 0; d < 128; ++d) s += bf2f(Qs[i * QS_STRIDE + d]) * bf2f(Ks[j * QS_STRIDE + d]);
            const float mk = i >= j ? expf(lf * (float)(i - j)) : expf(lb * (float)(j - i));
            SC[i * 128 + j] = s * mk;
        }
    }
    __syncthreads();
    const int dv = tid;
    const bf16_t* Sf = S + (((size_t)0 * 8 + bh) * NCH + n) * 128 * 256;
    const bf16_t* Sb = S + (((size_t)1 * 8 + bh) * NCH + n) * 128 * 256;
    for (int grp = (n == 0 ? 7 : 0); grp < 8; ++grp) {
        float acc[16]; for (int i = 0; i < 16; ++i) acc[i] = 0.f;
        for (int j = 0; j < 128; ++j) { const int r = chunk_row(b, n, j); if (r < 0) continue; const float v = bf2f(PROJ[(size_t)r * NPROJ + C_V + h * 256 + dv]);
            for (int i = 0; i < 16; ++i) acc[i] += SC[(grp * 16 + i) * 128 + j] * v; }
        float qf[16], qb[16];
        for (int i = 0; i < 16; ++i) { const int ii = grp * 16 + i; qf[i] = expf(lf * (float)(ii + 1)); qb[i] = expf(lb * (float)(128 - ii)); }
        for (int d = 0; d < 128; ++d) { const float sf = bf2f(Sf[(size_t)d * 256 + dv]), sb = bf2f(Sb[(size_t)d * 256 + dv]);
            for (int i = 0; i < 16; ++i) { const float q = bf2f(Qs[(grp * 16 + i) * QS_STRIDE + d]); acc[i] += q * (qf[i] * sf + qb[i] * sb); } }
        float ss[16];
        for (int i = 0; i < 16; ++i) { float v = acc[i] * acc[i]; for (int o = 32; o > 0; o >>= 1) v += __shfl_xor(v, o); ss[i] = v; }
        __syncthreads();
        if ((tid & 63) == 0) for (int i = 0; i < 16; ++i) red[(tid >> 6) * 16 + i] = ss[i];
        __syncthreads();
        for (int i = 0; i < 16; ++i) {
            const float ms = (red[i] + red[16 + i] + red[32 + i] + red[48 + i]) * (1.f / 256.f);
            const int r = chunk_row(b, n, grp * 16 + i);
            if (r < 0) continue;
            const float y = acc[i] * rsqrtf(ms + RMS_EPS) * hg[h * 256 + dv];
            ARET[(size_t)r * DM + h * 256 + dv] = f2bf(y * bf2f(PROJ[(size_t)r * NPROJ + C_G + h * 256 + dv]));
        }
    }
}

__device__ __forceinline__ float conv3(const bf16_t* __restrict__ PROJ, const float* __restrict__ cw, const float* __restrict__ cb, int b, int t, int ch) {
    float a = cb[ch];
    for (int j = 0; j < 3; ++j) { const int tt = t + j - 1; if (tt >= 0 && tt < TT) a += bf2f(PROJ[(size_t)row_of(b, tt) * NPROJ + C_U + ch]) * cw[j * 3072 + ch]; }
    return a;
}
__global__ void k_hy_prep(const bf16_t* __restrict__ PROJ, const float* __restrict__ cw, const float* __restrict__ cb, bf16_t* __restrict__ ZT) {
    const int c = blockIdx.x * 256 + threadIdx.x, t = blockIdx.y, b = blockIdx.z;
    bf16_t v = 0;
    if (t < TT) { const float x1 = conv3(PROJ, cw, cb, b, t, 1024 + c), vh = conv3(PROJ, cw, cb, b, t, 2048 + c); v = f2bf(x1 * vh); }
    ZT[((size_t)b * 1024 + c) * ZL + t] = v;
}
__global__ void __launch_bounds__(256) k_hy_conv(const bf16_t* __restrict__ G, const bf16_t* __restrict__ ZT, bf16_t* __restrict__ YCT) {
    __shared__ float zs[2][1024];
    __shared__ float gs[3072 + 8];
    const int tile = blockIdx.x, c = blockIdx.y, tid = threadIdx.x;
    const int tb = tile * 2048, t0 = tb + tid * 8;
    float acc0[8], acc1[8];
    for (int j = 0; j < 8; ++j) { acc0[j] = 0.f; acc1[j] = 0.f; }
    const bf16_t* g = G + (size_t)c * GL;
    for (int s0 = 0; s0 < TT; s0 += 1024) {
        __syncthreads();
        for (int i = tid; i < 2048; i += 256) { const int bb = i >> 10, s = s0 + (i & 1023); zs[bb][i & 1023] = s < TT ? bf2f(ZT[((size_t)bb * 1024 + c) * ZL + s]) : 0.f; }
        const int dlo = tb - s0 - 1023;
        for (int i = tid; i < 3072; i += 256) { const int idx = TT + dlo + i; gs[i] = (idx >= 0 && idx < GL) ? bf2f(g[idx]) : 0.f; }
        __syncthreads();
        const int base = tid * 8 + 1023;
        for (int u = 0; u < 1024; ++u) {
            const float z0 = zs[0][u], z1 = zs[1][u];
#pragma unroll
            for (int j = 0; j < 8; ++j) { const float gv = gs[base + j - u]; acc0[j] += gv * z0; acc1[j] += gv * z1; }
        }
    }
    for (int j = 0; j < 8; ++j) { const int t = t0 + j; if (t < ZL) { YCT[((size_t)0 * 1024 + c) * ZL + t] = f2bf(acc0[j]); YCT[((size_t)1 * 1024 + c) * ZL + t] = f2bf(acc1[j]); } }
}
__global__ void k_hy_post(const bf16_t* __restrict__ PROJ, const float* __restrict__ cw, const float* __restrict__ cb, const float* __restrict__ skip, const bf16_t* __restrict__ YCT, bf16_t* __restrict__ AHY) {
    const int c = blockIdx.x * 256 + threadIdx.x, m = blockIdx.y;
    int b, t; bt_of(m, b, t);
    const float x0 = conv3(PROJ, cw, cb, b, t, c), x1 = conv3(PROJ, cw, cb, b, t, 1024 + c), vh = conv3(PROJ, cw, cb, b, t, 2048 + c);
    const float z = x1 * vh;
    const float yc = bf2f(YCT[((size_t)b * 1024 + c) * ZL + t]);
    AHY[(size_t)m * DM + c] = f2bf(x0 * (yc + z * skip[c]));
}

__global__ void k_norm2_router(const float* __restrict__ H2, const float* __restrict__ H2M, const float* __restrict__ g2, const float* __restrict__ wr, bf16_t* __restrict__ XN2, float* __restrict__ AFF) {
    __shared__ float red[4]; __shared__ float lred[4][16];
    const int m = blockIdx.x, tid = threadIdx.x;
    const float* src = m < MX ? H2 + (size_t)m * DM : H2M + (size_t)(m - MX) * DM;
    float v[4]; float s = 0.f;
    for (int i = 0; i < 4; ++i) { v[i] = src[tid + 256 * i]; s += v[i] * v[i]; }
    s = block_sum256(s, red);
    const float r = rsqrtf(s * (1.f / DM) + RMS_EPS);
    float lg[16]; for (int e = 0; e < 16; ++e) lg[e] = 0.f;
    for (int i = 0; i < 4; ++i) { const int k = tid + 256 * i; const float xn = v[i] * r * g2[k]; XN2[(size_t)m * DM + k] = f2bf(xn);
        for (int e = 0; e < 16; ++e) lg[e] += xn * wr[k * 16 + e]; }
    for (int e = 0; e < 16; ++e) { float q = lg[e]; for (int o = 32; o > 0; o >>= 1) q += __shfl_xor(q, o); lg[e] = q; }
    if ((tid & 63) == 0) for (int e = 0; e < 16; ++e) lred[tid >> 6][e] = lg[e];
    __syncthreads();
    if (tid == 0) {
        float l[16], mx = -1e30f;
        for (int e = 0; e < 16; ++e) { l[e] = lred[0][e] + lred[1][e] + lred[2][e] + lred[3][e]; mx = fmaxf(mx, l[e]); }
        float sum = 0.f; for (int e = 0; e < 16; ++e) { l[e] = expf(l[e] - mx); sum += l[e]; }
        int b, t; bt_of(m, b, t);
        for (int e = 0; e < 16; ++e) AFF[((size_t)b * NE + e) * TT + t] = l[e] / sum;
    }
}
__global__ void k_topk(const float* __restrict__ AFF, int* __restrict__ IDX, float* __restrict__ GATEV, int* __restrict__ INV) {
    __shared__ float a[TT];
    const int be = blockIdx.y, t = blockIdx.x * 256 + threadIdx.x;
    for (int i = threadIdx.x; i < TT; i += 256) a[i] = AFF[(size_t)be * TT + i];
    __syncthreads();
    if (t >= TT) return;
    const float v = a[t]; int rank = 0;
    for (int i = 0; i < TT; ++i) { const float w = a[i]; rank += (w > v || (w == v && i < t)) ? 1 : 0; }
    if (rank < CAP) { IDX[(size_t)be * CAP + rank] = t; GATEV[(size_t)be * CAP + rank] = v; INV[(size_t)be * TT + t] = rank; }
    else INV[(size_t)be * TT + t] = -1;
}
__global__ void k_gather(const bf16_t* __restrict__ XN2, const int* __restrict__ IDX, bf16_t* __restrict__ XE) {
    const int r = blockIdx.x, e = blockIdx.y;
    uint4 v = make_uint4(0, 0, 0, 0);
    if (r < 2 * CAP) { const int b = r / CAP, slot = r % CAP; const int t = IDX[((size_t)b * NE + e) * CAP + slot]; v = *(const uint4*)(XN2 + (size_t)row_of(b, t) * DM + threadIdx.x * 8); }
    *(uint4*)(XE + ((size_t)e * ER + r) * DM + threadIdx.x * 8) = v;
}
__global__ void k_final(float* __restrict__ OUT, const bf16_t* __restrict__ YE, const int* __restrict__ INV, const float* __restrict__ gfin) {
    __shared__ float red[4];
    const int m = blockIdx.x, tid = threadIdx.x, b = m >> 13, t = (m & 8191) + NMETA;
    float v[4]; for (int i = 0; i < 4; ++i) v[i] = OUT[(size_t)m * DM + tid + 256 * i];
    for (int e = 0; e < NE; ++e) { const int slot = INV[((size_t)b * NE + e) * TT + t]; if (slot >= 0) { const bf16_t* y = YE + ((size_t)e * ER + b * CAP + slot) * DM; for (int i = 0; i < 4; ++i) v[i] += bf2f(y[tid + 256 * i]); } }
    float s = 0.f; for (int i = 0; i < 4; ++i) s += v[i] * v[i];
    s = block_sum256(s, red);
    const float r = rsqrtf(s * (1.f / DM) + RMS_EPS);
    for (int i = 0; i < 4; ++i) OUT[(size_t)m * DM + tid + 256 * i] = v[i] * r * gfin[tid + 256 * i];
}

extern "C" void kernel_launch(void* const* d_in, const int* in_sizes, int n_in, void* d_out, int out_size, void* d_ws, size_t ws_size, hipStream_t stream) {
    if (n_in != 27 || ws_size < WS_END || out_size != MX * DM) { fprintf(stderr, "kernel_launch: unexpected sizes n_in %d ws %zu out %d\n", n_in, ws_size, out_size); return; }
    const float* x = (const float*)d_in[0]; const float* meta = (const float*)d_in[1]; const float* norm1_g = (const float*)d_in[2]; const float* w_in = (const float*)d_in[3];
    const float* dec_f = (const float*)d_in[4]; const float* dec_b = (const float*)d_in[5]; const float* hg = (const float*)d_in[6]; const float* w_ret = (const float*)d_in[7];
    const float* cw = (const float*)d_in[8]; const float* cb = (const float*)d_in[9];
    const float* fw1 = (const float*)d_in[10]; const float* fb1 = (const float*)d_in[11]; const float* fw2 = (const float*)d_in[12]; const float* fb2 = (const float*)d_in[13];
    const float* fw3 = (const float*)d_in[14]; const float* fb3 = (const float*)d_in[15]; const float* ffq = (const float*)d_in[16]; const float* fw4 = (const float*)d_in[17];
    const float* skip = (const float*)d_in[18]; const float* w_hy = (const float*)d_in[19]; const float* w_o = (const float*)d_in[20]; const float* norm2_g = (const float*)d_in[21];
    const float* w_router = (const float*)d_in[22]; const float* w_eg = (const float*)d_in[23]; const float* w_eu = (const float*)d_in[24]; const float* w_ed = (const float*)d_in[25];
    const float* gfin = (const float*)d_in[26];
    unsigned char* ws = (unsigned char*)d_ws; unsigned char* dob = (unsigned char*)d_out;
    bf16_t* WRET = (bf16_t*)(ws + WS_WRET); bf16_t* WHY = (bf16_t*)(ws + WS_WHY); bf16_t* WO = (bf16_t*)(ws + WS_WO);
    bf16_t* XN = (bf16_t*)(ws + WS_XN); bf16_t* PROJ = (bf16_t*)(ws + WS_PROJ); bf16_t* S = (bf16_t*)(ws + WS_S); float* TMP = (float*)(ws + WS_S);
    bf16_t* ZT = (bf16_t*)(ws + WS_ZT); bf16_t* G = (bf16_t*)(ws + WS_G); bf16_t* AHY = (bf16_t*)(ws + WS_G); bf16_t* ARET = (bf16_t*)(ws + WS_ARET);
    bf16_t* WGU = (bf16_t*)(ws + WS_WGU); bf16_t* WD = (bf16_t*)(ws + WS_WD); bf16_t* XE = (bf16_t*)(ws + WS_XE); bf16_t* YE = (bf16_t*)(ws + WS_XE); bf16_t* HID = (bf16_t*)(ws + WS_HID);
    bf16_t* WIN = (bf16_t*)(dob + DO_WIN); float* ROPE = (float*)(dob + DO_ROPE); float* HDN = (float*)(dob + DO_HDN); bf16_t* YCT = (bf16_t*)(dob + DO_YCT);
    float* AFF = (float*)(ws + WS_MISC + MI_AFF); int* IDX = (int*)(ws + WS_MISC + MI_IDX); float* GATEV = (float*)(ws + WS_MISC + MI_GATE); int* INV = (int*)(ws + WS_MISC + MI_INV);
    float* H2M = (float*)(ws + WS_MISC + MI_H2M); float* H2 = (float*)d_out;

    k_wconv<<<dim3(32, 256, 1), dim3(32, 8), 0, stream>>>(w_in, nullptr, 1024, 8192, 8192, WIN, 1, 0, 0);
    k_wconv<<<dim3(32, 32, 1), dim3(32, 8), 0, stream>>>(w_ret, nullptr, 1024, 1024, 1024, WRET, 0, 0, 0);
    k_wconv<<<dim3(32, 32, 1), dim3(32, 8), 0, stream>>>(w_hy, nullptr, 1024, 1024, 1024, WHY, 0, 0, 0);
    k_wconv<<<dim3(32, 32, 1), dim3(32, 8), 0, stream>>>(w_o, nullptr, 1024, 1024, 1024, WO, 0, 0, 0);
    k_xn1<<<MROWS, 256, 0, stream>>>(x, meta, norm1_g, XN);
    k_rope<<<TT, 64, 0, stream>>>(ROPE);
    k_filt_hidden<<<TT, 64, 0, stream>>>(fw1, fb1, fw2, fb2, fw3, fb3, ffq, HDN);
    k_filt_out<<<dim3(4, TT), 256, 0, stream>>>(HDN, fw4, G);
    EpiArgs E{}; E.PROJ = PROJ; E.ROPE = ROPE; E.TMP = TMP; E.MIXED = XN; E.x = x; E.meta = meta; E.H2 = H2; E.H2M = H2M; E.HID = HID; E.YE = YE; E.GATEV = GATEV;
    k_gemm<<<dim3(NPROJ / 64, (MROWS + 127) / 128, 1), 256, 0, stream>>>(XN, WIN, MROWS, NPROJ, 1024, 0, 0, 1, E);
    k_ret_state<<<dim3(8, 8, 2), 256, 0, stream>>>(PROJ, dec_f, dec_b, S);
    k_hy_prep<<<dim3(4, ZL, 2), 256, 0, stream>>>(PROJ, cw, cb, ZT);
    k_hy_conv<<<dim3(5, 1024), 256, 0, stream>>>(G, ZT, YCT);
    hipFuncSetAttribute((const void*)k_ret_out, hipFuncAttributeMaxDynamicSharedMemorySize, R2_LDS);
    k_ret_out<<<dim3(NCH, 8), 256, R2_LDS, stream>>>(PROJ, S, dec_f, dec_b, hg, ARET);
    k_hy_post<<<dim3(4, MROWS), 256, 0, stream>>>(PROJ, cw, cb, skip, YCT, AHY);
    k_gemm<<<dim3(DM / 64, (MROWS + 127) / 128, 1), 256, 0, stream>>>(ARET, WRET, MROWS, DM, 1024, 0, 0, 2, E);
    k_gemm<<<dim3(DM / 64, (MROWS + 127) / 128, 1), 256, 0, stream>>>(AHY, WHY, MROWS, DM, 1024, 0, 0, 3, E);
    k_gemm<<<dim3(DM / 64, (MROWS + 127) / 128, 1), 256, 0, stream>>>(XN, WO, MROWS, DM, 1024, 0, 0, 4, E);
    k_norm2_router<<<MROWS, 256, 0, stream>>>(H2, H2M, norm2_g, w_router, XN, AFF);
    k_wconv<<<dim3(32, 128, NE), dim3(32, 8), 0, stream>>>(w_eg, w_eu, 1024, 2048, 4096, WGU, 2, (size_t)1024 * 2048, (size_t)4096 * 1024);
    k_wconv<<<dim3(64, 32, NE), dim3(32, 8), 0, stream>>>(w_ed, nullptr, 2048, 1024, 1024, WD, 0, (size_t)2048 * 1024, (size_t)1024 * 2048);
    k_topk<<<dim3(33, 32), 256, 0, stream>>>(AFF, IDX, GATEV, INV);
    k_gather<<<dim3(ER, NE), 128, 0, stream>>>(XN, IDX, XE);
    k_gemm<<<dim3(4096 / 64, ER / 128, NE), 256, 0, stream>>>(XE, WGU, ER, 4096, 1024, (size_t)ER * 1024, (size_t)4096 * 1024, 5, E);
    k_gemm<<<dim3(DM / 64, ER / 128, NE), 256, 0, stream>>>(HID, WD, ER, DM, 2048, (size_t)ER * 2048, (size_t)1024 * 2048, 6, E);
    k_final<<<MX, 256, 0, stream>>>(H2, YE, INV, gfin);
}
```

```cpp
#include <hip/hip_runtime.h>
#include <stdint.h>
#include <cstdio>
#include <hip/hip_cooperative_groups.h>
namespace cg = cooperative_groups;

typedef unsigned short bf16_t;
__device__ __forceinline__ float bf2f(bf16_t v) { return __uint_as_float(((unsigned)v) << 16); }
__device__ __forceinline__ bf16_t f2bf(float f) { unsigned u = __float_as_uint(f); u += 0x7fffu + ((u >> 16) & 1u); return (bf16_t)(u >> 16); }

constexpr int NB = 2, SEQ = 8192, DM = 1024, NMETA = 16, TT = 8208;
constexpr int MX = 16384, MROWS = 16416, MP = 16640;
constexpr int NPROJ = 8192;
constexpr int C_Q = 0, C_K = 512, C_V = 1024, C_G = 2048, C_U = 3072, C_GA = 6144, C_GB = 7168;
constexpr int NE = 16, CAP = 1026, ER = 2304, FF = 2048;
constexpr int NCH = 65;
constexpr int GL = 16640;
constexpr int ZL = 8320;
constexpr float RMS_EPS = 1e-6f;

constexpr size_t MiB = 1u << 20;
constexpr size_t WS_CTL = 0;
constexpr size_t WS_WRET = 1 * MiB, WS_WHY = 3 * MiB, WS_WO = 5 * MiB;
constexpr size_t WS_MISC = 7 * MiB;
constexpr size_t WS_XN = 12 * MiB;
constexpr size_t WS_PROJ = 48 * MiB;
constexpr size_t WS_S = 308 * MiB;
constexpr size_t WS_ZT = 374 * MiB;
constexpr size_t WS_G = 407 * MiB;
constexpr size_t WS_ARET = 440 * MiB;
constexpr size_t WS_WGU = 48 * MiB;
constexpr size_t WS_WD = 176 * MiB;
constexpr size_t WS_XE = 240 * MiB;
constexpr size_t WS_HID = 312 * MiB;
constexpr size_t WS_END = 456 * MiB;
constexpr size_t DO_WIN = 0;
constexpr size_t DO_ROPE = 16 * MiB;
constexpr size_t DO_HDN = 22 * MiB;
constexpr size_t DO_YCT = 0;
constexpr size_t MI_AFF = 0;
constexpr size_t MI_IDX = 1 * MiB + 64 * 1024;
constexpr size_t MI_GATE = 1 * MiB + 256 * 1024;
constexpr size_t MI_INV = 2 * MiB;
constexpr size_t MI_H2M = 3 * MiB + 256 * 1024;

__device__ __forceinline__ int row_of(int b, int t) { return t < NMETA ? MX + b * NMETA + t : b * SEQ + (t - NMETA); }
__device__ __forceinline__ void bt_of(int m, int& b, int& t) { if (m < MX) { b = m >> 13; t = (m & 8191) + NMETA; } else { b = (m - MX) >> 4; t = (m - MX) & 15; } }

__device__ __forceinline__ void b_wconv(const dim3 bid, unsigned char* sm, const float* __restrict__ W0, const float* __restrict__ W1, int K, int N, int Nd, bf16_t* __restrict__ WT, int mode, size_t src_bstride, size_t dst_bstride) {
    float (*tile)[33] = (float (*)[33])sm;
    const int tx = threadIdx.x & 31, ty = threadIdx.x >> 5;
    const int k0 = bid.x * 32, r0 = bid.y * 32, e = bid.z;
    const int r = r0 + tx;
    const float* src = W0 + (size_t)e * src_bstride; int col = r;
    if (mode == 1) { if (r < 1024) { const int sec = r >> 7, rl = r & 127, g = rl >> 3, j = rl & 7; col = sec * 128 + (j < 4 ? 4 * g + j : 64 + 4 * g + (j - 4)); } }
    else if (mode == 2) { const int g = r >> 3, j = r & 7; if (j < 4) { col = 4 * g + j; } else { col = 4 * g + j - 4; src = W1 + (size_t)e * src_bstride; } }
    for (int i = 0; i < 4; ++i) { const int k = k0 + ty + 8 * i; tile[ty + 8 * i][tx] = src[(size_t)k * N + col]; }
    __syncthreads();
    bf16_t* dst = WT + (size_t)e * dst_bstride;
    for (int i = 0; i < 4; ++i) { const int rr = r0 + ty + 8 * i; dst[(size_t)rr * K + k0 + tx] = f2bf(tile[tx][ty + 8 * i]); }
}

__device__ __forceinline__ float block_sum256(float v, float* red) {
    for (int o = 32; o > 0; o >>= 1) v += __shfl_xor(v, o);
    const int w = threadIdx.x >> 6;
    __syncthreads();
    if ((threadIdx.x & 63) == 0) red[w] = v;
    __syncthreads();
    return red[0] + red[1] + red[2] + red[3];
}

__device__ __forceinline__ void b_xn1(const dim3 bid, unsigned char* sm, const float* __restrict__ x, const float* __restrict__ meta, const float* __restrict__ g, bf16_t* __restrict__ XN) {
    float* red = (float*)sm;
    const int m = bid.x;
    const float* src = m < MX ? x + (size_t)m * DM : meta + (size_t)((m - MX) & 15) * DM;
    float v[4]; float s = 0.f;
    for (int i = 0; i < 4; ++i) { v[i] = src[threadIdx.x + 256 * i]; s += v[i] * v[i]; }
    s = block_sum256(s, red);
    const float r = rsqrtf(s * (1.f / DM) + RMS_EPS);
    for (int i = 0; i < 4; ++i) XN[(size_t)m * DM + threadIdx.x + 256 * i] = f2bf(v[i] * r * g[threadIdx.x + 256 * i]);
}

__device__ __forceinline__ void b_rope(const dim3 bid, float* __restrict__ ROPE) {
    const int t = bid.x * 4 + (threadIdx.x >> 6), i = threadIdx.x & 63;
    const float inv = powf(10000.0f, -(float)i / 64.0f);
    const float ang = (float)t * inv;
    ROPE[(size_t)t * 128 + i] = cosf(ang);
    ROPE[(size_t)t * 128 + 64 + i] = sinf(ang);
}

__device__ __forceinline__ void b_filt_hidden(const dim3 bid, unsigned char* sm, const float* __restrict__ w1, const float* __restrict__ b1, const float* __restrict__ w2, const float* __restrict__ b2,
                              const float* __restrict__ w3, const float* __restrict__ b3, const float* __restrict__ fq, float* __restrict__ HDN) {
    const int q = threadIdx.x >> 6;
    float* feat = (float*)sm + q * 192; float* ha = feat + 64; float* hb = feat + 128;
    const int t = bid.x * 4 + q, j = threadIdx.x & 63;
    if (j == 0) feat[0] = (float)t / (float)(TT - 1);
    if (j < 16) {
        const float fr = 1e-4f + (float)j * ((15.0f - 1e-4f) / 15.0f);
        const float ang = (2.0f * 3.14159265358979323846f * (float)t / (float)TT) * fr;
        feat[1 + j] = cosf(ang); feat[17 + j] = -sinf(ang);
    }
    __syncthreads();
    const float f = fq[j];
    float a = b1[j];
    for (int i = 0; i < 33; ++i) a += feat[i] * w1[i * 64 + j];
    ha[j] = sinf(f * a);
    __syncthreads();
    a = b2[j];
    for (int i = 0; i < 64; ++i) a += ha[i] * w2[i * 64 + j];
    hb[j] = sinf(f * a);
    __syncthreads();
    a = b3[j];
    for (int i = 0; i < 64; ++i) a += hb[i] * w3[i * 64 + j];
    HDN[(size_t)t * 64 + j] = sinf(f * a);
}

__device__ __forceinline__ void b_filt_out(const dim3 bid, unsigned char* sm, const float* __restrict__ HDN, const float* __restrict__ w4, bf16_t* __restrict__ G) {
    const int c = bid.x * 256 + threadIdx.x, t = bid.y;
    float* h = (float*)sm;
    if (threadIdx.x < 64) h[threadIdx.x] = HDN[(size_t)t * 64 + threadIdx.x];
    __syncthreads();
    float ff = 0.f, fb = 0.f;
    for (int j = 0; j < 64; ++j) { ff += h[j] * w4[j * 2048 + c]; fb += h[j] * w4[j * 2048 + 1024 + c]; }
    const float mind = logf(1e-2f) / 1.5f, maxd = logf(1e-2f) / 0.3f;
    const float delta = mind + (float)c * ((maxd - mind) / 1023.0f);
    const float tn = (float)t / (float)(TT - 1);
    const float win = expf(-tn * fabsf(delta));
    G[(size_t)c * GL + TT + t] = f2bf(ff * win);
    if (t >= 1) G[(size_t)c * GL + TT - t] = f2bf(fb * win);
    if (t == 0) { G[(size_t)c * GL] = 0; for (int i = 2 * TT; i < GL; ++i) G[(size_t)c * GL + i] = 0; }
}

struct EpiArgs {
    bf16_t* PROJ; const float* ROPE;
    float* TMP; bf16_t* MIXED;
    const float* x; const float* meta; float* H2; float* H2M;
    bf16_t* HID; bf16_t* YE; const float* GATEV;
};
__device__ __forceinline__ void epi8(int mode, const EpiArgs& E, int e, int m, int c0, const float* acc) {
    if (mode == 1) {
        bf16_t* dst = E.PROJ + (size_t)m * NPROJ + c0;
        if (c0 < C_V) {
            int b, t; bt_of(m, b, t);
            const int i0 = ((c0 & 127) >> 3) * 4;
            const float sc = c0 >= C_K ? 0.08838834764831845f : 1.0f;
            for (int j = 0; j < 4; ++j) {
                const float cs = E.ROPE[(size_t)t * 128 + i0 + j], sn = E.ROPE[(size_t)t * 128 + 64 + i0 + j];
                const float x1 = acc[j], x2 = acc[4 + j];
                dst[j] = f2bf((x1 * cs - x2 * sn) * sc); dst[4 + j] = f2bf((x1 * sn + x2 * cs) * sc);
            }
        } else if (c0 < C_G || (c0 >= C_U && c0 < C_GA)) { for (int j = 0; j < 8; ++j) dst[j] = f2bf(acc[j]); }
        else if (c0 < C_U) { for (int j = 0; j < 8; ++j) dst[j] = f2bf(acc[j] / (1.f + expf(-acc[j]))); }
        else { for (int j = 0; j < 8; ++j) dst[j] = f2bf(1.f / (1.f + expf(-acc[j]))); }
    } else if (mode == 2) {
        for (int j = 0; j < 8; ++j) E.TMP[(size_t)m * DM + c0 + j] = bf2f(E.PROJ[(size_t)m * NPROJ + C_GA + c0 + j]) * acc[j];
    } else if (mode == 3) {
        for (int j = 0; j < 8; ++j) E.MIXED[(size_t)m * DM + c0 + j] = f2bf(E.TMP[(size_t)m * DM + c0 + j] + bf2f(E.PROJ[(size_t)m * NPROJ + C_GB + c0 + j]) * acc[j]);
    } else if (mode == 4) {
        if (m < MX) { for (int j = 0; j < 8; ++j) E.H2[(size_t)m * DM + c0 + j] = E.x[(size_t)m * DM + c0 + j] + acc[j]; }
        else { for (int j = 0; j < 8; ++j) E.H2M[(size_t)(m - MX) * DM + c0 + j] = E.meta[(size_t)((m - MX) & 15) * DM + c0 + j] + acc[j]; }
    } else if (mode == 5) {
        bf16_t* dst = E.HID + ((size_t)e * ER + m) * FF + (c0 >> 1);
        for (int j = 0; j < 4; ++j) { const float g = acc[j], u = acc[4 + j]; dst[j] = f2bf(g / (1.f + expf(-g)) * u); }
    } else {
        const float gt = m < 2 * CAP ? E.GATEV[((size_t)(m / CAP) * NE + e) * CAP + (m % CAP)] : 0.f;
        bf16_t* dst = E.YE + ((size_t)e * ER + m) * DM + c0;
        for (int j = 0; j < 8; ++j) dst[j] = f2bf(gt * acc[j]);
    }
}

__device__ __forceinline__ void b_gemm(const dim3 bid, unsigned char* sm, const bf16_t* __restrict__ A, const bf16_t* __restrict__ Bt, int M, int N, int K, size_t a_bstride, size_t b_bstride, int mode, const EpiArgs& E) {
    float (*As)[132] = (float (*)[132])sm;
    float (*Bs)[68] = (float (*)[68])(sm + 32 * 132 * 4);
    const int tid = threadIdx.x, e = bid.z;
    const int m0 = bid.y * 128, n0 = bid.x * 64;
    A += (size_t)e * a_bstride; Bt += (size_t)e * b_bstride;
    const int ty = tid >> 3, tx = tid & 7;
    float acc[4][8];
    for (int i = 0; i < 4; ++i) for (int j = 0; j < 8; ++j) acc[i][j] = 0.f;
    const int ar = tid >> 1, ak = (tid & 1) * 16;
    const int br = tid >> 2, bk = (tid & 3) * 8;
    for (int k0 = 0; k0 < K; k0 += 32) {
        {
            const int m = m0 + ar;
            if (m < M) { const uint4* p = (const uint4*)(A + (size_t)m * K + k0 + ak); const uint4 v0 = p[0], v1 = p[1];
                const unsigned w[8] = {v0.x, v0.y, v0.z, v0.w, v1.x, v1.y, v1.z, v1.w};
                for (int q = 0; q < 8; ++q) { As[ak + 2 * q][ar] = __uint_as_float(w[q] << 16); As[ak + 2 * q + 1][ar] = __uint_as_float(w[q] & 0xffff0000u); } }
            else { for (int q = 0; q < 16; ++q) As[ak + q][ar] = 0.f; }
            const uint4 v = *(const uint4*)(Bt + (size_t)(n0 + br) * K + k0 + bk);
            const unsigned w[4] = {v.x, v.y, v.z, v.w};
            for (int q = 0; q < 4; ++q) { Bs[bk + 2 * q][br] = __uint_as_float(w[q] << 16); Bs[bk + 2 * q + 1][br] = __uint_as_float(w[q] & 0xffff0000u); }
        }
        __syncthreads();
#pragma unroll 8
        for (int k = 0; k < 32; ++k) {
            float a[4], b[8];
            for (int i = 0; i < 4; ++i) a[i] = As[k][ty + 32 * i];
            for (int j = 0; j < 8; ++j) b[j] = Bs[k][tx * 8 + j];
            for (int i = 0; i < 4; ++i) for (int j = 0; j < 8; ++j) acc[i][j] += a[i] * b[j];
        }
        __syncthreads();
    }
    for (int i = 0; i < 4; ++i) { const int m = m0 + ty + 32 * i; if (m < M) epi8(mode, E, e, m, n0 + tx * 8, acc[i]); }
}

__device__ __forceinline__ float log_sigmoid(float x) { return -log1pf(expf(-x)); }
__device__ __forceinline__ int chunk_row(int b, int n, int c) { return n == 0 ? (c >= 112 ? MX + b * 16 + (c - 112) : -1) : b * SEQ + 128 * (n - 1) + c; }

__device__ __forceinline__ void b_ret_state(const dim3 bid, unsigned char* sm, const bf16_t* __restrict__ PROJ, const float* __restrict__ dec_f, const float* __restrict__ dec_b, bf16_t* __restrict__ S) {
    bf16_t (*Ks)[128] = (bf16_t (*)[128])sm;
    float (*Vs)[32] = (float (*)[32])(sm + 128 * 128 * 2);
    const int sl = bid.x, bh = bid.y, dir = bid.z, b = bh >> 2, h = bh & 3, tid = threadIdx.x;
    const float lg = log_sigmoid(dir == 0 ? dec_f[h] : dec_b[h]);
    const float dec = expf(lg * 128.f);
    const int dk = tid & 127, hf = tid >> 7;
    float st[16]; for (int j = 0; j < 16; ++j) st[j] = 0.f;
    for (int step = 0; step < NCH; ++step) {
        const int n = dir == 0 ? step : NCH - 1 - step;
        bf16_t* dst = S + ((((size_t)dir * 8 + bh) * NCH + n) * 128 + dk) * 256 + sl * 32 + hf * 16;
        for (int j = 0; j < 16; ++j) dst[j] = f2bf(st[j]);
        __syncthreads();
        for (int i = tid; i < 128 * 128; i += 256) { const int c = i >> 7, d = i & 127; const int r = chunk_row(b, n, c); Ks[c][d] = r < 0 ? (bf16_t)0 : PROJ[(size_t)r * NPROJ + C_K + h * 128 + d]; }
        for (int i = tid; i < 128 * 32; i += 256) { const int c = i >> 5, d = i & 31; const int r = chunk_row(b, n, c);
            const float w = dir == 0 ? expf(lg * (float)(127 - c)) : expf(lg * (float)c);
            Vs[c][d] = r < 0 ? 0.f : bf2f(PROJ[(size_t)r * NPROJ + C_V + h * 256 + sl * 32 + d]) * w; }
        __syncthreads();
        float a[16]; for (int j = 0; j < 16; ++j) a[j] = 0.f;
        for (int c = 0; c < 128; ++c) { const float kv = bf2f(Ks[c][dk]); for (int j = 0; j < 16; ++j) a[j] += kv * Vs[c][hf * 16 + j]; }
        for (int j = 0; j < 16; ++j) st[j] = st[j] * dec + a[j];
    }
}

constexpr int QS_STRIDE = 130;
constexpr int R2_LDS = 2 * 128 * QS_STRIDE * 2 + 128 * 128 * 4 + 64 * 4;
__device__ __forceinline__ void b_ret_out(const dim3 bid, unsigned char* smem, const bf16_t* __restrict__ PROJ, const bf16_t* __restrict__ S, const float* __restrict__ dec_f, const float* __restrict__ dec_b,
                                                const float* __restrict__ hg, bf16_t* __restrict__ ARET) {
    bf16_t* Qs = (bf16_t*)smem; bf16_t* Ks = Qs + 128 * QS_STRIDE; float* SC = (float*)(Ks + 128 * QS_STRIDE); float* red = SC + 128 * 128;
    const int n = bid.x, bh = bid.y, b = bh >> 2, h = bh & 3, tid = threadIdx.x;
    const float lf = log_sigmoid(dec_f[h]), lb = log_sigmoid(dec_b[h]);
    for (int i = tid; i < 128 * 128; i += 256) { const int c = i >> 7, d = i & 127; const int r = chunk_row(b, n, c);
        Qs[c * QS_STRIDE + d] = r < 0 ? (bf16_t)0 : PROJ[(size_t)r * NPROJ + C_Q + h * 128 + d];
        Ks[c * QS_STRIDE + d] = r < 0 ? (bf16_t)0 : PROJ[(size_t)r * NPROJ + C_K + h * 128 + d]; }
    __syncthreads();
    {
        const int j = tid & 127, ib = (tid >> 7) * 64;
        for (int i = ib; i < ib + 64; ++i) {
            float s = 0.f;
            for (int d = 0; d < 128; ++d) s += bf2f(Qs[i * QS_STRIDE + d]) * bf2f(Ks[j * QS_STRIDE + d]);
            const float mk = i >= j ? expf(lf * (float)(i - j)) : expf(lb * (float)(j - i));
            SC[i * 128 + j] = s * mk;
        }
    }
    __syncthreads();
    const int dv = tid;
    const bf16_t* Sf = S + (((size_t)0 * 8 + bh) * NCH + n) * 128 * 256;
    const bf16_t* Sb = S + (((size_t)1 * 8 + bh) * NCH + n) * 128 * 256;
    for (int grp = (n == 0 ? 7 : 0); grp < 8; ++grp) {
        float acc[16]; for (int i = 0; i < 16; ++i) acc[i] = 0.f;
        for (int j = 0; j < 128; ++j) { const int r = chunk_row(b, n, j); if (r < 0) continue; const float v = bf2f(PROJ[(size_t)r * NPROJ + C_V + h * 256 + dv]);
            for (int i = 0; i < 16; ++i) acc[i] += SC[(grp * 16 + i) * 128 + j] * v; }
        float qf[16], qb[16];
        for (int i = 0; i < 16; ++i) { const int ii = grp * 16 + i; qf[i] = expf(lf * (float)(ii + 1)); qb[i] = expf(lb * (float)(128 - ii)); }
        for (int d = 0; d < 128; ++d) { const float sf = bf2f(Sf[(size_t)d * 256 + dv]), sb = bf2f(Sb[(size_t)d * 256 + dv]);
            for (int i = 0; i < 16; ++i) { const float q = bf2f(Qs[(grp * 16 + i) * QS_STRIDE + d]); acc[i] += q * (qf[i] * sf + qb[i] * sb); } }
        float ss[16];
        for (int i = 0; i < 16; ++i) { float v = acc[i] * acc[i]; for (int o = 32; o > 0; o >>= 1) v += __shfl_xor(v, o); ss[i] = v; }
        __syncthreads();
        if ((tid & 63) == 0) for (int i = 0; i < 16; ++i) red[(tid >> 6) * 16 + i] = ss[i];
        __syncthreads();
        for (int i = 0; i < 16; ++i) {
            const float ms = (red[i] + red[16 + i] + red[32 + i] + red[48 + i]) * (1.f / 256.f);
            const int r = chunk_row(b, n, grp * 16 + i);
            if (r < 0) continue;
            const float y = acc[i] * rsqrtf(ms + RMS_EPS) * hg[h * 256 + dv];
            ARET[(size_t)r * DM + h * 256 + dv] = f2bf(y * bf2f(PROJ[(size_t)r * NPROJ + C_G + h * 256 + dv]));
        }
    }
}

__device__ __forceinline__ float conv3(const bf16_t* __restrict__ PROJ, const float* __restrict__ cw, const float* __restrict__ cb, int b, int t, int ch) {
    float a = cb[ch];
    for (int j = 0; j < 3; ++j) { const int tt = t + j - 1; if (tt >= 0 && tt < TT) a += bf2f(PROJ[(size_t)row_of(b, tt) * NPROJ + C_U + ch]) * cw[j * 3072 + ch]; }
    return a;
}
__device__ __forceinline__ void b_hy_prep(const dim3 bid, const bf16_t* __restrict__ PROJ, const float* __restrict__ cw, const float* __restrict__ cb, bf16_t* __restrict__ ZT) {
    const int c = bid.x * 256 + threadIdx.x, t = bid.y, b = bid.z;
    bf16_t v = 0;
    if (t < TT) { const float x1 = conv3(PROJ, cw, cb, b, t, 1024 + c), vh = conv3(PROJ, cw, cb, b, t, 2048 + c); v = f2bf(x1 * vh); }
    ZT[((size_t)b * 1024 + c) * ZL + t] = v;
}
__device__ __forceinline__ void b_hy_conv(const dim3 bid, unsigned char* sm, const bf16_t* __restrict__ G, const bf16_t* __restrict__ ZT, bf16_t* __restrict__ YCT) {
    float (*zs)[1024] = (float (*)[1024])sm;
    float* gs = (float*)(sm + 8192);
    const int tile = bid.x, c = bid.y, tid = threadIdx.x;
    const int tb = tile * 2048, t0 = tb + tid * 8;
    float acc0[8], acc1[8];
    for (int j = 0; j < 8; ++j) { acc0[j] = 0.f; acc1[j] = 0.f; }
    const bf16_t* g = G + (size_t)c * GL;
    for (int s0 = 0; s0 < TT; s0 += 1024) {
        __syncthreads();
        for (int i = tid; i < 2048; i += 256) { const int bb = i >> 10, s = s0 + (i & 1023); zs[bb][i & 1023] = s < TT ? bf2f(ZT[((size_t)bb * 1024 + c) * ZL + s]) : 0.f; }
        const int dlo = tb - s0 - 1023;
        for (int i = tid; i < 3072; i += 256) { const int idx = TT + dlo + i; gs[i] = (idx >= 0 && idx < GL) ? bf2f(g[idx]) : 0.f; }
        __syncthreads();
        const int base = tid * 8 + 1023;
        for (int u = 0; u < 1024; ++u) {
            const float z0 = zs[0][u], z1 = zs[1][u];
#pragma unroll
            for (int j = 0; j < 8; ++j) { const float gv = gs[base + j - u]; acc0[j] += gv * z0; acc1[j] += gv * z1; }
        }
    }
    for (int j = 0; j < 8; ++j) { const int t = t0 + j; if (t < ZL) { YCT[((size_t)0 * 1024 + c) * ZL + t] = f2bf(acc0[j]); YCT[((size_t)1 * 1024 + c) * ZL + t] = f2bf(acc1[j]); } }
}
__device__ __forceinline__ void b_hy_post(const dim3 bid, const bf16_t* __restrict__ PROJ, const float* __restrict__ cw, const float* __restrict__ cb, const float* __restrict__ skip, const bf16_t* __restrict__ YCT, bf16_t* __restrict__ AHY) {
    const int c = bid.x * 256 + threadIdx.x, m = bid.y;
    int b, t; bt_of(m, b, t);
    const float x0 = conv3(PROJ, cw, cb, b, t, c), x1 = conv3(PROJ, cw, cb, b, t, 1024 + c), vh = conv3(PROJ, cw, cb, b, t, 2048 + c);
    const float z = x1 * vh;
    const float yc = bf2f(YCT[((size_t)b * 1024 + c) * ZL + t]);
    AHY[(size_t)m * DM + c] = f2bf(x0 * (yc + z * skip[c]));
}

__device__ __forceinline__ void b_norm2_router(const dim3 bid, unsigned char* sm, const float* __restrict__ H2, const float* __restrict__ H2M, const float* __restrict__ g2, const float* __restrict__ wr, bf16_t* __restrict__ XN2, float* __restrict__ AFF) {
    float* red = (float*)sm; float (*lred)[16] = (float (*)[16])(sm + 64);
    const int m = bid.x, tid = threadIdx.x;
    const float* src = m < MX ? H2 + (size_t)m * DM : H2M + (size_t)(m - MX) * DM;
    float v[4]; float s = 0.f;
    for (int i = 0; i < 4; ++i) { v[i] = src[tid + 256 * i]; s += v[i] * v[i]; }
    s = block_sum256(s, red);
    const float r = rsqrtf(s * (1.f / DM) + RMS_EPS);
    float lg[16]; for (int e = 0; e < 16; ++e) lg[e] = 0.f;
    for (int i = 0; i < 4; ++i) { const int k = tid + 256 * i; const float xn = v[i] * r * g2[k]; XN2[(size_t)m * DM + k] = f2bf(xn);
        for (int e = 0; e < 16; ++e) lg[e] += xn * wr[k * 16 + e]; }
    for (int e = 0; e < 16; ++e) { float q = lg[e]; for (int o = 32; o > 0; o >>= 1) q += __shfl_xor(q, o); lg[e] = q; }
    if ((tid & 63) == 0) for (int e = 0; e < 16; ++e) lred[tid >> 6][e] = lg[e];
    __syncthreads();
    if (tid == 0) {
        float l[16], mx = -1e30f;
        for (int e = 0; e < 16; ++e) { l[e] = lred[0][e] + lred[1][e] + lred[2][e] + lred[3][e]; mx = fmaxf(mx, l[e]); }
        float sum = 0.f; for (int e = 0; e < 16; ++e) { l[e] = expf(l[e] - mx); sum += l[e]; }
        int b, t; bt_of(m, b, t);
        for (int e = 0; e < 16; ++e) AFF[((size_t)b * NE + e) * TT + t] = l[e] / sum;
    }
}
__device__ __forceinline__ void b_topk(const dim3 bid, unsigned char* sm, const float* __restrict__ AFF, int* __restrict__ IDX, float* __restrict__ GATEV, int* __restrict__ INV) {
    float* a = (float*)sm;
    const int be = bid.y, t = bid.x * 256 + threadIdx.x;
    for (int i = threadIdx.x; i < TT; i += 256) a[i] = AFF[(size_t)be * TT + i];
    __syncthreads();
    if (t < TT) {
        const float v = a[t]; int rank = 0;
        for (int i = 0; i < TT; ++i) { const float w = a[i]; rank += (w > v || (w == v && i < t)) ? 1 : 0; }
        if (rank < CAP) { IDX[(size_t)be * CAP + rank] = t; GATEV[(size_t)be * CAP + rank] = v; INV[(size_t)be * TT + t] = rank; }
        else INV[(size_t)be * TT + t] = -1;
    }
}
__device__ __forceinline__ void b_gather(const dim3 bid, const bf16_t* __restrict__ XN2, const int* __restrict__ IDX, bf16_t* __restrict__ XE) {
    const int r = bid.x * 2 + (threadIdx.x >> 7), e = bid.y, tx = threadIdx.x & 127;
    uint4 v = make_uint4(0, 0, 0, 0);
    if (r < 2 * CAP) { const int b = r / CAP, slot = r % CAP; const int t = IDX[((size_t)b * NE + e) * CAP + slot]; v = *(const uint4*)(XN2 + (size_t)row_of(b, t) * DM + tx * 8); }
    *(uint4*)(XE + ((size_t)e * ER + r) * DM + tx * 8) = v;
}
__device__ __forceinline__ void b_final(const dim3 bid, unsigned char* sm, float* __restrict__ OUT, const bf16_t* __restrict__ YE, const int* __restrict__ INV, const float* __restrict__ gfin) {
    float* red = (float*)sm;
    const int m = bid.x, tid = threadIdx.x, b = m >> 13, t = (m & 8191) + NMETA;
    float v[4]; for (int i = 0; i < 4; ++i) v[i] = OUT[(size_t)m * DM + tid + 256 * i];
    for (int e = 0; e < NE; ++e) { const int slot = INV[((size_t)b * NE + e) * TT + t]; if (slot >= 0) { const bf16_t* y = YE + ((size_t)e * ER + b * CAP + slot) * DM; for (int i = 0; i < 4; ++i) v[i] += bf2f(y[tid + 256 * i]); } }
    float s = 0.f; for (int i = 0; i < 4; ++i) s += v[i] * v[i];
    s = block_sum256(s, red);
    const float r = rsqrtf(s * (1.f / DM) + RMS_EPS);
    for (int i = 0; i < 4; ++i) OUT[(size_t)m * DM + tid + 256 * i] = v[i] * r * gfin[tid + 256 * i];
}

struct Params {
    const float *x, *meta, *norm1_g, *w_in, *dec_f, *dec_b, *hg, *w_ret, *cw, *cb, *fw1, *fb1, *fw2, *fb2, *fw3, *fb3, *ffq, *fw4, *skip, *w_hy, *w_o, *norm2_g, *w_router, *w_eg, *w_eu, *w_ed, *gfin;
    unsigned char* ws; unsigned char* dob;
};
#define VLOOP(nx, ny, nz, BODY) do { const long _tot = (long)(nx) * (ny) * (nz); for (long _v = blockIdx.x; _v < _tot; _v += gridDim.x) { \
    const dim3 bid((unsigned)(_v % (nx)), (unsigned)((_v / (nx)) % (ny)), (unsigned)(_v / ((long)(nx) * (ny)))); BODY; __syncthreads(); } } while (0)

__global__ void __launch_bounds__(256) mega_simple(Params p) {
    extern __shared__ __attribute__((aligned(16))) unsigned char sm[];
    cg::grid_group grid = cg::this_grid();
    unsigned char* ws = p.ws; unsigned char* dob = p.dob;
    bf16_t* WRET = (bf16_t*)(ws + WS_WRET); bf16_t* WHY = (bf16_t*)(ws + WS_WHY); bf16_t* WO = (bf16_t*)(ws + WS_WO);
    bf16_t* XN = (bf16_t*)(ws + WS_XN); bf16_t* PROJ = (bf16_t*)(ws + WS_PROJ); bf16_t* S = (bf16_t*)(ws + WS_S); float* TMP = (float*)(ws + WS_S);
    bf16_t* ZT = (bf16_t*)(ws + WS_ZT); bf16_t* G = (bf16_t*)(ws + WS_G); bf16_t* AHY = (bf16_t*)(ws + WS_G); bf16_t* ARET = (bf16_t*)(ws + WS_ARET);
    bf16_t* WGU = (bf16_t*)(ws + WS_WGU); bf16_t* WD = (bf16_t*)(ws + WS_WD); bf16_t* XE = (bf16_t*)(ws + WS_XE); bf16_t* YE = (bf16_t*)(ws + WS_XE); bf16_t* HID = (bf16_t*)(ws + WS_HID);
    bf16_t* WIN = (bf16_t*)(dob + DO_WIN); float* ROPE = (float*)(dob + DO_ROPE); float* HDN = (float*)(dob + DO_HDN); bf16_t* YCT = (bf16_t*)(dob + DO_YCT);
    float* AFF = (float*)(ws + WS_MISC + MI_AFF); int* IDX = (int*)(ws + WS_MISC + MI_IDX); float* GATEV = (float*)(ws + WS_MISC + MI_GATE); int* INV = (int*)(ws + WS_MISC + MI_INV);
    float* H2M = (float*)(ws + WS_MISC + MI_H2M); float* H2 = (float*)dob;
    EpiArgs E{}; E.PROJ = PROJ; E.ROPE = ROPE; E.TMP = TMP; E.MIXED = XN; E.x = p.x; E.meta = p.meta; E.H2 = H2; E.H2M = H2M; E.HID = HID; E.YE = YE; E.GATEV = GATEV;

    VLOOP(32, 256, 1, b_wconv(bid, sm, p.w_in, nullptr, 1024, 8192, 8192, WIN, 1, 0, 0));
    VLOOP(32, 32, 1, b_wconv(bid, sm, p.w_ret, nullptr, 1024, 1024, 1024, WRET, 0, 0, 0));
    VLOOP(32, 32, 1, b_wconv(bid, sm, p.w_hy, nullptr, 1024, 1024, 1024, WHY, 0, 0, 0));
    VLOOP(32, 32, 1, b_wconv(bid, sm, p.w_o, nullptr, 1024, 1024, 1024, WO, 0, 0, 0));
    VLOOP(MROWS, 1, 1, b_xn1(bid, sm, p.x, p.meta, p.norm1_g, XN));
    VLOOP(TT / 4, 1, 1, b_rope(bid, ROPE));
    VLOOP(TT / 4, 1, 1, b_filt_hidden(bid, sm, p.fw1, p.fb1, p.fw2, p.fb2, p.fw3, p.fb3, p.ffq, HDN));
    grid.sync();
    VLOOP(4, TT, 1, b_filt_out(bid, sm, HDN, p.fw4, G));
    VLOOP(NPROJ / 64, (MROWS + 127) / 128, 1, b_gemm(bid, sm, XN, WIN, MROWS, NPROJ, 1024, 0, 0, 1, E));
    grid.sync();
    VLOOP(8, 8, 2, b_ret_state(bid, sm, PROJ, p.dec_f, p.dec_b, S));
    VLOOP(4, ZL, 2, b_hy_prep(bid, PROJ, p.cw, p.cb, ZT));
    grid.sync();
    VLOOP(5, 1024, 1, b_hy_conv(bid, sm, G, ZT, YCT));
    VLOOP(NCH, 8, 1, b_ret_out(bid, sm, PROJ, S, p.dec_f, p.dec_b, p.hg, ARET));
    grid.sync();
    VLOOP(4, MROWS, 1, b_hy_post(bid, PROJ, p.cw, p.cb, p.skip, YCT, AHY));
    VLOOP(DM / 64, (MROWS + 127) / 128, 1, b_gemm(bid, sm, ARET, WRET, MROWS, DM, 1024, 0, 0, 2, E));
    grid.sync();
    VLOOP(DM / 64, (MROWS + 127) / 128, 1, b_gemm(bid, sm, AHY, WHY, MROWS, DM, 1024, 0, 0, 3, E));
    grid.sync();
    VLOOP(DM / 64, (MROWS + 127) / 128, 1, b_gemm(bid, sm, XN, WO, MROWS, DM, 1024, 0, 0, 4, E));
    grid.sync();
    VLOOP(MROWS, 1, 1, b_norm2_router(bid, sm, H2, H2M, p.norm2_g, p.w_router, XN, AFF));
    VLOOP(32, 128, NE, b_wconv(bid, sm, p.w_eg, p.w_eu, 1024, 2048, 4096, WGU, 2, (size_t)1024 * 2048, (size_t)4096 * 1024));
    VLOOP(64, 32, NE, b_wconv(bid, sm, p.w_ed, nullptr, 2048, 1024, 1024, WD, 0, (size_t)2048 * 1024, (size_t)1024 * 2048));
    grid.sync();
    VLOOP(33, 32, 1, b_topk(bid, sm, AFF, IDX, GATEV, INV));
    grid.sync();
    VLOOP(ER / 2, NE, 1, b_gather(bid, XN, IDX, XE));
    grid.sync();
    VLOOP(4096 / 64, ER / 128, NE, b_gemm(bid, sm, XE, WGU, ER, 4096, 1024, (size_t)ER * 1024, (size_t)4096 * 1024, 5, E));
    grid.sync();
    VLOOP(DM / 64, ER / 128, NE, b_gemm(bid, sm, HID, WD, ER, DM, 2048, (size_t)ER * 2048, (size_t)1024 * 2048, 6, E));
    grid.sync();
    VLOOP(MX, 1, 1, b_final(bid, sm, H2, YE, INV, p.gfin));
}

extern "C" void kernel_launch(void* const* d_in, const int* in_sizes, int n_in, void* d_out, int out_size, void* d_ws, size_t ws_size, hipStream_t stream) {
    if (n_in != 27 || ws_size < WS_END || out_size != MX * DM) { fprintf(stderr, "kernel_launch: unexpected sizes n_in %d ws %zu out %d\n", n_in, ws_size, out_size); return; }
    constexpr size_t kDynLds = R2_LDS;
    static int grid_blocks = 0;
    if (!grid_blocks) {
        int dev = 0, cus = 0, per_cu = 0;
        (void)hipGetDevice(&dev);
        (void)hipDeviceGetAttribute(&cus, hipDeviceAttributeMultiprocessorCount, dev);
        (void)hipFuncSetAttribute((const void*)mega_simple, hipFuncAttributeMaxDynamicSharedMemorySize, (int)kDynLds);
        (void)hipOccupancyMaxActiveBlocksPerMultiprocessor(&per_cu, (const void*)mega_simple, 256, kDynLds);
        if (per_cu < 1) per_cu = 1;
        grid_blocks = cus * per_cu;
    }
    Params p{};
    const float** pp = (const float**)&p;
    for (int i = 0; i < 27; ++i) pp[i] = (const float*)d_in[i];
    p.ws = (unsigned char*)d_ws; p.dob = (unsigned char*)d_out;
    void* args[] = {&p};
    hipError_t e = hipLaunchCooperativeKernel((const void*)mega_simple, dim3(grid_blocks), dim3(256), args, kDynLds, stream);
    if (e != hipSuccess) fprintf(stderr, "cooperative launch failed: %s (grid %d)\n", hipGetErrorString(e), grid_blocks);
}
```

```cpp
#include <hip/hip_runtime.h>
#include <stdint.h>
#include <cstdio>

typedef unsigned short bf16_t;
__device__ __forceinline__ float bf2f(bf16_t v) { return __uint_as_float(((unsigned)v) << 16); }
__device__ __forceinline__ bf16_t f2bf(float f) { unsigned u = __float_as_uint(f); u += 0x7fffu + ((u >> 16) & 1u); return (bf16_t)(u >> 16); }

constexpr int NB = 2, SEQ = 8192, DM = 1024, NMETA = 16, TT = 8208;
constexpr int MX = 16384, MROWS = 16416, MP = 16640;
constexpr int NPROJ = 8192;
constexpr int C_Q = 0, C_K = 512, C_V = 1024, C_G = 2048, C_U = 3072, C_GA = 6144, C_GB = 7168;
constexpr int NE = 16, CAP = 1026, ER = 2304, FF = 2048;
constexpr int NCH = 65;
constexpr int GL = 16640;
constexpr int ZL = 8320;
constexpr float RMS_EPS = 1e-6f;

constexpr size_t MiB = 1u << 20;
constexpr size_t WS_CTL = 0;
constexpr size_t WS_WRET = 1 * MiB, WS_WHY = 3 * MiB, WS_WO = 5 * MiB;
constexpr size_t WS_MISC = 7 * MiB;
constexpr size_t WS_XN = 12 * MiB;
constexpr size_t WS_PROJ = 48 * MiB;
constexpr size_t WS_S = 308 * MiB;
constexpr size_t WS_ZT = 374 * MiB;
constexpr size_t WS_G = 407 * MiB;
constexpr size_t WS_ARET = 440 * MiB;
constexpr size_t WS_WGU = 48 * MiB;
constexpr size_t WS_WD = 176 * MiB;
constexpr size_t WS_XE = 240 * MiB;
constexpr size_t WS_HID = 312 * MiB;
constexpr size_t WS_END = 456 * MiB;
constexpr size_t DO_WIN = 0;
constexpr size_t DO_ROPE = 16 * MiB;
constexpr size_t DO_HDN = 22 * MiB;
constexpr size_t DO_YCT = 0;
constexpr size_t MI_AFF = 0;
constexpr size_t MI_IDX = 1 * MiB + 64 * 1024;
constexpr size_t MI_GATE = 1 * MiB + 256 * 1024;
constexpr size_t MI_INV = 2 * MiB;
constexpr size_t MI_H2M = 3 * MiB + 256 * 1024;

__device__ __forceinline__ int row_of(int b, int t) { return t < NMETA ? MX + b * NMETA + t : b * SEQ + (t - NMETA); }
__device__ __forceinline__ void bt_of(int m, int& b, int& t) { if (m < MX) { b = m >> 13; t = (m & 8191) + NMETA; } else { b = (m - MX) >> 4; t = (m - MX) & 15; } }

__global__ void k_wconv(const float* __restrict__ W0, const float* __restrict__ W1, int K, int N, int Nd, bf16_t* __restrict__ WT, int mode, size_t src_bstride, size_t dst_bstride) {
    __shared__ float tile[32][33];
    const int tx = threadIdx.x, ty = threadIdx.y;
    const int k0 = blockIdx.x * 32, r0 = blockIdx.y * 32, e = blockIdx.z;
    const int r = r0 + tx;
    const float* src = W0 + (size_t)e * src_bstride; int col = r;
    if (mode == 1) { if (r < 1024) { const int sec = r >> 7, rl = r & 127, g = rl >> 3, j = rl & 7; col = sec * 128 + (j < 4 ? 4 * g + j : 64 + 4 * g + (j - 4)); } }
    else if (mode == 2) { const int g = r >> 3, j = r & 7; if (j < 4) { col = 4 * g + j; } else { col = 4 * g + j - 4; src = W1 + (size_t)e * src_bstride; } }
    for (int i = 0; i < 4; ++i) { const int k = k0 + ty + 8 * i; tile[ty + 8 * i][tx] = src[(size_t)k * N + col]; }
    __syncthreads();
    bf16_t* dst = WT + (size_t)e * dst_bstride;
    for (int i = 0; i < 4; ++i) { const int rr = r0 + ty + 8 * i; dst[(size_t)rr * K + k0 + tx] = f2bf(tile[tx][ty + 8 * i]); }
}

__device__ __forceinline__ float block_sum256(float v, float* red) {
    for (int o = 32; o > 0; o >>= 1) v += __shfl_xor(v, o);
    const int w = threadIdx.x >> 6;
    __syncthreads();
    if ((threadIdx.x & 63) == 0) red[w] = v;
    __syncthreads();
    return red[0] + red[1] + red[2] + red[3];
}

__global__ void k_xn1(const float* __restrict__ x, const float* __restrict__ meta, const float* __restrict__ g, bf16_t* __restrict__ XN) {
    __shared__ float red[4];
    const int m = blockIdx.x;
    const float* src = m < MX ? x + (size_t)m * DM : meta + (size_t)((m - MX) & 15) * DM;
    float v[4]; float s = 0.f;
    for (int i = 0; i < 4; ++i) { v[i] = src[threadIdx.x + 256 * i]; s += v[i] * v[i]; }
    s = block_sum256(s, red);
    const float r = rsqrtf(s * (1.f / DM) + RMS_EPS);
    for (int i = 0; i < 4; ++i) XN[(size_t)m * DM + threadIdx.x + 256 * i] = f2bf(v[i] * r * g[threadIdx.x + 256 * i]);
}

__global__ void k_rope(float* __restrict__ ROPE) {
    const int t = blockIdx.x, i = threadIdx.x;
    const float inv = powf(10000.0f, -(float)i / 64.0f);
    const float ang = (float)t * inv;
    ROPE[(size_t)t * 128 + i] = cosf(ang);
    ROPE[(size_t)t * 128 + 64 + i] = sinf(ang);
}

__global__ void k_filt_hidden(const float* __restrict__ w1, const float* __restrict__ b1, const float* __restrict__ w2, const float* __restrict__ b2,
                              const float* __restrict__ w3, const float* __restrict__ b3, const float* __restrict__ fq, float* __restrict__ HDN) {
    __shared__ float feat[33]; __shared__ float ha[64]; __shared__ float hb[64];
    const int t = blockIdx.x, j = threadIdx.x;
    if (j == 0) feat[0] = (float)t / (float)(TT - 1);
    if (j < 16) {
        const float fr = 1e-4f + (float)j * ((15.0f - 1e-4f) / 15.0f);
        const float ang = (2.0f * 3.14159265358979323846f * (float)t / (float)TT) * fr;
        feat[1 + j] = cosf(ang); feat[17 + j] = -sinf(ang);
    }
    __syncthreads();
    const float f = fq[j];
    float a = b1[j];
    for (int i = 0; i < 33; ++i) a += feat[i] * w1[i * 64 + j];
    ha[j] = sinf(f * a);
    __syncthreads();
    a = b2[j];
    for (int i = 0; i < 64; ++i) a += ha[i] * w2[i * 64 + j];
    hb[j] = sinf(f * a);
    __syncthreads();
    a = b3[j];
    for (int i = 0; i < 64; ++i) a += hb[i] * w3[i * 64 + j];
    HDN[(size_t)t * 64 + j] = sinf(f * a);
}

__global__ void k_filt_out(const float* __restrict__ HDN, const float* __restrict__ w4, bf16_t* __restrict__ G) {
    const int c = blockIdx.x * 256 + threadIdx.x, t = blockIdx.y;
    __shared__ float h[64];
    if (threadIdx.x < 64) h[threadIdx.x] = HDN[(size_t)t * 64 + threadIdx.x];
    __syncthreads();
    float ff = 0.f, fb = 0.f;
    for (int j = 0; j < 64; ++j) { ff += h[j] * w4[j * 2048 + c]; fb += h[j] * w4[j * 2048 + 1024 + c]; }
    const float mind = logf(1e-2f) / 1.5f, maxd = logf(1e-2f) / 0.3f;
    const float delta = mind + (float)c * ((maxd - mind) / 1023.0f);
    const float tn = (float)t / (float)(TT - 1);
    const float win = expf(-tn * fabsf(delta));
    G[(size_t)c * GL + TT + t] = f2bf(ff * win);
    if (t >= 1) G[(size_t)c * GL + TT - t] = f2bf(fb * win);
    if (t == 0) { G[(size_t)c * GL] = 0; for (int i = 2 * TT; i < GL; ++i) G[(size_t)c * GL + i] = 0; }
}

struct EpiArgs {
    bf16_t* PROJ; const float* ROPE;
    float* TMP; bf16_t* MIXED;
    const float* x; const float* meta; float* H2; float* H2M;
    bf16_t* HID; bf16_t* YE; const float* GATEV;
};
typedef float f32x4 __attribute__((ext_vector_type(4)));
typedef float f32x16 __attribute__((ext_vector_type(16)));
typedef unsigned u32x4 __attribute__((ext_vector_type(4)));
typedef unsigned u32x2 __attribute__((ext_vector_type(2)));
typedef short bf16x8 __attribute__((ext_vector_type(8)));
__device__ __forceinline__ unsigned pk2(float lo, float hi) { return (unsigned)f2bf(lo) | ((unsigned)f2bf(hi) << 16); }
__device__ __forceinline__ float lo16(unsigned w) { return __uint_as_float(w << 16); }
__device__ __forceinline__ float hi16(unsigned w) { return __uint_as_float(w & 0xffff0000u); }
__device__ __forceinline__ float sigm(float x) { return 1.f / (1.f + __expf(-x)); }
__device__ __forceinline__ u32x4 pack8(f32x4 a, f32x4 b) { u32x4 w; w.x = pk2(a.x, a.y); w.y = pk2(a.z, a.w); w.z = pk2(b.x, b.y); w.w = pk2(b.z, b.w); return w; }
__device__ __forceinline__ void epi8v(int mode, const EpiArgs& E, int mg, int c0, f32x4 a0, f32x4 a1) {
    if (mode == 1) {
        bf16_t* dst = E.PROJ + (size_t)mg * NPROJ + c0;
        if (c0 < C_V) {
            int b, t; bt_of(mg, b, t);
            const int i0 = ((c0 & 127) >> 3) * 4;
            const float sc = c0 >= C_K ? 0.08838834764831845f : 1.0f;
            const f32x4 cs = *(const f32x4*)(E.ROPE + (size_t)t * 128 + i0), sn = *(const f32x4*)(E.ROPE + (size_t)t * 128 + 64 + i0);
            const f32x4 o1 = (a0 * cs - a1 * sn) * sc, o2 = (a0 * sn + a1 * cs) * sc;
            *(u32x4*)dst = pack8(o1, o2);
        } else if (c0 < C_G || (c0 >= C_U && c0 < C_GA)) { *(u32x4*)dst = pack8(a0, a1); }
        else if (c0 < C_U) { f32x4 s0, s1; for (int j = 0; j < 4; ++j) { s0[j] = a0[j] * sigm(a0[j]); s1[j] = a1[j] * sigm(a1[j]); } *(u32x4*)dst = pack8(s0, s1); }
        else { f32x4 s0, s1; for (int j = 0; j < 4; ++j) { s0[j] = sigm(a0[j]); s1[j] = sigm(a1[j]); } *(u32x4*)dst = pack8(s0, s1); }
    } else if (mode == 2) {
        const u32x4 g = *(const u32x4*)(E.PROJ + (size_t)mg * NPROJ + C_GA + c0);
        float* dst = E.TMP + (size_t)mg * DM + c0;
        *(f32x4*)dst = (f32x4){lo16(g.x) * a0.x, hi16(g.x) * a0.y, lo16(g.y) * a0.z, hi16(g.y) * a0.w};
        *(f32x4*)(dst + 4) = (f32x4){lo16(g.z) * a1.x, hi16(g.z) * a1.y, lo16(g.w) * a1.z, hi16(g.w) * a1.w};
    } else if (mode == 3) {
        const u32x4 g = *(const u32x4*)(E.PROJ + (size_t)mg * NPROJ + C_GB + c0);
        const float* tp = E.TMP + (size_t)mg * DM + c0;
        const f32x4 t0 = *(const f32x4*)tp, t1 = *(const f32x4*)(tp + 4);
        const f32x4 o0 = t0 + (f32x4){lo16(g.x) * a0.x, hi16(g.x) * a0.y, lo16(g.y) * a0.z, hi16(g.y) * a0.w};
        const f32x4 o1 = t1 + (f32x4){lo16(g.z) * a1.x, hi16(g.z) * a1.y, lo16(g.w) * a1.z, hi16(g.w) * a1.w};
        *(u32x4*)(E.MIXED + (size_t)mg * DM + c0) = pack8(o0, o1);
    } else if (mode == 4) {
        const float* rs; float* dst;
        if (mg < MX) { rs = E.x + (size_t)mg * DM + c0; dst = E.H2 + (size_t)mg * DM + c0; }
        else { rs = E.meta + (size_t)((mg - MX) & 15) * DM + c0; dst = E.H2M + (size_t)(mg - MX) * DM + c0; }
        *(f32x4*)dst = *(const f32x4*)rs + a0; *(f32x4*)(dst + 4) = *(const f32x4*)(rs + 4) + a1;
    } else if (mode == 5) {
        u32x2 w; w.x = pk2(a0.x * sigm(a0.x) * a1.x, a0.y * sigm(a0.y) * a1.y); w.y = pk2(a0.z * sigm(a0.z) * a1.z, a0.w * sigm(a0.w) * a1.w);
        *(u32x2*)(E.HID + (size_t)mg * FF + (c0 >> 1)) = w;
    } else {
        const int e = mg / ER, ml = mg - e * ER;
        const float gt = ml < 2 * CAP ? E.GATEV[((size_t)(ml / CAP) * NE + e) * CAP + (ml % CAP)] : 0.f;
        *(u32x4*)(E.YE + (size_t)mg * DM + c0) = pack8(a0 * gt, a1 * gt);
    }
}

__global__ void __launch_bounds__(256) k_gemm(const bf16_t* __restrict__ A, const bf16_t* __restrict__ Bt, int M, int N, int K, size_t a_bstride, size_t b_bstride, int mode, EpiArgs E) {
    __shared__ float As[32][128 + 4];
    __shared__ float Bs[32][64 + 4];
    const int tid = threadIdx.x, e = blockIdx.z;
    const int m0 = blockIdx.y * 128, n0 = blockIdx.x * 64;
    A += (size_t)e * a_bstride; Bt += (size_t)e * b_bstride;
    const int ty = tid >> 3, tx = tid & 7;
    float acc[4][8];
    for (int i = 0; i < 4; ++i) for (int j = 0; j < 8; ++j) acc[i][j] = 0.f;
    const int ar = tid >> 1, ak = (tid & 1) * 16;
    const int br = tid >> 2, bk = (tid & 3) * 8;
    for (int k0 = 0; k0 < K; k0 += 32) {
        {
            const int m = m0 + ar;
            if (m < M) { const uint4* p = (const uint4*)(A + (size_t)m * K + k0 + ak); const uint4 v0 = p[0], v1 = p[1];
                const unsigned w[8] = {v0.x, v0.y, v0.z, v0.w, v1.x, v1.y, v1.z, v1.w};
                for (int q = 0; q < 8; ++q) { As[ak + 2 * q][ar] = __uint_as_float(w[q] << 16); As[ak + 2 * q + 1][ar] = __uint_as_float(w[q] & 0xffff0000u); } }
            else { for (int q = 0; q < 16; ++q) As[ak + q][ar] = 0.f; }
            const uint4 v = *(const uint4*)(Bt + (size_t)(n0 + br) * K + k0 + bk);
            const unsigned w[4] = {v.x, v.y, v.z, v.w};
            for (int q = 0; q < 4; ++q) { Bs[bk + 2 * q][br] = __uint_as_float(w[q] << 16); Bs[bk + 2 * q + 1][br] = __uint_as_float(w[q] & 0xffff0000u); }
        }
        __syncthreads();
#pragma unroll 8
        for (int k = 0; k < 32; ++k) {
            float a[4], b[8];
            for (int i = 0; i < 4; ++i) a[i] = As[k][ty + 32 * i];
            for (int j = 0; j < 8; ++j) b[j] = Bs[k][tx * 8 + j];
            for (int i = 0; i < 4; ++i) for (int j = 0; j < 8; ++j) acc[i][j] += a[i] * b[j];
        }
        __syncthreads();
    }
    for (int i = 0; i < 4; ++i) { const int m = m0 + ty + 32 * i; if (m < M) epi8v(mode, E, (mode >= 5 ? e * ER : 0) + m, n0 + tx * 8, (f32x4){acc[i][0], acc[i][1], acc[i][2], acc[i][3]}, (f32x4){acc[i][4], acc[i][5], acc[i][6], acc[i][7]}); }
}

namespace pg8 {
#define PG8_LAS __attribute__((address_space(3)))
typedef unsigned short bf16_t;
typedef short bf16x8 __attribute__((ext_vector_type(8)));
typedef float f32x4 __attribute__((ext_vector_type(4)));
typedef unsigned u32x4 __attribute__((ext_vector_type(4)));
constexpr int BM = 256, BK = 64, HALF = 128, HTB = HALF * BK * 2  , STAGE_BYTES = 8 * HTB, NXCD = 8, WGM = 8;

__host__ __device__ __forceinline__ int lds_byte(int r, int c) { const int st = (r >> 4) * 2 + (c >> 5), rr = r & 15, cc = c & 31, ob = rr * 64 + cc * 2; return st * 1024 + (ob ^ (((ob >> 9) & 1) << 5)); }
__host__ __device__ __forceinline__ void stage_rc(int b, int& R, int& C) { const int st = b / 1024, sb = b % 1024, swz = sb ^ (((sb >> 9) & 1) << 5); R = (st >> 1) * 16 + swz / 64; C = (st & 1) * 32 + (swz % 64) / 2; }
__host__ __device__ __forceinline__ int perm32(int rho) { const int n = rho >> 4, i = rho & 15; return 8 * (i >> 2) + 4 * n + (i & 3); }

struct Unit { int pm, pn; };
struct Gemm { const bf16_t* A; const bf16_t* Bt; int M, N, K; int gt; size_t gstride; };

struct StaticOrder {
    int nM, nN, nwg, G, c;
    __host__ __device__ void init(int M, int N, int G_, int c_) { nM = M / BM; nN = N / BM; nwg = nM * nN; G = G_; c = c_; }
    __host__ __device__ bool next(int i, Unit& u) const {
        const long L = (long)i * G + c; if (L >= nwg) return false;
        int wgid = (int)L; { const int q = nwg / NXCD, r = nwg % NXCD, xcd = wgid % NXCD, off = wgid / NXCD; wgid = (xcd < r ? xcd * (q + 1) : r * (q + 1) + (xcd - r) * q) + off; }
        const int nig = WGM * nN, gid = wgid / nig, fm = gid * WGM, gsz = (nM - fm) < WGM ? (nM - fm) : WGM;
        u.pm = fm + ((wgid % nig) % gsz); u.pn = (wgid % nig) / gsz; return true;
    }
    __device__ __forceinline__ void a_ready(const Unit&) const {}
    __device__ __forceinline__ void done(const Unit&) const {}
};

__device__ __forceinline__ unsigned cvt_pk_bf16(float lo, float hi) { unsigned r; asm volatile("v_cvt_pk_bf16_f32 %0, %1, %2" : "=v"(r) : "v"(lo), "v"(hi)); return r; }
template <class Epi, class Sched, bool ALIGN_EPI = false, bool SP2 = false>
__device__ __forceinline__ void gemm_phase(PG8_LAS unsigned char* lds, const Gemm g, const Sched& S, const Epi& E) {
    const int tid = threadIdx.x, wid = __builtin_amdgcn_readfirstlane(tid >> 6), lane = tid & 63, wr = wid >> 2, wc = wid & 3, fr = lane & 15, fq = lane >> 4;
    const int K = g.K, nt = K / BK;
    unsigned voffA[2], voffB[2];
#pragma unroll
    for (int i = 0; i < 2; ++i) { int R, C; stage_rc(tid * 16 + i * 8192, R, C); const int Rb = Epi::PERM ? ((R & ~31) + perm32(R & 31)) : R;
        voffA[i] = (unsigned)(R * K + C) * 2u; voffB[i] = (unsigned)(Rb * K + C) * 2u; }
    const size_t kstep = (size_t)(BK * 2);
    const size_t hstep = (size_t)HALF * K * 2;
    const size_t tstep = 2 * hstep;
    const unsigned ldsw = (unsigned)wid * 1024u;
    const int aoff = lds_byte(wr * 64 + fr, fq * 8), boff = lds_byte(wc * 32 + fr, fq * 8);
#define PG8_SA(b, h) (((b) * 2 + (h)) * HTB)
#define PG8_SB(b, h) ((4 + (b) * 2 + (h)) * HTB)
#define PG8_STAGE(bufoff, gbase, voff) do { _Pragma("unroll") for (int _i = 0; _i < 2; ++_i) \
        __builtin_amdgcn_global_load_lds((const unsigned*)((const char*)(gbase) + (voff)[_i]), (PG8_LAS unsigned*)(lds + (bufoff) + ldsw + _i * 8192), 16, 0, 0); } while (0)
#define PG8_LDA(dst, b, h) do { _Pragma("unroll") for (int m = 0; m < 4; ++m) _Pragma("unroll") for (int k = 0; k < 2; ++k) dst[m][k] = *(const PG8_LAS bf16x8*)(lds + PG8_SA(b, h) + aoff + m * 2048 + k * 1024); } while (0)
#define PG8_LDB(dst, b, h) do { _Pragma("unroll") for (int n = 0; n < 2; ++n) _Pragma("unroll") for (int k = 0; k < 2; ++k) dst[n][k] = *(const PG8_LAS bf16x8*)(lds + PG8_SB(b, h) + boff + n * 2048 + k * 1024); } while (0)
#define PG8_MMA(ai, bj, At, Bt) do { __builtin_amdgcn_s_setprio(1); _Pragma("unroll") for (int m = 0; m < 4; ++m) _Pragma("unroll") for (int n = 0; n < 2; ++n) _Pragma("unroll") for (int k = 0; k < 2; ++k) \
        acc[ai][bj][m][n] = __builtin_amdgcn_mfma_f32_16x16x32_bf16(Bt[n][k], At[m][k], acc[ai][bj][m][n], 0, 0, 0); __builtin_amdgcn_s_setprio(0); } while (0)
#define PG8_WAIT_V(n) asm volatile("s_waitcnt vmcnt(" #n ")" ::: "memory")
#define PG8_WAIT_L(n) asm volatile("s_waitcnt lgkmcnt(" #n ")" ::: "memory")
#define PG8_BAR __builtin_amdgcn_s_barrier()
#define PG8_SCHED __builtin_amdgcn_sched_barrier(0)
    Unit cur, nxt; int ui = 0;
    if (!S.next(0, cur)) return;
    f32x4 acc[2][2][4][2];
#pragma unroll
    for (int a = 0; a < 2; ++a)
#pragma unroll
        for (int b = 0; b < 2; ++b)
#pragma unroll
            for (int m = 0; m < 4; ++m)
#pragma unroll
                for (int n = 0; n < 2; ++n) acc[a][b][m][n] = (f32x4){0.f, 0.f, 0.f, 0.f};
    bf16x8 At[4][2], B0[2][2], B1[2][2];
    const char* cA = (const char*)g.A + (size_t)cur.pm * tstep; const char* cB = (const char*)g.Bt + (size_t)(cur.pm / g.gt) * g.gstride + (size_t)cur.pn * tstep;
    S.a_ready(cur);
    if constexpr (SP2) {
        PG8_STAGE(PG8_SB(0, 0), cB, voffB); PG8_STAGE(PG8_SB(0, 1), cB + hstep, voffB); PG8_STAGE(PG8_SA(0, 0), cA, voffA); PG8_STAGE(PG8_SA(0, 1), cA + hstep, voffA);
        if (wr == 1) PG8_BAR;
        PG8_WAIT_V(2); PG8_BAR;
        PG8_STAGE(PG8_SB(1, 0), cB + kstep, voffB); PG8_STAGE(PG8_SA(1, 0), cA + kstep, voffA); PG8_STAGE(PG8_SB(1, 1), cB + hstep + kstep, voffB);
        PG8_WAIT_V(6); PG8_BAR;
    } else {
        PG8_STAGE(PG8_SB(0, 0), cB, voffB); PG8_STAGE(PG8_SA(0, 0), cA, voffA); PG8_STAGE(PG8_SB(0, 1), cB + hstep, voffB); PG8_STAGE(PG8_SA(0, 1), cA + hstep, voffA);
        if (wr == 1) PG8_BAR;
        PG8_WAIT_V(4); PG8_BAR;
        PG8_STAGE(PG8_SB(1, 0), cB + kstep, voffB); PG8_STAGE(PG8_SA(1, 0), cA + kstep, voffA); PG8_STAGE(PG8_SB(1, 1), cB + hstep + kstep, voffB);
        PG8_WAIT_V(6); PG8_BAR;
    }
    for (;;) {
        const bool has_next = S.next(ui + 1, nxt);
        const char* nA = has_next ? (const char*)g.A + (size_t)nxt.pm * tstep : cA; const char* nB = has_next ? (const char*)g.Bt + (size_t)(nxt.pm / g.gt) * g.gstride + (size_t)nxt.pn * tstep : cB;
        for (int t = 0; t < nt; t += 2) {
            const bool last = (t == nt - 2);
            const char* a1 = cA + (size_t)(t + 1) * kstep;
            const char* a2 = last ? nA : cA + (size_t)(t + 2) * kstep; const char* b2 = last ? nB : cB + (size_t)(t + 2) * kstep;
            const char* a3 = a2 + kstep; const char* b3 = b2 + kstep;
            if (last && has_next) S.a_ready(nxt);
            if constexpr (SP2) {
            PG8_LDB(B0, 0, 0); PG8_LDB(B1, 0, 1); PG8_SCHED; PG8_LDA(At, 0, 0); PG8_STAGE(PG8_SA(1, 1), a1 + hstep, voffA);
            PG8_WAIT_V(8); PG8_WAIT_L(0); PG8_BAR; PG8_MMA(0, 0, At, B0); PG8_MMA(0, 1, At, B1); PG8_BAR; PG8_SCHED;
            PG8_LDA(At, 0, 1); PG8_STAGE(PG8_SB(0, 0), b2, voffB); PG8_STAGE(PG8_SB(0, 1), b2 + hstep, voffB); PG8_STAGE(PG8_SA(0, 0), a2, voffA);
            PG8_WAIT_V(8); PG8_WAIT_L(0); PG8_BAR; PG8_MMA(1, 0, At, B0); PG8_MMA(1, 1, At, B1); PG8_BAR; PG8_SCHED;
            PG8_LDB(B0, 1, 0); PG8_LDB(B1, 1, 1); PG8_SCHED; PG8_LDA(At, 1, 0); PG8_STAGE(PG8_SA(0, 1), a2 + hstep, voffA);
            PG8_WAIT_V(8); PG8_WAIT_L(0); PG8_BAR; PG8_MMA(0, 0, At, B0); PG8_MMA(0, 1, At, B1); PG8_BAR; PG8_SCHED;
            PG8_LDA(At, 1, 1); PG8_STAGE(PG8_SB(1, 0), b3, voffB); PG8_STAGE(PG8_SB(1, 1), b3 + hstep, voffB); PG8_STAGE(PG8_SA(1, 0), a3, voffA);
            PG8_WAIT_V(8); PG8_WAIT_L(0); PG8_BAR; PG8_MMA(1, 0, At, B0); PG8_MMA(1, 1, At, B1); PG8_BAR; PG8_SCHED;
            } else {
            PG8_LDB(B0, 0, 0); PG8_SCHED; PG8_LDA(At, 0, 0); PG8_STAGE(PG8_SA(1, 1), a1 + hstep, voffA);
            PG8_WAIT_L(8); PG8_BAR; PG8_WAIT_L(0); PG8_MMA(0, 0, At, B0); PG8_BAR; PG8_SCHED;
            PG8_LDB(B1, 0, 1); PG8_STAGE(PG8_SB(0, 0), b2, voffB);
            PG8_BAR; PG8_WAIT_L(0); PG8_MMA(0, 1, At, B1); PG8_BAR;
            PG8_LDA(At, 0, 1); PG8_STAGE(PG8_SA(0, 0), a2, voffA);
            PG8_BAR; PG8_WAIT_L(0); PG8_MMA(1, 0, At, B0); PG8_BAR; PG8_SCHED;
            PG8_STAGE(PG8_SB(0, 1), b2 + hstep, voffB);
            PG8_WAIT_V(6); PG8_BAR; PG8_MMA(1, 1, At, B1); PG8_BAR;
            PG8_LDB(B0, 1, 0); PG8_SCHED; PG8_LDA(At, 1, 0); PG8_STAGE(PG8_SA(0, 1), a2 + hstep, voffA);
            PG8_WAIT_L(8); PG8_BAR; PG8_WAIT_L(0); PG8_MMA(0, 0, At, B0); PG8_BAR; PG8_SCHED;
            PG8_LDB(B1, 1, 1); PG8_STAGE(PG8_SB(1, 0), b3, voffB);
            PG8_BAR; PG8_WAIT_L(0); PG8_MMA(0, 1, At, B1); PG8_BAR;
            PG8_LDA(At, 1, 1); PG8_STAGE(PG8_SA(1, 0), a3, voffA);
            PG8_BAR; PG8_WAIT_L(0); PG8_MMA(1, 0, At, B0); PG8_BAR; PG8_SCHED;
            PG8_STAGE(PG8_SB(1, 1), b3 + hstep, voffB);
            PG8_WAIT_V(6); PG8_BAR; PG8_MMA(1, 1, At, B1); PG8_BAR;
            }
        }
        if constexpr (ALIGN_EPI) { if (wr == 0) PG8_BAR; }
        if constexpr (!Epi::AFTER_DRAIN) { E(acc, cur, wr, wc, fr, fq); S.done(cur); }
        if (!has_next) break;
#pragma unroll
        for (int a = 0; a < 2; ++a)
#pragma unroll
            for (int b = 0; b < 2; ++b)
#pragma unroll
                for (int m = 0; m < 4; ++m)
#pragma unroll
                    for (int n = 0; n < 2; ++n) acc[a][b][m][n] = (f32x4){0.f, 0.f, 0.f, 0.f};
        cur = nxt; cA = nA; cB = nB; ++ui;
        if constexpr (ALIGN_EPI) { if (wr == 1) PG8_BAR; }
    }
    PG8_WAIT_V(0);
    if constexpr (!ALIGN_EPI) { if (wr == 0) PG8_BAR; }
    PG8_BAR;
    if constexpr (Epi::AFTER_DRAIN) { E.fused(acc, cur, wr, wc, fr, fq, lds, wid, lane); S.done(cur); }
#undef PG8_SA
#undef PG8_SB
#undef PG8_STAGE
#undef PG8_LDA
#undef PG8_LDB
#undef PG8_MMA
#undef PG8_WAIT_V
#undef PG8_WAIT_L
#undef PG8_BAR
#undef PG8_SCHED
}
}

#define LAS __attribute__((address_space(3)))
template <int MODE> struct EpiFast {
    static constexpr bool PERM = true, AFTER_DRAIN = false;
    EpiArgs E;
    __device__ __forceinline__ void operator()(const pg8::f32x4 (&acc)[2][2][4][2], const pg8::Unit& u, int wr, int wc, int fr, int fq) const {
        const int row0 = u.pm * 256 + wr * 64 + fr, col0 = u.pn * 256 + wc * 32 + 8 * fq;
#pragma unroll
        for (int ai = 0; ai < 2; ++ai)
#pragma unroll
            for (int m = 0; m < 4; ++m)
#pragma unroll
                for (int bj = 0; bj < 2; ++bj) epi8v(MODE, E, row0 + ai * 128 + m * 16, col0 + bj * 128, acc[ai][bj][m][0], acc[ai][bj][m][1]);
    }
};
__device__ __forceinline__ void side_tile(int mode, const EpiArgs& E, const bf16_t* __restrict__ A, int erow0, const bf16_t* __restrict__ Bt, int K, int n0) {
    const int l = threadIdx.x & 63, i = l & 31, h = l >> 5;
    const int g = i >> 3, hh = (i >> 2) & 1, q = i & 3, L = 8 * (2 * hh + (g >> 1)) + 4 * (g & 1) + q;
    const bf16_t* wp = Bt + (size_t)(n0 + L) * K + 8 * h;
    const bf16_t* xp = A + (size_t)i * K + 8 * h;
    f32x16 acc; for (int r = 0; r < 16; ++r) acc[r] = 0.f;
#pragma unroll 8
    for (int k0 = 0; k0 < K; k0 += 16) { const bf16x8 wf = *(const bf16x8*)(wp + k0), xf = *(const bf16x8*)(xp + k0); acc = __builtin_amdgcn_mfma_f32_32x32x16_bf16(wf, xf, acc, 0, 0, 0); }
    epi8v(mode, E, erow0 + i, n0 + 16 * h, (f32x4){acc[0], acc[1], acc[2], acc[3]}, (f32x4){acc[4], acc[5], acc[6], acc[7]});
    epi8v(mode, E, erow0 + i, n0 + 16 * h + 8, (f32x4){acc[8], acc[9], acc[10], acc[11]}, (f32x4){acc[12], acc[13], acc[14], acc[15]});
}
struct GemmArgs { const bf16_t* A; const bf16_t* Bt; int M, N, K, gt; size_t gstride; int side; int pad; };
constexpr int GEMM_LDS = 131072 + 1024;
template <int MODE> __device__ __forceinline__ void gemm_fast_body(LAS unsigned char* lds, const GemmArgs& ga, const EpiArgs& E) {
    if (ga.side) {
        const int wid = threadIdx.x >> 6, nt = ga.N / 32;
        for (int t = wid * gridDim.x + blockIdx.x; t < nt; t += 8 * gridDim.x) side_tile(MODE, E, ga.A + (size_t)MX * ga.K, MX, ga.Bt, ga.K, t * 32);
        asm volatile("s_waitcnt vmcnt(0)" ::: "memory");
    }
    pg8::Gemm g{ga.A, ga.Bt, ga.M, ga.N, ga.K, ga.gt, ga.gstride};
    pg8::StaticOrder S; S.init(ga.M, ga.N, (int)gridDim.x, (int)blockIdx.x);
    EpiFast<MODE> Ep{E};
    pg8::gemm_phase<EpiFast<MODE>, pg8::StaticOrder, true, true>(lds, g, S, Ep);
}
template <int MODE> __global__ void __launch_bounds__(512, 2) k_gemm_fast(GemmArgs ga, EpiArgs E) {
    extern __shared__ __attribute__((aligned(16))) unsigned char smem_g[];
    gemm_fast_body<MODE>((LAS unsigned char*)smem_g, ga, E);
}
template <int MODE> static void launch_gemm_fast(hipStream_t stream, const bf16_t* A, const bf16_t* Bt, int M, int N, int K, int gt, size_t gstride, int side, const EpiArgs& E) {
    (void)hipFuncSetAttribute((const void*)k_gemm_fast<MODE>, hipFuncAttributeMaxDynamicSharedMemorySize, GEMM_LDS);
    GemmArgs ga{}; ga.A = A; ga.Bt = Bt; ga.M = M; ga.N = N; ga.K = K; ga.gt = gt; ga.gstride = gstride; ga.side = side;
    k_gemm_fast<MODE><<<256, 512, GEMM_LDS, stream>>>(ga, E);
}

__device__ __forceinline__ float log_sigmoid(float x) { return -log1pf(expf(-x)); }
__device__ __forceinline__ int chunk_row(int b, int n, int c) { return n == 0 ? (c >= 112 ? MX + b * 16 + (c - 112) : -1) : b * SEQ + 128 * (n - 1) + c; }

__global__ void __launch_bounds__(256) k_ret_state(const bf16_t* __restrict__ PROJ, const float* __restrict__ dec_f, const float* __restrict__ dec_b, bf16_t* __restrict__ S) {
    __shared__ bf16_t Ks[128][128];
    __shared__ float Vs[128][32];
    const int sl = blockIdx.x, bh = blockIdx.y, dir = blockIdx.z, b = bh >> 2, h = bh & 3, tid = threadIdx.x;
    const float lg = log_sigmoid(dir == 0 ? dec_f[h] : dec_b[h]);
    const float dec = expf(lg * 128.f);
    const int dk = tid & 127, hf = tid >> 7;
    float st[16]; for (int j = 0; j < 16; ++j) st[j] = 0.f;
    for (int step = 0; step < NCH; ++step) {
        const int n = dir == 0 ? step : NCH - 1 - step;
        bf16_t* dst = S + ((((size_t)dir * 8 + bh) * NCH + n) * 128 + dk) * 256 + sl * 32 + hf * 16;
        for (int j = 0; j < 16; ++j) dst[j] = f2bf(st[j]);
        __syncthreads();
        for (int i = tid; i < 128 * 128; i += 256) { const int c = i >> 7, d = i & 127; const int r = chunk_row(b, n, c); Ks[c][d] = r < 0 ? (bf16_t)0 : PROJ[(size_t)r * NPROJ + C_K + h * 128 + d]; }
        for (int i = tid; i < 128 * 32; i += 256) { const int c = i >> 5, d = i & 31; const int r = chunk_row(b, n, c);
            const float w = dir == 0 ? expf(lg * (float)(127 - c)) : expf(lg * (float)c);
            Vs[c][d] = r < 0 ? 0.f : bf2f(PROJ[(size_t)r * NPROJ + C_V + h * 256 + sl * 32 + d]) * w; }
        __syncthreads();
        float a[16]; for (int j = 0; j < 16; ++j) a[j] = 0.f;
        for (int c = 0; c < 128; ++c) { const float kv = bf2f(Ks[c][dk]); for (int j = 0; j < 16; ++j) a[j] += kv * Vs[c][hf * 16 + j]; }
        for (int j = 0; j < 16; ++j) st[j] = st[j] * dec + a[j];
    }
}

constexpr int QS_STRIDE = 130;
constexpr int R2_LDS = 2 * 128 * QS_STRIDE * 2 + 128 * 128 * 4 + 64 * 4;
__global__ void __launch_bounds__(256) k_ret_out(const bf16_t* __restrict__ PROJ, const bf16_t* __restrict__ S, const float* __restrict__ dec_f, const float* __restrict__ dec_b,
                                                const float* __restrict__ hg, bf16_t* __restrict__ ARET) {
    extern __shared__ __attribute__((aligned(16))) unsigned char smem[];
    bf16_t* Qs = (bf16_t*)smem; bf16_t* Ks = Qs + 128 * QS_STRIDE; float* SC = (float*)(Ks + 128 * QS_STRIDE); float* red = SC + 128 * 128;
    const int n = blockIdx.x, bh = blockIdx.y, b = bh >> 2, h = bh & 3, tid = threadIdx.x;
    const float lf = log_sigmoid(dec_f[h]), lb = log_sigmoid(dec_b[h]);
    for (int i = tid; i < 128 * 128; i += 256) { const int c = i >> 7, d = i & 127; const int r = chunk_row(b, n, c);
        Qs[c * QS_STRIDE + d] = r < 0 ? (bf16_t)0 : PROJ[(size_t)r * NPROJ + C_Q + h * 128 + d];
        Ks[c * QS_STRIDE + d] = r < 0 ? (bf16_t)0 : PROJ[(size_t)r * NPROJ + C_K + h * 128 + d]; }
    __syncthreads();
    {
        const int j = tid & 127, ib = (tid >> 7) * 64;
        for (int i = ib; i < ib + 64; ++i) {
            float s = 0.f;
            for (int d = 0; d < 128; ++d) s += bf2f(Qs[i * QS_STRIDE + d]) * bf2f(Ks[j * QS_STRIDE + d]);
            const float mk = i >= j ? expf(lf * (float)(i - j)) : expf(lb * (float)(j - i));
            SC[i * 128 + j] = s * mk;
        }
    }
    __syncthreads();
    const int dv = tid;
    const bf16_t* Sf = S + (((size_t)0 * 8 + bh) * NCH + n) * 128 * 256;
    const bf16_t* Sb = S + (((size_t)1 * 8 + bh) * NCH + n) * 128 * 256;
    for (int grp = (n == 0 ? 7 : 0); grp < 8; ++grp) {
        float acc[16]; for (int i = 0; i < 16; ++i) acc[i] = 0.f;
        for (int j = 0; j < 128; ++j) { const int r = chunk_row(b, n, j); if (r < 0) continue; const float v = bf2f(PROJ[(size_t)r * NPROJ + C_V + h * 256 + dv]);
            for (int i = 0; i < 16; ++i) acc[i] += SC[(grp * 16 + i) * 128 + j] * v; }
        float qf[16], qb[16];
        for (int i = 0; i < 16; ++i) { const int ii = grp * 16 + i; qf[i] = expf(lf * (float)(ii + 1)); qb[i] = expf(lb * (float)(128 - ii)); }
        for (int d = 0; d < 128; ++d) { const float sf = bf2f(Sf[(size_t)d * 256 + dv]), sb = bf2f(Sb[(size_t)d * 256 + dv]);
            for (int i = 0; i < 16; ++i) { const float q = bf2f(Qs[(grp * 16 + i) * QS_STRIDE + d]); acc[i] += q * (qf[i] * sf + qb[i] * sb); } }
        float ss[16];
        for (int i = 0; i < 16; ++i) { float v = acc[i] * acc[i]; for (int o = 32; o > 0; o >>= 1) v += __shfl_xor(v, o); ss[i] = v; }
        __syncthreads();
        if ((tid & 63) == 0) for (int i = 0; i < 16; ++i) red[(tid >> 6) * 16 + i] = ss[i];
        __syncthreads();
        for (int i = 0; i < 16; ++i) {
            const float ms = (red[i] + red[16 + i] + red[32 + i] + red[48 + i]) * (1.f / 256.f);
            const int r = chunk_row(b, n, grp * 16 + i);
            if (r < 0) continue;
            const float y = acc[i] * rsqrtf(ms + RMS_EPS) * hg[h * 256 + dv];
            ARET[(size_t)r * DM + h * 256 + dv] = f2bf(y * bf2f(PROJ[(size_t)r * NPROJ + C_G + h * 256 + dv]));
        }
    }
}

__device__ __forceinline__ float conv3(const bf16_t* __restrict__ PROJ, const float* __restrict__ cw, const float* __restrict__ cb, int b, int t, int ch) {
    float a = cb[ch];
    for (int j = 0; j < 3; ++j) { const int tt = t + j - 1; if (tt >= 0 && tt < TT) a += bf2f(PROJ[(size_t)row_of(b, tt) * NPROJ + C_U + ch]) * cw[j * 3072 + ch]; }
    return a;
}
__global__ void k_hy_prep(const bf16_t* __restrict__ PROJ, const float* __restrict__ cw, const float* __restrict__ cb, bf16_t* __restrict__ ZT) {
    const int c = blockIdx.x * 256 + threadIdx.x, t = blockIdx.y, b = blockIdx.z;
    bf16_t v = 0;
    if (t < TT) { const float x1 = conv3(PROJ, cw, cb, b, t, 1024 + c), vh = conv3(PROJ, cw, cb, b, t, 2048 + c); v = f2bf(x1 * vh); }
    ZT[((size_t)b * 1024 + c) * ZL + t] = v;
}
__global__ void __launch_bounds__(256) k_hy_conv(const bf16_t* __restrict__ G, const bf16_t* __restrict__ ZT, bf16_t* __restrict__ YCT) {
    __shared__ float zs[2][1024];
    __shared__ float gs[3072 + 8];
    const int tile = blockIdx.x, c = blockIdx.y, tid = threadIdx.x;
    const int tb = tile * 2048, t0 = tb + tid * 8;
    float acc0[8], acc1[8];
    for (int j = 0; j < 8; ++j) { acc0[j] = 0.f; acc1[j] = 0.f; }
    const bf16_t* g = G + (size_t)c * GL;
    for (int s0 = 0; s0 < TT; s0 += 1024) {
        __syncthreads();
        for (int i = tid; i < 2048; i += 256) { const int bb = i >> 10, s = s0 + (i & 1023); zs[bb][i & 1023] = s < TT ? bf2f(ZT[((size_t)bb * 1024 + c) * ZL + s]) : 0.f; }
        const int dlo = tb - s0 - 1023;
        for (int i = tid; i < 3072; i += 256) { const int idx = TT + dlo + i; gs[i] = (idx >= 0 && idx < GL) ? bf2f(g[idx]) : 0.f; }
        __syncthreads();
        const int base = tid * 8 + 1023;
        for (int u = 0; u < 1024; ++u) {
            const float z0 = zs[0][u], z1 = zs[1][u];
#pragma unroll
            for (int j = 0; j < 8; ++j) { const float gv = gs[base + j - u]; acc0[j] += gv * z0; acc1[j] += gv * z1; }
        }
    }
    for (int j = 0; j < 8; ++j) { const int t = t0 + j; if (t < ZL) { YCT[((size_t)0 * 1024 + c) * ZL + t] = f2bf(acc0[j]); YCT[((size_t)1 * 1024 + c) * ZL + t] = f2bf(acc1[j]); } }
}
__global__ void k_hy_post(const bf16_t* __restrict__ PROJ, const float* __restrict__ cw, const float* __restrict__ cb, const float* __restrict__ skip, const bf16_t* __restrict__ YCT, bf16_t* __restrict__ AHY) {
    const int c = blockIdx.x * 256 + threadIdx.x, m = blockIdx.y;
    int b, t; bt_of(m, b, t);
    const float x0 = conv3(PROJ, cw, cb, b, t, c), x1 = conv3(PROJ, cw, cb, b, t, 1024 + c), vh = conv3(PROJ, cw, cb, b, t, 2048 + c);
    const float z = x1 * vh;
    const float yc = bf2f(YCT[((size_t)b * 1024 + c) * ZL + t]);
    AHY[(size_t)m * DM + c] = f2bf(x0 * (yc + z * skip[c]));
}

__global__ void k_norm2_router(const float* __restrict__ H2, const float* __restrict__ H2M, const float* __restrict__ g2, const float* __restrict__ wr, bf16_t* __restrict__ XN2, float* __restrict__ AFF) {
    __shared__ float red[4]; __shared__ float lred[4][16];
    const int m = blockIdx.x, tid = threadIdx.x;
    const float* src = m < MX ? H2 + (size_t)m * DM : H2M + (size_t)(m - MX) * DM;
    float v[4]; float s = 0.f;
    for (int i = 0; i < 4; ++i) { v[i] = src[tid + 256 * i]; s += v[i] * v[i]; }
    s = block_sum256(s, red);
    const float r = rsqrtf(s * (1.f / DM) + RMS_EPS);
    float lg[16]; for (int e = 0; e < 16; ++e) lg[e] = 0.f;
    for (int i = 0; i < 4; ++i) { const int k = tid + 256 * i; const float xn = v[i] * r * g2[k]; XN2[(size_t)m * DM + k] = f2bf(xn);
        for (int e = 0; e < 16; ++e) lg[e] += xn * wr[k * 16 + e]; }
    for (int e = 0; e < 16; ++e) { float q = lg[e]; for (int o = 32; o > 0; o >>= 1) q += __shfl_xor(q, o); lg[e] = q; }
    if ((tid & 63) == 0) for (int e = 0; e < 16; ++e) lred[tid >> 6][e] = lg[e];
    __syncthreads();
    if (tid == 0) {
        float l[16], mx = -1e30f;
        for (int e = 0; e < 16; ++e) { l[e] = lred[0][e] + lred[1][e] + lred[2][e] + lred[3][e]; mx = fmaxf(mx, l[e]); }
        float sum = 0.f; for (int e = 0; e < 16; ++e) { l[e] = expf(l[e] - mx); sum += l[e]; }
        int b, t; bt_of(m, b, t);
        for (int e = 0; e < 16; ++e) AFF[((size_t)b * NE + e) * TT + t] = l[e] / sum;
    }
}
__global__ void k_topk(const float* __restrict__ AFF, int* __restrict__ IDX, float* __restrict__ GATEV, int* __restrict__ INV) {
    __shared__ float a[TT];
    const int be = blockIdx.y, t = blockIdx.x * 256 + threadIdx.x;
    for (int i = threadIdx.x; i < TT; i += 256) a[i] = AFF[(size_t)be * TT + i];
    __syncthreads();
    if (t >= TT) return;
    const float v = a[t]; int rank = 0;
    for (int i = 0; i < TT; ++i) { const float w = a[i]; rank += (w > v || (w == v && i < t)) ? 1 : 0; }
    if (rank < CAP) { IDX[(size_t)be * CAP + rank] = t; GATEV[(size_t)be * CAP + rank] = v; INV[(size_t)be * TT + t] = rank; }
    else INV[(size_t)be * TT + t] = -1;
}
__global__ void k_gather(const bf16_t* __restrict__ XN2, const int* __restrict__ IDX, bf16_t* __restrict__ XE) {
    const int r = blockIdx.x, e = blockIdx.y;
    uint4 v = make_uint4(0, 0, 0, 0);
    if (r < 2 * CAP) { const int b = r / CAP, slot = r % CAP; const int t = IDX[((size_t)b * NE + e) * CAP + slot]; v = *(const uint4*)(XN2 + (size_t)row_of(b, t) * DM + threadIdx.x * 8); }
    *(uint4*)(XE + ((size_t)e * ER + r) * DM + threadIdx.x * 8) = v;
}
__global__ void k_final(float* __restrict__ OUT, const bf16_t* __restrict__ YE, const int* __restrict__ INV, const float* __restrict__ gfin) {
    __shared__ float red[4];
    const int m = blockIdx.x, tid = threadIdx.x, b = m >> 13, t = (m & 8191) + NMETA;
    float v[4]; for (int i = 0; i < 4; ++i) v[i] = OUT[(size_t)m * DM + tid + 256 * i];
    for (int e = 0; e < NE; ++e) { const int slot = INV[((size_t)b * NE + e) * TT + t]; if (slot >= 0) { const bf16_t* y = YE + ((size_t)e * ER + b * CAP + slot) * DM; for (int i = 0; i < 4; ++i) v[i] += bf2f(y[tid + 256 * i]); } }
    float s = 0.f; for (int i = 0; i < 4; ++i) s += v[i] * v[i];
    s = block_sum256(s, red);
    const float r = rsqrtf(s * (1.f / DM) + RMS_EPS);
    for (int i = 0; i < 4; ++i) OUT[(size_t)m * DM + tid + 256 * i] = v[i] * r * gfin[tid + 256 * i];
}

extern "C" void kernel_launch(void* const* d_in, const int* in_sizes, int n_in, void* d_out, int out_size, void* d_ws, size_t ws_size, hipStream_t stream) {
    if (n_in != 27 || ws_size < WS_END || out_size != MX * DM) { fprintf(stderr, "kernel_launch: unexpected sizes n_in %d ws %zu out %d\n", n_in, ws_size, out_size); return; }
    const float* x = (const float*)d_in[0]; const float* meta = (const float*)d_in[1]; const float* norm1_g = (const float*)d_in[2]; const float* w_in = (const float*)d_in[3];
    const float* dec_f = (const float*)d_in[4]; const float* dec_b = (const float*)d_in[5]; const float* hg = (const float*)d_in[6]; const float* w_ret = (const float*)d_in[7];
    const float* cw = (const float*)d_in[8]; const float* cb = (const float*)d_in[9];
    const float* fw1 = (const float*)d_in[10]; const float* fb1 = (const float*)d_in[11]; const float* fw2 = (const float*)d_in[12]; const float* fb2 = (const float*)d_in[13];
    const float* fw3 = (const float*)d_in[14]; const float* fb3 = (const float*)d_in[15]; const float* ffq = (const float*)d_in[16]; const float* fw4 = (const float*)d_in[17];
    const float* skip = (const float*)d_in[18]; const float* w_hy = (const float*)d_in[19]; const float* w_o = (const float*)d_in[20]; const float* norm2_g = (const float*)d_in[21];
    const float* w_router = (const float*)d_in[22]; const float* w_eg = (const float*)d_in[23]; const float* w_eu = (const float*)d_in[24]; const float* w_ed = (const float*)d_in[25];
    const float* gfin = (const float*)d_in[26];
    unsigned char* ws = (unsigned char*)d_ws; unsigned char* dob = (unsigned char*)d_out;
    bf16_t* WRET = (bf16_t*)(ws + WS_WRET); bf16_t* WHY = (bf16_t*)(ws + WS_WHY); bf16_t* WO = (bf16_t*)(ws + WS_WO);
    bf16_t* XN = (bf16_t*)(ws + WS_XN); bf16_t* PROJ = (bf16_t*)(ws + WS_PROJ); bf16_t* S = (bf16_t*)(ws + WS_S); float* TMP = (float*)(ws + WS_S);
    bf16_t* ZT = (bf16_t*)(ws + WS_ZT); bf16_t* G = (bf16_t*)(ws + WS_G); bf16_t* AHY = (bf16_t*)(ws + WS_G); bf16_t* ARET = (bf16_t*)(ws + WS_ARET);
    bf16_t* WGU = (bf16_t*)(ws + WS_WGU); bf16_t* WD = (bf16_t*)(ws + WS_WD); bf16_t* XE = (bf16_t*)(ws + WS_XE); bf16_t* YE = (bf16_t*)(ws + WS_XE); bf16_t* HID = (bf16_t*)(ws + WS_HID);
    bf16_t* WIN = (bf16_t*)(dob + DO_WIN); float* ROPE = (float*)(dob + DO_ROPE); float* HDN = (float*)(dob + DO_HDN); bf16_t* YCT = (bf16_t*)(dob + DO_YCT);
    float* AFF = (float*)(ws + WS_MISC + MI_AFF); int* IDX = (int*)(ws + WS_MISC + MI_IDX); float* GATEV = (float*)(ws + WS_MISC + MI_GATE); int* INV = (int*)(ws + WS_MISC + MI_INV);
    float* H2M = (float*)(ws + WS_MISC + MI_H2M); float* H2 = (float*)d_out;

    k_wconv<<<dim3(32, 256, 1), dim3(32, 8), 0, stream>>>(w_in, nullptr, 1024, 8192, 8192, WIN, 1, 0, 0);
    k_wconv<<<dim3(32, 32, 1), dim3(32, 8), 0, stream>>>(w_ret, nullptr, 1024, 1024, 1024, WRET, 0, 0, 0);
    k_wconv<<<dim3(32, 32, 1), dim3(32, 8), 0, stream>>>(w_hy, nullptr, 1024, 1024, 1024, WHY, 0, 0, 0);
    k_wconv<<<dim3(32, 32, 1), dim3(32, 8), 0, stream>>>(w_o, nullptr, 1024, 1024, 1024, WO, 0, 0, 0);
    k_xn1<<<MROWS, 256, 0, stream>>>(x, meta, norm1_g, XN);
    k_rope<<<TT, 64, 0, stream>>>(ROPE);
    k_filt_hidden<<<TT, 64, 0, stream>>>(fw1, fb1, fw2, fb2, fw3, fb3, ffq, HDN);
    k_filt_out<<<dim3(4, TT), 256, 0, stream>>>(HDN, fw4, G);
    EpiArgs E{}; E.PROJ = PROJ; E.ROPE = ROPE; E.TMP = TMP; E.MIXED = XN; E.x = x; E.meta = meta; E.H2 = H2; E.H2M = H2M; E.HID = HID; E.YE = YE; E.GATEV = GATEV;
    launch_gemm_fast<1>(stream, XN, WIN, MX, NPROJ, 1024, 1 << 20, 0, 1, E);
    k_ret_state<<<dim3(8, 8, 2), 256, 0, stream>>>(PROJ, dec_f, dec_b, S);
    k_hy_prep<<<dim3(4, ZL, 2), 256, 0, stream>>>(PROJ, cw, cb, ZT);
    k_hy_conv<<<dim3(5, 1024), 256, 0, stream>>>(G, ZT, YCT);
    hipFuncSetAttribute((const void*)k_ret_out, hipFuncAttributeMaxDynamicSharedMemorySize, R2_LDS);
    k_ret_out<<<dim3(NCH, 8), 256, R2_LDS, stream>>>(PROJ, S, dec_f, dec_b, hg, ARET);
    k_hy_post<<<dim3(4, MROWS), 256, 0, stream>>>(PROJ, cw, cb, skip, YCT, AHY);
    launch_gemm_fast<2>(stream, ARET, WRET, MX, DM, 1024, 1 << 20, 0, 1, E);
    launch_gemm_fast<3>(stream, AHY, WHY, MX, DM, 1024, 1 << 20, 0, 1, E);
    launch_gemm_fast<4>(stream, XN, WO, MX, DM, 1024, 1 << 20, 0, 1, E);
    k_norm2_router<<<MROWS, 256, 0, stream>>>(H2, H2M, norm2_g, w_router, XN, AFF);
    k_wconv<<<dim3(32, 128, NE), dim3(32, 8), 0, stream>>>(w_eg, w_eu, 1024, 2048, 4096, WGU, 2, (size_t)1024 * 2048, (size_t)4096 * 1024);
    k_wconv<<<dim3(64, 32, NE), dim3(32, 8), 0, stream>>>(w_ed, nullptr, 2048, 1024, 1024, WD, 0, (size_t)2048 * 1024, (size_t)1024 * 2048);
    k_topk<<<dim3(33, 32), 256, 0, stream>>>(AFF, IDX, GATEV, INV);
    k_gather<<<dim3(ER, NE), 128, 0, stream>>>(XN, IDX, XE);
    launch_gemm_fast<5>(stream, XE, WGU, NE * ER, 4096, 1024, ER / 256, (size_t)4096 * 1024 * 2, 0, E);
    launch_gemm_fast<6>(stream, HID, WD, NE * ER, DM, 2048, ER / 256, (size_t)1024 * 2048 * 2, 0, E);
    k_final<<<MX, 256, 0, stream>>>(H2, YE, INV, gfin);
}
```

```cpp
#include <hip/hip_runtime.h>
#include <stdint.h>
#include <cstdio>

typedef unsigned short bf16_t;
__device__ __forceinline__ float bf2f(bf16_t v) { return __uint_as_float(((unsigned)v) << 16); }
__device__ __forceinline__ bf16_t f2bf(float f) { unsigned u = __float_as_uint(f); u += 0x7fffu + ((u >> 16) & 1u); return (bf16_t)(u >> 16); }

constexpr int NB = 2, SEQ = 8192, DM = 1024, NMETA = 16, TT = 8208;
constexpr int MX = 16384, MROWS = 16416, MP = 16640;
constexpr int NPROJ = 8192;
constexpr int C_Q = 0, C_K = 512, C_V = 1024, C_G = 2048, C_U = 3072, C_GA = 6144, C_GB = 7168;
constexpr int NE = 16, CAP = 1026, ER = 2304, FF = 2048;
constexpr int NCH = 65;
constexpr int GL = 16640;
constexpr int ZL = 8320;
constexpr float RMS_EPS = 1e-6f;

constexpr size_t MiB = 1u << 20;
constexpr size_t WS_CTL = 0;
constexpr size_t WS_WRET = 1 * MiB, WS_WHY = 3 * MiB, WS_WO = 5 * MiB;
constexpr size_t WS_MISC = 7 * MiB;
constexpr size_t WS_XN = 12 * MiB;
constexpr size_t WS_PROJ = 48 * MiB;
constexpr size_t WS_S = 308 * MiB;
constexpr size_t WS_ZT = 374 * MiB;
constexpr size_t WS_G = 407 * MiB;
constexpr size_t WS_ARET = 440 * MiB;
constexpr size_t WS_WGU = 48 * MiB;
constexpr size_t WS_WD = 176 * MiB;
constexpr size_t WS_XE = 240 * MiB;
constexpr size_t WS_HID = 312 * MiB;
constexpr size_t WS_END = 456 * MiB;
constexpr size_t DO_WIN = 0;
constexpr size_t DO_ROPE = 16 * MiB;
constexpr size_t DO_HDN = 22 * MiB;
constexpr size_t DO_YCT = 0;
constexpr size_t MI_AFF = 0;
constexpr size_t MI_IDX = 1 * MiB + 64 * 1024;
constexpr size_t MI_GATE = 1 * MiB + 256 * 1024;
constexpr size_t MI_INV = 2 * MiB;
constexpr size_t MI_H2M = 3 * MiB + 256 * 1024;

__device__ __forceinline__ int row_of(int b, int t) { return t < NMETA ? MX + b * NMETA + t : b * SEQ + (t - NMETA); }
__device__ __forceinline__ void bt_of(int m, int& b, int& t) { if (m < MX) { b = m >> 13; t = (m & 8191) + NMETA; } else { b = (m - MX) >> 4; t = (m - MX) & 15; } }

__global__ void k_wconv(const float* __restrict__ W0, const float* __restrict__ W1, int K, int N, int Nd, bf16_t* __restrict__ WT, int mode, size_t src_bstride, size_t dst_bstride) {
    __shared__ float tile[32][33];
    const int tx = threadIdx.x, ty = threadIdx.y;
    const int k0 = blockIdx.x * 32, r0 = blockIdx.y * 32, e = blockIdx.z;
    const int r = r0 + tx;
    const float* src = W0 + (size_t)e * src_bstride; int col = r;
    if (mode == 1) { if (r < 1024) { const int sec = r >> 7, rl = r & 127, g = rl >> 3, j = rl & 7; col = sec * 128 + (j < 4 ? 4 * g + j : 64 + 4 * g + (j - 4)); } }
    else if (mode == 2) { const int g = r >> 3, j = r & 7; if (j < 4) { col = 4 * g + j; } else { col = 4 * g + j - 4; src = W1 + (size_t)e * src_bstride; } }
    for (int i = 0; i < 4; ++i) { const int k = k0 + ty + 8 * i; tile[ty + 8 * i][tx] = src[(size_t)k * N + col]; }
    __syncthreads();
    bf16_t* dst = WT + (size_t)e * dst_bstride;
    for (int i = 0; i < 4; ++i) { const int rr = r0 + ty + 8 * i; dst[(size_t)rr * K + k0 + tx] = f2bf(tile[tx][ty + 8 * i]); }
}

__device__ __forceinline__ float block_sum256(float v, float* red) {
    for (int o = 32; o > 0; o >>= 1) v += __shfl_xor(v, o);
    const int w = threadIdx.x >> 6;
    __syncthreads();
    if ((threadIdx.x & 63) == 0) red[w] = v;
    __syncthreads();
    return red[0] + red[1] + red[2] + red[3];
}

__global__ void k_xn1(const float* __restrict__ x, const float* __restrict__ meta, const float* __restrict__ g, bf16_t* __restrict__ XN) {
    __shared__ float red[4];
    const int m = blockIdx.x;
    const float* src = m < MX ? x + (size_t)m * DM : meta + (size_t)((m - MX) & 15) * DM;
    float v[4]; float s = 0.f;
    for (int i = 0; i < 4; ++i) { v[i] = src[threadIdx.x + 256 * i]; s += v[i] * v[i]; }
    s = block_sum256(s, red);
    const float r = rsqrtf(s * (1.f / DM) + RMS_EPS);
    for (int i = 0; i < 4; ++i) XN[(size_t)m * DM + threadIdx.x + 256 * i] = f2bf(v[i] * r * g[threadIdx.x + 256 * i]);
}

__global__ void k_rope(float* __restrict__ ROPE) {
    const int t = blockIdx.x, i = threadIdx.x;
    const float inv = powf(10000.0f, -(float)i / 64.0f);
    const float ang = (float)t * inv;
    ROPE[(size_t)t * 128 + i] = cosf(ang);
    ROPE[(size_t)t * 128 + 64 + i] = sinf(ang);
}

__global__ void k_filt_hidden(const float* __restrict__ w1, const float* __restrict__ b1, const float* __restrict__ w2, const float* __restrict__ b2,
                              const float* __restrict__ w3, const float* __restrict__ b3, const float* __restrict__ fq, float* __restrict__ HDN) {
    __shared__ float feat[33]; __shared__ float ha[64]; __shared__ float hb[64];
    const int t = blockIdx.x, j = threadIdx.x;
    if (j == 0) feat[0] = (float)t / (float)(TT - 1);
    if (j < 16) {
        const float fr = 1e-4f + (float)j * ((15.0f - 1e-4f) / 15.0f);
        const float ang = (2.0f * 3.14159265358979323846f * (float)t / (float)TT) * fr;
        feat[1 + j] = cosf(ang); feat[17 + j] = -sinf(ang);
    }
    __syncthreads();
    const float f = fq[j];
    float a = b1[j];
    for (int i = 0; i < 33; ++i) a += feat[i] * w1[i * 64 + j];
    ha[j] = sinf(f * a);
    __syncthreads();
    a = b2[j];
    for (int i = 0; i < 64; ++i) a += ha[i] * w2[i * 64 + j];
    hb[j] = sinf(f * a);
    __syncthreads();
    a = b3[j];
    for (int i = 0; i < 64; ++i) a += hb[i] * w3[i * 64 + j];
    HDN[(size_t)t * 64 + j] = sinf(f * a);
}

__global__ void k_filt_out(const float* __restrict__ HDN, const float* __restrict__ w4, bf16_t* __restrict__ G) {
    const int c = blockIdx.x * 256 + threadIdx.x, t = blockIdx.y;
    __shared__ float h[64];
    if (threadIdx.x < 64) h[threadIdx.x] = HDN[(size_t)t * 64 + threadIdx.x];
    __syncthreads();
    float ff = 0.f, fb = 0.f;
    for (int j = 0; j < 64; ++j) { ff += h[j] * w4[j * 2048 + c]; fb += h[j] * w4[j * 2048 + 1024 + c]; }
    const float mind = logf(1e-2f) / 1.5f, maxd = logf(1e-2f) / 0.3f;
    const float delta = mind + (float)c * ((maxd - mind) / 1023.0f);
    const float tn = (float)t / (float)(TT - 1);
    const float win = expf(-tn * fabsf(delta));
    G[(size_t)c * GL + TT + t] = f2bf(ff * win);
    if (t >= 1) G[(size_t)c * GL + TT - t] = f2bf(fb * win);
    if (t == 0) { G[(size_t)c * GL] = 0; for (int i = 2 * TT; i < GL; ++i) G[(size_t)c * GL + i] = 0; }
}

struct EpiArgs {
    bf16_t* PROJ; const float* ROPE;
    float* TMP; bf16_t* MIXED;
    const float* x; const float* meta; float* H2; float* H2M;
    bf16_t* HID; bf16_t* YE; const float* GATEV;
};
typedef float f32x4 __attribute__((ext_vector_type(4)));
typedef float f32x16 __attribute__((ext_vector_type(16)));
typedef unsigned u32x4 __attribute__((ext_vector_type(4)));
typedef unsigned u32x2 __attribute__((ext_vector_type(2)));
typedef short bf16x8 __attribute__((ext_vector_type(8)));
__device__ __forceinline__ unsigned pk2(float lo, float hi) { return (unsigned)f2bf(lo) | ((unsigned)f2bf(hi) << 16); }
__device__ __forceinline__ float lo16(unsigned w) { return __uint_as_float(w << 16); }
__device__ __forceinline__ float hi16(unsigned w) { return __uint_as_float(w & 0xffff0000u); }
__device__ __forceinline__ float sigm(float x) { return 1.f / (1.f + __expf(-x)); }
__device__ __forceinline__ u32x4 pack8(f32x4 a, f32x4 b) { u32x4 w; w.x = pk2(a.x, a.y); w.y = pk2(a.z, a.w); w.z = pk2(b.x, b.y); w.w = pk2(b.z, b.w); return w; }
__device__ __forceinline__ void epi8v(int mode, const EpiArgs& E, int mg, int c0, f32x4 a0, f32x4 a1) {
    if (mode == 1) {
        bf16_t* dst = E.PROJ + (size_t)mg * NPROJ + c0;
        if (c0 < C_V) {
            int b, t; bt_of(mg, b, t);
            const int i0 = ((c0 & 127) >> 3) * 4;
            const float sc = c0 >= C_K ? 0.08838834764831845f : 1.0f;
            const f32x4 cs = *(const f32x4*)(E.ROPE + (size_t)t * 128 + i0), sn = *(const f32x4*)(E.ROPE + (size_t)t * 128 + 64 + i0);
            const f32x4 o1 = (a0 * cs - a1 * sn) * sc, o2 = (a0 * sn + a1 * cs) * sc;
            *(u32x4*)dst = pack8(o1, o2);
        } else if (c0 < C_G || (c0 >= C_U && c0 < C_GA)) { *(u32x4*)dst = pack8(a0, a1); }
        else if (c0 < C_U) { f32x4 s0, s1; for (int j = 0; j < 4; ++j) { s0[j] = a0[j] * sigm(a0[j]); s1[j] = a1[j] * sigm(a1[j]); } *(u32x4*)dst = pack8(s0, s1); }
        else { f32x4 s0, s1; for (int j = 0; j < 4; ++j) { s0[j] = sigm(a0[j]); s1[j] = sigm(a1[j]); } *(u32x4*)dst = pack8(s0, s1); }
    } else if (mode == 2) {
        const u32x4 g = *(const u32x4*)(E.PROJ + (size_t)mg * NPROJ + C_GA + c0);
        float* dst = E.TMP + (size_t)mg * DM + c0;
        *(f32x4*)dst = (f32x4){lo16(g.x) * a0.x, hi16(g.x) * a0.y, lo16(g.y) * a0.z, hi16(g.y) * a0.w};
        *(f32x4*)(dst + 4) = (f32x4){lo16(g.z) * a1.x, hi16(g.z) * a1.y, lo16(g.w) * a1.z, hi16(g.w) * a1.w};
    } else if (mode == 3) {
        const u32x4 g = *(const u32x4*)(E.PROJ + (size_t)mg * NPROJ + C_GB + c0);
        const float* tp = E.TMP + (size_t)mg * DM + c0;
        const f32x4 t0 = *(const f32x4*)tp, t1 = *(const f32x4*)(tp + 4);
        const f32x4 o0 = t0 + (f32x4){lo16(g.x) * a0.x, hi16(g.x) * a0.y, lo16(g.y) * a0.z, hi16(g.y) * a0.w};
        const f32x4 o1 = t1 + (f32x4){lo16(g.z) * a1.x, hi16(g.z) * a1.y, lo16(g.w) * a1.z, hi16(g.w) * a1.w};
        *(u32x4*)(E.MIXED + (size_t)mg * DM + c0) = pack8(o0, o1);
    } else if (mode == 4) {
        const float* rs; float* dst;
        if (mg < MX) { rs = E.x + (size_t)mg * DM + c0; dst = E.H2 + (size_t)mg * DM + c0; }
        else { rs = E.meta + (size_t)((mg - MX) & 15) * DM + c0; dst = E.H2M + (size_t)(mg - MX) * DM + c0; }
        *(f32x4*)dst = *(const f32x4*)rs + a0; *(f32x4*)(dst + 4) = *(const f32x4*)(rs + 4) + a1;
    } else if (mode == 5) {
        u32x2 w; w.x = pk2(a0.x * sigm(a0.x) * a1.x, a0.y * sigm(a0.y) * a1.y); w.y = pk2(a0.z * sigm(a0.z) * a1.z, a0.w * sigm(a0.w) * a1.w);
        *(u32x2*)(E.HID + (size_t)mg * FF + (c0 >> 1)) = w;
    } else {
        const int e = mg / ER, ml = mg - e * ER;
        const float gt = ml < 2 * CAP ? E.GATEV[((size_t)(ml / CAP) * NE + e) * CAP + (ml % CAP)] : 0.f;
        *(u32x4*)(E.YE + (size_t)mg * DM + c0) = pack8(a0 * gt, a1 * gt);
    }
}

__global__ void __launch_bounds__(256) k_gemm(const bf16_t* __restrict__ A, const bf16_t* __restrict__ Bt, int M, int N, int K, size_t a_bstride, size_t b_bstride, int mode, EpiArgs E) {
    __shared__ float As[32][128 + 4];
    __shared__ float Bs[32][64 + 4];
    const int tid = threadIdx.x, e = blockIdx.z;
    const int m0 = blockIdx.y * 128, n0 = blockIdx.x * 64;
    A += (size_t)e * a_bstride; Bt += (size_t)e * b_bstride;
    const int ty = tid >> 3, tx = tid & 7;
    float acc[4][8];
    for (int i = 0; i < 4; ++i) for (int j = 0; j < 8; ++j) acc[i][j] = 0.f;
    const int ar = tid >> 1, ak = (tid & 1) * 16;
    const int br = tid >> 2, bk = (tid & 3) * 8;
    for (int k0 = 0; k0 < K; k0 += 32) {
        {
            const int m = m0 + ar;
            if (m < M) { const uint4* p = (const uint4*)(A + (size_t)m * K + k0 + ak); const uint4 v0 = p[0], v1 = p[1];
                const unsigned w[8] = {v0.x, v0.y, v0.z, v0.w, v1.x, v1.y, v1.z, v1.w};
                for (int q = 0; q < 8; ++q) { As[ak + 2 * q][ar] = __uint_as_float(w[q] << 16); As[ak + 2 * q + 1][ar] = __uint_as_float(w[q] & 0xffff0000u); } }
            else { for (int q = 0; q < 16; ++q) As[ak + q][ar] = 0.f; }
            const uint4 v = *(const uint4*)(Bt + (size_t)(n0 + br) * K + k0 + bk);
            const unsigned w[4] = {v.x, v.y, v.z, v.w};
            for (int q = 0; q < 4; ++q) { Bs[bk + 2 * q][br] = __uint_as_float(w[q] << 16); Bs[bk + 2 * q + 1][br] = __uint_as_float(w[q] & 0xffff0000u); }
        }
        __syncthreads();
#pragma unroll 8
        for (int k = 0; k < 32; ++k) {
            float a[4], b[8];
            for (int i = 0; i < 4; ++i) a[i] = As[k][ty + 32 * i];
            for (int j = 0; j < 8; ++j) b[j] = Bs[k][tx * 8 + j];
            for (int i = 0; i < 4; ++i) for (int j = 0; j < 8; ++j) acc[i][j] += a[i] * b[j];
        }
        __syncthreads();
    }
    for (int i = 0; i < 4; ++i) { const int m = m0 + ty + 32 * i; if (m < M) epi8v(mode, E, (mode >= 5 ? e * ER : 0) + m, n0 + tx * 8, (f32x4){acc[i][0], acc[i][1], acc[i][2], acc[i][3]}, (f32x4){acc[i][4], acc[i][5], acc[i][6], acc[i][7]}); }
}

namespace pg8 {
#define PG8_LAS __attribute__((address_space(3)))
typedef unsigned short bf16_t;
typedef short bf16x8 __attribute__((ext_vector_type(8)));
typedef float f32x4 __attribute__((ext_vector_type(4)));
typedef unsigned u32x4 __attribute__((ext_vector_type(4)));
constexpr int BM = 256, BK = 64, HALF = 128, HTB = HALF * BK * 2  , STAGE_BYTES = 8 * HTB, NXCD = 8, WGM = 8;

__host__ __device__ __forceinline__ int lds_byte(int r, int c) { const int st = (r >> 4) * 2 + (c >> 5), rr = r & 15, cc = c & 31, ob = rr * 64 + cc * 2; return st * 1024 + (ob ^ (((ob >> 9) & 1) << 5)); }
__host__ __device__ __forceinline__ void stage_rc(int b, int& R, int& C) { const int st = b / 1024, sb = b % 1024, swz = sb ^ (((sb >> 9) & 1) << 5); R = (st >> 1) * 16 + swz / 64; C = (st & 1) * 32 + (swz % 64) / 2; }
__host__ __device__ __forceinline__ int perm32(int rho) { const int n = rho >> 4, i = rho & 15; return 8 * (i >> 2) + 4 * n + (i & 3); }

struct Unit { int pm, pn; };
struct Gemm { const bf16_t* A; const bf16_t* Bt; int M, N, K; int gt; size_t gstride; };

struct StaticOrder {
    int nM, nN, nwg, G, c;
    __host__ __device__ void init(int M, int N, int G_, int c_) { nM = M / BM; nN = N / BM; nwg = nM * nN; G = G_; c = c_; }
    __host__ __device__ bool next(int i, Unit& u) const {
        const long L = (long)i * G + c; if (L >= nwg) return false;
        int wgid = (int)L; { const int q = nwg / NXCD, r = nwg % NXCD, xcd = wgid % NXCD, off = wgid / NXCD; wgid = (xcd < r ? xcd * (q + 1) : r * (q + 1) + (xcd - r) * q) + off; }
        const int nig = WGM * nN, gid = wgid / nig, fm = gid * WGM, gsz = (nM - fm) < WGM ? (nM - fm) : WGM;
        u.pm = fm + ((wgid % nig) % gsz); u.pn = (wgid % nig) / gsz; return true;
    }
    __device__ __forceinline__ void a_ready(const Unit&) const {}
    __device__ __forceinline__ void done(const Unit&) const {}
};

__device__ __forceinline__ unsigned cvt_pk_bf16(float lo, float hi) { unsigned r; asm volatile("v_cvt_pk_bf16_f32 %0, %1, %2" : "=v"(r) : "v"(lo), "v"(hi)); return r; }
template <class Epi, class Sched, bool ALIGN_EPI = false, bool SP2 = false>
__device__ __forceinline__ void gemm_phase(PG8_LAS unsigned char* lds, const Gemm g, const Sched& S, const Epi& E) {
    const int tid = threadIdx.x, wid = __builtin_amdgcn_readfirstlane(tid >> 6), lane = tid & 63, wr = wid >> 2, wc = wid & 3, fr = lane & 15, fq = lane >> 4;
    const int K = g.K, nt = K / BK;
    unsigned voffA[2], voffB[2];
#pragma unroll
    for (int i = 0; i < 2; ++i) { int R, C; stage_rc(tid * 16 + i * 8192, R, C); const int Rb = Epi::PERM ? ((R & ~31) + perm32(R & 31)) : R;
        voffA[i] = (unsigned)(R * K + C) * 2u; voffB[i] = (unsigned)(Rb * K + C) * 2u; }
    const size_t kstep = (size_t)(BK * 2);
    const size_t hstep = (size_t)HALF * K * 2;
    const size_t tstep = 2 * hstep;
    const unsigned ldsw = (unsigned)wid * 1024u;
    const int aoff = lds_byte(wr * 64 + fr, fq * 8), boff = lds_byte(wc * 32 + fr, fq * 8);
#define PG8_SA(b, h) (((b) * 2 + (h)) * HTB)
#define PG8_SB(b, h) ((4 + (b) * 2 + (h)) * HTB)
#define PG8_STAGE(bufoff, gbase, voff) do { _Pragma("unroll") for (int _i = 0; _i < 2; ++_i) \
        __builtin_amdgcn_global_load_lds((const unsigned*)((const char*)(gbase) + (voff)[_i]), (PG8_LAS unsigned*)(lds + (bufoff) + ldsw + _i * 8192), 16, 0, 0); } while (0)
#define PG8_LDA(dst, b, h) do { _Pragma("unroll") for (int m = 0; m < 4; ++m) _Pragma("unroll") for (int k = 0; k < 2; ++k) dst[m][k] = *(const PG8_LAS bf16x8*)(lds + PG8_SA(b, h) + aoff + m * 2048 + k * 1024); } while (0)
#define PG8_LDB(dst, b, h) do { _Pragma("unroll") for (int n = 0; n < 2; ++n) _Pragma("unroll") for (int k = 0; k < 2; ++k) dst[n][k] = *(const PG8_LAS bf16x8*)(lds + PG8_SB(b, h) + boff + n * 2048 + k * 1024); } while (0)
#define PG8_MMA(ai, bj, At, Bt) do { __builtin_amdgcn_s_setprio(1); _Pragma("unroll") for (int m = 0; m < 4; ++m) _Pragma("unroll") for (int n = 0; n < 2; ++n) _Pragma("unroll") for (int k = 0; k < 2; ++k) \
        acc[ai][bj][m][n] = __builtin_amdgcn_mfma_f32_16x16x32_bf16(Bt[n][k], At[m][k], acc[ai][bj][m][n], 0, 0, 0); __builtin_amdgcn_s_setprio(0); } while (0)
#define PG8_WAIT_V(n) asm volatile("s_waitcnt vmcnt(" #n ")" ::: "memory")
#define PG8_WAIT_L(n) asm volatile("s_waitcnt lgkmcnt(" #n ")" ::: "memory")
#define PG8_BAR __builtin_amdgcn_s_barrier()
#define PG8_SCHED __builtin_amdgcn_sched_barrier(0)
    Unit cur, nxt; int ui = 0;
    if (!S.next(0, cur)) return;
    f32x4 acc[2][2][4][2];
#pragma unroll
    for (int a = 0; a < 2; ++a)
#pragma unroll
        for (int b = 0; b < 2; ++b)
#pragma unroll
            for (int m = 0; m < 4; ++m)
#pragma unroll
                for (int n = 0; n < 2; ++n) acc[a][b][m][n] = (f32x4){0.f, 0.f, 0.f, 0.f};
    bf16x8 At[4][2], B0[2][2], B1[2][2];
    const char* cA = (const char*)g.A + (size_t)cur.pm * tstep; const char* cB = (const char*)g.Bt + (size_t)(cur.pm / g.gt) * g.gstride + (size_t)cur.pn * tstep;
    S.a_ready(cur);
    if constexpr (SP2) {
        PG8_STAGE(PG8_SB(0, 0), cB, voffB); PG8_STAGE(PG8_SB(0, 1), cB + hstep, voffB); PG8_STAGE(PG8_SA(0, 0), cA, voffA); PG8_STAGE(PG8_SA(0, 1), cA + hstep, voffA);
        if (wr == 1) PG8_BAR;
        PG8_WAIT_V(2); PG8_BAR;
        PG8_STAGE(PG8_SB(1, 0), cB + kstep, voffB); PG8_STAGE(PG8_SA(1, 0), cA + kstep, voffA); PG8_STAGE(PG8_SB(1, 1), cB + hstep + kstep, voffB);
        PG8_WAIT_V(6); PG8_BAR;
    } else {
        PG8_STAGE(PG8_SB(0, 0), cB, voffB); PG8_STAGE(PG8_SA(0, 0), cA, voffA); PG8_STAGE(PG8_SB(0, 1), cB + hstep, voffB); PG8_STAGE(PG8_SA(0, 1), cA + hstep, voffA);
        if (wr == 1) PG8_BAR;
        PG8_WAIT_V(4); PG8_BAR;
        PG8_STAGE(PG8_SB(1, 0), cB + kstep, voffB); PG8_STAGE(PG8_SA(1, 0), cA + kstep, voffA); PG8_STAGE(PG8_SB(1, 1), cB + hstep + kstep, voffB);
        PG8_WAIT_V(6); PG8_BAR;
    }
    for (;;) {
        const bool has_next = S.next(ui + 1, nxt);
        const char* nA = has_next ? (const char*)g.A + (size_t)nxt.pm * tstep : cA; const char* nB = has_next ? (const char*)g.Bt + (size_t)(nxt.pm / g.gt) * g.gstride + (size_t)nxt.pn * tstep : cB;
        for (int t = 0; t < nt; t += 2) {
            const bool last = (t == nt - 2);
            const char* a1 = cA + (size_t)(t + 1) * kstep;
            const char* a2 = last ? nA : cA + (size_t)(t + 2) * kstep; const char* b2 = last ? nB : cB + (size_t)(t + 2) * kstep;
            const char* a3 = a2 + kstep; const char* b3 = b2 + kstep;
            if (last && has_next) S.a_ready(nxt);
            if constexpr (SP2) {
            PG8_LDB(B0, 0, 0); PG8_LDB(B1, 0, 1); PG8_SCHED; PG8_LDA(At, 0, 0); PG8_STAGE(PG8_SA(1, 1), a1 + hstep, voffA);
            PG8_WAIT_V(8); PG8_WAIT_L(0); PG8_BAR; PG8_MMA(0, 0, At, B0); PG8_MMA(0, 1, At, B1); PG8_BAR; PG8_SCHED;
            PG8_LDA(At, 0, 1); PG8_STAGE(PG8_SB(0, 0), b2, voffB); PG8_STAGE(PG8_SB(0, 1), b2 + hstep, voffB); PG8_STAGE(PG8_SA(0, 0), a2, voffA);
            PG8_WAIT_V(8); PG8_WAIT_L(0); PG8_BAR; PG8_MMA(1, 0, At, B0); PG8_MMA(1, 1, At, B1); PG8_BAR; PG8_SCHED;
            PG8_LDB(B0, 1, 0); PG8_LDB(B1, 1, 1); PG8_SCHED; PG8_LDA(At, 1, 0); PG8_STAGE(PG8_SA(0, 1), a2 + hstep, voffA);
            PG8_WAIT_V(8); PG8_WAIT_L(0); PG8_BAR; PG8_MMA(0, 0, At, B0); PG8_MMA(0, 1, At, B1); PG8_BAR; PG8_SCHED;
            PG8_LDA(At, 1, 1); PG8_STAGE(PG8_SB(1, 0), b3, voffB); PG8_STAGE(PG8_SB(1, 1), b3 + hstep, voffB); PG8_STAGE(PG8_SA(1, 0), a3, voffA);
            PG8_WAIT_V(8); PG8_WAIT_L(0); PG8_BAR; PG8_MMA(1, 0, At, B0); PG8_MMA(1, 1, At, B1); PG8_BAR; PG8_SCHED;
            } else {
            PG8_LDB(B0, 0, 0); PG8_SCHED; PG8_LDA(At, 0, 0); PG8_STAGE(PG8_SA(1, 1), a1 + hstep, voffA);
            PG8_WAIT_L(8); PG8_BAR; PG8_WAIT_L(0); PG8_MMA(0, 0, At, B0); PG8_BAR; PG8_SCHED;
            PG8_LDB(B1, 0, 1); PG8_STAGE(PG8_SB(0, 0), b2, voffB);
            PG8_BAR; PG8_WAIT_L(0); PG8_MMA(0, 1, At, B1); PG8_BAR;
            PG8_LDA(At, 0, 1); PG8_STAGE(PG8_SA(0, 0), a2, voffA);
            PG8_BAR; PG8_WAIT_L(0); PG8_MMA(1, 0, At, B0); PG8_BAR; PG8_SCHED;
            PG8_STAGE(PG8_SB(0, 1), b2 + hstep, voffB);
            PG8_WAIT_V(6); PG8_BAR; PG8_MMA(1, 1, At, B1); PG8_BAR;
            PG8_LDB(B0, 1, 0); PG8_SCHED; PG8_LDA(At, 1, 0); PG8_STAGE(PG8_SA(0, 1), a2 + hstep, voffA);
            PG8_WAIT_L(8); PG8_BAR; PG8_WAIT_L(0); PG8_MMA(0, 0, At, B0); PG8_BAR; PG8_SCHED;
            PG8_LDB(B1, 1, 1); PG8_STAGE(PG8_SB(1, 0), b3, voffB);
            PG8_BAR; PG8_WAIT_L(0); PG8_MMA(0, 1, At, B1); PG8_BAR;
            PG8_LDA(At, 1, 1); PG8_STAGE(PG8_SA(1, 0), a3, voffA);
            PG8_BAR; PG8_WAIT_L(0); PG8_MMA(1, 0, At, B0); PG8_BAR; PG8_SCHED;
            PG8_STAGE(PG8_SB(1, 1), b3 + hstep, voffB);
            PG8_WAIT_V(6); PG8_BAR; PG8_MMA(1, 1, At, B1); PG8_BAR;
            }
        }
        if constexpr (ALIGN_EPI) { if (wr == 0) PG8_BAR; }
        if constexpr (!Epi::AFTER_DRAIN) { E(acc, cur, wr, wc, fr, fq); S.done(cur); }
        if (!has_next) break;
#pragma unroll
        for (int a = 0; a < 2; ++a)
#pragma unroll
            for (int b = 0; b < 2; ++b)
#pragma unroll
                for (int m = 0; m < 4; ++m)
#pragma unroll
                    for (int n = 0; n < 2; ++n) acc[a][b][m][n] = (f32x4){0.f, 0.f, 0.f, 0.f};
        cur = nxt; cA = nA; cB = nB; ++ui;
        if constexpr (ALIGN_EPI) { if (wr == 1) PG8_BAR; }
    }
    PG8_WAIT_V(0);
    if constexpr (!ALIGN_EPI) { if (wr == 0) PG8_BAR; }
    PG8_BAR;
    if constexpr (Epi::AFTER_DRAIN) { E.fused(acc, cur, wr, wc, fr, fq, lds, wid, lane); S.done(cur); }
#undef PG8_SA
#undef PG8_SB
#undef PG8_STAGE
#undef PG8_LDA
#undef PG8_LDB
#undef PG8_MMA
#undef PG8_WAIT_V
#undef PG8_WAIT_L
#undef PG8_BAR
#undef PG8_SCHED
}
}

#define LAS __attribute__((address_space(3)))
template <int MODE> struct EpiFast {
    static constexpr bool PERM = true, AFTER_DRAIN = false;
    EpiArgs E;
    __device__ __forceinline__ void operator()(const pg8::f32x4 (&acc)[2][2][4][2], const pg8::Unit& u, int wr, int wc, int fr, int fq) const {
        const int row0 = u.pm * 256 + wr * 64 + fr, col0 = u.pn * 256 + wc * 32 + 8 * fq;
#pragma unroll
        for (int ai = 0; ai < 2; ++ai)
#pragma unroll
            for (int m = 0; m < 4; ++m)
#pragma unroll
                for (int bj = 0; bj < 2; ++bj) epi8v(MODE, E, row0 + ai * 128 + m * 16, col0 + bj * 128, acc[ai][bj][m][0], acc[ai][bj][m][1]);
    }
};
__device__ __forceinline__ void side_tile(int mode, const EpiArgs& E, const bf16_t* __restrict__ A, int erow0, const bf16_t* __restrict__ Bt, int K, int n0) {
    const int l = threadIdx.x & 63, i = l & 31, h = l >> 5;
    const int g = i >> 3, hh = (i >> 2) & 1, q = i & 3, L = 8 * (2 * hh + (g >> 1)) + 4 * (g & 1) + q;
    const bf16_t* wp = Bt + (size_t)(n0 + L) * K + 8 * h;
    const bf16_t* xp = A + (size_t)i * K + 8 * h;
    f32x16 acc; for (int r = 0; r < 16; ++r) acc[r] = 0.f;
#pragma unroll 8
    for (int k0 = 0; k0 < K; k0 += 16) { const bf16x8 wf = *(const bf16x8*)(wp + k0), xf = *(const bf16x8*)(xp + k0); acc = __builtin_amdgcn_mfma_f32_32x32x16_bf16(wf, xf, acc, 0, 0, 0); }
    epi8v(mode, E, erow0 + i, n0 + 16 * h, (f32x4){acc[0], acc[1], acc[2], acc[3]}, (f32x4){acc[4], acc[5], acc[6], acc[7]});
    epi8v(mode, E, erow0 + i, n0 + 16 * h + 8, (f32x4){acc[8], acc[9], acc[10], acc[11]}, (f32x4){acc[12], acc[13], acc[14], acc[15]});
}
struct GemmArgs { const bf16_t* A; const bf16_t* Bt; int M, N, K, gt; size_t gstride; int side; int pad; };
constexpr int GEMM_LDS = 131072 + 1024;
template <int MODE> __device__ __forceinline__ void gemm_fast_body(LAS unsigned char* lds, const GemmArgs& ga, const EpiArgs& E) {
    if (ga.side) {
        const int wid = threadIdx.x >> 6, nt = ga.N / 32;
        for (int t = wid * gridDim.x + blockIdx.x; t < nt; t += 8 * gridDim.x) side_tile(MODE, E, ga.A + (size_t)MX * ga.K, MX, ga.Bt, ga.K, t * 32);
        asm volatile("s_waitcnt vmcnt(0)" ::: "memory");
    }
    pg8::Gemm g{ga.A, ga.Bt, ga.M, ga.N, ga.K, ga.gt, ga.gstride};
    pg8::StaticOrder S; S.init(ga.M, ga.N, (int)gridDim.x, (int)blockIdx.x);
    EpiFast<MODE> Ep{E};
    pg8::gemm_phase<EpiFast<MODE>, pg8::StaticOrder, true, true>(lds, g, S, Ep);
}
template <int MODE> __global__ void __launch_bounds__(512, 2) k_gemm_fast(GemmArgs ga, EpiArgs E) {
    extern __shared__ __attribute__((aligned(16))) unsigned char smem_g[];
    gemm_fast_body<MODE>((LAS unsigned char*)smem_g, ga, E);
}
template <int MODE> static void launch_gemm_fast(hipStream_t stream, const bf16_t* A, const bf16_t* Bt, int M, int N, int K, int gt, size_t gstride, int side, const EpiArgs& E) {
    (void)hipFuncSetAttribute((const void*)k_gemm_fast<MODE>, hipFuncAttributeMaxDynamicSharedMemorySize, GEMM_LDS);
    GemmArgs ga{}; ga.A = A; ga.Bt = Bt; ga.M = M; ga.N = N; ga.K = K; ga.gt = gt; ga.gstride = gstride; ga.side = side;
    k_gemm_fast<MODE><<<256, 512, GEMM_LDS, stream>>>(ga, E);
}

__device__ __forceinline__ float log_sigmoid(float x) { return -log1pf(expf(-x)); }
__device__ __forceinline__ int chunk_row(int b, int n, int c) { return n == 0 ? (c >= 112 ? MX + b * 16 + (c - 112) : -1) : b * SEQ + 128 * (n - 1) + c; }

__global__ void __launch_bounds__(256) k_ret_state(const bf16_t* __restrict__ PROJ, const float* __restrict__ dec_f, const float* __restrict__ dec_b, bf16_t* __restrict__ S) {
    __shared__ bf16_t Ks[128][128];
    __shared__ float Vs[128][32];
    const int sl = blockIdx.x, bh = blockIdx.y, dir = blockIdx.z, b = bh >> 2, h = bh & 3, tid = threadIdx.x;
    const float lg = log_sigmoid(dir == 0 ? dec_f[h] : dec_b[h]);
    const float dec = expf(lg * 128.f);
    const int dk = tid & 127, hf = tid >> 7;
    float st[16]; for (int j = 0; j < 16; ++j) st[j] = 0.f;
    for (int step = 0; step < NCH; ++step) {
        const int n = dir == 0 ? step : NCH - 1 - step;
        bf16_t* dst = S + ((((size_t)dir * 8 + bh) * NCH + n) * 128 + dk) * 256 + sl * 32 + hf * 16;
        for (int j = 0; j < 16; ++j) dst[j] = f2bf(st[j]);
        __syncthreads();
        for (int i = tid; i < 128 * 128; i += 256) { const int c = i >> 7, d = i & 127; const int r = chunk_row(b, n, c); Ks[c][d] = r < 0 ? (bf16_t)0 : PROJ[(size_t)r * NPROJ + C_K + h * 128 + d]; }
        for (int i = tid; i < 128 * 32; i += 256) { const int c = i >> 5, d = i & 31; const int r = chunk_row(b, n, c);
            const float w = dir == 0 ? expf(lg * (float)(127 - c)) : expf(lg * (float)c);
            Vs[c][d] = r < 0 ? 0.f : bf2f(PROJ[(size_t)r * NPROJ + C_V + h * 256 + sl * 32 + d]) * w; }
        __syncthreads();
        float a[16]; for (int j = 0; j < 16; ++j) a[j] = 0.f;
        for (int c = 0; c < 128; ++c) { const float kv = bf2f(Ks[c][dk]); for (int j = 0; j < 16; ++j) a[j] += kv * Vs[c][hf * 16 + j]; }
        for (int j = 0; j < 16; ++j) st[j] = st[j] * dec + a[j];
    }
}

constexpr int QS_STRIDE = 130;
constexpr int R2_LDS = 2 * 128 * QS_STRIDE * 2 + 128 * 128 * 4 + 64 * 4;
__global__ void __launch_bounds__(256) k_ret_out(const bf16_t* __restrict__ PROJ, const bf16_t* __restrict__ S, const float* __restrict__ dec_f, const float* __restrict__ dec_b,
                                                const float* __restrict__ hg, bf16_t* __restrict__ ARET) {
    extern __shared__ __attribute__((aligned(16))) unsigned char smem[];
    bf16_t* Qs = (bf16_t*)smem; bf16_t* Ks = Qs + 128 * QS_STRIDE; float* SC = (float*)(Ks + 128 * QS_STRIDE); float* red = SC + 128 * 128;
    const int n = blockIdx.x, bh = blockIdx.y, b = bh >> 2, h = bh & 3, tid = threadIdx.x;
    const float lf = log_sigmoid(dec_f[h]), lb = log_sigmoid(dec_b[h]);
    for (int i = tid; i < 128 * 128; i += 256) { const int c = i >> 7, d = i & 127; const int r = chunk_row(b, n, c);
        Qs[c * QS_STRIDE + d] = r < 0 ? (bf16_t)0 : PROJ[(size_t)r * NPROJ + C_Q + h * 128 + d];
        Ks[c * QS_STRIDE + d] = r < 0 ? (bf16_t)0 : PROJ[(size_t)r * NPROJ + C_K + h * 128 + d]; }
    __syncthreads();
    {
        const int j = tid & 127, ib = (tid >> 7) * 64;
        for (int i = ib; i < ib + 64; ++i) {
            float s = 0.f;
            for (int d = 0; d < 128; ++d) s += bf2f(Qs[i * QS_STRIDE + d]) * bf2f(Ks[j * QS_STRIDE + d]);
            const float mk = i >= j ? expf(lf * (float)(i - j)) : expf(lb * (float)(j - i));
            SC[i * 128 + j] = s * mk;
        }
    }
    __syncthreads();
    const int dv = tid;
    const bf16_t* Sf = S + (((size_t)0 * 8 + bh) * NCH + n) * 128 * 256;
    const bf16_t* Sb = S + (((size_t)1 * 8 + bh) * NCH + n) * 128 * 256;
    for (int grp = (n == 0 ? 7 : 0); grp < 8; ++grp) {
        float acc[16]; for (int i = 0; i < 16; ++i) acc[i] = 0.f;
        for (int j = 0; j < 128; ++j) { const int r = chunk_row(b, n, j); if (r < 0) continue; const float v = bf2f(PROJ[(size_t)r * NPROJ + C_V + h * 256 + dv]);
            for (int i = 0; i < 16; ++i) acc[i] += SC[(grp * 16 + i) * 128 + j] * v; }
        float qf[16], qb[16];
        for (int i = 0; i < 16; ++i) { const int ii = grp * 16 + i; qf[i] = expf(lf * (float)(ii + 1)); qb[i] = expf(lb * (float)(128 - ii)); }
        for (int d = 0; d < 128; ++d) { const float sf = bf2f(Sf[(size_t)d * 256 + dv]), sb = bf2f(Sb[(size_t)d * 256 + dv]);
            for (int i = 0; i < 16; ++i) { const float q = bf2f(Qs[(grp * 16 + i) * QS_STRIDE + d]); acc[i] += q * (qf[i] * sf + qb[i] * sb); } }
        float ss[16];
        for (int i = 0; i < 16; ++i) { float v = acc[i] * acc[i]; for (int o = 32; o > 0; o >>= 1) v += __shfl_xor(v, o); ss[i] = v; }
        __syncthreads();
        if ((tid & 63) == 0) for (int i = 0; i < 16; ++i) red[(tid >> 6) * 16 + i] = ss[i];
        __syncthreads();
        for (int i = 0; i < 16; ++i) {
            const float ms = (red[i] + red[16 + i] + red[32 + i] + red[48 + i]) * (1.f / 256.f);
            const int r = chunk_row(b, n, grp * 16 + i);
            if (r < 0) continue;
            const float y = acc[i] * rsqrtf(ms + RMS_EPS) * hg[h * 256 + dv];
            ARET[(size_t)r * DM + h * 256 + dv] = f2bf(y * bf2f(PROJ[(size_t)r * NPROJ + C_G + h * 256 + dv]));
        }
    }
}

__device__ __forceinline__ float conv3(const bf16_t* __restrict__ PROJ, const float* __restrict__ cw, const float* __restrict__ cb, int b, int t, int ch) {
    float a = cb[ch];
    for (int j = 0; j < 3; ++j) { const int tt = t + j - 1; if (tt >= 0 && tt < TT) a += bf2f(PROJ[(size_t)row_of(b, tt) * NPROJ + C_U + ch]) * cw[j * 3072 + ch]; }
    return a;
}
__global__ void k_hy_prep(const bf16_t* __restrict__ PROJ, const float* __restrict__ cw, const float* __restrict__ cb, bf16_t* __restrict__ ZT) {
    const int c = blockIdx.x * 256 + threadIdx.x, t = blockIdx.y, b = blockIdx.z;
    bf16_t v = 0;
    if (t < TT) { const float x1 = conv3(PROJ, cw, cb, b, t, 1024 + c), vh = conv3(PROJ, cw, cb, b, t, 2048 + c); v = f2bf(x1 * vh); }
    ZT[((size_t)b * 1024 + c) * ZL + t] = v;
}
__global__ void __launch_bounds__(256) k_hy_conv(const bf16_t* __restrict__ G, const bf16_t* __restrict__ ZT, bf16_t* __restrict__ YCT) {
    __shared__ float zs[2][1024];
    __shared__ float gs[3072 + 8];
    const int tile = blockIdx.x, c = blockIdx.y, tid = threadIdx.x;
    const int tb = tile * 2048, t0 = tb + tid * 8;
    float acc0[8], acc1[8];
    for (int j = 0; j < 8; ++j) { acc0[j] = 0.f; acc1[j] = 0.f; }
    const bf16_t* g = G + (size_t)c * GL;
    for (int s0 = 0; s0 < TT; s0 += 1024) {
        __syncthreads();
        for (int i = tid; i < 2048; i += 256) { const int bb = i >> 10, s = s0 + (i & 1023); zs[bb][i & 1023] = s < TT ? bf2f(ZT[((size_t)bb * 1024 + c) * ZL + s]) : 0.f; }
        const int dlo = tb - s0 - 1023;
        for (int i = tid; i < 3072; i += 256) { const int idx = TT + dlo + i; gs[i] = (idx >= 0 && idx < GL) ? bf2f(g[idx]) : 0.f; }
        __syncthreads();
        const int base = tid * 8 + 1023;
        for (int u = 0; u < 1024; ++u) {
            const float z0 = zs[0][u], z1 = zs[1][u];
#pragma unroll
            for (int j = 0; j < 8; ++j) { const float gv = gs[base + j - u]; acc0[j] += gv * z0; acc1[j] += gv * z1; }
        }
    }
    for (int j = 0; j < 8; ++j) { const int t = t0 + j; if (t < ZL) { YCT[((size_t)0 * 1024 + c) * ZL + t] = f2bf(acc0[j]); YCT[((size_t)1 * 1024 + c) * ZL + t] = f2bf(acc1[j]); } }
}
__global__ void k_hy_post(const bf16_t* __restrict__ PROJ, const float* __restrict__ cw, const float* __restrict__ cb, const float* __restrict__ skip, const bf16_t* __restrict__ YCT, bf16_t* __restrict__ AHY) {
    const int c = blockIdx.x * 256 + threadIdx.x, m = blockIdx.y;
    int b, t; bt_of(m, b, t);
    const float x0 = conv3(PROJ, cw, cb, b, t, c), x1 = conv3(PROJ, cw, cb, b, t, 1024 + c), vh = conv3(PROJ, cw, cb, b, t, 2048 + c);
    const float z = x1 * vh;
    const float yc = bf2f(YCT[((size_t)b * 1024 + c) * ZL + t]);
    AHY[(size_t)m * DM + c] = f2bf(x0 * (yc + z * skip[c]));
}


constexpr int CV_GR_BYTES = GL * 2;
constexpr int CV_ZROW = 272, CV_ZB = 18176  , CV_Z_BYTES = 2 * CV_ZB;
constexpr int CV_SLOT = CV_GR_BYTES + CV_Z_BYTES;
constexpr int CV_LDS = 2 * CV_SLOT;
__device__ __forceinline__ bf16x8 cv_load_frag(const LAS unsigned char* p, unsigned sh) {
    unsigned X[5];
#pragma unroll
    for (int i = 0; i < 5; ++i) X[i] = *(const LAS unsigned*)(p + 4 * i);
    u32x4 o;
    o.x = __builtin_amdgcn_alignbit(X[1], X[0], sh); o.y = __builtin_amdgcn_alignbit(X[2], X[1], sh);
    o.z = __builtin_amdgcn_alignbit(X[3], X[2], sh); o.w = __builtin_amdgcn_alignbit(X[4], X[3], sh);
    return __builtin_bit_cast(bf16x8, o);
}
__device__ __forceinline__ void conv_fast_body(LAS unsigned char* lds, const bf16_t* __restrict__ G, const bf16_t* __restrict__ ZT, bf16_t* __restrict__ YCT, int c_first) {
    const int tid = threadIdx.x, l = tid & 63, wid = tid >> 6, slot = wid >> 2, ct = wid & 3;
    const int ts = tid & 255;
    LAS unsigned char* grb = lds + slot * CV_SLOT;
    LAS unsigned char* zb = grb + CV_GR_BYTES;
    for (int rd = 0; rd < 2; ++rd) {
        const int c = c_first + 2 * rd + slot;
        __syncthreads();
        {
            const u32x4* gsrc = (const u32x4*)(G + (size_t)c * GL);
            for (int i = ts; i < GL / 8; i += 256) {
                const u32x4 v = gsrc[i]; u32x4 o;
                o.x = __builtin_amdgcn_alignbit(v.w, v.w, 16); o.y = __builtin_amdgcn_alignbit(v.z, v.z, 16); o.z = __builtin_amdgcn_alignbit(v.y, v.y, 16); o.w = __builtin_amdgcn_alignbit(v.x, v.x, 16);
                *(LAS u32x4*)(grb + (size_t)(GL - 8 * (i + 1)) * 2) = o;
            }
            for (int i = ts; i < 2 * 66 * 17; i += 256) {
                const int bb = i / (66 * 17), rem = i - bb * (66 * 17), Ib = rem / 17, q = rem - Ib * 17;
                u32x4 v = (u32x4){0u, 0u, 0u, 0u};
                const bf16_t* zr = ZT + ((size_t)bb * 1024 + c) * ZL;
                if (q < 16) { if (Ib == 0) { if (q >= 14) v = *(const u32x4*)(zr + 8 * (q - 14)); } else if (Ib <= 64) v = *(const u32x4*)(zr + 16 + 128 * (Ib - 1) + 8 * q); }
                *(LAS u32x4*)(zb + bb * CV_ZB + Ib * CV_ZROW + q * 16) = v;
            }
        }
        __syncthreads();
        const int r = l & 31, h = l >> 5;
        const int Ec = 8431 + 112 - r + 8 * h;
        const unsigned sh = (unsigned)(Ec & 1) * 16u;
        const int Io = 16 * ct + (r & 15), bcol = r >> 4;
        f32x16 acc[4];
#pragma unroll
        for (int rt = 0; rt < 4; ++rt) for (int q = 0; q < 16; ++q) acc[rt][q] = 0.f;
        bf16x8 F[14];
        int d = 16 * ct - 63;
        const LAS unsigned char* abase = grb + 4 * (Ec >> 1) - 256 * d;
#pragma unroll
        for (int f = 0; f < 6; ++f) F[f] = cv_load_frag(abase - 32 * f, sh);
        const int dend = 16 * ct + 16;
        for (; d <= dend; ++d) {
#pragma unroll
            for (int f = 6; f < 14; ++f) F[f] = cv_load_frag(abase - 32 * f, sh);
            int Ib = Io - d + 1; Ib = (Ib < 0 || Ib > 64) ? 65 : Ib;
            const LAS unsigned char* zp = zb + bcol * CV_ZB + Ib * CV_ZROW + 16 * h;
#pragma unroll
            for (int ks = 0; ks < 8; ++ks) {
                const bf16x8 Bf = *(const LAS bf16x8*)(zp + 32 * ks);
#pragma unroll
                for (int rt = 0; rt < 4; ++rt) acc[rt] = __builtin_amdgcn_mfma_f32_32x32x16_bf16(F[2 * rt - ks + 7], Bf, acc[rt], 0, 0, 0);
            }
#pragma unroll
            for (int f = 0; f < 6; ++f) F[f] = F[f + 8];
            abase -= 256;
        }
        {
            bf16_t* yr = YCT + ((size_t)bcol * 1024 + c) * ZL + 16 + 128 * Io + 4 * h;
#pragma unroll
            for (int rt = 0; rt < 4; ++rt)
#pragma unroll
                for (int g = 0; g < 4; ++g) { u32x2 w; w.x = pk2(acc[rt][4 * g], acc[rt][4 * g + 1]); w.y = pk2(acc[rt][4 * g + 2], acc[rt][4 * g + 3]); *(u32x2*)(yr + 32 * rt + 8 * g) = w; }
        }
        {
            float a0[4], a1[4];
#pragma unroll
            for (int q = 0; q < 4; ++q) { a0[q] = 0.f; a1[q] = 0.f; }
            const LAS bf16_t* grh = (const LAS bf16_t*)grb;
            for (int s = l; s < TT; s += 64) {
                int Ib, j; if (s < 16) { Ib = 0; j = 112 + s; } else { const int s2 = s - 16; Ib = 1 + (s2 >> 7); j = s2 & 127; }
                const float z0 = bf2f(*(const LAS bf16_t*)(zb + Ib * CV_ZROW + 2 * j)), z1 = bf2f(*(const LAS bf16_t*)(zb + CV_ZB + Ib * CV_ZROW + 2 * j));
#pragma unroll
                for (int q = 0; q < 4; ++q) { const float gv = bf2f(grh[8431 - (4 * ct + q) + s]); a0[q] += gv * z0; a1[q] += gv * z1; }
            }
#pragma unroll
            for (int q = 0; q < 4; ++q) {
                float v0 = a0[q], v1 = a1[q];
                for (int o = 32; o > 0; o >>= 1) { v0 += __shfl_xor(v0, o); v1 += __shfl_xor(v1, o); }
                if (l == 0) { YCT[((size_t)0 * 1024 + c) * ZL + 4 * ct + q] = f2bf(v0); YCT[((size_t)1 * 1024 + c) * ZL + 4 * ct + q] = f2bf(v1); }
            }
        }
    }
}
__global__ void __launch_bounds__(512, 2) k_conv_fast(const bf16_t* __restrict__ G, const bf16_t* __restrict__ ZT, bf16_t* __restrict__ YCT) {
    extern __shared__ __attribute__((aligned(16))) unsigned char smem_c[];
    conv_fast_body((LAS unsigned char*)smem_c, G, ZT, YCT, 4 * blockIdx.x);
}
__global__ void k_norm2_router(const float* __restrict__ H2, const float* __restrict__ H2M, const float* __restrict__ g2, const float* __restrict__ wr, bf16_t* __restrict__ XN2, float* __restrict__ AFF) {
    __shared__ float red[4]; __shared__ float lred[4][16];
    const int m = blockIdx.x, tid = threadIdx.x;
    const float* src = m < MX ? H2 + (size_t)m * DM : H2M + (size_t)(m - MX) * DM;
    float v[4]; float s = 0.f;
    for (int i = 0; i < 4; ++i) { v[i] = src[tid + 256 * i]; s += v[i] * v[i]; }
    s = block_sum256(s, red);
    const float r = rsqrtf(s * (1.f / DM) + RMS_EPS);
    float lg[16]; for (int e = 0; e < 16; ++e) lg[e] = 0.f;
    for (int i = 0; i < 4; ++i) { const int k = tid + 256 * i; const float xn = v[i] * r * g2[k]; XN2[(size_t)m * DM + k] = f2bf(xn);
        for (int e = 0; e < 16; ++e) lg[e] += xn * wr[k * 16 + e]; }
    for (int e = 0; e < 16; ++e) { float q = lg[e]; for (int o = 32; o > 0; o >>= 1) q += __shfl_xor(q, o); lg[e] = q; }
    if ((tid & 63) == 0) for (int e = 0; e < 16; ++e) lred[tid >> 6][e] = lg[e];
    __syncthreads();
    if (tid == 0) {
        float l[16], mx = -1e30f;
        for (int e = 0; e < 16; ++e) { l[e] = lred[0][e] + lred[1][e] + lred[2][e] + lred[3][e]; mx = fmaxf(mx, l[e]); }
        float sum = 0.f; for (int e = 0; e < 16; ++e) { l[e] = expf(l[e] - mx); sum += l[e]; }
        int b, t; bt_of(m, b, t);
        for (int e = 0; e < 16; ++e) AFF[((size_t)b * NE + e) * TT + t] = l[e] / sum;
    }
}
__global__ void k_topk(const float* __restrict__ AFF, int* __restrict__ IDX, float* __restrict__ GATEV, int* __restrict__ INV) {
    __shared__ float a[TT];
    const int be = blockIdx.y, t = blockIdx.x * 256 + threadIdx.x;
    for (int i = threadIdx.x; i < TT; i += 256) a[i] = AFF[(size_t)be * TT + i];
    __syncthreads();
    if (t >= TT) return;
    const float v = a[t]; int rank = 0;
    for (int i = 0; i < TT; ++i) { const float w = a[i]; rank += (w > v || (w == v && i < t)) ? 1 : 0; }
    if (rank < CAP) { IDX[(size_t)be * CAP + rank] = t; GATEV[(size_t)be * CAP + rank] = v; INV[(size_t)be * TT + t] = rank; }
    else INV[(size_t)be * TT + t] = -1;
}
__global__ void k_gather(const bf16_t* __restrict__ XN2, const int* __restrict__ IDX, bf16_t* __restrict__ XE) {
    const int r = blockIdx.x, e = blockIdx.y;
    uint4 v = make_uint4(0, 0, 0, 0);
    if (r < 2 * CAP) { const int b = r / CAP, slot = r % CAP; const int t = IDX[((size_t)b * NE + e) * CAP + slot]; v = *(const uint4*)(XN2 + (size_t)row_of(b, t) * DM + threadIdx.x * 8); }
    *(uint4*)(XE + ((size_t)e * ER + r) * DM + threadIdx.x * 8) = v;
}
__global__ void k_final(float* __restrict__ OUT, const bf16_t* __restrict__ YE, const int* __restrict__ INV, const float* __restrict__ gfin) {
    __shared__ float red[4];
    const int m = blockIdx.x, tid = threadIdx.x, b = m >> 13, t = (m & 8191) + NMETA;
    float v[4]; for (int i = 0; i < 4; ++i) v[i] = OUT[(size_t)m * DM + tid + 256 * i];
    for (int e = 0; e < NE; ++e) { const int slot = INV[((size_t)b * NE + e) * TT + t]; if (slot >= 0) { const bf16_t* y = YE + ((size_t)e * ER + b * CAP + slot) * DM; for (int i = 0; i < 4; ++i) v[i] += bf2f(y[tid + 256 * i]); } }
    float s = 0.f; for (int i = 0; i < 4; ++i) s += v[i] * v[i];
    s = block_sum256(s, red);
    const float r = rsqrtf(s * (1.f / DM) + RMS_EPS);
    for (int i = 0; i < 4; ++i) OUT[(size_t)m * DM + tid + 256 * i] = v[i] * r * gfin[tid + 256 * i];
}

extern "C" void kernel_launch(void* const* d_in, const int* in_sizes, int n_in, void* d_out, int out_size, void* d_ws, size_t ws_size, hipStream_t stream) {
    if (n_in != 27 || ws_size < WS_END || out_size != MX * DM) { fprintf(stderr, "kernel_launch: unexpected sizes n_in %d ws %zu out %d\n", n_in, ws_size, out_size); return; }
    const float* x = (const float*)d_in[0]; const float* meta = (const float*)d_in[1]; const float* norm1_g = (const float*)d_in[2]; const float* w_in = (const float*)d_in[3];
    const float* dec_f = (const float*)d_in[4]; const float* dec_b = (const float*)d_in[5]; const float* hg = (const float*)d_in[6]; const float* w_ret = (const float*)d_in[7];
    const float* cw = (const float*)d_in[8]; const float* cb = (const float*)d_in[9];
    const float* fw1 = (const float*)d_in[10]; const float* fb1 = (const float*)d_in[11]; const float* fw2 = (const float*)d_in[12]; const float* fb2 = (const float*)d_in[13];
    const float* fw3 = (const float*)d_in[14]; const float* fb3 = (const float*)d_in[15]; const float* ffq = (const float*)d_in[16]; const float* fw4 = (const float*)d_in[17];
    const float* skip = (const float*)d_in[18]; const float* w_hy = (const float*)d_in[19]; const float* w_o = (const float*)d_in[20]; const float* norm2_g = (const float*)d_in[21];
    const float* w_router = (const float*)d_in[22]; const float* w_eg = (const float*)d_in[23]; const float* w_eu = (const float*)d_in[24]; const float* w_ed = (const float*)d_in[25];
    const float* gfin = (const float*)d_in[26];
    unsigned char* ws = (unsigned char*)d_ws; unsigned char* dob = (unsigned char*)d_out;
    bf16_t* WRET = (bf16_t*)(ws + WS_WRET); bf16_t* WHY = (bf16_t*)(ws + WS_WHY); bf16_t* WO = (bf16_t*)(ws + WS_WO);
    bf16_t* XN = (bf16_t*)(ws + WS_XN); bf16_t* PROJ = (bf16_t*)(ws + WS_PROJ); bf16_t* S = (bf16_t*)(ws + WS_S); float* TMP = (float*)(ws + WS_S);
    bf16_t* ZT = (bf16_t*)(ws + WS_ZT); bf16_t* G = (bf16_t*)(ws + WS_G); bf16_t* AHY = (bf16_t*)(ws + WS_G); bf16_t* ARET = (bf16_t*)(ws + WS_ARET);
    bf16_t* WGU = (bf16_t*)(ws + WS_WGU); bf16_t* WD = (bf16_t*)(ws + WS_WD); bf16_t* XE = (bf16_t*)(ws + WS_XE); bf16_t* YE = (bf16_t*)(ws + WS_XE); bf16_t* HID = (bf16_t*)(ws + WS_HID);
    bf16_t* WIN = (bf16_t*)(dob + DO_WIN); float* ROPE = (float*)(dob + DO_ROPE); float* HDN = (float*)(dob + DO_HDN); bf16_t* YCT = (bf16_t*)(dob + DO_YCT);
    float* AFF = (float*)(ws + WS_MISC + MI_AFF); int* IDX = (int*)(ws + WS_MISC + MI_IDX); float* GATEV = (float*)(ws + WS_MISC + MI_GATE); int* INV = (int*)(ws + WS_MISC + MI_INV);
    float* H2M = (float*)(ws + WS_MISC + MI_H2M); float* H2 = (float*)d_out;

    k_wconv<<<dim3(32, 256, 1), dim3(32, 8), 0, stream>>>(w_in, nullptr, 1024, 8192, 8192, WIN, 1, 0, 0);
    k_wconv<<<dim3(32, 32, 1), dim3(32, 8), 0, stream>>>(w_ret, nullptr, 1024, 1024, 1024, WRET, 0, 0, 0);
    k_wconv<<<dim3(32, 32, 1), dim3(32, 8), 0, stream>>>(w_hy, nullptr, 1024, 1024, 1024, WHY, 0, 0, 0);
    k_wconv<<<dim3(32, 32, 1), dim3(32, 8), 0, stream>>>(w_o, nullptr, 1024, 1024, 1024, WO, 0, 0, 0);
    k_xn1<<<MROWS, 256, 0, stream>>>(x, meta, norm1_g, XN);
    k_rope<<<TT, 64, 0, stream>>>(ROPE);
    k_filt_hidden<<<TT, 64, 0, stream>>>(fw1, fb1, fw2, fb2, fw3, fb3, ffq, HDN);
    k_filt_out<<<dim3(4, TT), 256, 0, stream>>>(HDN, fw4, G);
    EpiArgs E{}; E.PROJ = PROJ; E.ROPE = ROPE; E.TMP = TMP; E.MIXED = XN; E.x = x; E.meta = meta; E.H2 = H2; E.H2M = H2M; E.HID = HID; E.YE = YE; E.GATEV = GATEV;
    launch_gemm_fast<1>(stream, XN, WIN, MX, NPROJ, 1024, 1 << 20, 0, 1, E);
    k_ret_state<<<dim3(8, 8, 2), 256, 0, stream>>>(PROJ, dec_f, dec_b, S);
    k_hy_prep<<<dim3(4, ZL, 2), 256, 0, stream>>>(PROJ, cw, cb, ZT);
    (void)hipFuncSetAttribute((const void*)k_conv_fast, hipFuncAttributeMaxDynamicSharedMemorySize, CV_LDS);
    k_conv_fast<<<256, 512, CV_LDS, stream>>>(G, ZT, YCT);
    hipFuncSetAttribute((const void*)k_ret_out, hipFuncAttributeMaxDynamicSharedMemorySize, R2_LDS);
    k_ret_out<<<dim3(NCH, 8), 256, R2_LDS, stream>>>(PROJ, S, dec_f, dec_b, hg, ARET);
    k_hy_post<<<dim3(4, MROWS), 256, 0, stream>>>(PROJ, cw, cb, skip, YCT, AHY);
    launch_gemm_fast<2>(stream, ARET, WRET, MX, DM, 1024, 1 << 20, 0, 1, E);
    launch_gemm_fast<3>(stream, AHY, WHY, MX, DM, 1024, 1 << 20, 0, 1, E);
    launch_gemm_fast<4>(stream, XN, WO, MX, DM, 1024, 1 << 20, 0, 1, E);
    k_norm2_router<<<MROWS, 256, 0, stream>>>(H2, H2M, norm2_g, w_router, XN, AFF);
    k_wconv<<<dim3(32, 128, NE), dim3(32, 8), 0, stream>>>(w_eg, w_eu, 1024, 2048, 4096, WGU, 2, (size_t)1024 * 2048, (size_t)4096 * 1024);
    k_wconv<<<dim3(64, 32, NE), dim3(32, 8), 0, stream>>>(w_ed, nullptr, 2048, 1024, 1024, WD, 0, (size_t)2048 * 1024, (size_t)1024 * 2048);
    k_topk<<<dim3(33, 32), 256, 0, stream>>>(AFF, IDX, GATEV, INV);
    k_gather<<<dim3(ER, NE), 128, 0, stream>>>(XN, IDX, XE);
    launch_gemm_fast<5>(stream, XE, WGU, NE * ER, 4096, 1024, ER / 256, (size_t)4096 * 1024 * 2, 0, E);
    launch_gemm_fast<6>(stream, HID, WD, NE * ER, DM, 2048, ER / 256, (size_t)1024 * 2048 * 2, 0, E);
    k_final<<<MX, 256, 0, stream>>>(H2, YE, INV, gfin);
}
```

```cpp
#include <hip/hip_runtime.h>
#include <stdint.h>
#include <cstdio>
#include <hip/hip_cooperative_groups.h>
namespace cg = cooperative_groups;

typedef unsigned short bf16_t;
__device__ __forceinline__ int tidf() { int t = (int)__builtin_amdgcn_workitem_id_x(); asm volatile("" : "+v"(t)); return t; }
__device__ __forceinline__ float bf2f(bf16_t v) { return __uint_as_float(((unsigned)v) << 16); }
__device__ __forceinline__ bf16_t f2bf(float f) { unsigned u = __float_as_uint(f); u += 0x7fffu + ((u >> 16) & 1u); return (bf16_t)(u >> 16); }

constexpr int NB = 2, SEQ = 8192, DM = 1024, NMETA = 16, TT = 8208;
constexpr int MX = 16384, MROWS = 16416, MP = 16640;
constexpr int NPROJ = 8192;
constexpr int C_Q = 0, C_K = 512, C_V = 1024, C_G = 2048, C_U = 3072, C_GA = 6144, C_GB = 7168;
constexpr int NE = 16, CAP = 1026, ER = 2304, FF = 2048;
constexpr int NCH = 65;
constexpr int GL = 16640;
constexpr int ZL = 8320;
constexpr float RMS_EPS = 1e-6f;

constexpr size_t MiB = 1u << 20;
constexpr size_t WS_CTL = 0;
constexpr size_t WS_WRET = 1 * MiB, WS_WHY = 3 * MiB, WS_WO = 5 * MiB;
constexpr size_t WS_MISC = 7 * MiB;
constexpr size_t WS_XN = 12 * MiB;
constexpr size_t WS_PROJ = 48 * MiB;
constexpr size_t WS_S = 308 * MiB;
constexpr size_t WS_ZT = 374 * MiB;
constexpr size_t WS_G = 407 * MiB;
constexpr size_t WS_ARET = 440 * MiB;
constexpr size_t WS_WGU = 48 * MiB;
constexpr size_t WS_WD = 176 * MiB;
constexpr size_t WS_XE = 240 * MiB;
constexpr size_t WS_HID = 312 * MiB;
constexpr size_t WS_END = 456 * MiB;
constexpr size_t DO_WIN = 0;
constexpr size_t DO_ROPE = 16 * MiB;
constexpr size_t DO_HDN = 22 * MiB;
constexpr size_t DO_YCT = 0;
constexpr size_t MI_AFF = 0;
constexpr size_t MI_IDX = 1 * MiB + 64 * 1024;
constexpr size_t MI_GATE = 1 * MiB + 256 * 1024;
constexpr size_t MI_INV = 2 * MiB;
constexpr size_t MI_H2M = 3 * MiB + 256 * 1024;

__device__ __forceinline__ int row_of(int b, int t) { return t < NMETA ? MX + b * NMETA + t : b * SEQ + (t - NMETA); }
__device__ __forceinline__ void bt_of(int m, int& b, int& t) { if (m < MX) { b = m >> 13; t = (m & 8191) + NMETA; } else { b = (m - MX) >> 4; t = (m - MX) & 15; } }

__global__ void k_wconv(const float* __restrict__ W0, const float* __restrict__ W1, int K, int N, int Nd, bf16_t* __restrict__ WT, int mode, size_t src_bstride, size_t dst_bstride) {
    __shared__ float tile[32][33];
    const int tx = tidf(), ty = threadIdx.y;
    const int k0 = blockIdx.x * 32, r0 = blockIdx.y * 32, e = blockIdx.z;
    const int r = r0 + tx;
    const float* src = W0 + (size_t)e * src_bstride; int col = r;
    if (mode == 1) { if (r < 1024) { const int sec = r >> 7, rl = r & 127, g = rl >> 3, j = rl & 7; col = sec * 128 + (j < 4 ? 4 * g + j : 64 + 4 * g + (j - 4)); } }
    else if (mode == 2) { const int g = r >> 3, j = r & 7; if (j < 4) { col = 4 * g + j; } else { col = 4 * g + j - 4; src = W1 + (size_t)e * src_bstride; } }
    for (int i = 0; i < 4; ++i) { const int k = k0 + ty + 8 * i; tile[ty + 8 * i][tx] = src[(size_t)k * N + col]; }
    __syncthreads();
    bf16_t* dst = WT + (size_t)e * dst_bstride;
    for (int i = 0; i < 4; ++i) { const int rr = r0 + ty + 8 * i; dst[(size_t)rr * K + k0 + tx] = f2bf(tile[tx][ty + 8 * i]); }
}

__device__ __forceinline__ float block_sum256(float v, float* red) {
    for (int o = 32; o > 0; o >>= 1) v += __shfl_xor(v, o);
    const int w = tidf() >> 6;
    __syncthreads();
    if ((tidf() & 63) == 0) red[w] = v;
    __syncthreads();
    return red[0] + red[1] + red[2] + red[3];
}

__global__ void k_xn1(const float* __restrict__ x, const float* __restrict__ meta, const float* __restrict__ g, bf16_t* __restrict__ XN) {
    __shared__ float red[4];
    const int m = blockIdx.x;
    const float* src = m < MX ? x + (size_t)m * DM : meta + (size_t)((m - MX) & 15) * DM;
    float v[4]; float s = 0.f;
    for (int i = 0; i < 4; ++i) { v[i] = src[tidf() + 256 * i]; s += v[i] * v[i]; }
    s = block_sum256(s, red);
    const float r = rsqrtf(s * (1.f / DM) + RMS_EPS);
    for (int i = 0; i < 4; ++i) XN[(size_t)m * DM + tidf() + 256 * i] = f2bf(v[i] * r * g[tidf() + 256 * i]);
}

__global__ void k_rope(float* __restrict__ ROPE) {
    const int t = blockIdx.x, i = tidf();
    const float inv = powf(10000.0f, -(float)i / 64.0f);
    const float ang = (float)t * inv;
    ROPE[(size_t)t * 128 + i] = cosf(ang);
    ROPE[(size_t)t * 128 + 64 + i] = sinf(ang);
}

__global__ void k_filt_hidden(const float* __restrict__ w1, const float* __restrict__ b1, const float* __restrict__ w2, const float* __restrict__ b2,
                              const float* __restrict__ w3, const float* __restrict__ b3, const float* __restrict__ fq, float* __restrict__ HDN) {
    __shared__ float feat[33]; __shared__ float ha[64]; __shared__ float hb[64];
    const int t = blockIdx.x, j = tidf();
    if (j == 0) feat[0] = (float)t / (float)(TT - 1);
    if (j < 16) {
        const float fr = 1e-4f + (float)j * ((15.0f - 1e-4f) / 15.0f);
        const float ang = (2.0f * 3.14159265358979323846f * (float)t / (float)TT) * fr;
        feat[1 + j] = cosf(ang); feat[17 + j] = -sinf(ang);
    }
    __syncthreads();
    const float f = fq[j];
    float a = b1[j];
    for (int i = 0; i < 33; ++i) a += feat[i] * w1[i * 64 + j];
    ha[j] = sinf(f * a);
    __syncthreads();
    a = b2[j];
    for (int i = 0; i < 64; ++i) a += ha[i] * w2[i * 64 + j];
    hb[j] = sinf(f * a);
    __syncthreads();
    a = b3[j];
    for (int i = 0; i < 64; ++i) a += hb[i] * w3[i * 64 + j];
    HDN[(size_t)t * 64 + j] = sinf(f * a);
}

__global__ void k_filt_out(const float* __restrict__ HDN, const float* __restrict__ w4, bf16_t* __restrict__ G) {
    const int c = blockIdx.x * 256 + tidf(), t = blockIdx.y;
    __shared__ float h[64];
    if (tidf() < 64) h[tidf()] = HDN[(size_t)t * 64 + tidf()];
    __syncthreads();
    float ff = 0.f, fb = 0.f;
    for (int j = 0; j < 64; ++j) { ff += h[j] * w4[j * 2048 + c]; fb += h[j] * w4[j * 2048 + 1024 + c]; }
    const float mind = logf(1e-2f) / 1.5f, maxd = logf(1e-2f) / 0.3f;
    const float delta = mind + (float)c * ((maxd - mind) / 1023.0f);
    const float tn = (float)t / (float)(TT - 1);
    const float win = expf(-tn * fabsf(delta));
    G[(size_t)c * GL + TT + t] = f2bf(ff * win);
    if (t >= 1) G[(size_t)c * GL + TT - t] = f2bf(fb * win);
    if (t == 0) { G[(size_t)c * GL] = 0; for (int i = 2 * TT; i < GL; ++i) G[(size_t)c * GL + i] = 0; }
}

struct EpiArgs {
    bf16_t* PROJ; const float* ROPE;
    float* TMP; bf16_t* MIXED;
    const float* x; const float* meta; float* H2; float* H2M;
    bf16_t* HID; bf16_t* YE; const float* GATEV;
};
typedef float f32x4 __attribute__((ext_vector_type(4)));
typedef float f32x16 __attribute__((ext_vector_type(16)));
typedef unsigned u32x4 __attribute__((ext_vector_type(4)));
typedef unsigned u32x2 __attribute__((ext_vector_type(2)));
typedef short bf16x8 __attribute__((ext_vector_type(8)));
__device__ __forceinline__ unsigned pk2(float lo, float hi) { return (unsigned)f2bf(lo) | ((unsigned)f2bf(hi) << 16); }
__device__ __forceinline__ float lo16(unsigned w) { return __uint_as_float(w << 16); }
__device__ __forceinline__ float hi16(unsigned w) { return __uint_as_float(w & 0xffff0000u); }
__device__ __forceinline__ float sigm(float x) { return 1.f / (1.f + __expf(-x)); }
__device__ __forceinline__ u32x4 pack8(f32x4 a, f32x4 b) { u32x4 w; w.x = pk2(a.x, a.y); w.y = pk2(a.z, a.w); w.z = pk2(b.x, b.y); w.w = pk2(b.z, b.w); return w; }
__device__ __forceinline__ void epi8v(int mode, const EpiArgs& E, int mg, int c0, f32x4 a0, f32x4 a1) {
    if (mode == 1) {
        bf16_t* dst = E.PROJ + (size_t)mg * NPROJ + c0;
        if (c0 < C_V) {
            int b, t; bt_of(mg, b, t);
            const int i0 = ((c0 & 127) >> 3) * 4;
            const float sc = c0 >= C_K ? 0.08838834764831845f : 1.0f;
            const f32x4 cs = *(const f32x4*)(E.ROPE + (size_t)t * 128 + i0), sn = *(const f32x4*)(E.ROPE + (size_t)t * 128 + 64 + i0);
            const f32x4 o1 = (a0 * cs - a1 * sn) * sc, o2 = (a0 * sn + a1 * cs) * sc;
            *(u32x4*)dst = pack8(o1, o2);
        } else if (c0 < C_G || (c0 >= C_U && c0 < C_GA)) { *(u32x4*)dst = pack8(a0, a1); }
        else if (c0 < C_U) { f32x4 s0, s1; for (int j = 0; j < 4; ++j) { s0[j] = a0[j] * sigm(a0[j]); s1[j] = a1[j] * sigm(a1[j]); } *(u32x4*)dst = pack8(s0, s1); }
        else { f32x4 s0, s1; for (int j = 0; j < 4; ++j) { s0[j] = sigm(a0[j]); s1[j] = sigm(a1[j]); } *(u32x4*)dst = pack8(s0, s1); }
    } else if (mode == 2) {
        const u32x4 g = *(const u32x4*)(E.PROJ + (size_t)mg * NPROJ + C_GA + c0);
        float* dst = E.TMP + (size_t)mg * DM + c0;
        *(f32x4*)dst = (f32x4){lo16(g.x) * a0.x, hi16(g.x) * a0.y, lo16(g.y) * a0.z, hi16(g.y) * a0.w};
        *(f32x4*)(dst + 4) = (f32x4){lo16(g.z) * a1.x, hi16(g.z) * a1.y, lo16(g.w) * a1.z, hi16(g.w) * a1.w};
    } else if (mode == 3) {
        const u32x4 g = *(const u32x4*)(E.PROJ + (size_t)mg * NPROJ + C_GB + c0);
        const float* tp = E.TMP + (size_t)mg * DM + c0;
        const f32x4 t0 = *(const f32x4*)tp, t1 = *(const f32x4*)(tp + 4);
        const f32x4 o0 = t0 + (f32x4){lo16(g.x) * a0.x, hi16(g.x) * a0.y, lo16(g.y) * a0.z, hi16(g.y) * a0.w};
        const f32x4 o1 = t1 + (f32x4){lo16(g.z) * a1.x, hi16(g.z) * a1.y, lo16(g.w) * a1.z, hi16(g.w) * a1.w};
        *(u32x4*)(E.MIXED + (size_t)mg * DM + c0) = pack8(o0, o1);
    } else if (mode == 4) {
        const float* rs; float* dst;
        if (mg < MX) { rs = E.x + (size_t)mg * DM + c0; dst = E.H2 + (size_t)mg * DM + c0; }
        else { rs = E.meta + (size_t)((mg - MX) & 15) * DM + c0; dst = E.H2M + (size_t)(mg - MX) * DM + c0; }
        *(f32x4*)dst = *(const f32x4*)rs + a0; *(f32x4*)(dst + 4) = *(const f32x4*)(rs + 4) + a1;
    } else if (mode == 5) {
        u32x2 w; w.x = pk2(a0.x * sigm(a0.x) * a1.x, a0.y * sigm(a0.y) * a1.y); w.y = pk2(a0.z * sigm(a0.z) * a1.z, a0.w * sigm(a0.w) * a1.w);
        *(u32x2*)(E.HID + (size_t)mg * FF + (c0 >> 1)) = w;
    } else {
        const int e = mg / ER, ml = mg - e * ER;
        const float gt = ml < 2 * CAP ? E.GATEV[((size_t)(ml / CAP) * NE + e) * CAP + (ml % CAP)] : 0.f;
        *(u32x4*)(E.YE + (size_t)mg * DM + c0) = pack8(a0 * gt, a1 * gt);
    }
}

__global__ void __launch_bounds__(256) k_gemm(const bf16_t* __restrict__ A, const bf16_t* __restrict__ Bt, int M, int N, int K, size_t a_bstride, size_t b_bstride, int mode, EpiArgs E) {
    __shared__ float As[32][128 + 4];
    __shared__ float Bs[32][64 + 4];
    const int tid = tidf(), e = blockIdx.z;
    const int m0 = blockIdx.y * 128, n0 = blockIdx.x * 64;
    A += (size_t)e * a_bstride; Bt += (size_t)e * b_bstride;
    const int ty = tid >> 3, tx = tid & 7;
    float acc[4][8];
    for (int i = 0; i < 4; ++i) for (int j = 0; j < 8; ++j) acc[i][j] = 0.f;
    const int ar = tid >> 1, ak = (tid & 1) * 16;
    const int br = tid >> 2, bk = (tid & 3) * 8;
    for (int k0 = 0; k0 < K; k0 += 32) {
        {
            const int m = m0 + ar;
            if (m < M) { const uint4* p = (const uint4*)(A + (size_t)m * K + k0 + ak); const uint4 v0 = p[0], v1 = p[1];
                const unsigned w[8] = {v0.x, v0.y, v0.z, v0.w, v1.x, v1.y, v1.z, v1.w};
                for (int q = 0; q < 8; ++q) { As[ak + 2 * q][ar] = __uint_as_float(w[q] << 16); As[ak + 2 * q + 1][ar] = __uint_as_float(w[q] & 0xffff0000u); } }
            else { for (int q = 0; q < 16; ++q) As[ak + q][ar] = 0.f; }
            const uint4 v = *(const uint4*)(Bt + (size_t)(n0 + br) * K + k0 + bk);
            const unsigned w[4] = {v.x, v.y, v.z, v.w};
            for (int q = 0; q < 4; ++q) { Bs[bk + 2 * q][br] = __uint_as_float(w[q] << 16); Bs[bk + 2 * q + 1][br] = __uint_as_float(w[q] & 0xffff0000u); }
        }
        __syncthreads();
#pragma unroll 8
        for (int k = 0; k < 32; ++k) {
            float a[4], b[8];
            for (int i = 0; i < 4; ++i) a[i] = As[k][ty + 32 * i];
            for (int j = 0; j < 8; ++j) b[j] = Bs[k][tx * 8 + j];
            for (int i = 0; i < 4; ++i) for (int j = 0; j < 8; ++j) acc[i][j] += a[i] * b[j];
        }
        __syncthreads();
    }
    for (int i = 0; i < 4; ++i) { const int m = m0 + ty + 32 * i; if (m < M) epi8v(mode, E, (mode >= 5 ? e * ER : 0) + m, n0 + tx * 8, (f32x4){acc[i][0], acc[i][1], acc[i][2], acc[i][3]}, (f32x4){acc[i][4], acc[i][5], acc[i][6], acc[i][7]}); }
}

namespace pg8 {
#define PG8_LAS __attribute__((address_space(3)))
typedef unsigned short bf16_t;
typedef short bf16x8 __attribute__((ext_vector_type(8)));
typedef float f32x4 __attribute__((ext_vector_type(4)));
typedef unsigned u32x4 __attribute__((ext_vector_type(4)));
constexpr int BM = 256, BK = 64, HALF = 128, HTB = HALF * BK * 2  , STAGE_BYTES = 8 * HTB, NXCD = 8, WGM = 8;

__host__ __device__ __forceinline__ int lds_byte(int r, int c) { const int st = (r >> 4) * 2 + (c >> 5), rr = r & 15, cc = c & 31, ob = rr * 64 + cc * 2; return st * 1024 + (ob ^ (((ob >> 9) & 1) << 5)); }
__host__ __device__ __forceinline__ void stage_rc(int b, int& R, int& C) { const int st = b / 1024, sb = b % 1024, swz = sb ^ (((sb >> 9) & 1) << 5); R = (st >> 1) * 16 + swz / 64; C = (st & 1) * 32 + (swz % 64) / 2; }
__host__ __device__ __forceinline__ int perm32(int rho) { const int n = rho >> 4, i = rho & 15; return 8 * (i >> 2) + 4 * n + (i & 3); }

struct Unit { int pm, pn; };
struct Gemm { const bf16_t* A; const bf16_t* Bt; int M, N, K; int gt; size_t gstride; };

struct StaticOrder {
    int nM, nN, nwg, G, c;
    __host__ __device__ void init(int M, int N, int G_, int c_) { nM = M / BM; nN = N / BM; nwg = nM * nN; G = G_; c = c_; }
    __host__ __device__ bool next(int i, Unit& u) const {
        const long L = (long)i * G + c; if (L >= nwg) return false;
        int wgid = (int)L; { const int q = nwg / NXCD, r = nwg % NXCD, xcd = wgid % NXCD, off = wgid / NXCD; wgid = (xcd < r ? xcd * (q + 1) : r * (q + 1) + (xcd - r) * q) + off; }
        const int nig = WGM * nN, gid = wgid / nig, fm = gid * WGM, gsz = (nM - fm) < WGM ? (nM - fm) : WGM;
        u.pm = fm + ((wgid % nig) % gsz); u.pn = (wgid % nig) / gsz; return true;
    }
    __device__ __forceinline__ void a_ready(const Unit&) const {}
    __device__ __forceinline__ void done(const Unit&) const {}
};

__device__ __forceinline__ unsigned cvt_pk_bf16(float lo, float hi) { unsigned r; asm volatile("v_cvt_pk_bf16_f32 %0, %1, %2" : "=v"(r) : "v"(lo), "v"(hi)); return r; }
template <class Epi, class Sched, bool ALIGN_EPI = false, bool SP2 = false>
__device__ __forceinline__ void gemm_phase(PG8_LAS unsigned char* lds, const Gemm g, const Sched& S, const Epi& E) {
    const int tid = tidf(), wid = __builtin_amdgcn_readfirstlane(tid >> 6), lane = tid & 63, wr = wid >> 2, wc = wid & 3, fr = lane & 15, fq = lane >> 4;
    const int K = g.K, nt = K / BK;
    unsigned voffA[2], voffB[2];
#pragma unroll
    for (int i = 0; i < 2; ++i) { int R, C; stage_rc(tid * 16 + i * 8192, R, C); const int Rb = Epi::PERM ? ((R & ~31) + perm32(R & 31)) : R;
        voffA[i] = (unsigned)(R * K + C) * 2u; voffB[i] = (unsigned)(Rb * K + C) * 2u; }
    const size_t kstep = (size_t)(BK * 2);
    const size_t hstep = (size_t)HALF * K * 2;
    const size_t tstep = 2 * hstep;
    const unsigned ldsw = (unsigned)wid * 1024u;
    const int aoff = lds_byte(wr * 64 + fr, fq * 8), boff = lds_byte(wc * 32 + fr, fq * 8);
#define PG8_SA(b, h) (((b) * 2 + (h)) * HTB)
#define PG8_SB(b, h) ((4 + (b) * 2 + (h)) * HTB)
#define PG8_STAGE(bufoff, gbase, voff) do { _Pragma("unroll") for (int _i = 0; _i < 2; ++_i) \
        __builtin_amdgcn_global_load_lds((const unsigned*)((const char*)(gbase) + (voff)[_i]), (PG8_LAS unsigned*)(lds + (bufoff) + ldsw + _i * 8192), 16, 0, 0); } while (0)
#define PG8_LDA(dst, b, h) do { _Pragma("unroll") for (int m = 0; m < 4; ++m) _Pragma("unroll") for (int k = 0; k < 2; ++k) dst[m][k] = *(const PG8_LAS bf16x8*)(lds + PG8_SA(b, h) + aoff + m * 2048 + k * 1024); } while (0)
#define PG8_LDB(dst, b, h) do { _Pragma("unroll") for (int n = 0; n < 2; ++n) _Pragma("unroll") for (int k = 0; k < 2; ++k) dst[n][k] = *(const PG8_LAS bf16x8*)(lds + PG8_SB(b, h) + boff + n * 2048 + k * 1024); } while (0)
#define PG8_MMA(ai, bj, At, Bt) do { __builtin_amdgcn_s_setprio(1); _Pragma("unroll") for (int m = 0; m < 4; ++m) _Pragma("unroll") for (int n = 0; n < 2; ++n) _Pragma("unroll") for (int k = 0; k < 2; ++k) \
        acc[ai][bj][m][n] = __builtin_amdgcn_mfma_f32_16x16x32_bf16(Bt[n][k], At[m][k], acc[ai][bj][m][n], 0, 0, 0); __builtin_amdgcn_s_setprio(0); } while (0)
#define PG8_WAIT_V(n) asm volatile("s_waitcnt vmcnt(" #n ")" ::: "memory")
#define PG8_WAIT_L(n) asm volatile("s_waitcnt lgkmcnt(" #n ")" ::: "memory")
#define PG8_BAR __builtin_amdgcn_s_barrier()
#define PG8_SCHED __builtin_amdgcn_sched_barrier(0)
    Unit cur, nxt; int ui = 0;
    if (!S.next(0, cur)) return;
    f32x4 acc[2][2][4][2];
#pragma unroll
    for (int a = 0; a < 2; ++a)
#pragma unroll
        for (int b = 0; b < 2; ++b)
#pragma unroll
            for (int m = 0; m < 4; ++m)
#pragma unroll
                for (int n = 0; n < 2; ++n) acc[a][b][m][n] = (f32x4){0.f, 0.f, 0.f, 0.f};
    bf16x8 At[4][2], B0[2][2], B1[2][2];
    const char* cA = (const char*)g.A + (size_t)cur.pm * tstep; const char* cB = (const char*)g.Bt + (size_t)(cur.pm / g.gt) * g.gstride + (size_t)cur.pn * tstep;
    S.a_ready(cur);
    if constexpr (SP2) {
        PG8_STAGE(PG8_SB(0, 0), cB, voffB); PG8_STAGE(PG8_SB(0, 1), cB + hstep, voffB); PG8_STAGE(PG8_SA(0, 0), cA, voffA); PG8_STAGE(PG8_SA(0, 1), cA + hstep, voffA);
        if (wr == 1) PG8_BAR;
        PG8_WAIT_V(2); PG8_BAR;
        PG8_STAGE(PG8_SB(1, 0), cB + kstep, voffB); PG8_STAGE(PG8_SA(1, 0), cA + kstep, voffA); PG8_STAGE(PG8_SB(1, 1), cB + hstep + kstep, voffB);
        PG8_WAIT_V(6); PG8_BAR;
    } else {
        PG8_STAGE(PG8_SB(0, 0), cB, voffB); PG8_STAGE(PG8_SA(0, 0), cA, voffA); PG8_STAGE(PG8_SB(0, 1), cB + hstep, voffB); PG8_STAGE(PG8_SA(0, 1), cA + hstep, voffA);
        if (wr == 1) PG8_BAR;
        PG8_WAIT_V(4); PG8_BAR;
        PG8_STAGE(PG8_SB(1, 0), cB + kstep, voffB); PG8_STAGE(PG8_SA(1, 0), cA + kstep, voffA); PG8_STAGE(PG8_SB(1, 1), cB + hstep + kstep, voffB);
        PG8_WAIT_V(6); PG8_BAR;
    }
    for (;;) {
        const bool has_next = S.next(ui + 1, nxt);
        const char* nA = has_next ? (const char*)g.A + (size_t)nxt.pm * tstep : cA; const char* nB = has_next ? (const char*)g.Bt + (size_t)(nxt.pm / g.gt) * g.gstride + (size_t)nxt.pn * tstep : cB;
        for (int t = 0; t < nt; t += 2) {
            const bool last = (t == nt - 2);
            const char* a1 = cA + (size_t)(t + 1) * kstep;
            const char* a2 = last ? nA : cA + (size_t)(t + 2) * kstep; const char* b2 = last ? nB : cB + (size_t)(t + 2) * kstep;
            const char* a3 = a2 + kstep; const char* b3 = b2 + kstep;
            if (last && has_next) S.a_ready(nxt);
            if constexpr (SP2) {
            PG8_LDB(B0, 0, 0); PG8_LDB(B1, 0, 1); PG8_SCHED; PG8_LDA(At, 0, 0); PG8_STAGE(PG8_SA(1, 1), a1 + hstep, voffA);
            PG8_WAIT_V(8); PG8_WAIT_L(0); PG8_BAR; PG8_MMA(0, 0, At, B0); PG8_MMA(0, 1, At, B1); PG8_BAR; PG8_SCHED;
            PG8_LDA(At, 0, 1); PG8_STAGE(PG8_SB(0, 0), b2, voffB); PG8_STAGE(PG8_SB(0, 1), b2 + hstep, voffB); PG8_STAGE(PG8_SA(0, 0), a2, voffA);
            PG8_WAIT_V(8); PG8_WAIT_L(0); PG8_BAR; PG8_MMA(1, 0, At, B0); PG8_MMA(1, 1, At, B1); PG8_BAR; PG8_SCHED;
            PG8_LDB(B0, 1, 0); PG8_LDB(B1, 1, 1); PG8_SCHED; PG8_LDA(At, 1, 0); PG8_STAGE(PG8_SA(0, 1), a2 + hstep, voffA);
            PG8_WAIT_V(8); PG8_WAIT_L(0); PG8_BAR; PG8_MMA(0, 0, At, B0); PG8_MMA(0, 1, At, B1); PG8_BAR; PG8_SCHED;
            PG8_LDA(At, 1, 1); PG8_STAGE(PG8_SB(1, 0), b3, voffB); PG8_STAGE(PG8_SB(1, 1), b3 + hstep, voffB); PG8_STAGE(PG8_SA(1, 0), a3, voffA);
            PG8_WAIT_V(8); PG8_WAIT_L(0); PG8_BAR; PG8_MMA(1, 0, At, B0); PG8_MMA(1, 1, At, B1); PG8_BAR; PG8_SCHED;
            } else {
            PG8_LDB(B0, 0, 0); PG8_SCHED; PG8_LDA(At, 0, 0); PG8_STAGE(PG8_SA(1, 1), a1 + hstep, voffA);
            PG8_WAIT_L(8); PG8_BAR; PG8_WAIT_L(0); PG8_MMA(0, 0, At, B0); PG8_BAR; PG8_SCHED;
            PG8_LDB(B1, 0, 1); PG8_STAGE(PG8_SB(0, 0), b2, voffB);
            PG8_BAR; PG8_WAIT_L(0); PG8_MMA(0, 1, At, B1); PG8_BAR;
            PG8_LDA(At, 0, 1); PG8_STAGE(PG8_SA(0, 0), a2, voffA);
            PG8_BAR; PG8_WAIT_L(0); PG8_MMA(1, 0, At, B0); PG8_BAR; PG8_SCHED;
            PG8_STAGE(PG8_SB(0, 1), b2 + hstep, voffB);
            PG8_WAIT_V(6); PG8_BAR; PG8_MMA(1, 1, At, B1); PG8_BAR;
            PG8_LDB(B0, 1, 0); PG8_SCHED; PG8_LDA(At, 1, 0); PG8_STAGE(PG8_SA(0, 1), a2 + hstep, voffA);
            PG8_WAIT_L(8); PG8_BAR; PG8_WAIT_L(0); PG8_MMA(0, 0, At, B0); PG8_BAR; PG8_SCHED;
            PG8_LDB(B1, 1, 1); PG8_STAGE(PG8_SB(1, 0), b3, voffB);
            PG8_BAR; PG8_WAIT_L(0); PG8_MMA(0, 1, At, B1); PG8_BAR;
            PG8_LDA(At, 1, 1); PG8_STAGE(PG8_SA(1, 0), a3, voffA);
            PG8_BAR; PG8_WAIT_L(0); PG8_MMA(1, 0, At, B0); PG8_BAR; PG8_SCHED;
            PG8_STAGE(PG8_SB(1, 1), b3 + hstep, voffB);
            PG8_WAIT_V(6); PG8_BAR; PG8_MMA(1, 1, At, B1); PG8_BAR;
            }
        }
        if constexpr (ALIGN_EPI) { if (wr == 0) PG8_BAR; }
        if constexpr (!Epi::AFTER_DRAIN) { E(acc, cur, wr, wc, fr, fq); S.done(cur); }
        if (!has_next) break;
#pragma unroll
        for (int a = 0; a < 2; ++a)
#pragma unroll
            for (int b = 0; b < 2; ++b)
#pragma unroll
                for (int m = 0; m < 4; ++m)
#pragma unroll
                    for (int n = 0; n < 2; ++n) acc[a][b][m][n] = (f32x4){0.f, 0.f, 0.f, 0.f};
        cur = nxt; cA = nA; cB = nB; ++ui;
        if constexpr (ALIGN_EPI) { if (wr == 1) PG8_BAR; }
    }
    PG8_WAIT_V(0);
    if constexpr (!ALIGN_EPI) { if (wr == 0) PG8_BAR; }
    PG8_BAR;
    if constexpr (Epi::AFTER_DRAIN) { E.fused(acc, cur, wr, wc, fr, fq, lds, wid, lane); S.done(cur); }
#undef PG8_SA
#undef PG8_SB
#undef PG8_STAGE
#undef PG8_LDA
#undef PG8_LDB
#undef PG8_MMA
#undef PG8_WAIT_V
#undef PG8_WAIT_L
#undef PG8_BAR
#undef PG8_SCHED
}
}

#define LAS __attribute__((address_space(3)))
template <int MODE> struct EpiFast {
    static constexpr bool PERM = true, AFTER_DRAIN = false;
    EpiArgs E;
    __device__ __forceinline__ void operator()(const pg8::f32x4 (&acc)[2][2][4][2], const pg8::Unit& u, int wr, int wc, int fr, int fq) const {
        const int row0 = u.pm * 256 + wr * 64 + fr, col0 = u.pn * 256 + wc * 32 + 8 * fq;
#pragma unroll
        for (int ai = 0; ai < 2; ++ai)
#pragma unroll
            for (int m = 0; m < 4; ++m)
#pragma unroll
                for (int bj = 0; bj < 2; ++bj) epi8v(MODE, E, row0 + ai * 128 + m * 16, col0 + bj * 128, acc[ai][bj][m][0], acc[ai][bj][m][1]);
    }
};
__device__ __forceinline__ void side_tile(int mode, const EpiArgs& E, const bf16_t* __restrict__ A, int erow0, const bf16_t* __restrict__ Bt, int K, int n0) {
    const int l = tidf() & 63, i = l & 31, h = l >> 5;
    const int g = i >> 3, hh = (i >> 2) & 1, q = i & 3, L = 8 * (2 * hh + (g >> 1)) + 4 * (g & 1) + q;
    const bf16_t* wp = Bt + (size_t)(n0 + L) * K + 8 * h;
    const bf16_t* xp = A + (size_t)i * K + 8 * h;
    f32x16 acc; for (int r = 0; r < 16; ++r) acc[r] = 0.f;
#pragma unroll 8
    for (int k0 = 0; k0 < K; k0 += 16) { const bf16x8 wf = *(const bf16x8*)(wp + k0), xf = *(const bf16x8*)(xp + k0); acc = __builtin_amdgcn_mfma_f32_32x32x16_bf16(wf, xf, acc, 0, 0, 0); }
    epi8v(mode, E, erow0 + i, n0 + 16 * h, (f32x4){acc[0], acc[1], acc[2], acc[3]}, (f32x4){acc[4], acc[5], acc[6], acc[7]});
    epi8v(mode, E, erow0 + i, n0 + 16 * h + 8, (f32x4){acc[8], acc[9], acc[10], acc[11]}, (f32x4){acc[12], acc[13], acc[14], acc[15]});
}
struct GemmArgs { const bf16_t* A; const bf16_t* Bt; int M, N, K, gt; size_t gstride; int side; int pad; };
constexpr int GEMM_LDS = 131072 + 1024;
template <int MODE> __device__ __forceinline__ void gemm_fast_body(LAS unsigned char* lds, const GemmArgs& ga, const EpiArgs& E) {
    if (ga.side) {
        const int wid = tidf() >> 6, nt = ga.N / 32;
        for (int t = wid * gridDim.x + blockIdx.x; t < nt; t += 8 * gridDim.x) side_tile(MODE, E, ga.A + (size_t)MX * ga.K, MX, ga.Bt, ga.K, t * 32);
        asm volatile("s_waitcnt vmcnt(0)" ::: "memory");
    }
    pg8::Gemm g{ga.A, ga.Bt, ga.M, ga.N, ga.K, ga.gt, ga.gstride};
    pg8::StaticOrder S; S.init(ga.M, ga.N, (int)gridDim.x, (int)blockIdx.x);
    EpiFast<MODE> Ep{E};
    pg8::gemm_phase<EpiFast<MODE>, pg8::StaticOrder, true, true>(lds, g, S, Ep);
}
template <int MODE> __global__ void __launch_bounds__(512, 2) k_gemm_fast(GemmArgs ga, EpiArgs E) {
    extern __shared__ __attribute__((aligned(16))) unsigned char smem_g[];
    gemm_fast_body<MODE>((LAS unsigned char*)smem_g, ga, E);
}
template <int MODE> static void launch_gemm_fast(hipStream_t stream, const bf16_t* A, const bf16_t* Bt, int M, int N, int K, int gt, size_t gstride, int side, const EpiArgs& E) {
    (void)hipFuncSetAttribute((const void*)k_gemm_fast<MODE>, hipFuncAttributeMaxDynamicSharedMemorySize, GEMM_LDS);
    GemmArgs ga{}; ga.A = A; ga.Bt = Bt; ga.M = M; ga.N = N; ga.K = K; ga.gt = gt; ga.gstride = gstride; ga.side = side;
    k_gemm_fast<MODE><<<256, 512, GEMM_LDS, stream>>>(ga, E);
}

__device__ __forceinline__ float log_sigmoid(float x) { return -log1pf(expf(-x)); }
__device__ __forceinline__ int chunk_row(int b, int n, int c) { return n == 0 ? (c >= 112 ? MX + b * 16 + (c - 112) : -1) : b * SEQ + 128 * (n - 1) + c; }

__global__ void __launch_bounds__(256) k_ret_state(const bf16_t* __restrict__ PROJ, const float* __restrict__ dec_f, const float* __restrict__ dec_b, bf16_t* __restrict__ S) {
    __shared__ bf16_t Ks[128][128];
    __shared__ float Vs[128][32];
    const int sl = blockIdx.x, bh = blockIdx.y, dir = blockIdx.z, b = bh >> 2, h = bh & 3, tid = tidf();
    const float lg = log_sigmoid(dir == 0 ? dec_f[h] : dec_b[h]);
    const float dec = expf(lg * 128.f);
    const int dk = tid & 127, hf = tid >> 7;
    float st[16]; for (int j = 0; j < 16; ++j) st[j] = 0.f;
    for (int step = 0; step < NCH; ++step) {
        const int n = dir == 0 ? step : NCH - 1 - step;
        bf16_t* dst = S + ((((size_t)dir * 8 + bh) * NCH + n) * 128 + dk) * 256 + sl * 32 + hf * 16;
        for (int j = 0; j < 16; ++j) dst[j] = f2bf(st[j]);
        __syncthreads();
        for (int i = tid; i < 128 * 128; i += 256) { const int c = i >> 7, d = i & 127; const int r = chunk_row(b, n, c); Ks[c][d] = r < 0 ? (bf16_t)0 : PROJ[(size_t)r * NPROJ + C_K + h * 128 + d]; }
        for (int i = tid; i < 128 * 32; i += 256) { const int c = i >> 5, d = i & 31; const int r = chunk_row(b, n, c);
            const float w = dir == 0 ? expf(lg * (float)(127 - c)) : expf(lg * (float)c);
            Vs[c][d] = r < 0 ? 0.f : bf2f(PROJ[(size_t)r * NPROJ + C_V + h * 256 + sl * 32 + d]) * w; }
        __syncthreads();
        float a[16]; for (int j = 0; j < 16; ++j) a[j] = 0.f;
        for (int c = 0; c < 128; ++c) { const float kv = bf2f(Ks[c][dk]); for (int j = 0; j < 16; ++j) a[j] += kv * Vs[c][hf * 16 + j]; }
        for (int j = 0; j < 16; ++j) st[j] = st[j] * dec + a[j];
    }
}

constexpr int QS_STRIDE = 130;
constexpr int R2_LDS = 2 * 128 * QS_STRIDE * 2 + 128 * 128 * 4 + 64 * 4;
__global__ void __launch_bounds__(256) k_ret_out(const bf16_t* __restrict__ PROJ, const bf16_t* __restrict__ S, const float* __restrict__ dec_f, const float* __restrict__ dec_b,
                                                const float* __restrict__ hg, bf16_t* __restrict__ ARET) {
    extern __shared__ __attribute__((aligned(16))) unsigned char smem[];
    bf16_t* Qs = (bf16_t*)smem; bf16_t* Ks = Qs + 128 * QS_STRIDE; float* SC = (float*)(Ks + 128 * QS_STRIDE); float* red = SC + 128 * 128;
    const int n = blockIdx.x, bh = blockIdx.y, b = bh >> 2, h = bh & 3, tid = tidf();
    const float lf = log_sigmoid(dec_f[h]), lb = log_sigmoid(dec_b[h]);
    for (int i = tid; i < 128 * 128; i += 256) { const int c = i >> 7, d = i & 127; const int r = chunk_row(b, n, c);
        Qs[c * QS_STRIDE + d] = r < 0 ? (bf16_t)0 : PROJ[(size_t)r * NPROJ + C_Q + h * 128 + d];
        Ks[c * QS_STRIDE + d] = r < 0 ? (bf16_t)0 : PROJ[(size_t)r * NPROJ + C_K + h * 128 + d]; }
    __syncthreads();
    {
        const int j = tid & 127, ib = (tid >> 7) * 64;
        for (int i = ib; i < ib + 64; ++i) {
            float s = 0.f;
            for (int d = 0; d < 128; ++d) s += bf2f(Qs[i * QS_STRIDE + d]) * bf2f(Ks[j * QS_STRIDE + d]);
            const float mk = i >= j ? expf(lf * (float)(i - j)) : expf(lb * (float)(j - i));
            SC[i * 128 + j] = s * mk;
        }
    }
    __syncthreads();
    const int dv = tid;
    const bf16_t* Sf = S + (((size_t)0 * 8 + bh) * NCH + n) * 128 * 256;
    const bf16_t* Sb = S + (((size_t)1 * 8 + bh) * NCH + n) * 128 * 256;
    for (int grp = (n == 0 ? 7 : 0); grp < 8; ++grp) {
        float acc[16]; for (int i = 0; i < 16; ++i) acc[i] = 0.f;
        for (int j = 0; j < 128; ++j) { const int r = chunk_row(b, n, j); if (r < 0) continue; const float v = bf2f(PROJ[(size_t)r * NPROJ + C_V + h * 256 + dv]);
            for (int i = 0; i < 16; ++i) acc[i] += SC[(grp * 16 + i) * 128 + j] * v; }
        float qf[16], qb[16];
        for (int i = 0; i < 16; ++i) { const int ii = grp * 16 + i; qf[i] = expf(lf * (float)(ii + 1)); qb[i] = expf(lb * (float)(128 - ii)); }
        for (int d = 0; d < 128; ++d) { const float sf = bf2f(Sf[(size_t)d * 256 + dv]), sb = bf2f(Sb[(size_t)d * 256 + dv]);
            for (int i = 0; i < 16; ++i) { const float q = bf2f(Qs[(grp * 16 + i) * QS_STRIDE + d]); acc[i] += q * (qf[i] * sf + qb[i] * sb); } }
        float ss[16];
        for (int i = 0; i < 16; ++i) { float v = acc[i] * acc[i]; for (int o = 32; o > 0; o >>= 1) v += __shfl_xor(v, o); ss[i] = v; }
        __syncthreads();
        if ((tid & 63) == 0) for (int i = 0; i < 16; ++i) red[(tid >> 6) * 16 + i] = ss[i];
        __syncthreads();
        for (int i = 0; i < 16; ++i) {
            const float ms = (red[i] + red[16 + i] + red[32 + i] + red[48 + i]) * (1.f / 256.f);
            const int r = chunk_row(b, n, grp * 16 + i);
            if (r < 0) continue;
            const float y = acc[i] * rsqrtf(ms + RMS_EPS) * hg[h * 256 + dv];
            ARET[(size_t)r * DM + h * 256 + dv] = f2bf(y * bf2f(PROJ[(size_t)r * NPROJ + C_G + h * 256 + dv]));
        }
    }
}

__device__ __forceinline__ float conv3(const bf16_t* __restrict__ PROJ, const float* __restrict__ cw, const float* __restrict__ cb, int b, int t, int ch) {
    float a = cb[ch];
    for (int j = 0; j < 3; ++j) { const int tt = t + j - 1; if (tt >= 0 && tt < TT) a += bf2f(PROJ[(size_t)row_of(b, tt) * NPROJ + C_U + ch]) * cw[j * 3072 + ch]; }
    return a;
}
__global__ void k_hy_prep(const bf16_t* __restrict__ PROJ, const float* __restrict__ cw, const float* __restrict__ cb, bf16_t* __restrict__ ZT) {
    const int c = blockIdx.x * 256 + tidf(), t = blockIdx.y, b = blockIdx.z;
    bf16_t v = 0;
    if (t < TT) { const float x1 = conv3(PROJ, cw, cb, b, t, 1024 + c), vh = conv3(PROJ, cw, cb, b, t, 2048 + c); v = f2bf(x1 * vh); }
    ZT[((size_t)b * 1024 + c) * ZL + t] = v;
}
__global__ void __launch_bounds__(256) k_hy_conv(const bf16_t* __restrict__ G, const bf16_t* __restrict__ ZT, bf16_t* __restrict__ YCT) {
    __shared__ float zs[2][1024];
    __shared__ float gs[3072 + 8];
    const int tile = blockIdx.x, c = blockIdx.y, tid = tidf();
    const int tb = tile * 2048, t0 = tb + tid * 8;
    float acc0[8], acc1[8];
    for (int j = 0; j < 8; ++j) { acc0[j] = 0.f; acc1[j] = 0.f; }
    const bf16_t* g = G + (size_t)c * GL;
    for (int s0 = 0; s0 < TT; s0 += 1024) {
        __syncthreads();
        for (int i = tid; i < 2048; i += 256) { const int bb = i >> 10, s = s0 + (i & 1023); zs[bb][i & 1023] = s < TT ? bf2f(ZT[((size_t)bb * 1024 + c) * ZL + s]) : 0.f; }
        const int dlo = tb - s0 - 1023;
        for (int i = tid; i < 3072; i += 256) { const int idx = TT + dlo + i; gs[i] = (idx >= 0 && idx < GL) ? bf2f(g[idx]) : 0.f; }
        __syncthreads();
        const int base = tid * 8 + 1023;
        for (int u = 0; u < 1024; ++u) {
            const float z0 = zs[0][u], z1 = zs[1][u];
#pragma unroll
            for (int j = 0; j < 8; ++j) { const float gv = gs[base + j - u]; acc0[j] += gv * z0; acc1[j] += gv * z1; }
        }
    }
    for (int j = 0; j < 8; ++j) { const int t = t0 + j; if (t < ZL) { YCT[((size_t)0 * 1024 + c) * ZL + t] = f2bf(acc0[j]); YCT[((size_t)1 * 1024 + c) * ZL + t] = f2bf(acc1[j]); } }
}
__global__ void k_hy_post(const bf16_t* __restrict__ PROJ, const float* __restrict__ cw, const float* __restrict__ cb, const float* __restrict__ skip, const bf16_t* __restrict__ YCT, bf16_t* __restrict__ AHY) {
    const int c = blockIdx.x * 256 + tidf(), m = blockIdx.y;
    int b, t; bt_of(m, b, t);
    const float x0 = conv3(PROJ, cw, cb, b, t, c), x1 = conv3(PROJ, cw, cb, b, t, 1024 + c), vh = conv3(PROJ, cw, cb, b, t, 2048 + c);
    const float z = x1 * vh;
    const float yc = bf2f(YCT[((size_t)b * 1024 + c) * ZL + t]);
    AHY[(size_t)m * DM + c] = f2bf(x0 * (yc + z * skip[c]));
}


constexpr int CV_GR_BYTES = GL * 2;
constexpr int CV_ZROW = 272, CV_ZB = 18176  , CV_Z_BYTES = 2 * CV_ZB;
constexpr int CV_SLOT = CV_GR_BYTES + CV_Z_BYTES;
constexpr int CV_LDS = 2 * CV_SLOT;
__device__ __forceinline__ bf16x8 cv_load_frag(const LAS unsigned char* p, unsigned sh) {
    unsigned X[5];
#pragma unroll
    for (int i = 0; i < 5; ++i) X[i] = *(const LAS unsigned*)(p + 4 * i);
    u32x4 o;
    o.x = __builtin_amdgcn_alignbit(X[1], X[0], sh); o.y = __builtin_amdgcn_alignbit(X[2], X[1], sh);
    o.z = __builtin_amdgcn_alignbit(X[3], X[2], sh); o.w = __builtin_amdgcn_alignbit(X[4], X[3], sh);
    return __builtin_bit_cast(bf16x8, o);
}
__device__ __forceinline__ void conv_fast_body(LAS unsigned char* lds, const bf16_t* __restrict__ G, const bf16_t* __restrict__ ZT, bf16_t* __restrict__ YCT, int c_first) {
    const int tid = tidf(), l = tid & 63, wid = tid >> 6, slot = wid >> 2, ct = wid & 3;
    const int ts = tid & 255;
    LAS unsigned char* grb = lds + slot * CV_SLOT;
    LAS unsigned char* zb = grb + CV_GR_BYTES;
    for (int rd = 0; rd < 2; ++rd) {
        const int c = c_first + 2 * rd + slot;
        __syncthreads();
        {
            const u32x4* gsrc = (const u32x4*)(G + (size_t)c * GL);
            for (int i = ts; i < GL / 8; i += 256) {
                const u32x4 v = gsrc[i]; u32x4 o;
                o.x = __builtin_amdgcn_alignbit(v.w, v.w, 16); o.y = __builtin_amdgcn_alignbit(v.z, v.z, 16); o.z = __builtin_amdgcn_alignbit(v.y, v.y, 16); o.w = __builtin_amdgcn_alignbit(v.x, v.x, 16);
                *(LAS u32x4*)(grb + (size_t)(GL - 8 * (i + 1)) * 2) = o;
            }
            for (int i = ts; i < 2 * 66 * 17; i += 256) {
                const int bb = i / (66 * 17), rem = i - bb * (66 * 17), Ib = rem / 17, q = rem - Ib * 17;
                u32x4 v = (u32x4){0u, 0u, 0u, 0u};
                const bf16_t* zr = ZT + ((size_t)bb * 1024 + c) * ZL;
                if (q < 16) { if (Ib == 0) { if (q >= 14) v = *(const u32x4*)(zr + 8 * (q - 14)); } else if (Ib <= 64) v = *(const u32x4*)(zr + 16 + 128 * (Ib - 1) + 8 * q); }
                *(LAS u32x4*)(zb + bb * CV_ZB + Ib * CV_ZROW + q * 16) = v;
            }
        }
        __syncthreads();
        const int r = l & 31, h = l >> 5;
        const int Ec = 8431 + 112 - r + 8 * h;
        const unsigned sh = (unsigned)(Ec & 1) * 16u;
        const int Io = 16 * ct + (r & 15), bcol = r >> 4;
        f32x16 acc[4];
#pragma unroll
        for (int rt = 0; rt < 4; ++rt) for (int q = 0; q < 16; ++q) acc[rt][q] = 0.f;
        bf16x8 F[14];
        int d = 16 * ct - 63;
        const LAS unsigned char* abase = grb + 4 * (Ec >> 1) - 256 * d;
#pragma unroll
        for (int f = 0; f < 6; ++f) F[f] = cv_load_frag(abase - 32 * f, sh);
        const int dend = 16 * ct + 16;
        for (; d <= dend; ++d) {
#pragma unroll
            for (int f = 6; f < 14; ++f) F[f] = cv_load_frag(abase - 32 * f, sh);
            int Ib = Io - d + 1; Ib = (Ib < 0 || Ib > 64) ? 65 : Ib;
            const LAS unsigned char* zp = zb + bcol * CV_ZB + Ib * CV_ZROW + 16 * h;
#pragma unroll
            for (int ks = 0; ks < 8; ++ks) {
                const bf16x8 Bf = *(const LAS bf16x8*)(zp + 32 * ks);
#pragma unroll
                for (int rt = 0; rt < 4; ++rt) acc[rt] = __builtin_amdgcn_mfma_f32_32x32x16_bf16(F[2 * rt - ks + 7], Bf, acc[rt], 0, 0, 0);
            }
#pragma unroll
            for (int f = 0; f < 6; ++f) F[f] = F[f + 8];
            abase -= 256;
        }
        {
            bf16_t* yr = YCT + ((size_t)bcol * 1024 + c) * ZL + 16 + 128 * Io + 4 * h;
#pragma unroll
            for (int rt = 0; rt < 4; ++rt)
#pragma unroll
                for (int g = 0; g < 4; ++g) { u32x2 w; w.x = pk2(acc[rt][4 * g], acc[rt][4 * g + 1]); w.y = pk2(acc[rt][4 * g + 2], acc[rt][4 * g + 3]); *(u32x2*)(yr + 32 * rt + 8 * g) = w; }
        }
        {
            float a0[4], a1[4];
#pragma unroll
            for (int q = 0; q < 4; ++q) { a0[q] = 0.f; a1[q] = 0.f; }
            const LAS bf16_t* grh = (const LAS bf16_t*)grb;
            for (int s = l; s < TT; s += 64) {
                int Ib, j; if (s < 16) { Ib = 0; j = 112 + s; } else { const int s2 = s - 16; Ib = 1 + (s2 >> 7); j = s2 & 127; }
                const float z0 = bf2f(*(const LAS bf16_t*)(zb + Ib * CV_ZROW + 2 * j)), z1 = bf2f(*(const LAS bf16_t*)(zb + CV_ZB + Ib * CV_ZROW + 2 * j));
#pragma unroll
                for (int q = 0; q < 4; ++q) { const float gv = bf2f(grh[8431 - (4 * ct + q) + s]); a0[q] += gv * z0; a1[q] += gv * z1; }
            }
#pragma unroll
            for (int q = 0; q < 4; ++q) {
                float v0 = a0[q], v1 = a1[q];
                for (int o = 32; o > 0; o >>= 1) { v0 += __shfl_xor(v0, o); v1 += __shfl_xor(v1, o); }
                if (l == 0) { YCT[((size_t)0 * 1024 + c) * ZL + 4 * ct + q] = f2bf(v0); YCT[((size_t)1 * 1024 + c) * ZL + 4 * ct + q] = f2bf(v1); }
            }
        }
    }
}
__global__ void __launch_bounds__(512, 2) k_conv_fast(const bf16_t* __restrict__ G, const bf16_t* __restrict__ ZT, bf16_t* __restrict__ YCT) {
    extern __shared__ __attribute__((aligned(16))) unsigned char smem_c[];
    conv_fast_body((LAS unsigned char*)smem_c, G, ZT, YCT, 4 * blockIdx.x);
}
__global__ void k_norm2_router(const float* __restrict__ H2, const float* __restrict__ H2M, const float* __restrict__ g2, const float* __restrict__ wr, bf16_t* __restrict__ XN2, float* __restrict__ AFF) {
    __shared__ float red[4]; __shared__ float lred[4][16];
    const int m = blockIdx.x, tid = tidf();
    const float* src = m < MX ? H2 + (size_t)m * DM : H2M + (size_t)(m - MX) * DM;
    float v[4]; float s = 0.f;
    for (int i = 0; i < 4; ++i) { v[i] = src[tid + 256 * i]; s += v[i] * v[i]; }
    s = block_sum256(s, red);
    const float r = rsqrtf(s * (1.f / DM) + RMS_EPS);
    float lg[16]; for (int e = 0; e < 16; ++e) lg[e] = 0.f;
    for (int i = 0; i < 4; ++i) { const int k = tid + 256 * i; const float xn = v[i] * r * g2[k]; XN2[(size_t)m * DM + k] = f2bf(xn);
        for (int e = 0; e < 16; ++e) lg[e] += xn * wr[k * 16 + e]; }
    for (int e = 0; e < 16; ++e) { float q = lg[e]; for (int o = 32; o > 0; o >>= 1) q += __shfl_xor(q, o); lg[e] = q; }
    if ((tid & 63) == 0) for (int e = 0; e < 16; ++e) lred[tid >> 6][e] = lg[e];
    __syncthreads();
    if (tid == 0) {
        float l[16], mx = -1e30f;
        for (int e = 0; e < 16; ++e) { l[e] = lred[0][e] + lred[1][e] + lred[2][e] + lred[3][e]; mx = fmaxf(mx, l[e]); }
        float sum = 0.f; for (int e = 0; e < 16; ++e) { l[e] = expf(l[e] - mx); sum += l[e]; }
        int b, t; bt_of(m, b, t);
        for (int e = 0; e < 16; ++e) AFF[((size_t)b * NE + e) * TT + t] = l[e] / sum;
    }
}
__global__ void k_topk(const float* __restrict__ AFF, int* __restrict__ IDX, float* __restrict__ GATEV, int* __restrict__ INV) {
    __shared__ float a[TT];
    const int be = blockIdx.y, t = blockIdx.x * 256 + tidf();
    for (int i = tidf(); i < TT; i += 256) a[i] = AFF[(size_t)be * TT + i];
    __syncthreads();
    if (t >= TT) return;
    const float v = a[t]; int rank = 0;
    for (int i = 0; i < TT; ++i) { const float w = a[i]; rank += (w > v || (w == v && i < t)) ? 1 : 0; }
    if (rank < CAP) { IDX[(size_t)be * CAP + rank] = t; GATEV[(size_t)be * CAP + rank] = v; INV[(size_t)be * TT + t] = rank; }
    else INV[(size_t)be * TT + t] = -1;
}
__global__ void k_gather(const bf16_t* __restrict__ XN2, const int* __restrict__ IDX, bf16_t* __restrict__ XE) {
    const int r = blockIdx.x, e = blockIdx.y;
    uint4 v = make_uint4(0, 0, 0, 0);
    if (r < 2 * CAP) { const int b = r / CAP, slot = r % CAP; const int t = IDX[((size_t)b * NE + e) * CAP + slot]; v = *(const uint4*)(XN2 + (size_t)row_of(b, t) * DM + tidf() * 8); }
    *(uint4*)(XE + ((size_t)e * ER + r) * DM + tidf() * 8) = v;
}
__global__ void k_final(float* __restrict__ OUT, const bf16_t* __restrict__ YE, const int* __restrict__ INV, const float* __restrict__ gfin) {
    __shared__ float red[4];
    const int m = blockIdx.x, tid = tidf(), b = m >> 13, t = (m & 8191) + NMETA;
    float v[4]; for (int i = 0; i < 4; ++i) v[i] = OUT[(size_t)m * DM + tid + 256 * i];
    for (int e = 0; e < NE; ++e) { const int slot = INV[((size_t)b * NE + e) * TT + t]; if (slot >= 0) { const bf16_t* y = YE + ((size_t)e * ER + b * CAP + slot) * DM; for (int i = 0; i < 4; ++i) v[i] += bf2f(y[tid + 256 * i]); } }
    float s = 0.f; for (int i = 0; i < 4; ++i) s += v[i] * v[i];
    s = block_sum256(s, red);
    const float r = rsqrtf(s * (1.f / DM) + RMS_EPS);
    for (int i = 0; i < 4; ++i) OUT[(size_t)m * DM + tid + 256 * i] = v[i] * r * gfin[tid + 256 * i];
}


struct Ctx {
    const float *x, *meta, *norm1_g, *w_in, *dec_f, *dec_b, *hg, *w_ret, *cw, *cb, *fw1, *fb1, *fw2, *fb2, *fw3, *fb3, *ffq, *fw4, *skip, *w_hy, *w_o, *norm2_g, *w_router, *w_eg, *w_eu, *w_ed, *gfin;
    unsigned char* ws; unsigned char* dob;
};
#define P_WRET ((bf16_t*)(c.ws + WS_WRET))
#define P_WHY ((bf16_t*)(c.ws + WS_WHY))
#define P_WO ((bf16_t*)(c.ws + WS_WO))
#define P_XN ((bf16_t*)(c.ws + WS_XN))
#define P_PROJ ((bf16_t*)(c.ws + WS_PROJ))
#define P_S ((bf16_t*)(c.ws + WS_S))
#define P_TMP ((float*)(c.ws + WS_S))
#define P_ZT ((bf16_t*)(c.ws + WS_ZT))
#define P_G ((bf16_t*)(c.ws + WS_G))
#define P_AHY ((bf16_t*)(c.ws + WS_G))
#define P_ARET ((bf16_t*)(c.ws + WS_ARET))
#define P_WGU ((bf16_t*)(c.ws + WS_WGU))
#define P_WD ((bf16_t*)(c.ws + WS_WD))
#define P_XE ((bf16_t*)(c.ws + WS_XE))
#define P_YE ((bf16_t*)(c.ws + WS_XE))
#define P_HID ((bf16_t*)(c.ws + WS_HID))
#define P_WIN ((bf16_t*)(c.dob + DO_WIN))
#define P_ROPE ((float*)(c.dob + DO_ROPE))
#define P_YCT ((bf16_t*)(c.dob + DO_YCT))
#define P_AFF ((float*)(c.ws + WS_MISC + MI_AFF))
#define P_IDX ((int*)(c.ws + WS_MISC + MI_IDX))
#define P_GATEV ((float*)(c.ws + WS_MISC + MI_GATE))
#define P_INV ((int*)(c.ws + WS_MISC + MI_INV))
#define P_H2M ((float*)(c.ws + WS_MISC + MI_H2M))
#define P_H2 ((float*)c.dob)
#define LDSW() asm volatile("s_waitcnt lgkmcnt(0)" ::: "memory")
__device__ __forceinline__ float wave_sum(float v) {
#pragma unroll
    for (int o = 1; o < 64; o <<= 1) v += __shfl_xor(v, o);
    return v;
}
__device__ __forceinline__ EpiArgs make_epi(const Ctx& c) {
    EpiArgs E{}; E.PROJ = P_PROJ; E.ROPE = P_ROPE; E.TMP = P_TMP; E.MIXED = P_XN; E.x = c.x; E.meta = c.meta; E.H2 = P_H2; E.H2M = P_H2M; E.HID = P_HID; E.YE = P_YE; E.GATEV = P_GATEV; return E;
}

__device__ __forceinline__ int wt_dst_row(int mode, int s) {
    if (mode == 1) { if (s >= 1024) return s; const int sl = s & 127; const int i = sl & 63; return (s & ~127) + 8 * (i >> 2) + (sl >= 64 ? 4 : 0) + (i & 3); }
    if (mode == 2) return 8 * (s >> 2) + (s & 3);
    if (mode == 3) return 8 * (s >> 2) + 4 + (s & 3);
    return s;
}
__device__ __forceinline__ void wt_item(const float* __restrict__ W, int K, int N, bf16_t* __restrict__ WT, LAS float* scr, int kb, int nb, int lane, int mode) {
    const int k0 = 64 * kb, n0 = 32 * nb;
#pragma unroll
    for (int i = 0; i < 8; ++i) { const int kk = 8 * i + (lane >> 3); const f32x4 v = *(const f32x4*)(W + (size_t)(k0 + kk) * N + n0 + 4 * (lane & 7));
        LAS float* d = scr + kk * 33 + 4 * (lane & 7); d[0] = v.x; d[1] = v.y; d[2] = v.z; d[3] = v.w; }
    LDSW();
    const int cc = lane & 7;
#pragma unroll
    for (int j = 0; j < 4; ++j) { const int n = (lane >> 3) + 8 * j; const LAS float* s = scr + (8 * cc) * 33 + n;
        u32x4 o; o.x = pk2(s[0 * 33], s[1 * 33]); o.y = pk2(s[2 * 33], s[3 * 33]); o.z = pk2(s[4 * 33], s[5 * 33]); o.w = pk2(s[6 * 33], s[7 * 33]);
        *(u32x4*)(WT + (size_t)wt_dst_row(mode, n0 + n) * K + k0 + 8 * cc) = o; }
    LDSW();
}

__device__ __forceinline__ void phase_p0(LAS unsigned char* lds, const Ctx& c) {
    const int tid = tidf(), lane = tid & 63, wid = tid >> 6;
    const int gw = blockIdx.x * 8 + wid, NGW = gridDim.x * 8;
    {
        LAS float* scr = (LAS float*)(lds + wid * 8448);
        constexpr int I_IN = 16 * 256, I_SM = 16 * 32;
        for (int it = gw; it < I_IN + 3 * I_SM; it += NGW) {
            int r = it;
            if (r < I_IN) { wt_item(c.w_in, 1024, 8192, P_WIN, scr, r / 256, r % 256, lane, 1); continue; } r -= I_IN;
            if (r < I_SM) { wt_item(c.w_ret, 1024, 1024, P_WRET, scr, r / 32, r % 32, lane, 0); continue; } r -= I_SM;
            if (r < I_SM) { wt_item(c.w_hy, 1024, 1024, P_WHY, scr, r / 32, r % 32, lane, 0); continue; } r -= I_SM;
            wt_item(c.w_o, 1024, 1024, P_WO, scr, r / 32, r % 32, lane, 0);
        }
    }
    for (int m = gw; m < MROWS; m += NGW) {
        const float* src = m < MX ? c.x + (size_t)m * DM : c.meta + (size_t)((m - MX) & 15) * DM;
        f32x4 v[4]; float s = 0.f;
#pragma unroll
        for (int j = 0; j < 4; ++j) { v[j] = *(const f32x4*)(src + 4 * (lane + 64 * j)); s += (v[j].x * v[j].x + v[j].y * v[j].y) + (v[j].z * v[j].z + v[j].w * v[j].w); }
        const float r = rsqrtf(wave_sum(s) * (1.f / DM) + RMS_EPS);
#pragma unroll
        for (int j = 0; j < 4; ++j) { const f32x4 g = *(const f32x4*)(c.norm1_g + 4 * (lane + 64 * j)); u32x2 w; w.x = pk2(v[j].x * r * g.x, v[j].y * r * g.y); w.y = pk2(v[j].z * r * g.z, v[j].w * r * g.w);
            *(u32x2*)(P_XN + (size_t)m * DM + 4 * (lane + 64 * j)) = w; }
    }
    for (int i = blockIdx.x * 512 + tid; i < TT * 64; i += gridDim.x * 512) {
        const int t = i >> 6, f = i & 63; const float inv = powf(10000.0f, -(float)f / 64.0f); const float ang = (float)t * inv;
        P_ROPE[(size_t)t * 128 + f] = cosf(ang); P_ROPE[(size_t)t * 128 + 64 + f] = sinf(ang);
    }
    {
        LAS float* feat = (LAS float*)(lds + 69632);
        LAS float* ha = feat + 32 * 34;
        LAS float* hb = ha + 32 * 65;
        LAS bf16_t* hd = (LAS bf16_t*)(hb + 32 * 65);
        const float mind = logf(1e-2f) / 1.5f, maxd = logf(1e-2f) / 0.3f;
        for (int it = blockIdx.x; it < (TT + 31) / 32; it += gridDim.x) {
            const int p = tid >> 4, q = tid & 15, t = it * 32 + p;
            __syncthreads();
            {
                const float fr = 1e-4f + (float)q * ((15.0f - 1e-4f) / 15.0f);
                const float ang = (2.0f * 3.14159265358979323846f * (float)t / (float)TT) * fr;
                feat[p * 34 + 1 + q] = cosf(ang); feat[p * 34 + 17 + q] = -sinf(ang);
                if (q == 0) feat[p * 34] = (float)t / (float)(TT - 1);
            }
            __syncthreads();
            const int u = q * 4;
            const f32x4 fq = *(const f32x4*)(c.ffq + u);
            {
                f32x4 a = *(const f32x4*)(c.fb1 + u);
#pragma unroll 3
                for (int i = 0; i < 33; ++i) a += feat[p * 34 + i] * *(const f32x4*)(c.fw1 + i * 64 + u);
#pragma unroll
                for (int j = 0; j < 4; ++j) ha[p * 65 + u + j] = sinf(fq[j] * a[j]);
            }
            __syncthreads();
            {
                f32x4 a = *(const f32x4*)(c.fb2 + u);
#pragma unroll 4
                for (int i = 0; i < 64; ++i) a += ha[p * 65 + i] * *(const f32x4*)(c.fw2 + i * 64 + u);
#pragma unroll
                for (int j = 0; j < 4; ++j) hb[p * 65 + u + j] = sinf(fq[j] * a[j]);
            }
            __syncthreads();
            {
                f32x4 a = *(const f32x4*)(c.fb3 + u);
#pragma unroll 4
                for (int i = 0; i < 64; ++i) a += hb[p * 65 + i] * *(const f32x4*)(c.fw3 + i * 64 + u);
#pragma unroll
                for (int j = 0; j < 4; ++j) hd[p * 72 + u + j] = f2bf(sinf(fq[j] * a[j]));
            }
            __syncthreads();
            const int r = lane & 31, h = lane >> 5;
            bf16x8 Af[4];
#pragma unroll
            for (int ks = 0; ks < 4; ++ks) Af[ks] = *(const LAS bf16x8*)((const LAS unsigned char*)hd + r * 144 + (16 * ks + 8 * h) * 2);
#pragma unroll 1
            for (int k8 = 0; k8 < 8; ++k8) {
                const int o = 32 * (wid + 8 * k8) + r;
                f32x16 acc; for (int z = 0; z < 16; ++z) acc[z] = 0.f;
#pragma unroll
                for (int ks = 0; ks < 4; ++ks) {
                    const float* wp = c.fw4 + (size_t)(16 * ks + 8 * h) * 2048 + o;
                    u32x4 bw; bw.x = pk2(wp[0], wp[2048]); bw.y = pk2(wp[2 * 2048], wp[3 * 2048]); bw.z = pk2(wp[4 * 2048], wp[5 * 2048]); bw.w = pk2(wp[6 * 2048], wp[7 * 2048]);
                    acc = __builtin_amdgcn_mfma_f32_32x32x16_bf16(Af[ks], __builtin_bit_cast(bf16x8, bw), acc, 0, 0, 0);
                }
                const int ch = o & 1023, bwd = o >> 10;
                const float ad = fabsf(mind + (float)ch * ((maxd - mind) / 1023.0f));
                bf16_t* grow = P_G + (size_t)ch * GL;
#pragma unroll
                for (int g = 0; g < 4; ++g)
#pragma unroll
                    for (int z = 0; z < 4; ++z) {
                        const int tt = it * 32 + 8 * g + 4 * h + z;
                        if (tt < TT) { const float win = __expf(-((float)tt / (float)(TT - 1)) * ad); const bf16_t v = f2bf(acc[4 * g + z] * win);
                            if (!bwd) grow[TT + tt] = v; else if (tt >= 1) grow[TT - tt] = v; }
                    }
            }
        }
        for (int ch = blockIdx.x * 512 + tid; ch < 1024; ch += gridDim.x * 512) { bf16_t* grow = P_G + (size_t)ch * GL; grow[0] = 0; for (int i = 2 * TT; i < GL; ++i) grow[i] = 0; }
    }
}

__device__ __forceinline__ void phase_p6(LAS unsigned char* lds, const Ctx& c) {
    const int tid = tidf(), lane = tid & 63, wid = tid >> 6;
    const int gw = blockIdx.x * 8 + wid, NGW = gridDim.x * 8;
    LAS float* wr = (LAS float*)lds;
    for (int i = tid; i < 1024 * 16 / 4; i += 512) ((LAS f32x4*)wr)[i] = ((const f32x4*)c.w_router)[i];
    __syncthreads();
    for (int m = gw; m < MROWS; m += NGW) {
        const float* src = m < MX ? P_H2 + (size_t)m * DM : P_H2M + (size_t)(m - MX) * DM;
        f32x4 v[4]; float s = 0.f;
#pragma unroll
        for (int j = 0; j < 4; ++j) { v[j] = *(const f32x4*)(src + 4 * (lane + 64 * j)); s += (v[j].x * v[j].x + v[j].y * v[j].y) + (v[j].z * v[j].z + v[j].w * v[j].w); }
        const float r = rsqrtf(wave_sum(s) * (1.f / DM) + RMS_EPS);
        float lg[16];
#pragma unroll
        for (int e = 0; e < 16; ++e) lg[e] = 0.f;
#pragma unroll
        for (int j = 0; j < 4; ++j) {
            const f32x4 g = *(const f32x4*)(c.norm2_g + 4 * (lane + 64 * j));
            const f32x4 xn = (f32x4){v[j].x * r * g.x, v[j].y * r * g.y, v[j].z * r * g.z, v[j].w * r * g.w};
            u32x2 w; w.x = pk2(xn.x, xn.y); w.y = pk2(xn.z, xn.w);
            *(u32x2*)(P_XN + (size_t)m * DM + 4 * (lane + 64 * j)) = w;
#pragma unroll
            for (int z = 0; z < 4; ++z) { const LAS f32x4* wp = (const LAS f32x4*)(wr + (4 * (lane + 64 * j) + z) * 16);
#pragma unroll
                for (int e4 = 0; e4 < 4; ++e4) { const f32x4 w4 = wp[e4]; lg[4 * e4] += xn[z] * w4.x; lg[4 * e4 + 1] += xn[z] * w4.y; lg[4 * e4 + 2] += xn[z] * w4.z; lg[4 * e4 + 3] += xn[z] * w4.w; } }
            asm volatile("" ::: "memory");
        }
        float mx = -1e30f;
#pragma unroll
        for (int e = 0; e < 16; ++e) { lg[e] = wave_sum(lg[e]); mx = fmaxf(mx, lg[e]); }
        float sum = 0.f;
#pragma unroll
        for (int e = 0; e < 16; ++e) { lg[e] = expf(lg[e] - mx); sum += lg[e]; }
        int b, t; bt_of(m, b, t);
        const float inv = 1.f / sum;
#pragma unroll
        for (int e = 0; e < 16; ++e) if (lane == e) P_AFF[((size_t)b * NE + e) * TT + t] = lg[e] * inv;
    }
    __syncthreads();
    {
        LAS float* scr = (LAS float*)(lds + wid * 8448);
        for (int it = gw; it < NE * 3072; it += NGW) {
            const int e = it / 3072, r = it % 3072;
            if (r < 1024) wt_item(c.w_eg + (size_t)e * 1024 * 2048, 1024, 2048, P_WGU + (size_t)e * 4096 * 1024, scr, r / 64, r % 64, lane, 2);
            else if (r < 2048) wt_item(c.w_eu + (size_t)e * 1024 * 2048, 1024, 2048, P_WGU + (size_t)e * 4096 * 1024, scr, (r - 1024) / 64, (r - 1024) % 64, lane, 3);
            else wt_item(c.w_ed + (size_t)e * 2048 * 1024, 2048, 1024, P_WD + (size_t)e * 1024 * 2048, scr, (r - 2048) / 32, (r - 2048) % 32, lane, 0);
        }
    }
}

__device__ __forceinline__ void phase_topk(LAS unsigned char* lds, const Ctx& c) {
    const int tid = tidf(), lane = tid & 63, wid = tid >> 6;
    LAS unsigned* hist = (LAS unsigned*)lds;
    LAS unsigned* sh = hist + 256;
    for (int be = blockIdx.x; be < NB * NE; be += gridDim.x) {
        const float* a = P_AFF + (size_t)be * TT;
        unsigned key[17];
#pragma unroll
        for (int j = 0; j < 17; ++j) { const int t = tid * 17 + j; key[j] = t < TT ? __float_as_uint(a[t]) : 0u; }
        unsigned prefix = 0u, kk = CAP;
        for (int pass = 0; pass < 4; ++pass) {
            const int shift = 24 - 8 * pass;
            __syncthreads();
            if (tid < 256) hist[tid] = 0u;
            __syncthreads();
            const unsigned himask = pass == 0 ? 0u : (0xffffffffu << (shift + 8));
#pragma unroll
            for (int j = 0; j < 17; ++j) if ((key[j] & himask) == prefix && tid * 17 + j < TT) __hip_atomic_fetch_add(&hist[(key[j] >> shift) & 255u], 1u, __ATOMIC_RELAXED, __HIP_MEMORY_SCOPE_WORKGROUP);
            __syncthreads();
            if (tid == 0) { unsigned cum = 0u; int d = 255; for (; d > 0; --d) { if (cum + hist[d] >= kk) break; cum += hist[d]; } sh[0] = prefix | ((unsigned)d << shift); sh[1] = kk - cum; }
            __syncthreads();
            prefix = sh[0]; kk = sh[1];
        }
        int ngt = 0, neq = 0;
#pragma unroll
        for (int j = 0; j < 17; ++j) { const bool v = tid * 17 + j < TT; ngt += (v && key[j] > prefix) ? 1 : 0; neq += (v && key[j] == prefix) ? 1 : 0; }
        int sg = ngt, se = neq;
#pragma unroll
        for (int o = 1; o < 64; o <<= 1) { const int ug = __shfl_up(sg, o), ue = __shfl_up(se, o); if (lane >= o) { sg += ug; se += ue; } }
        __syncthreads();
        if (lane == 63) { sh[8 + wid] = (unsigned)sg; sh[16 + wid] = (unsigned)se; }
        __syncthreads();
        int bg = 0, beq = 0;
        for (int w = 0; w < wid; ++w) { bg += (int)sh[8 + w]; beq += (int)sh[16 + w]; }
        int pg = bg + sg - ngt, pe = beq + se - neq;
        int slot = pg + ((pe < (int)kk) ? pe : (int)kk);
        int* idx = P_IDX + (size_t)be * CAP; float* gv = P_GATEV + (size_t)be * CAP; int* inv = P_INV + (size_t)be * TT;
#pragma unroll
        for (int j = 0; j < 17; ++j) {
            const int t = tid * 17 + j;
            if (t < TT) {
                bool sel = false;
                if (key[j] > prefix) sel = true; else if (key[j] == prefix) { sel = pe < (int)kk; ++pe; }
                if (sel) { idx[slot] = t; gv[slot] = __uint_as_float(key[j]); inv[t] = slot; ++slot; } else inv[t] = -1;
            }
        }
    }
}
__device__ __forceinline__ void phase_gather(const Ctx& c) {
    const int lane = tidf() & 63, gw = blockIdx.x * 8 + (tidf() >> 6), NGW = gridDim.x * 8;
    for (int it = gw; it < NE * ER; it += NGW) {
        const int e = it / ER, r = it - e * ER;
        u32x4 v0 = (u32x4){0u, 0u, 0u, 0u}, v1 = v0;
        if (r < 2 * CAP) { const int b = r / CAP, slot = r - b * CAP; const int t = P_IDX[((size_t)b * NE + e) * CAP + slot]; const u32x4* s = (const u32x4*)(P_XN + (size_t)row_of(b, t) * DM); v0 = s[lane]; v1 = s[64 + lane]; }
        u32x4* d = (u32x4*)(P_XE + (size_t)it * DM); d[lane] = v0; d[64 + lane] = v1;
    }
}
__device__ __forceinline__ void phase_final(const Ctx& c) {
    const int lane = tidf() & 63, gw = blockIdx.x * 8 + (tidf() >> 6), NGW = gridDim.x * 8;
    for (int m = gw; m < MX; m += NGW) {
        const int b = m >> 13, t = (m & 8191) + NMETA;
        float* row = P_H2 + (size_t)m * DM;
        f32x4 v[4];
#pragma unroll
        for (int j = 0; j < 4; ++j) v[j] = *(const f32x4*)(row + 4 * (lane + 64 * j));
        for (int e = 0; e < NE; ++e) {
            const int slot = P_INV[((size_t)b * NE + e) * TT + t];
            if (slot >= 0) { const bf16_t* y = P_YE + ((size_t)e * ER + b * CAP + slot) * DM;
#pragma unroll
                for (int j = 0; j < 4; ++j) { const u32x2 w = *(const u32x2*)(y + 4 * (lane + 64 * j)); v[j].x += lo16(w.x); v[j].y += hi16(w.x); v[j].z += lo16(w.y); v[j].w += hi16(w.y); } }
        }
        float s = 0.f;
#pragma unroll
        for (int j = 0; j < 4; ++j) s += (v[j].x * v[j].x + v[j].y * v[j].y) + (v[j].z * v[j].z + v[j].w * v[j].w);
        const float r = rsqrtf(wave_sum(s) * (1.f / DM) + RMS_EPS);
#pragma unroll
        for (int j = 0; j < 4; ++j) { const f32x4 g = *(const f32x4*)(c.gfin + 4 * (lane + 64 * j)); *(f32x4*)(row + 4 * (lane + 64 * j)) = (f32x4){v[j].x * r * g.x, v[j].y * r * g.y, v[j].z * r * g.z, v[j].w * r * g.w}; }
    }
}

__device__ __forceinline__ void unpack8(const u32x4 w, float* f) { f[0] = lo16(w.x); f[1] = hi16(w.x); f[2] = lo16(w.y); f[3] = hi16(w.y); f[4] = lo16(w.z); f[5] = hi16(w.z); f[6] = lo16(w.w); f[7] = hi16(w.w); }
__device__ __forceinline__ void conv3x8(const bf16_t* __restrict__ PROJ, const float* __restrict__ cw, const float* __restrict__ cb, int b, int t, int ch0, float* out) {
    const f32x4 b0 = *(const f32x4*)(cb + ch0), b1 = *(const f32x4*)(cb + ch0 + 4);
    out[0] = b0.x; out[1] = b0.y; out[2] = b0.z; out[3] = b0.w; out[4] = b1.x; out[5] = b1.y; out[6] = b1.z; out[7] = b1.w;
#pragma unroll
    for (int j = 0; j < 3; ++j) {
        const int tt = t + j - 1;
        if (tt >= 0 && tt < TT) {
            const u32x4 w = *(const u32x4*)(PROJ + (size_t)row_of(b, tt) * NPROJ + C_U + ch0);
            float u[8]; unpack8(w, u);
            const f32x4 w0 = *(const f32x4*)(cw + j * 3072 + ch0), w1 = *(const f32x4*)(cw + j * 3072 + ch0 + 4);
            out[0] += u[0] * w0.x; out[1] += u[1] * w0.y; out[2] += u[2] * w0.z; out[3] += u[3] * w0.w; out[4] += u[4] * w1.x; out[5] += u[5] * w1.y; out[6] += u[6] * w1.z; out[7] += u[7] * w1.w;
        }
    }
}
__device__ __forceinline__ void phase_hyprep(LAS unsigned char* lds, const Ctx& c) {
    const int tid = tidf(), cg = tid & 7, tp = tid >> 3;
    for (int it = blockIdx.x; it < 2 * 129 * 16; it += gridDim.x) {
        const int ct = it & 15, tt = (it >> 4) % 129, b = (it >> 4) / 129;
        const int t = 64 * tt + tp, c0 = 64 * ct + 8 * cg;
        __syncthreads();
        float z[8];
        if (t < TT) { float x1[8], vh[8]; conv3x8(P_PROJ, c.cw, c.cb, b, t, 1024 + c0, x1); conv3x8(P_PROJ, c.cw, c.cb, b, t, 2048 + c0, vh);
#pragma unroll
            for (int k = 0; k < 8; ++k) z[k] = x1[k] * vh[k]; }
        else {
#pragma unroll
            for (int k = 0; k < 8; ++k) z[k] = 0.f; }
#pragma unroll
        for (int k = 0; k < 8; ++k) *(LAS bf16_t*)(lds + (8 * cg + k) * 144 + tp * 2) = f2bf(z[k]);
        __syncthreads();
        const int ch = tid >> 3, pc = tid & 7;
        *(u32x4*)(P_ZT + ((size_t)b * 1024 + 64 * ct + ch) * ZL + 64 * tt + 8 * pc) = *(const LAS u32x4*)(lds + ch * 144 + pc * 16);
    }
}
__device__ __forceinline__ void phase_hypost(LAS unsigned char* lds, const Ctx& c) {
    const int tid = tidf(), cg = tid & 7, tp = tid >> 3;
    for (int it = blockIdx.x; it < 2 * 129 * 16; it += gridDim.x) {
        const int ct = it & 15, tt = (it >> 4) % 129, b = (it >> 4) / 129;
        const int t = 64 * tt + tp, c0 = 64 * ct + 8 * cg;
        __syncthreads();
        { const int ch = tid >> 3, pc = tid & 7; *(LAS u32x4*)(lds + ch * 144 + pc * 16) = *(const u32x4*)(P_YCT + ((size_t)b * 1024 + 64 * ct + ch) * ZL + 64 * tt + 8 * pc); }
        __syncthreads();
        if (t < TT) {
            float x0[8], x1[8], vh[8];
            conv3x8(P_PROJ, c.cw, c.cb, b, t, c0, x0); conv3x8(P_PROJ, c.cw, c.cb, b, t, 1024 + c0, x1); conv3x8(P_PROJ, c.cw, c.cb, b, t, 2048 + c0, vh);
            const f32x4 s0 = *(const f32x4*)(c.skip + c0), s1 = *(const f32x4*)(c.skip + c0 + 4);
            const float sk[8] = {s0.x, s0.y, s0.z, s0.w, s1.x, s1.y, s1.z, s1.w};
            float o[8];
#pragma unroll
            for (int k = 0; k < 8; ++k) { const float yc = bf2f(*(const LAS bf16_t*)(lds + (8 * cg + k) * 144 + tp * 2)); o[k] = x0[k] * (yc + x1[k] * vh[k] * sk[k]); }
            u32x4 w; w.x = pk2(o[0], o[1]); w.y = pk2(o[2], o[3]); w.z = pk2(o[4], o[5]); w.w = pk2(o[6], o[7]);
            *(u32x4*)(P_AHY + (size_t)row_of(b, t) * DM + c0) = w;
        }
    }
}

typedef short s16x4 __attribute__((ext_vector_type(4)));
__device__ __forceinline__ bf16x8 tr2(const LAS unsigned char* p, int second_off) {
    const s16x4 lo = __builtin_bit_cast(s16x4, __builtin_amdgcn_ds_read_tr16_b64_v4i16((LAS s16x4*)p));
    const s16x4 hi = __builtin_bit_cast(s16x4, __builtin_amdgcn_ds_read_tr16_b64_v4i16((LAS s16x4*)(p + second_off)));
    return (bf16x8){lo[0], lo[1], lo[2], lo[3], hi[0], hi[1], hi[2], hi[3]};
}
__device__ __forceinline__ u32x4 scale8(const u32x4 w, float s) {
    u32x4 o; o.x = pk2(lo16(w.x) * s, hi16(w.x) * s); o.y = pk2(lo16(w.y) * s, hi16(w.y) * s); o.z = pk2(lo16(w.z) * s, hi16(w.z) * s); o.w = pk2(lo16(w.w) * s, hi16(w.w) * s); return o;
}
constexpr int R1_KROW = 288, R1_VROW = 40;
__device__ __forceinline__ void phase_retstate(LAS unsigned char* lds, const Ctx& c) {
    const int tid = tidf(), lane = tid & 63, wid = tid >> 6;
    LAS unsigned char* Kl = lds; LAS unsigned char* Vl = lds + 128 * R1_KROW;
    const bf16_t* PROJ = P_PROJ;
    for (int item = blockIdx.x; item < 256; item += gridDim.x) {
        const int sl = item & 15, dir = (item >> 4) & 1, bh = item >> 5, b = bh >> 2, h = bh & 3;
        const float lg = log_sigmoid(dir ? c.dec_b[h] : c.dec_f[h]); const float dec = expf(lg * 128.f);
        const int kr = tid >> 2, kq = tid & 3, vr = (tid >> 1) & 127, vh = tid & 1;
        const float wv = dir == 0 ? expf(lg * (float)(127 - vr)) : expf(lg * (float)vr);
        const bf16_t* kcol = PROJ + C_K + h * 128 + 32 * kq;
        const bf16_t* vcol = PROJ + C_V + h * 256 + 16 * sl + 8 * vh;
        u32x4 kreg[4][4], vreg[4];
#define R1_LOAD(set, s_) do { int s2 = (s_); if (s2 > 64) s2 = 64; const int n_ = dir ? 64 - s2 : s2; int rk = chunk_row(b, n_, kr); if (rk < 0) rk = 0; int rv = chunk_row(b, n_, vr); if (rv < 0) rv = 0; \
        const u32x4* kp = (const u32x4*)(kcol + (size_t)rk * NPROJ); kreg[set][0] = kp[0]; kreg[set][1] = kp[1]; kreg[set][2] = kp[2]; kreg[set][3] = kp[3]; vreg[set] = *(const u32x4*)(vcol + (size_t)rv * NPROJ); } while (0)
        f32x4 st = (f32x4){0.f, 0.f, 0.f, 0.f};
        const int i16 = lane & 15, kq4 = lane >> 4, q = i16 >> 2, p = i16 & 3;
        const LAS unsigned char* ka = Kl + (8 * kq4 + q) * R1_KROW + (16 * wid + 4 * p) * 2;
        const LAS unsigned char* va = Vl + (8 * kq4 + q) * R1_VROW + 8 * p;
#define R1_STEP(set, s_) do { const int s = (s_); if (s < NCH) { const int n = dir ? 64 - s : s; \
        __syncthreads(); \
        { const bool zk = (n == 0 && kr < 112), zv = (n == 0 && vr < 112); const u32x4 z4 = (u32x4){0u, 0u, 0u, 0u}; \
          LAS u32x4* kd = (LAS u32x4*)(Kl + kr * R1_KROW + kq * 64); kd[0] = zk ? z4 : kreg[set][0]; kd[1] = zk ? z4 : kreg[set][1]; kd[2] = zk ? z4 : kreg[set][2]; kd[3] = zk ? z4 : kreg[set][3]; \
          if (tid < 256) { const u32x4 sv = zv ? z4 : scale8(vreg[set], wv); LAS u32x2* vd = (LAS u32x2*)(Vl + vr * R1_VROW + vh * 16); vd[0] = (u32x2){sv.x, sv.y}; vd[1] = (u32x2){sv.z, sv.w}; } } \
        R1_LOAD(set, s + 4); \
        __syncthreads(); \
        { u32x2 w; w.x = pk2(st.x, st.y); w.y = pk2(st.z, st.w); \
          *(u32x2*)(P_S + ((((size_t)dir * 8 + bh) * NCH + n) * 256 + 16 * sl + i16) * 128 + 16 * wid + 4 * kq4) = w; } \
        f32x4 d4 = (f32x4){0.f, 0.f, 0.f, 0.f}; \
        _Pragma("unroll") for (int ks = 0; ks < 4; ++ks) { const bf16x8 af = tr2(ka + 32 * ks * R1_KROW, 4 * R1_KROW), bf = tr2(va + 32 * ks * R1_VROW, 4 * R1_VROW); d4 = __builtin_amdgcn_mfma_f32_16x16x32_bf16(af, bf, d4, 0, 0, 0); } \
        st = st * dec + d4; } } while (0)
        R1_LOAD(0, 0); R1_LOAD(1, 1); R1_LOAD(2, 2); R1_LOAD(3, 3);
        for (int s0 = 0; s0 < 68; s0 += 4) { R1_STEP(0, s0); R1_STEP(1, s0 + 1); R1_STEP(2, s0 + 2); R1_STEP(3, s0 + 3); }
        __syncthreads();
#undef R1_LOAD
#undef R1_STEP
    }
}
constexpr int R2Q = 272, R2V = 576, R2O = 528;
__device__ __forceinline__ void phase_retout(LAS unsigned char* lds, const Ctx& c) {
    const int tid = tidf(), lane = tid & 63, wid = tid >> 6;
    LAS unsigned char* Ql = lds; LAS unsigned char* Kl = lds + 128 * R2Q; LAS unsigned char* Vl = lds + 2 * 128 * R2Q; LAS float* red = (LAS float*)(lds + 2 * 128 * R2Q + 128 * R2V);
    const bf16_t* PROJ = P_PROJ;
    for (int u = blockIdx.x; u < 520; u += gridDim.x) {
        int bh, n; if (u < 512) { bh = u >> 6; n = 1 + (u & 63); } else { bh = u - 512; n = 0; }
        const int b = bh >> 2, h = bh & 3;
        const float lf = log_sigmoid(c.dec_f[h]), lb = log_sigmoid(c.dec_b[h]);
        const float lf2 = lf * 1.4426950408889634f, lb2 = lb * 1.4426950408889634f;
        __syncthreads();
        {
            const int row = tid >> 2, qt = tid & 3; const int gr = chunk_row(b, n, row);
            const u32x4 z4 = (u32x4){0u, 0u, 0u, 0u};
            LAS u32x4* qd = (LAS u32x4*)(Ql + row * R2Q + qt * 64); LAS u32x4* kd = (LAS u32x4*)(Kl + row * R2Q + qt * 64); LAS u32x4* vd = (LAS u32x4*)(Vl + row * R2V + qt * 128);
            if (gr >= 0) {
                const u32x4* qs = (const u32x4*)(PROJ + (size_t)gr * NPROJ + C_Q + h * 128 + 32 * qt); const u32x4* ks = (const u32x4*)(PROJ + (size_t)gr * NPROJ + C_K + h * 128 + 32 * qt);
                const u32x4* vs = (const u32x4*)(PROJ + (size_t)gr * NPROJ + C_V + h * 256 + 64 * qt);
#pragma unroll
                for (int i = 0; i < 4; ++i) { qd[i] = qs[i]; kd[i] = ks[i]; }
#pragma unroll
                for (int i = 0; i < 8; ++i) vd[i] = vs[i];
            } else {
#pragma unroll
                for (int i = 0; i < 4; ++i) { qd[i] = z4; kd[i] = z4; }
#pragma unroll
                for (int i = 0; i < 8; ++i) vd[i] = z4;
            }
        }
        __syncthreads();
        const int wr = wid >> 1, wc = wid & 1, r = lane & 31, hh = lane >> 5;
        f32x16 sc[2];
#pragma unroll
        for (int jt = 0; jt < 2; ++jt) for (int z = 0; z < 16; ++z) sc[jt][z] = 0.f;
#pragma unroll
        for (int ks = 0; ks < 8; ++ks) {
            const bf16x8 af = *(const LAS bf16x8*)(Ql + (32 * wr + r) * R2Q + (16 * ks + 8 * hh) * 2);
#pragma unroll
            for (int jt = 0; jt < 2; ++jt) { const bf16x8 bf = *(const LAS bf16x8*)(Kl + (64 * wc + 32 * jt + r) * R2Q + (16 * ks + 8 * hh) * 2); sc[jt] = __builtin_amdgcn_mfma_f32_32x32x16_bf16(af, bf, sc[jt], 0, 0, 0); }
        }
        __syncthreads();
#pragma unroll
        for (int jt = 0; jt < 2; ++jt) { const int j = 64 * wc + 32 * jt + r;
#pragma unroll
            for (int z = 0; z < 16; ++z) { const int i = 32 * wr + (z & 3) + 8 * (z >> 2) + 4 * hh; const int df = i - j;
                const float m = __builtin_amdgcn_exp2f(df >= 0 ? lf2 * (float)df : lb2 * (float)(-df));
                *(LAS bf16_t*)(Kl + i * R2Q + j * 2) = f2bf(sc[jt][z] * m); } }
        __syncthreads();
        f32x16 acc[4];
#pragma unroll
        for (int nt = 0; nt < 4; ++nt) for (int z = 0; z < 16; ++z) acc[nt][z] = 0.f;
        {
            const int g16 = lane >> 4, i16 = lane & 15, q = i16 >> 2, p = i16 & 3;
            const LAS unsigned char* vb = Vl + (8 * hh + q) * R2V + (128 * wc + 16 * (g16 & 1) + 4 * p) * 2;
#pragma unroll
            for (int ks = 0; ks < 8; ++ks) {
                const bf16x8 af = *(const LAS bf16x8*)(Kl + (32 * wr + r) * R2Q + (16 * ks + 8 * hh) * 2);
#pragma unroll
                for (int nt = 0; nt < 4; ++nt) { const bf16x8 bf = tr2(vb + 16 * ks * R2V + 64 * nt, 4 * R2V); acc[nt] = __builtin_amdgcn_mfma_f32_32x32x16_bf16(af, bf, acc[nt], 0, 0, 0); }
            }
        }
        {
            const int i = 32 * wr + r;
            const float qwf = expf(lf * (float)(i + 1)), qwb = expf(lb * (float)(128 - i));
            const bf16_t* Sf = P_S + (((size_t)0 * 8 + bh) * NCH + n) * 256 * 128 + (size_t)(128 * wc + r) * 128 + 8 * hh;
            const bf16_t* Sb = P_S + (((size_t)1 * 8 + bh) * NCH + n) * 256 * 128 + (size_t)(128 * wc + r) * 128 + 8 * hh;
#pragma unroll
            for (int ks = 0; ks < 8; ++ks) {
                const u32x4 aq = *(const LAS u32x4*)(Ql + (32 * wr + r) * R2Q + (16 * ks + 8 * hh) * 2);
                const bf16x8 af = __builtin_bit_cast(bf16x8, scale8(aq, qwf)), ab = __builtin_bit_cast(bf16x8, scale8(aq, qwb));
#pragma unroll
                for (int nt = 0; nt < 4; ++nt) {
                    const bf16x8 bf = *(const bf16x8*)(Sf + (size_t)32 * nt * 128 + 16 * ks), bb = *(const bf16x8*)(Sb + (size_t)32 * nt * 128 + 16 * ks);
                    acc[nt] = __builtin_amdgcn_mfma_f32_32x32x16_bf16(af, bf, acc[nt], 0, 0, 0); acc[nt] = __builtin_amdgcn_mfma_f32_32x32x16_bf16(ab, bb, acc[nt], 0, 0, 0);
                }
            }
        }
        {
            float ss[16];
#pragma unroll
            for (int z = 0; z < 16; ++z) { float v = 0.f;
#pragma unroll
                for (int nt = 0; nt < 4; ++nt) v += acc[nt][z] * acc[nt][z];
#pragma unroll
                for (int o = 1; o < 32; o <<= 1) v += __shfl_xor(v, o);
                ss[z] = v; }
            if (r == 0) {
#pragma unroll
                for (int z = 0; z < 16; ++z) red[(32 * wr + (z & 3) + 8 * (z >> 2) + 4 * hh) * 2 + wc] = ss[z]; }
        }
        __syncthreads();
        {
            float hgv[4];
#pragma unroll
            for (int nt = 0; nt < 4; ++nt) hgv[nt] = c.hg[h * 256 + 128 * wc + 32 * nt + r];
#pragma unroll
            for (int z = 0; z < 16; ++z) { const int i = 32 * wr + (z & 3) + 8 * (z >> 2) + 4 * hh; const float rs = rsqrtf((red[i * 2] + red[i * 2 + 1]) * (1.f / 256.f) + RMS_EPS);
#pragma unroll
                for (int nt = 0; nt < 4; ++nt) *(LAS bf16_t*)(Vl + i * R2O + (128 * wc + 32 * nt + r) * 2) = f2bf(acc[nt][z] * rs * hgv[nt]); }
        }
        __syncthreads();
        {
            const int row = tid >> 2, qt = tid & 3; const int gr = chunk_row(b, n, row);
            if (gr >= 0) {
                const u32x4* gs = (const u32x4*)(PROJ + (size_t)gr * NPROJ + C_G + h * 256 + 64 * qt); u32x4* od = (u32x4*)(P_ARET + (size_t)gr * DM + h * 256 + 64 * qt);
#pragma unroll
                for (int i = 0; i < 8; ++i) { const u32x4 o = *(const LAS u32x4*)(Vl + row * R2O + qt * 128 + 16 * i), g = gs[i]; u32x4 w;
                    w.x = pk2(lo16(o.x) * lo16(g.x), hi16(o.x) * hi16(g.x)); w.y = pk2(lo16(o.y) * lo16(g.y), hi16(o.y) * hi16(g.y)); w.z = pk2(lo16(o.z) * lo16(g.z), hi16(o.z) * hi16(g.z)); w.w = pk2(lo16(o.w) * lo16(g.w), hi16(o.w) * hi16(g.w));
                    od[i] = w; }
            }
        }
    }
}
constexpr int PH_LDS = 147456;
template <int PH> __global__ void __launch_bounds__(512, 2) k_phase(Ctx c) {
    extern __shared__ __attribute__((aligned(16))) unsigned char smem_p[];
    LAS unsigned char* lds = (LAS unsigned char*)smem_p;
    if (PH == 0) phase_p0(lds, c);
    else if (PH == 6) phase_p6(lds, c);
    else if (PH == 7) phase_topk(lds, c);
    else if (PH == 8) phase_gather(c);
    else if (PH == 10) phase_final(c);
    else if (PH == 2) { phase_retstate(lds, c); phase_hyprep(lds, c); }
    else if (PH == 3) phase_retout(lds, c);
    else if (PH == 4) phase_hypost(lds, c);
}
template <int PH> static void launch_phase(hipStream_t stream, const Ctx& c) {
    (void)hipFuncSetAttribute((const void*)k_phase<PH>, hipFuncAttributeMaxDynamicSharedMemorySize, PH_LDS);
    k_phase<PH><<<256, 512, PH_LDS, stream>>>(c);
}

__device__ __forceinline__ GemmArgs mk_ga(const bf16_t* A, const bf16_t* Bt, int M, int N, int K, int gt, size_t gstride, int side) {
    GemmArgs ga{}; ga.A = A; ga.Bt = Bt; ga.M = M; ga.N = N; ga.K = K; ga.gt = gt; ga.gstride = gstride; ga.side = side; return ga;
}
__global__ void __launch_bounds__(512, 2) mega_fwd(Ctx c) {
    extern __shared__ __attribute__((aligned(16))) unsigned char smem_m[];
    LAS unsigned char* lds = (LAS unsigned char*)smem_m;
    cg::grid_group grid = cg::this_grid();
    const EpiArgs E = make_epi(c);
    phase_p0(lds, c);
    grid.sync();
    gemm_fast_body<1>(lds, mk_ga(P_XN, P_WIN, MX, NPROJ, 1024, 1 << 20, 0, 1), E);
    grid.sync();
    phase_retstate(lds, c);
    phase_hyprep(lds, c);
    grid.sync();
    for (int cb = blockIdx.x; cb < 256; cb += gridDim.x) conv_fast_body(lds, P_G, P_ZT, P_YCT, 4 * cb);
    phase_retout(lds, c);
    grid.sync();
    phase_hypost(lds, c);
    grid.sync();
    gemm_fast_body<2>(lds, mk_ga(P_ARET, P_WRET, MX, DM, 1024, 1 << 20, 0, 1), E);
    grid.sync();
    gemm_fast_body<3>(lds, mk_ga(P_AHY, P_WHY, MX, DM, 1024, 1 << 20, 0, 1), E);
    grid.sync();
    gemm_fast_body<4>(lds, mk_ga(P_XN, P_WO, MX, DM, 1024, 1 << 20, 0, 1), E);
    grid.sync();
    phase_p6(lds, c);
    grid.sync();
    phase_topk(lds, c);
    grid.sync();
    phase_gather(c);
    grid.sync();
    gemm_fast_body<5>(lds, mk_ga(P_XE, P_WGU, NE * ER, 4096, 1024, ER / 256, (size_t)4096 * 1024 * 2, 0), E);
    grid.sync();
    gemm_fast_body<6>(lds, mk_ga(P_HID, P_WD, NE * ER, DM, 2048, ER / 256, (size_t)1024 * 2048 * 2, 0), E);
    grid.sync();
    phase_final(c);
}
extern "C" void kernel_launch(void* const* d_in, const int* in_sizes, int n_in, void* d_out, int out_size, void* d_ws, size_t ws_size, hipStream_t stream) {
    if (n_in != 27 || ws_size < WS_END || out_size != MX * DM) { fprintf(stderr, "kernel_launch: unexpected sizes n_in %d ws %zu out %d\n", n_in, ws_size, out_size); return; }
    constexpr size_t kDynLds = PH_LDS;
    static int grid_blocks = 0;
    if (!grid_blocks) {
        int dev = 0, cus = 0, per_cu = 0;
        (void)hipGetDevice(&dev);
        (void)hipDeviceGetAttribute(&cus, hipDeviceAttributeMultiprocessorCount, dev);
        (void)hipFuncSetAttribute((const void*)mega_fwd, hipFuncAttributeMaxDynamicSharedMemorySize, (int)kDynLds);
        (void)hipOccupancyMaxActiveBlocksPerMultiprocessor(&per_cu, (const void*)mega_fwd, 512, kDynLds);
        if (per_cu < 1) per_cu = 1;
        grid_blocks = cus * per_cu;
    }
    Ctx cx{};
    { const float** pp = (const float**)&cx; for (int i = 0; i < 27; ++i) pp[i] = (const float*)d_in[i]; }
    cx.ws = (unsigned char*)d_ws; cx.dob = (unsigned char*)d_out;
    void* args[] = {&cx};
    hipError_t e = hipLaunchCooperativeKernel((const void*)mega_fwd, dim3(grid_blocks), dim3(512), args, kDynLds, stream);
    if (e != hipSuccess) fprintf(stderr, "cooperative launch failed: %s (grid %d)\n", hipGetErrorString(e), grid_blocks);
}
```

```cpp
#include <hip/hip_runtime.h>
#include <stdint.h>
#include <cstdio>
#include <hip/hip_cooperative_groups.h>
namespace cg = cooperative_groups;

typedef unsigned short bf16_t;
__device__ __forceinline__ int tidf() { int t = (int)__builtin_amdgcn_workitem_id_x(); asm volatile("" : "+v"(t)); return t; }
__device__ __forceinline__ float bf2f(bf16_t v) { return __uint_as_float(((unsigned)v) << 16); }
__device__ __forceinline__ bf16_t f2bf(float f) { unsigned u = __float_as_uint(f); u += 0x7fffu + ((u >> 16) & 1u); return (bf16_t)(u >> 16); }

constexpr int NB = 2, SEQ = 8192, DM = 1024, NMETA = 16, TT = 8208;
constexpr int MX = 16384, MROWS = 16416, MP = 16640;
constexpr int NPROJ = 8192;
constexpr int C_Q = 0, C_K = 512, C_V = 1024, C_G = 2048, C_U = 3072, C_GA = 6144, C_GB = 7168;
constexpr int NE = 16, CAP = 1026, ER = 2304, FF = 2048;
constexpr int NCH = 65;
constexpr int GL = 16640;
constexpr int ZL = 8320;
constexpr float RMS_EPS = 1e-6f;

constexpr size_t MiB = 1u << 20;
constexpr size_t WS_CTL = 0;
constexpr size_t WS_WRET = 1 * MiB, WS_WHY = 3 * MiB, WS_WO = 5 * MiB;
constexpr size_t WS_MISC = 7 * MiB;
constexpr size_t WS_XN = 12 * MiB;
constexpr size_t WS_PROJ = 48 * MiB;
constexpr size_t WS_S = 308 * MiB;
constexpr size_t WS_ZT = 374 * MiB;
constexpr size_t WS_G = 407 * MiB;
constexpr size_t WS_ARET = 440 * MiB;
constexpr size_t WS_WGU = 48 * MiB;
constexpr size_t WS_WD = 176 * MiB;
constexpr size_t WS_XE = 240 * MiB;
constexpr size_t WS_HID = 312 * MiB;
constexpr size_t WS_END = 456 * MiB;
constexpr size_t DO_WIN = 0;
constexpr size_t DO_ROPE = 16 * MiB;
constexpr size_t DO_HDN = 22 * MiB;
constexpr size_t DO_YCT = 0;
constexpr size_t MI_AFF = 0;
constexpr size_t MI_IDX = 1 * MiB + 64 * 1024;
constexpr size_t MI_GATE = 1 * MiB + 256 * 1024;
constexpr size_t MI_INV = 2 * MiB;
constexpr size_t MI_H2M = 3 * MiB + 256 * 1024;

__device__ __forceinline__ int row_of(int b, int t) { return t < NMETA ? MX + b * NMETA + t : b * SEQ + (t - NMETA); }
__device__ __forceinline__ void bt_of(int m, int& b, int& t) { if (m < MX) { b = m >> 13; t = (m & 8191) + NMETA; } else { b = (m - MX) >> 4; t = (m - MX) & 15; } }

__global__ void k_wconv(const float* __restrict__ W0, const float* __restrict__ W1, int K, int N, int Nd, bf16_t* __restrict__ WT, int mode, size_t src_bstride, size_t dst_bstride) {
    __shared__ float tile[32][33];
    const int tx = tidf(), ty = threadIdx.y;
    const int k0 = blockIdx.x * 32, r0 = blockIdx.y * 32, e = blockIdx.z;
    const int r = r0 + tx;
    const float* src = W0 + (size_t)e * src_bstride; int col = r;
    if (mode == 1) { if (r < 1024) { const int sec = r >> 7, rl = r & 127, g = rl >> 3, j = rl & 7; col = sec * 128 + (j < 4 ? 4 * g + j : 64 + 4 * g + (j - 4)); } }
    else if (mode == 2) { const int g = r >> 3, j = r & 7; if (j < 4) { col = 4 * g + j; } else { col = 4 * g + j - 4; src = W1 + (size_t)e * src_bstride; } }
    for (int i = 0; i < 4; ++i) { const int k = k0 + ty + 8 * i; tile[ty + 8 * i][tx] = src[(size_t)k * N + col]; }
    __syncthreads();
    bf16_t* dst = WT + (size_t)e * dst_bstride;
    for (int i = 0; i < 4; ++i) { const int rr = r0 + ty + 8 * i; dst[(size_t)rr * K + k0 + tx] = f2bf(tile[tx][ty + 8 * i]); }
}

__device__ __forceinline__ float block_sum256(float v, float* red) {
    for (int o = 32; o > 0; o >>= 1) v += __shfl_xor(v, o);
    const int w = tidf() >> 6;
    __syncthreads();
    if ((tidf() & 63) == 0) red[w] = v;
    __syncthreads();
    return red[0] + red[1] + red[2] + red[3];
}

__global__ void k_xn1(const float* __restrict__ x, const float* __restrict__ meta, const float* __restrict__ g, bf16_t* __restrict__ XN) {
    __shared__ float red[4];
    const int m = blockIdx.x;
    const float* src = m < MX ? x + (size_t)m * DM : meta + (size_t)((m - MX) & 15) * DM;
    float v[4]; float s = 0.f;
    for (int i = 0; i < 4; ++i) { v[i] = src[tidf() + 256 * i]; s += v[i] * v[i]; }
    s = block_sum256(s, red);
    const float r = rsqrtf(s * (1.f / DM) + RMS_EPS);
    for (int i = 0; i < 4; ++i) XN[(size_t)m * DM + tidf() + 256 * i] = f2bf(v[i] * r * g[tidf() + 256 * i]);
}

__global__ void k_rope(float* __restrict__ ROPE) {
    const int t = blockIdx.x, i = tidf();
    const float inv = powf(10000.0f, -(float)i / 64.0f);
    const float ang = (float)t * inv;
    ROPE[(size_t)t * 128 + i] = cosf(ang);
    ROPE[(size_t)t * 128 + 64 + i] = sinf(ang);
}

__global__ void k_filt_hidden(const float* __restrict__ w1, const float* __restrict__ b1, const float* __restrict__ w2, const float* __restrict__ b2,
                              const float* __restrict__ w3, const float* __restrict__ b3, const float* __restrict__ fq, float* __restrict__ HDN) {
    __shared__ float feat[33]; __shared__ float ha[64]; __shared__ float hb[64];
    const int t = blockIdx.x, j = tidf();
    if (j == 0) feat[0] = (float)t / (float)(TT - 1);
    if (j < 16) {
        const float fr = 1e-4f + (float)j * ((15.0f - 1e-4f) / 15.0f);
        const float ang = (2.0f * 3.14159265358979323846f * (float)t / (float)TT) * fr;
        feat[1 + j] = cosf(ang); feat[17 + j] = -sinf(ang);
    }
    __syncthreads();
    const float f = fq[j];
    float a = b1[j];
    for (int i = 0; i < 33; ++i) a += feat[i] * w1[i * 64 + j];
    ha[j] = sinf(f * a);
    __syncthreads();
    a = b2[j];
    for (int i = 0; i < 64; ++i) a += ha[i] * w2[i * 64 + j];
    hb[j] = sinf(f * a);
    __syncthreads();
    a = b3[j];
    for (int i = 0; i < 64; ++i) a += hb[i] * w3[i * 64 + j];
    HDN[(size_t)t * 64 + j] = sinf(f * a);
}

__global__ void k_filt_out(const float* __restrict__ HDN, const float* __restrict__ w4, bf16_t* __restrict__ G) {
    const int c = blockIdx.x * 256 + tidf(), t = blockIdx.y;
    __shared__ float h[64];
    if (tidf() < 64) h[tidf()] = HDN[(size_t)t * 64 + tidf()];
    __syncthreads();
    float ff = 0.f, fb = 0.f;
    for (int j = 0; j < 64; ++j) { ff += h[j] * w4[j * 2048 + c]; fb += h[j] * w4[j * 2048 + 1024 + c]; }
    const float mind = logf(1e-2f) / 1.5f, maxd = logf(1e-2f) / 0.3f;
    const float delta = mind + (float)c * ((maxd - mind) / 1023.0f);
    const float tn = (float)t / (float)(TT - 1);
    const float win = expf(-tn * fabsf(delta));
    G[(size_t)c * GL + TT + t] = f2bf(ff * win);
    if (t >= 1) G[(size_t)c * GL + TT - t] = f2bf(fb * win);
    if (t == 0) { G[(size_t)c * GL] = 0; for (int i = 2 * TT; i < GL; ++i) G[(size_t)c * GL + i] = 0; }
}

struct EpiArgs {
    bf16_t* PROJ; const float* ROPE;
    float* TMP; bf16_t* MIXED;
    const float* x; const float* meta; float* H2; float* H2M;
    bf16_t* HID; bf16_t* YE; const float* GATEV;
};
typedef float f32x4 __attribute__((ext_vector_type(4)));
typedef float f32x16 __attribute__((ext_vector_type(16)));
typedef unsigned u32x4 __attribute__((ext_vector_type(4)));
typedef unsigned u32x2 __attribute__((ext_vector_type(2)));
typedef short bf16x8 __attribute__((ext_vector_type(8)));
__device__ __forceinline__ unsigned pk2(float lo, float hi) { return (unsigned)f2bf(lo) | ((unsigned)f2bf(hi) << 16); }
__device__ __forceinline__ float lo16(unsigned w) { return __uint_as_float(w << 16); }
__device__ __forceinline__ float hi16(unsigned w) { return __uint_as_float(w & 0xffff0000u); }
__device__ __forceinline__ float sigm(float x) { return 1.f / (1.f + __expf(-x)); }
__device__ __forceinline__ u32x4 pack8(f32x4 a, f32x4 b) { u32x4 w; w.x = pk2(a.x, a.y); w.y = pk2(a.z, a.w); w.z = pk2(b.x, b.y); w.w = pk2(b.z, b.w); return w; }
__device__ __forceinline__ void epi8v(int mode, const EpiArgs& E, int mg, int c0, f32x4 a0, f32x4 a1) {
    if (mode == 1) {
        bf16_t* dst = E.PROJ + (size_t)mg * NPROJ + c0;
        if (c0 < C_V) {
            int b, t; bt_of(mg, b, t);
            const int i0 = ((c0 & 127) >> 3) * 4;
            const float sc = c0 >= C_K ? 0.08838834764831845f : 1.0f;
            const f32x4 cs = *(const f32x4*)(E.ROPE + (size_t)t * 128 + i0), sn = *(const f32x4*)(E.ROPE + (size_t)t * 128 + 64 + i0);
            const f32x4 o1 = (a0 * cs - a1 * sn) * sc, o2 = (a0 * sn + a1 * cs) * sc;
            *(u32x4*)dst = pack8(o1, o2);
        } else if (c0 < C_G || (c0 >= C_U && c0 < C_GA)) { *(u32x4*)dst = pack8(a0, a1); }
        else if (c0 < C_U) { f32x4 s0, s1; for (int j = 0; j < 4; ++j) { s0[j] = a0[j] * sigm(a0[j]); s1[j] = a1[j] * sigm(a1[j]); } *(u32x4*)dst = pack8(s0, s1); }
        else { f32x4 s0, s1; for (int j = 0; j < 4; ++j) { s0[j] = sigm(a0[j]); s1[j] = sigm(a1[j]); } *(u32x4*)dst = pack8(s0, s1); }
    } else if (mode == 2) {
        const u32x4 g = *(const u32x4*)(E.PROJ + (size_t)mg * NPROJ + C_GA + c0);
        float* dst = E.TMP + (size_t)mg * DM + c0;
        *(f32x4*)dst = (f32x4){lo16(g.x) * a0.x, hi16(g.x) * a0.y, lo16(g.y) * a0.z, hi16(g.y) * a0.w};
        *(f32x4*)(dst + 4) = (f32x4){lo16(g.z) * a1.x, hi16(g.z) * a1.y, lo16(g.w) * a1.z, hi16(g.w) * a1.w};
    } else if (mode == 3) {
        const u32x4 g = *(const u32x4*)(E.PROJ + (size_t)mg * NPROJ + C_GB + c0);
        const float* tp = E.TMP + (size_t)mg * DM + c0;
        const f32x4 t0 = *(const f32x4*)tp, t1 = *(const f32x4*)(tp + 4);
        const f32x4 o0 = t0 + (f32x4){lo16(g.x) * a0.x, hi16(g.x) * a0.y, lo16(g.y) * a0.z, hi16(g.y) * a0.w};
        const f32x4 o1 = t1 + (f32x4){lo16(g.z) * a1.x, hi16(g.z) * a1.y, lo16(g.w) * a1.z, hi16(g.w) * a1.w};
        *(u32x4*)(E.MIXED + (size_t)mg * DM + c0) = pack8(o0, o1);
    } else if (mode == 4) {
        const float* rs; float* dst;
        if (mg < MX) { rs = E.x + (size_t)mg * DM + c0; dst = E.H2 + (size_t)mg * DM + c0; }
        else { rs = E.meta + (size_t)((mg - MX) & 15) * DM + c0; dst = E.H2M + (size_t)(mg - MX) * DM + c0; }
        *(f32x4*)dst = *(const f32x4*)rs + a0; *(f32x4*)(dst + 4) = *(const f32x4*)(rs + 4) + a1;
    } else if (mode == 5) {
        u32x2 w; w.x = pk2(a0.x * sigm(a0.x) * a1.x, a0.y * sigm(a0.y) * a1.y); w.y = pk2(a0.z * sigm(a0.z) * a1.z, a0.w * sigm(a0.w) * a1.w);
        *(u32x2*)(E.HID + (size_t)mg * FF + (c0 >> 1)) = w;
    } else {
        const int e = mg / ER, ml = mg - e * ER;
        const float gt = ml < 2 * CAP ? E.GATEV[((size_t)(ml / CAP) * NE + e) * CAP + (ml % CAP)] : 0.f;
        *(u32x4*)(E.YE + (size_t)mg * DM + c0) = pack8(a0 * gt, a1 * gt);
    }
}

__global__ void __launch_bounds__(256) k_gemm(const bf16_t* __restrict__ A, const bf16_t* __restrict__ Bt, int M, int N, int K, size_t a_bstride, size_t b_bstride, int mode, EpiArgs E) {
    __shared__ float As[32][128 + 4];
    __shared__ float Bs[32][64 + 4];
    const int tid = tidf(), e = blockIdx.z;
    const int m0 = blockIdx.y * 128, n0 = blockIdx.x * 64;
    A += (size_t)e * a_bstride; Bt += (size_t)e * b_bstride;
    const int ty = tid >> 3, tx = tid & 7;
    float acc[4][8];
    for (int i = 0; i < 4; ++i) for (int j = 0; j < 8; ++j) acc[i][j] = 0.f;
    const int ar = tid >> 1, ak = (tid & 1) * 16;
    const int br = tid >> 2, bk = (tid & 3) * 8;
    for (int k0 = 0; k0 < K; k0 += 32) {
        {
            const int m = m0 + ar;
            if (m < M) { const uint4* p = (const uint4*)(A + (size_t)m * K + k0 + ak); const uint4 v0 = p[0], v1 = p[1];
                const unsigned w[8] = {v0.x, v0.y, v0.z, v0.w, v1.x, v1.y, v1.z, v1.w};
                for (int q = 0; q < 8; ++q) { As[ak + 2 * q][ar] = __uint_as_float(w[q] << 16); As[ak + 2 * q + 1][ar] = __uint_as_float(w[q] & 0xffff0000u); } }
            else { for (int q = 0; q < 16; ++q) As[ak + q][ar] = 0.f; }
            const uint4 v = *(const uint4*)(Bt + (size_t)(n0 + br) * K + k0 + bk);
            const unsigned w[4] = {v.x, v.y, v.z, v.w};
            for (int q = 0; q < 4; ++q) { Bs[bk + 2 * q][br] = __uint_as_float(w[q] << 16); Bs[bk + 2 * q + 1][br] = __uint_as_float(w[q] & 0xffff0000u); }
        }
        __syncthreads();
#pragma unroll 8
        for (int k = 0; k < 32; ++k) {
            float a[4], b[8];
            for (int i = 0; i < 4; ++i) a[i] = As[k][ty + 32 * i];
            for (int j = 0; j < 8; ++j) b[j] = Bs[k][tx * 8 + j];
            for (int i = 0; i < 4; ++i) for (int j = 0; j < 8; ++j) acc[i][j] += a[i] * b[j];
        }
        __syncthreads();
    }
    for (int i = 0; i < 4; ++i) { const int m = m0 + ty + 32 * i; if (m < M) epi8v(mode, E, (mode >= 5 ? e * ER : 0) + m, n0 + tx * 8, (f32x4){acc[i][0], acc[i][1], acc[i][2], acc[i][3]}, (f32x4){acc[i][4], acc[i][5], acc[i][6], acc[i][7]}); }
}

namespace pg8 {
#define PG8_LAS __attribute__((address_space(3)))
typedef unsigned short bf16_t;
typedef short bf16x8 __attribute__((ext_vector_type(8)));
typedef float f32x4 __attribute__((ext_vector_type(4)));
typedef unsigned u32x4 __attribute__((ext_vector_type(4)));
constexpr int BM = 256, BK = 64, HALF = 128, HTB = HALF * BK * 2  , STAGE_BYTES = 8 * HTB, NXCD = 8, WGM = 8;

__host__ __device__ __forceinline__ int lds_byte(int r, int c) { const int st = (r >> 4) * 2 + (c >> 5), rr = r & 15, cc = c & 31, ob = rr * 64 + cc * 2; return st * 1024 + (ob ^ (((ob >> 9) & 1) << 5)); }
__host__ __device__ __forceinline__ void stage_rc(int b, int& R, int& C) { const int st = b / 1024, sb = b % 1024, swz = sb ^ (((sb >> 9) & 1) << 5); R = (st >> 1) * 16 + swz / 64; C = (st & 1) * 32 + (swz % 64) / 2; }
__host__ __device__ __forceinline__ int perm32(int rho) { const int n = rho >> 4, i = rho & 15; return 8 * (i >> 2) + 4 * n + (i & 3); }

struct Unit { int pm, pn; };
struct Gemm { const bf16_t* A; const bf16_t* Bt; int M, N, K; int gt; size_t gstride; };

struct StaticOrder {
    int nM, nN, nwg, G, c;
    __host__ __device__ void init(int M, int N, int G_, int c_) { nM = M / BM; nN = N / BM; nwg = nM * nN; G = G_; c = c_; }
    __host__ __device__ bool next(int i, Unit& u) const {
        const long L = (long)i * G + c; if (L >= nwg) return false;
        int wgid = (int)L; { const int q = nwg / NXCD, r = nwg % NXCD, xcd = wgid % NXCD, off = wgid / NXCD; wgid = (xcd < r ? xcd * (q + 1) : r * (q + 1) + (xcd - r) * q) + off; }
        const int nig = WGM * nN, gid = wgid / nig, fm = gid * WGM, gsz = (nM - fm) < WGM ? (nM - fm) : WGM;
        u.pm = fm + ((wgid % nig) % gsz); u.pn = (wgid % nig) / gsz; return true;
    }
    __device__ __forceinline__ void a_ready(const Unit&) const {}
    __device__ __forceinline__ void done(const Unit&) const {}
};

__device__ __forceinline__ unsigned cvt_pk_bf16(float lo, float hi) { unsigned r; asm volatile("v_cvt_pk_bf16_f32 %0, %1, %2" : "=v"(r) : "v"(lo), "v"(hi)); return r; }
template <class Epi, class Sched, bool ALIGN_EPI = false, bool SP2 = false>
__device__ __forceinline__ void gemm_phase(PG8_LAS unsigned char* lds, const Gemm g, const Sched& S, const Epi& E) {
    const int tid = tidf(), wid = __builtin_amdgcn_readfirstlane(tid >> 6), lane = tid & 63, wr = wid >> 2, wc = wid & 3, fr = lane & 15, fq = lane >> 4;
    const int K = g.K, nt = K / BK;
    unsigned voffA[2], voffB[2];
#pragma unroll
    for (int i = 0; i < 2; ++i) { int R, C; stage_rc(tid * 16 + i * 8192, R, C); const int Rb = Epi::PERM ? ((R & ~31) + perm32(R & 31)) : R;
        voffA[i] = (unsigned)(R * K + C) * 2u; voffB[i] = (unsigned)(Rb * K + C) * 2u; }
    const size_t kstep = (size_t)(BK * 2);
    const size_t hstep = (size_t)HALF * K * 2;
    const size_t tstep = 2 * hstep;
    const unsigned ldsw = (unsigned)wid * 1024u;
    const int aoff = lds_byte(wr * 64 + fr, fq * 8), boff = lds_byte(wc * 32 + fr, fq * 8);
#define PG8_SA(b, h) (((b) * 2 + (h)) * HTB)
#define PG8_SB(b, h) ((4 + (b) * 2 + (h)) * HTB)
#define PG8_STAGE(bufoff, gbase, voff) do { _Pragma("unroll") for (int _i = 0; _i < 2; ++_i) \
        __builtin_amdgcn_global_load_lds((const unsigned*)((const char*)(gbase) + (voff)[_i]), (PG8_LAS unsigned*)(lds + (bufoff) + ldsw + _i * 8192), 16, 0, 0); } while (0)
#define PG8_LDA(dst, b, h) do { _Pragma("unroll") for (int m = 0; m < 4; ++m) _Pragma("unroll") for (int k = 0; k < 2; ++k) dst[m][k] = *(const PG8_LAS bf16x8*)(lds + PG8_SA(b, h) + aoff + m * 2048 + k * 1024); } while (0)
#define PG8_LDB(dst, b, h) do { _Pragma("unroll") for (int n = 0; n < 2; ++n) _Pragma("unroll") for (int k = 0; k < 2; ++k) dst[n][k] = *(const PG8_LAS bf16x8*)(lds + PG8_SB(b, h) + boff + n * 2048 + k * 1024); } while (0)
#define PG8_MMA(ai, bj, At, Bt) do { __builtin_amdgcn_s_setprio(1); _Pragma("unroll") for (int m = 0; m < 4; ++m) _Pragma("unroll") for (int n = 0; n < 2; ++n) _Pragma("unroll") for (int k = 0; k < 2; ++k) \
        acc[ai][bj][m][n] = __builtin_amdgcn_mfma_f32_16x16x32_bf16(Bt[n][k], At[m][k], acc[ai][bj][m][n], 0, 0, 0); __builtin_amdgcn_s_setprio(0); } while (0)
#define PG8_WAIT_V(n) asm volatile("s_waitcnt vmcnt(" #n ")" ::: "memory")
#define PG8_WAIT_L(n) asm volatile("s_waitcnt lgkmcnt(" #n ")" ::: "memory")
#define PG8_BAR __builtin_amdgcn_s_barrier()
#define PG8_SCHED __builtin_amdgcn_sched_barrier(0)
    Unit cur, nxt; int ui = 0;
    if (!S.next(0, cur)) return;
    f32x4 acc[2][2][4][2];
#pragma unroll
    for (int a = 0; a < 2; ++a)
#pragma unroll
        for (int b = 0; b < 2; ++b)
#pragma unroll
            for (int m = 0; m < 4; ++m)
#pragma unroll
                for (int n = 0; n < 2; ++n) acc[a][b][m][n] = (f32x4){0.f, 0.f, 0.f, 0.f};
    bf16x8 At[4][2], B0[2][2], B1[2][2];
    const char* cA = (const char*)g.A + (size_t)cur.pm * tstep; const char* cB = (const char*)g.Bt + (size_t)(cur.pm / g.gt) * g.gstride + (size_t)cur.pn * tstep;
    S.a_ready(cur);
    if constexpr (SP2) {
        PG8_STAGE(PG8_SB(0, 0), cB, voffB); PG8_STAGE(PG8_SB(0, 1), cB + hstep, voffB); PG8_STAGE(PG8_SA(0, 0), cA, voffA); PG8_STAGE(PG8_SA(0, 1), cA + hstep, voffA);
        if (wr == 1) PG8_BAR;
        PG8_WAIT_V(2); PG8_BAR;
        PG8_STAGE(PG8_SB(1, 0), cB + kstep, voffB); PG8_STAGE(PG8_SA(1, 0), cA + kstep, voffA); PG8_STAGE(PG8_SB(1, 1), cB + hstep + kstep, voffB);
        PG8_WAIT_V(6); PG8_BAR;
    } else {
        PG8_STAGE(PG8_SB(0, 0), cB, voffB); PG8_STAGE(PG8_SA(0, 0), cA, voffA); PG8_STAGE(PG8_SB(0, 1), cB + hstep, voffB); PG8_STAGE(PG8_SA(0, 1), cA + hstep, voffA);
        if (wr == 1) PG8_BAR;
        PG8_WAIT_V(4); PG8_BAR;
        PG8_STAGE(PG8_SB(1, 0), cB + kstep, voffB); PG8_STAGE(PG8_SA(1, 0), cA + kstep, voffA); PG8_STAGE(PG8_SB(1, 1), cB + hstep + kstep, voffB);
        PG8_WAIT_V(6); PG8_BAR;
    }
    for (;;) {
        const bool has_next = S.next(ui + 1, nxt);
        const char* nA = has_next ? (const char*)g.A + (size_t)nxt.pm * tstep : cA; const char* nB = has_next ? (const char*)g.Bt + (size_t)(nxt.pm / g.gt) * g.gstride + (size_t)nxt.pn * tstep : cB;
        for (int t = 0; t < nt; t += 2) {
            const bool last = (t == nt - 2);
            const char* a1 = cA + (size_t)(t + 1) * kstep;
            const char* a2 = last ? nA : cA + (size_t)(t + 2) * kstep; const char* b2 = last ? nB : cB + (size_t)(t + 2) * kstep;
            const char* a3 = a2 + kstep; const char* b3 = b2 + kstep;
            if (last && has_next) S.a_ready(nxt);
            if constexpr (SP2) {
            PG8_LDB(B0, 0, 0); PG8_LDB(B1, 0, 1); PG8_SCHED; PG8_LDA(At, 0, 0); PG8_STAGE(PG8_SA(1, 1), a1 + hstep, voffA);
            PG8_WAIT_V(8); PG8_WAIT_L(0); PG8_BAR; PG8_MMA(0, 0, At, B0); PG8_MMA(0, 1, At, B1); PG8_BAR; PG8_SCHED;
            PG8_LDA(At, 0, 1); PG8_STAGE(PG8_SB(0, 0), b2, voffB); PG8_STAGE(PG8_SB(0, 1), b2 + hstep, voffB); PG8_STAGE(PG8_SA(0, 0), a2, voffA);
            PG8_WAIT_V(8); PG8_WAIT_L(0); PG8_BAR; PG8_MMA(1, 0, At, B0); PG8_MMA(1, 1, At, B1); PG8_BAR; PG8_SCHED;
            PG8_LDB(B0, 1, 0); PG8_LDB(B1, 1, 1); PG8_SCHED; PG8_LDA(At, 1, 0); PG8_STAGE(PG8_SA(0, 1), a2 + hstep, voffA);
            PG8_WAIT_V(8); PG8_WAIT_L(0); PG8_BAR; PG8_MMA(0, 0, At, B0); PG8_MMA(0, 1, At, B1); PG8_BAR; PG8_SCHED;
            PG8_LDA(At, 1, 1); PG8_STAGE(PG8_SB(1, 0), b3, voffB); PG8_STAGE(PG8_SB(1, 1), b3 + hstep, voffB); PG8_STAGE(PG8_SA(1, 0), a3, voffA);
            PG8_WAIT_V(8); PG8_WAIT_L(0); PG8_BAR; PG8_MMA(1, 0, At, B0); PG8_MMA(1, 1, At, B1); PG8_BAR; PG8_SCHED;
            } else {
            PG8_LDB(B0, 0, 0); PG8_SCHED; PG8_LDA(At, 0, 0); PG8_STAGE(PG8_SA(1, 1), a1 + hstep, voffA);
            PG8_WAIT_L(8); PG8_BAR; PG8_WAIT_L(0); PG8_MMA(0, 0, At, B0); PG8_BAR; PG8_SCHED;
            PG8_LDB(B1, 0, 1); PG8_STAGE(PG8_SB(0, 0), b2, voffB);
            PG8_BAR; PG8_WAIT_L(0); PG8_MMA(0, 1, At, B1); PG8_BAR;
            PG8_LDA(At, 0, 1); PG8_STAGE(PG8_SA(0, 0), a2, voffA);
            PG8_BAR; PG8_WAIT_L(0); PG8_MMA(1, 0, At, B0); PG8_BAR; PG8_SCHED;
            PG8_STAGE(PG8_SB(0, 1), b2 + hstep, voffB);
            PG8_WAIT_V(6); PG8_BAR; PG8_MMA(1, 1, At, B1); PG8_BAR;
            PG8_LDB(B0, 1, 0); PG8_SCHED; PG8_LDA(At, 1, 0); PG8_STAGE(PG8_SA(0, 1), a2 + hstep, voffA);
            PG8_WAIT_L(8); PG8_BAR; PG8_WAIT_L(0); PG8_MMA(0, 0, At, B0); PG8_BAR; PG8_SCHED;
            PG8_LDB(B1, 1, 1); PG8_STAGE(PG8_SB(1, 0), b3, voffB);
            PG8_BAR; PG8_WAIT_L(0); PG8_MMA(0, 1, At, B1); PG8_BAR;
            PG8_LDA(At, 1, 1); PG8_STAGE(PG8_SA(1, 0), a3, voffA);
            PG8_BAR; PG8_WAIT_L(0); PG8_MMA(1, 0, At, B0); PG8_BAR; PG8_SCHED;
            PG8_STAGE(PG8_SB(1, 1), b3 + hstep, voffB);
            PG8_WAIT_V(6); PG8_BAR; PG8_MMA(1, 1, At, B1); PG8_BAR;
            }
        }
        if constexpr (ALIGN_EPI) { if (wr == 0) PG8_BAR; }
        if constexpr (!Epi::AFTER_DRAIN) { E(acc, cur, wr, wc, fr, fq); S.done(cur); }
        if (!has_next) break;
#pragma unroll
        for (int a = 0; a < 2; ++a)
#pragma unroll
            for (int b = 0; b < 2; ++b)
#pragma unroll
                for (int m = 0; m < 4; ++m)
#pragma unroll
                    for (int n = 0; n < 2; ++n) acc[a][b][m][n] = (f32x4){0.f, 0.f, 0.f, 0.f};
        cur = nxt; cA = nA; cB = nB; ++ui;
        if constexpr (ALIGN_EPI) { if (wr == 1) PG8_BAR; }
    }
    PG8_WAIT_V(0);
    if constexpr (!ALIGN_EPI) { if (wr == 0) PG8_BAR; }
    PG8_BAR;
    if constexpr (Epi::AFTER_DRAIN) { E.fused(acc, cur, wr, wc, fr, fq, lds, wid, lane); S.done(cur); }
#undef PG8_SA
#undef PG8_SB
#undef PG8_STAGE
#undef PG8_LDA
#undef PG8_LDB
#undef PG8_MMA
#undef PG8_WAIT_V
#undef PG8_WAIT_L
#undef PG8_BAR
#undef PG8_SCHED
}
}

#define LAS __attribute__((address_space(3)))
template <int MODE> struct EpiFast {
    static constexpr bool PERM = true, AFTER_DRAIN = false;
    EpiArgs E;
    __device__ __forceinline__ void operator()(const pg8::f32x4 (&acc)[2][2][4][2], const pg8::Unit& u, int wr, int wc, int fr, int fq) const {
        const int row0 = u.pm * 256 + wr * 64 + fr, col0 = u.pn * 256 + wc * 32 + 8 * fq;
#pragma unroll
        for (int ai = 0; ai < 2; ++ai)
#pragma unroll
            for (int m = 0; m < 4; ++m)
#pragma unroll
                for (int bj = 0; bj < 2; ++bj) epi8v(MODE, E, row0 + ai * 128 + m * 16, col0 + bj * 128, acc[ai][bj][m][0], acc[ai][bj][m][1]);
    }
};
__device__ __forceinline__ void side_tile(int mode, const EpiArgs& E, const bf16_t* __restrict__ A, int erow0, const bf16_t* __restrict__ Bt, int K, int n0) {
    const int l = tidf() & 63, i = l & 31, h = l >> 5;
    const int g = i >> 3, hh = (i >> 2) & 1, q = i & 3, L = 8 * (2 * hh + (g >> 1)) + 4 * (g & 1) + q;
    const bf16_t* wp = Bt + (size_t)(n0 + L) * K + 8 * h;
    const bf16_t* xp = A + (size_t)i * K + 8 * h;
    f32x16 acc; for (int r = 0; r < 16; ++r) acc[r] = 0.f;
#pragma unroll 8
    for (int k0 = 0; k0 < K; k0 += 16) { const bf16x8 wf = *(const bf16x8*)(wp + k0), xf = *(const bf16x8*)(xp + k0); acc = __builtin_amdgcn_mfma_f32_32x32x16_bf16(wf, xf, acc, 0, 0, 0); }
    epi8v(mode, E, erow0 + i, n0 + 16 * h, (f32x4){acc[0], acc[1], acc[2], acc[3]}, (f32x4){acc[4], acc[5], acc[6], acc[7]});
    epi8v(mode, E, erow0 + i, n0 + 16 * h + 8, (f32x4){acc[8], acc[9], acc[10], acc[11]}, (f32x4){acc[12], acc[13], acc[14], acc[15]});
}
struct GemmArgs { const bf16_t* A; const bf16_t* Bt; int M, N, K, gt; size_t gstride; int side; int pad; };
constexpr int GEMM_LDS = 131072 + 1024;
template <int MODE> __device__ __forceinline__ void gemm_fast_body(LAS unsigned char* lds, const GemmArgs& ga, const EpiArgs& E) {
    if (ga.side) {
        const int wid = tidf() >> 6, nt = ga.N / 32;
        for (int t = wid * gridDim.x + blockIdx.x; t < nt; t += 8 * gridDim.x) side_tile(MODE, E, ga.A + (size_t)MX * ga.K, MX, ga.Bt, ga.K, t * 32);
        asm volatile("s_waitcnt vmcnt(0)" ::: "memory");
    }
    pg8::Gemm g{ga.A, ga.Bt, ga.M, ga.N, ga.K, ga.gt, ga.gstride};
    pg8::StaticOrder S; S.init(ga.M, ga.N, (int)gridDim.x, (int)blockIdx.x);
    EpiFast<MODE> Ep{E};
    pg8::gemm_phase<EpiFast<MODE>, pg8::StaticOrder, true, true>(lds, g, S, Ep);
}
template <int MODE> __global__ void __launch_bounds__(512, 2) k_gemm_fast(GemmArgs ga, EpiArgs E) {
    extern __shared__ __attribute__((aligned(16))) unsigned char smem_g[];
    gemm_fast_body<MODE>((LAS unsigned char*)smem_g, ga, E);
}
template <int MODE> static void launch_gemm_fast(hipStream_t stream, const bf16_t* A, const bf16_t* Bt, int M, int N, int K, int gt, size_t gstride, int side, const EpiArgs& E) {
    (void)hipFuncSetAttribute((const void*)k_gemm_fast<MODE>, hipFuncAttributeMaxDynamicSharedMemorySize, GEMM_LDS);
    GemmArgs ga{}; ga.A = A; ga.Bt = Bt; ga.M = M; ga.N = N; ga.K = K; ga.gt = gt; ga.gstride = gstride; ga.side = side;
    k_gemm_fast<MODE><<<256, 512, GEMM_LDS, stream>>>(ga, E);
}

__device__ __forceinline__ float log_sigmoid(float x) { return -log1pf(expf(-x)); }
__device__ __forceinline__ int chunk_row(int b, int n, int c) { return n == 0 ? (c >= 112 ? MX + b * 16 + (c - 112) : -1) : b * SEQ + 128 * (n - 1) + c; }

__global__ void __launch_bounds__(256) k_ret_state(const bf16_t* __restrict__ PROJ, const float* __restrict__ dec_f, const float* __restrict__ dec_b, bf16_t* __restrict__ S) {
    __shared__ bf16_t Ks[128][128];
    __shared__ float Vs[128][32];
    const int sl = blockIdx.x, bh = blockIdx.y, dir = blockIdx.z, b = bh >> 2, h = bh & 3, tid = tidf();
    const float lg = log_sigmoid(dir == 0 ? dec_f[h] : dec_b[h]);
    const float dec = expf(lg * 128.f);
    const int dk = tid & 127, hf = tid >> 7;
    float st[16]; for (int j = 0; j < 16; ++j) st[j] = 0.f;
    for (int step = 0; step < NCH; ++step) {
        const int n = dir == 0 ? step : NCH - 1 - step;
        bf16_t* dst = S + ((((size_t)dir * 8 + bh) * NCH + n) * 128 + dk) * 256 + sl * 32 + hf * 16;
        for (int j = 0; j < 16; ++j) dst[j] = f2bf(st[j]);
        __syncthreads();
        for (int i = tid; i < 128 * 128; i += 256) { const int c = i >> 7, d = i & 127; const int r = chunk_row(b, n, c); Ks[c][d] = r < 0 ? (bf16_t)0 : PROJ[(size_t)r * NPROJ + C_K + h * 128 + d]; }
        for (int i = tid; i < 128 * 32; i += 256) { const int c = i >> 5, d = i & 31; const int r = chunk_row(b, n, c);
            const float w = dir == 0 ? expf(lg * (float)(127 - c)) : expf(lg * (float)c);
            Vs[c][d] = r < 0 ? 0.f : bf2f(PROJ[(size_t)r * NPROJ + C_V + h * 256 + sl * 32 + d]) * w; }
        __syncthreads();
        float a[16]; for (int j = 0; j < 16; ++j) a[j] = 0.f;
        for (int c = 0; c < 128; ++c) { const float kv = bf2f(Ks[c][dk]); for (int j = 0; j < 16; ++j) a[j] += kv * Vs[c][hf * 16 + j]; }
        for (int j = 0; j < 16; ++j) st[j] = st[j] * dec + a[j];
    }
}

constexpr int QS_STRIDE = 130;
constexpr int R2_LDS = 2 * 128 * QS_STRIDE * 2 + 128 * 128 * 4 + 64 * 4;
__global__ void __launch_bounds__(256) k_ret_out(const bf16_t* __restrict__ PROJ, const bf16_t* __restrict__ S, const float* __restrict__ dec_f, const float* __restrict__ dec_b,
                                                const float* __restrict__ hg, bf16_t* __restrict__ ARET) {
    extern __shared__ __attribute__((aligned(16))) unsigned char smem[];
    bf16_t* Qs = (bf16_t*)smem; bf16_t* Ks = Qs + 128 * QS_STRIDE; float* SC = (float*)(Ks + 128 * QS_STRIDE); float* red = SC + 128 * 128;
    const int n = blockIdx.x, bh = blockIdx.y, b = bh >> 2, h = bh & 3, tid = tidf();
    const float lf = log_sigmoid(dec_f[h]), lb = log_sigmoid(dec_b[h]);
    for (int i = tid; i < 128 * 128; i += 256) { const int c = i >> 7, d = i & 127; const int r = chunk_row(b, n, c);
        Qs[c * QS_STRIDE + d] = r < 0 ? (bf16_t)0 : PROJ[(size_t)r * NPROJ + C_Q + h * 128 + d];
        Ks[c * QS_STRIDE + d] = r < 0 ? (bf16_t)0 : PROJ[(size_t)r * NPROJ + C_K + h * 128 + d]; }
    __syncthreads();
    {
        const int j = tid & 127, ib = (tid >> 7) * 64;
        for (int i = ib; i < ib + 64; ++i) {
            float s = 0.f;
            for (int d = 0; d < 128; ++d) s += bf2f(Qs[i * QS_STRIDE + d]) * bf2f(Ks[j * QS_STRIDE + d]);
            const float mk = i >= j ? expf(lf * (float)(i - j)) : expf(lb * (float)(j - i));
            SC[i * 128 + j] = s * mk;
        }
    }
    __syncthreads();
    const int dv = tid;
    const bf16_t* Sf = S + (((size_t)0 * 8 + bh) * NCH + n) * 128 * 256;
    const bf16_t* Sb = S + (((size_t)1 * 8 + bh) * NCH + n) * 128 * 256;
    for (int grp = (n == 0 ? 7 : 0); grp < 8; ++grp) {
        float acc[16]; for (int i = 0; i < 16; ++i) acc[i] = 0.f;
        for (int j = 0; j < 128; ++j) { const int r = chunk_row(b, n, j); if (r < 0) continue; const float v = bf2f(PROJ[(size_t)r * NPROJ + C_V + h * 256 + dv]);
            for (int i = 0; i < 16; ++i) acc[i] += SC[(grp * 16 + i) * 128 + j] * v; }
        float qf[16], qb[16];
        for (int i = 0; i < 16; ++i) { const int ii = grp * 16 + i; qf[i] = expf(lf * (float)(ii + 1)); qb[i] = expf(lb * (float)(128 - ii)); }
        for (int d = 0; d < 128; ++d) { const float sf = bf2f(Sf[(size_t)d * 256 + dv]), sb = bf2f(Sb[(size_t)d * 256 + dv]);
            for (int i = 0; i < 16; ++i) { const float q = bf2f(Qs[(grp * 16 + i) * QS_STRIDE + d]); acc[i] += q * (qf[i] * sf + qb[i] * sb); } }
        float ss[16];
        for (int i = 0; i < 16; ++i) { float v = acc[i] * acc[i]; for (int o = 32; o > 0; o >>= 1) v += __shfl_xor(v, o); ss[i] = v; }
        __syncthreads();
        if ((tid & 63) == 0) for (int i = 0; i < 16; ++i) red[(tid >> 6) * 16 + i] = ss[i];
        __syncthreads();
        for (int i = 0; i < 16; ++i) {
            const float ms = (red[i] + red[16 + i] + red[32 + i] + red[48 + i]) * (1.f / 256.f);
            const int r = chunk_row(b, n, grp * 16 + i);
            if (r < 0) continue;
            const float y = acc[i] * rsqrtf(ms + RMS_EPS) * hg[h * 256 + dv];
            ARET[(size_t)r * DM + h * 256 + dv] = f2bf(y * bf2f(PROJ[(size_t)r * NPROJ + C_G + h * 256 + dv]));
        }
    }
}

__device__ __forceinline__ float conv3(const bf16_t* __restrict__ PROJ, const float* __restrict__ cw, const float* __restrict__ cb, int b, int t, int ch) {
    float a = cb[ch];
    for (int j = 0; j < 3; ++j) { const int tt = t + j - 1; if (tt >= 0 && tt < TT) a += bf2f(PROJ[(size_t)row_of(b, tt) * NPROJ + C_U + ch]) * cw[j * 3072 + ch]; }
    return a;
}
__global__ void k_hy_prep(const bf16_t* __restrict__ PROJ, const float* __restrict__ cw, const float* __restrict__ cb, bf16_t* __restrict__ ZT) {
    const int c = blockIdx.x * 256 + tidf(), t = blockIdx.y, b = blockIdx.z;
    bf16_t v = 0;
    if (t < TT) { const float x1 = conv3(PROJ, cw, cb, b, t, 1024 + c), vh = conv3(PROJ, cw, cb, b, t, 2048 + c); v = f2bf(x1 * vh); }
    ZT[((size_t)b * 1024 + c) * ZL + t] = v;
}
__global__ void __launch_bounds__(256) k_hy_conv(const bf16_t* __restrict__ G, const bf16_t* __restrict__ ZT, bf16_t* __restrict__ YCT) {
    __shared__ float zs[2][1024];
    __shared__ float gs[3072 + 8];
    const int tile = blockIdx.x, c = blockIdx.y, tid = tidf();
    const int tb = tile * 2048, t0 = tb + tid * 8;
    float acc0[8], acc1[8];
    for (int j = 0; j < 8; ++j) { acc0[j] = 0.f; acc1[j] = 0.f; }
    const bf16_t* g = G + (size_t)c * GL;
    for (int s0 = 0; s0 < TT; s0 += 1024) {
        __syncthreads();
        for (int i = tid; i < 2048; i += 256) { const int bb = i >> 10, s = s0 + (i & 1023); zs[bb][i & 1023] = s < TT ? bf2f(ZT[((size_t)bb * 1024 + c) * ZL + s]) : 0.f; }
        const int dlo = tb - s0 - 1023;
        for (int i = tid; i < 3072; i += 256) { const int idx = TT + dlo + i; gs[i] = (idx >= 0 && idx < GL) ? bf2f(g[idx]) : 0.f; }
        __syncthreads();
        const int base = tid * 8 + 1023;
        for (int u = 0; u < 1024; ++u) {
            const float z0 = zs[0][u], z1 = zs[1][u];
#pragma unroll
            for (int j = 0; j < 8; ++j) { const float gv = gs[base + j - u]; acc0[j] += gv * z0; acc1[j] += gv * z1; }
        }
    }
    for (int j = 0; j < 8; ++j) { const int t = t0 + j; if (t < ZL) { YCT[((size_t)0 * 1024 + c) * ZL + t] = f2bf(acc0[j]); YCT[((size_t)1 * 1024 + c) * ZL + t] = f2bf(acc1[j]); } }
}
__global__ void k_hy_post(const bf16_t* __restrict__ PROJ, const float* __restrict__ cw, const float* __restrict__ cb, const float* __restrict__ skip, const bf16_t* __restrict__ YCT, bf16_t* __restrict__ AHY) {
    const int c = blockIdx.x * 256 + tidf(), m = blockIdx.y;
    int b, t; bt_of(m, b, t);
    const float x0 = conv3(PROJ, cw, cb, b, t, c), x1 = conv3(PROJ, cw, cb, b, t, 1024 + c), vh = conv3(PROJ, cw, cb, b, t, 2048 + c);
    const float z = x1 * vh;
    const float yc = bf2f(YCT[((size_t)b * 1024 + c) * ZL + t]);
    AHY[(size_t)m * DM + c] = f2bf(x0 * (yc + z * skip[c]));
}


constexpr int CV_GR_BYTES = GL * 2;
constexpr int CV_ZROW = 272, CV_ZB = 18176  , CV_Z_BYTES = 2 * CV_ZB;
constexpr int CV_SLOT = CV_GR_BYTES + CV_Z_BYTES;
constexpr int CV_LDS = 2 * CV_SLOT;
__device__ __forceinline__ bf16x8 cv_load_frag(const LAS unsigned char* p, unsigned sh) {
    unsigned X[5];
#pragma unroll
    for (int i = 0; i < 5; ++i) X[i] = *(const LAS unsigned*)(p + 4 * i);
    u32x4 o;
    o.x = __builtin_amdgcn_alignbit(X[1], X[0], sh); o.y = __builtin_amdgcn_alignbit(X[2], X[1], sh);
    o.z = __builtin_amdgcn_alignbit(X[3], X[2], sh); o.w = __builtin_amdgcn_alignbit(X[4], X[3], sh);
    return __builtin_bit_cast(bf16x8, o);
}
__device__ __forceinline__ void conv_fast_body(LAS unsigned char* lds, const bf16_t* __restrict__ G, const bf16_t* __restrict__ ZT, bf16_t* __restrict__ YCT, int c_first) {
    const int tid = tidf(), l = tid & 63, wid = tid >> 6, slot = wid >> 2, ct = wid & 3;
    const int ts = tid & 255;
    LAS unsigned char* grb = lds + slot * CV_SLOT;
    LAS unsigned char* zb = grb + CV_GR_BYTES;
    for (int rd = 0; rd < 2; ++rd) {
        const int c = c_first + 2 * rd + slot;
        __syncthreads();
        {
            const u32x4* gsrc = (const u32x4*)(G + (size_t)c * GL);
            for (int i = ts; i < GL / 8; i += 256) {
                const u32x4 v = gsrc[i]; u32x4 o;
                o.x = __builtin_amdgcn_alignbit(v.w, v.w, 16); o.y = __builtin_amdgcn_alignbit(v.z, v.z, 16); o.z = __builtin_amdgcn_alignbit(v.y, v.y, 16); o.w = __builtin_amdgcn_alignbit(v.x, v.x, 16);
                *(LAS u32x4*)(grb + (size_t)(GL - 8 * (i + 1)) * 2) = o;
            }
            for (int i = ts; i < 2 * 66 * 17; i += 256) {
                const int bb = i / (66 * 17), rem = i - bb * (66 * 17), Ib = rem / 17, q = rem - Ib * 17;
                u32x4 v = (u32x4){0u, 0u, 0u, 0u};
                const bf16_t* zr = ZT + ((size_t)bb * 1024 + c) * ZL;
                if (q < 16) { if (Ib == 0) { if (q >= 14) v = *(const u32x4*)(zr + 8 * (q - 14)); } else if (Ib <= 64) v = *(const u32x4*)(zr + 16 + 128 * (Ib - 1) + 8 * q); }
                *(LAS u32x4*)(zb + bb * CV_ZB + Ib * CV_ZROW + q * 16) = v;
            }
        }
        __syncthreads();
        const int r = l & 31, h = l >> 5;
        const int Ec = 8431 + 112 - r + 8 * h;
        const unsigned sh = (unsigned)(Ec & 1) * 16u;
        const int Io = 16 * ct + (r & 15), bcol = r >> 4;
        f32x16 acc[4];
#pragma unroll
        for (int rt = 0; rt < 4; ++rt) for (int q = 0; q < 16; ++q) acc[rt][q] = 0.f;
        bf16x8 F[14];
        int d = 16 * ct - 63;
        const LAS unsigned char* abase = grb + 4 * (Ec >> 1) - 256 * d;
#pragma unroll
        for (int f = 0; f < 6; ++f) F[f] = cv_load_frag(abase - 32 * f, sh);
        const int dend = 16 * ct + 16;
        for (; d <= dend; ++d) {
#pragma unroll
            for (int f = 6; f < 14; ++f) F[f] = cv_load_frag(abase - 32 * f, sh);
            int Ib = Io - d + 1; Ib = (Ib < 0 || Ib > 64) ? 65 : Ib;
            const LAS unsigned char* zp = zb + bcol * CV_ZB + Ib * CV_ZROW + 16 * h;
#pragma unroll
            for (int ks = 0; ks < 8; ++ks) {
                const bf16x8 Bf = *(const LAS bf16x8*)(zp + 32 * ks);
#pragma unroll
                for (int rt = 0; rt < 4; ++rt) acc[rt] = __builtin_amdgcn_mfma_f32_32x32x16_bf16(F[2 * rt - ks + 7], Bf, acc[rt], 0, 0, 0);
            }
#pragma unroll
            for (int f = 0; f < 6; ++f) F[f] = F[f + 8];
            abase -= 256;
        }
        {
            bf16_t* yr = YCT + ((size_t)bcol * 1024 + c) * ZL + 16 + 128 * Io + 4 * h;
#pragma unroll
            for (int rt = 0; rt < 4; ++rt)
#pragma unroll
                for (int g = 0; g < 4; ++g) { u32x2 w; w.x = pk2(acc[rt][4 * g], acc[rt][4 * g + 1]); w.y = pk2(acc[rt][4 * g + 2], acc[rt][4 * g + 3]); *(u32x2*)(yr + 32 * rt + 8 * g) = w; }
        }
        {
            float a0[4], a1[4];
#pragma unroll
            for (int q = 0; q < 4; ++q) { a0[q] = 0.f; a1[q] = 0.f; }
            const LAS bf16_t* grh = (const LAS bf16_t*)grb;
            for (int s = l; s < TT; s += 64) {
                int Ib, j; if (s < 16) { Ib = 0; j = 112 + s; } else { const int s2 = s - 16; Ib = 1 + (s2 >> 7); j = s2 & 127; }
                const float z0 = bf2f(*(const LAS bf16_t*)(zb + Ib * CV_ZROW + 2 * j)), z1 = bf2f(*(const LAS bf16_t*)(zb + CV_ZB + Ib * CV_ZROW + 2 * j));
#pragma unroll
                for (int q = 0; q < 4; ++q) { const float gv = bf2f(grh[8431 - (4 * ct + q) + s]); a0[q] += gv * z0; a1[q] += gv * z1; }
            }
#pragma unroll
            for (int q = 0; q < 4; ++q) {
                float v0 = a0[q], v1 = a1[q];
                for (int o = 32; o > 0; o >>= 1) { v0 += __shfl_xor(v0, o); v1 += __shfl_xor(v1, o); }
                if (l == 0) { YCT[((size_t)0 * 1024 + c) * ZL + 4 * ct + q] = f2bf(v0); YCT[((size_t)1 * 1024 + c) * ZL + 4 * ct + q] = f2bf(v1); }
            }
        }
    }
}
__global__ void __launch_bounds__(512, 2) k_conv_fast(const bf16_t* __restrict__ G, const bf16_t* __restrict__ ZT, bf16_t* __restrict__ YCT) {
    extern __shared__ __attribute__((aligned(16))) unsigned char smem_c[];
    conv_fast_body((LAS unsigned char*)smem_c, G, ZT, YCT, 4 * blockIdx.x);
}
__global__ void k_norm2_router(const float* __restrict__ H2, const float* __restrict__ H2M, const float* __restrict__ g2, const float* __restrict__ wr, bf16_t* __restrict__ XN2, float* __restrict__ AFF) {
    __shared__ float red[4]; __shared__ float lred[4][16];
    const int m = blockIdx.x, tid = tidf();
    const float* src = m < MX ? H2 + (size_t)m * DM : H2M + (size_t)(m - MX) * DM;
    float v[4]; float s = 0.f;
    for (int i = 0; i < 4; ++i) { v[i] = src[tid + 256 * i]; s += v[i] * v[i]; }
    s = block_sum256(s, red);
    const float r = rsqrtf(s * (1.f / DM) + RMS_EPS);
    float lg[16]; for (int e = 0; e < 16; ++e) lg[e] = 0.f;
    for (int i = 0; i < 4; ++i) { const int k = tid + 256 * i; const float xn = v[i] * r * g2[k]; XN2[(size_t)m * DM + k] = f2bf(xn);
        for (int e = 0; e < 16; ++e) lg[e] += xn * wr[k * 16 + e]; }
    for (int e = 0; e < 16; ++e) { float q = lg[e]; for (int o = 32; o > 0; o >>= 1) q += __shfl_xor(q, o); lg[e] = q; }
    if ((tid & 63) == 0) for (int e = 0; e < 16; ++e) lred[tid >> 6][e] = lg[e];
    __syncthreads();
    if (tid == 0) {
        float l[16], mx = -1e30f;
        for (int e = 0; e < 16; ++e) { l[e] = lred[0][e] + lred[1][e] + lred[2][e] + lred[3][e]; mx = fmaxf(mx, l[e]); }
        float sum = 0.f; for (int e = 0; e < 16; ++e) { l[e] = expf(l[e] - mx); sum += l[e]; }
        int b, t; bt_of(m, b, t);
        for (int e = 0; e < 16; ++e) AFF[((size_t)b * NE + e) * TT + t] = l[e] / sum;
    }
}
__global__ void k_topk(const float* __restrict__ AFF, int* __restrict__ IDX, float* __restrict__ GATEV, int* __restrict__ INV) {
    __shared__ float a[TT];
    const int be = blockIdx.y, t = blockIdx.x * 256 + tidf();
    for (int i = tidf(); i < TT; i += 256) a[i] = AFF[(size_t)be * TT + i];
    __syncthreads();
    if (t >= TT) return;
    const float v = a[t]; int rank = 0;
    for (int i = 0; i < TT; ++i) { const float w = a[i]; rank += (w > v || (w == v && i < t)) ? 1 : 0; }
    if (rank < CAP) { IDX[(size_t)be * CAP + rank] = t; GATEV[(size_t)be * CAP + rank] = v; INV[(size_t)be * TT + t] = rank; }
    else INV[(size_t)be * TT + t] = -1;
}
__global__ void k_gather(const bf16_t* __restrict__ XN2, const int* __restrict__ IDX, bf16_t* __restrict__ XE) {
    const int r = blockIdx.x, e = blockIdx.y;
    uint4 v = make_uint4(0, 0, 0, 0);
    if (r < 2 * CAP) { const int b = r / CAP, slot = r % CAP; const int t = IDX[((size_t)b * NE + e) * CAP + slot]; v = *(const uint4*)(XN2 + (size_t)row_of(b, t) * DM + tidf() * 8); }
    *(uint4*)(XE + ((size_t)e * ER + r) * DM + tidf() * 8) = v;
}
__global__ void k_final(float* __restrict__ OUT, const bf16_t* __restrict__ YE, const int* __restrict__ INV, const float* __restrict__ gfin) {
    __shared__ float red[4];
    const int m = blockIdx.x, tid = tidf(), b = m >> 13, t = (m & 8191) + NMETA;
    float v[4]; for (int i = 0; i < 4; ++i) v[i] = OUT[(size_t)m * DM + tid + 256 * i];
    for (int e = 0; e < NE; ++e) { const int slot = INV[((size_t)b * NE + e) * TT + t]; if (slot >= 0) { const bf16_t* y = YE + ((size_t)e * ER + b * CAP + slot) * DM; for (int i = 0; i < 4; ++i) v[i] += bf2f(y[tid + 256 * i]); } }
    float s = 0.f; for (int i = 0; i < 4; ++i) s += v[i] * v[i];
    s = block_sum256(s, red);
    const float r = rsqrtf(s * (1.f / DM) + RMS_EPS);
    for (int i = 0; i < 4; ++i) OUT[(size_t)m * DM + tid + 256 * i] = v[i] * r * gfin[tid + 256 * i];
}


struct Ctx {
    const float *x, *meta, *norm1_g, *w_in, *dec_f, *dec_b, *hg, *w_ret, *cw, *cb, *fw1, *fb1, *fw2, *fb2, *fw3, *fb3, *ffq, *fw4, *skip, *w_hy, *w_o, *norm2_g, *w_router, *w_eg, *w_eu, *w_ed, *gfin;
    unsigned char* ws; unsigned char* dob;
};
#define P_WRET ((bf16_t*)(c.ws + WS_WRET))
#define P_WHY ((bf16_t*)(c.ws + WS_WHY))
#define P_WO ((bf16_t*)(c.ws + WS_WO))
#define P_XN ((bf16_t*)(c.ws + WS_XN))
#define P_PROJ ((bf16_t*)(c.ws + WS_PROJ))
#define P_S ((bf16_t*)(c.ws + WS_S))
#define P_TMP ((float*)(c.ws + WS_S))
#define P_ZT ((bf16_t*)(c.ws + WS_ZT))
#define P_G ((bf16_t*)(c.ws + WS_G))
#define P_AHY ((bf16_t*)(c.ws + WS_G))
#define P_ARET ((bf16_t*)(c.ws + WS_ARET))
#define P_WGU ((bf16_t*)(c.ws + WS_WGU))
#define P_WD ((bf16_t*)(c.ws + WS_WD))
#define P_XE ((bf16_t*)(c.ws + WS_XE))
#define P_YE ((bf16_t*)(c.ws + WS_XE))
#define P_HID ((bf16_t*)(c.ws + WS_HID))
#define P_WIN ((bf16_t*)(c.dob + DO_WIN))
#define P_ROPE ((float*)(c.dob + DO_ROPE))
#define P_YCT ((bf16_t*)(c.dob + DO_YCT))
#define P_AFF ((float*)(c.ws + WS_MISC + MI_AFF))
#define P_IDX ((int*)(c.ws + WS_MISC + MI_IDX))
#define P_GATEV ((float*)(c.ws + WS_MISC + MI_GATE))
#define P_INV ((int*)(c.ws + WS_MISC + MI_INV))
#define P_H2M ((float*)(c.ws + WS_MISC + MI_H2M))
#define P_H2 ((float*)c.dob)
#define LDSW() asm volatile("s_waitcnt lgkmcnt(0)" ::: "memory")
__device__ __forceinline__ float wave_sum(float v) {
#pragma unroll
    for (int o = 1; o < 64; o <<= 1) v += __shfl_xor(v, o);
    return v;
}
__device__ __forceinline__ EpiArgs make_epi(const Ctx& c) {
    EpiArgs E{}; E.PROJ = P_PROJ; E.ROPE = P_ROPE; E.TMP = P_TMP; E.MIXED = P_XN; E.x = c.x; E.meta = c.meta; E.H2 = P_H2; E.H2M = P_H2M; E.HID = P_HID; E.YE = P_YE; E.GATEV = P_GATEV; return E;
}

__device__ __forceinline__ int wt_dst_row(int mode, int s) {
    if (mode == 1) { if (s >= 1024) return s; const int sl = s & 127; const int i = sl & 63; return (s & ~127) + 8 * (i >> 2) + (sl >= 64 ? 4 : 0) + (i & 3); }
    if (mode == 2) return 8 * (s >> 2) + (s & 3);
    if (mode == 3) return 8 * (s >> 2) + 4 + (s & 3);
    return s;
}
__device__ __forceinline__ void wt_item(const float* __restrict__ W, int K, int N, bf16_t* __restrict__ WT, LAS float* scr, int kb, int nb, int lane, int mode) {
    const int k0 = 64 * kb, n0 = 32 * nb;
#pragma unroll
    for (int i = 0; i < 8; ++i) { const int kk = 8 * i + (lane >> 3); const f32x4 v = *(const f32x4*)(W + (size_t)(k0 + kk) * N + n0 + 4 * (lane & 7));
        LAS float* d = scr + kk * 33 + 4 * (lane & 7); d[0] = v.x; d[1] = v.y; d[2] = v.z; d[3] = v.w; }
    LDSW();
    const int cc = lane & 7;
#pragma unroll
    for (int j = 0; j < 4; ++j) { const int n = (lane >> 3) + 8 * j; const LAS float* s = scr + (8 * cc) * 33 + n;
        u32x4 o; o.x = pk2(s[0 * 33], s[1 * 33]); o.y = pk2(s[2 * 33], s[3 * 33]); o.z = pk2(s[4 * 33], s[5 * 33]); o.w = pk2(s[6 * 33], s[7 * 33]);
        *(u32x4*)(WT + (size_t)wt_dst_row(mode, n0 + n) * K + k0 + 8 * cc) = o; }
    LDSW();
}

__device__ __forceinline__ void phase_p0(LAS unsigned char* lds, const Ctx& c) {
    const int tid = tidf(), lane = tid & 63, wid = tid >> 6;
    const int gw = blockIdx.x * 8 + wid, NGW = gridDim.x * 8;
    {
        LAS float* scr = (LAS float*)(lds + wid * 8448);
        constexpr int I_IN = 16 * 256, I_SM = 16 * 32;
        for (int it = gw; it < I_IN + 3 * I_SM; it += NGW) {
            int r = it;
            if (r < I_IN) { wt_item(c.w_in, 1024, 8192, P_WIN, scr, r / 256, r % 256, lane, 1); continue; } r -= I_IN;
            if (r < I_SM) { wt_item(c.w_ret, 1024, 1024, P_WRET, scr, r / 32, r % 32, lane, 0); continue; } r -= I_SM;
            if (r < I_SM) { wt_item(c.w_hy, 1024, 1024, P_WHY, scr, r / 32, r % 32, lane, 0); continue; } r -= I_SM;
            wt_item(c.w_o, 1024, 1024, P_WO, scr, r / 32, r % 32, lane, 0);
        }
    }
    for (int m = gw; m < MROWS; m += NGW) {
        const float* src = m < MX ? c.x + (size_t)m * DM : c.meta + (size_t)((m - MX) & 15) * DM;
        f32x4 v[4]; float s = 0.f;
#pragma unroll
        for (int j = 0; j < 4; ++j) { v[j] = *(const f32x4*)(src + 4 * (lane + 64 * j)); s += (v[j].x * v[j].x + v[j].y * v[j].y) + (v[j].z * v[j].z + v[j].w * v[j].w); }
        const float r = rsqrtf(wave_sum(s) * (1.f / DM) + RMS_EPS);
#pragma unroll
        for (int j = 0; j < 4; ++j) { const f32x4 g = *(const f32x4*)(c.norm1_g + 4 * (lane + 64 * j)); u32x2 w; w.x = pk2(v[j].x * r * g.x, v[j].y * r * g.y); w.y = pk2(v[j].z * r * g.z, v[j].w * r * g.w);
            *(u32x2*)(P_XN + (size_t)m * DM + 4 * (lane + 64 * j)) = w; }
    }
    for (int i = blockIdx.x * 512 + tid; i < TT * 64; i += gridDim.x * 512) {
        const int t = i >> 6, f = i & 63; const float inv = powf(10000.0f, -(float)f / 64.0f); const float ang = (float)t * inv;
        P_ROPE[(size_t)t * 128 + f] = cosf(ang); P_ROPE[(size_t)t * 128 + 64 + f] = sinf(ang);
    }
    {
        LAS float* feat = (LAS float*)(lds + 69632);
        LAS float* ha = feat + 32 * 34;
        LAS float* hb = ha + 32 * 65;
        LAS bf16_t* hd = (LAS bf16_t*)(hb + 32 * 65);
        const float mind = logf(1e-2f) / 1.5f, maxd = logf(1e-2f) / 0.3f;
        for (int it = blockIdx.x; it < (TT + 31) / 32; it += gridDim.x) {
            const int p = tid >> 4, q = tid & 15, t = it * 32 + p;
            __syncthreads();
            {
                const float fr = 1e-4f + (float)q * ((15.0f - 1e-4f) / 15.0f);
                const float ang = (2.0f * 3.14159265358979323846f * (float)t / (float)TT) * fr;
                feat[p * 34 + 1 + q] = cosf(ang); feat[p * 34 + 17 + q] = -sinf(ang);
                if (q == 0) feat[p * 34] = (float)t / (float)(TT - 1);
            }
            __syncthreads();
            const int u = q * 4;
            const f32x4 fq = *(const f32x4*)(c.ffq + u);
            {
                f32x4 a = *(const f32x4*)(c.fb1 + u);
#pragma unroll 3
                for (int i = 0; i < 33; ++i) a += feat[p * 34 + i] * *(const f32x4*)(c.fw1 + i * 64 + u);
#pragma unroll
                for (int j = 0; j < 4; ++j) ha[p * 65 + u + j] = sinf(fq[j] * a[j]);
            }
            __syncthreads();
            {
                f32x4 a = *(const f32x4*)(c.fb2 + u);
#pragma unroll 4
                for (int i = 0; i < 64; ++i) a += ha[p * 65 + i] * *(const f32x4*)(c.fw2 + i * 64 + u);
#pragma unroll
                for (int j = 0; j < 4; ++j) hb[p * 65 + u + j] = sinf(fq[j] * a[j]);
            }
            __syncthreads();
            {
                f32x4 a = *(const f32x4*)(c.fb3 + u);
#pragma unroll 4
                for (int i = 0; i < 64; ++i) a += hb[p * 65 + i] * *(const f32x4*)(c.fw3 + i * 64 + u);
#pragma unroll
                for (int j = 0; j < 4; ++j) hd[p * 72 + u + j] = f2bf(sinf(fq[j] * a[j]));
            }
            __syncthreads();
            const int r = lane & 31, h = lane >> 5;
            bf16x8 Af[4];
#pragma unroll
            for (int ks = 0; ks < 4; ++ks) Af[ks] = *(const LAS bf16x8*)((const LAS unsigned char*)hd + r * 144 + (16 * ks + 8 * h) * 2);
#pragma unroll 1
            for (int k8 = 0; k8 < 8; ++k8) {
                const int o = 32 * (wid + 8 * k8) + r;
                f32x16 acc; for (int z = 0; z < 16; ++z) acc[z] = 0.f;
#pragma unroll
                for (int ks = 0; ks < 4; ++ks) {
                    const float* wp = c.fw4 + (size_t)(16 * ks + 8 * h) * 2048 + o;
                    u32x4 bw; bw.x = pk2(wp[0], wp[2048]); bw.y = pk2(wp[2 * 2048], wp[3 * 2048]); bw.z = pk2(wp[4 * 2048], wp[5 * 2048]); bw.w = pk2(wp[6 * 2048], wp[7 * 2048]);
                    acc = __builtin_amdgcn_mfma_f32_32x32x16_bf16(Af[ks], __builtin_bit_cast(bf16x8, bw), acc, 0, 0, 0);
                }
                const int ch = o & 1023, bwd = o >> 10;
                const float ad = fabsf(mind + (float)ch * ((maxd - mind) / 1023.0f));
                bf16_t* grow = P_G + (size_t)ch * GL;
#pragma unroll
                for (int g = 0; g < 4; ++g)
#pragma unroll
                    for (int z = 0; z < 4; ++z) {
                        const int tt = it * 32 + 8 * g + 4 * h + z;
                        if (tt < TT) { const float win = __expf(-((float)tt / (float)(TT - 1)) * ad); const bf16_t v = f2bf(acc[4 * g + z] * win);
                            if (!bwd) grow[TT + tt] = v; else if (tt >= 1) grow[TT - tt] = v; }
                    }
            }
        }
        for (int ch = blockIdx.x * 512 + tid; ch < 1024; ch += gridDim.x * 512) { bf16_t* grow = P_G + (size_t)ch * GL; grow[0] = 0; for (int i = 2 * TT; i < GL; ++i) grow[i] = 0; }
    }
}

__device__ __forceinline__ void phase_p6(LAS unsigned char* lds, const Ctx& c) {
    const int tid = tidf(), lane = tid & 63, wid = tid >> 6;
    const int gw = blockIdx.x * 8 + wid, NGW = gridDim.x * 8;
    LAS float* wr = (LAS float*)lds;
    for (int i = tid; i < 1024 * 16 / 4; i += 512) ((LAS f32x4*)wr)[i] = ((const f32x4*)c.w_router)[i];
    __syncthreads();
    for (int m = gw; m < MROWS; m += NGW) {
        const float* src = m < MX ? P_H2 + (size_t)m * DM : P_H2M + (size_t)(m - MX) * DM;
        f32x4 v[4]; float s = 0.f;
#pragma unroll
        for (int j = 0; j < 4; ++j) { v[j] = *(const f32x4*)(src + 4 * (lane + 64 * j)); s += (v[j].x * v[j].x + v[j].y * v[j].y) + (v[j].z * v[j].z + v[j].w * v[j].w); }
        const float r = rsqrtf(wave_sum(s) * (1.f / DM) + RMS_EPS);
        float lg[16];
#pragma unroll
        for (int e = 0; e < 16; ++e) lg[e] = 0.f;
#pragma unroll
        for (int j = 0; j < 4; ++j) {
            const f32x4 g = *(const f32x4*)(c.norm2_g + 4 * (lane + 64 * j));
            const f32x4 xn = (f32x4){v[j].x * r * g.x, v[j].y * r * g.y, v[j].z * r * g.z, v[j].w * r * g.w};
            u32x2 w; w.x = pk2(xn.x, xn.y); w.y = pk2(xn.z, xn.w);
            *(u32x2*)(P_XN + (size_t)m * DM + 4 * (lane + 64 * j)) = w;
#pragma unroll
            for (int z = 0; z < 4; ++z) { const LAS f32x4* wp = (const LAS f32x4*)(wr + (4 * (lane + 64 * j) + z) * 16);
#pragma unroll
                for (int e4 = 0; e4 < 4; ++e4) { const f32x4 w4 = wp[e4]; lg[4 * e4] += xn[z] * w4.x; lg[4 * e4 + 1] += xn[z] * w4.y; lg[4 * e4 + 2] += xn[z] * w4.z; lg[4 * e4 + 3] += xn[z] * w4.w; } }
            asm volatile("" ::: "memory");
        }
        float mx = -1e30f;
#pragma unroll
        for (int e = 0; e < 16; ++e) { lg[e] = wave_sum(lg[e]); mx = fmaxf(mx, lg[e]); }
        float sum = 0.f;
#pragma unroll
        for (int e = 0; e < 16; ++e) { lg[e] = expf(lg[e] - mx); sum += lg[e]; }
        int b, t; bt_of(m, b, t);
        const float inv = 1.f / sum;
#pragma unroll
        for (int e = 0; e < 16; ++e) if (lane == e) P_AFF[((size_t)b * NE + e) * TT + t] = lg[e] * inv;
    }
    __syncthreads();
    {
        LAS float* scr = (LAS float*)(lds + wid * 8448);
        for (int it = gw; it < NE * 3072; it += NGW) {
            const int e = it / 3072, r = it % 3072;
            if (r < 1024) wt_item(c.w_eg + (size_t)e * 1024 * 2048, 1024, 2048, P_WGU + (size_t)e * 4096 * 1024, scr, r / 64, r % 64, lane, 2);
            else if (r < 2048) wt_item(c.w_eu + (size_t)e * 1024 * 2048, 1024, 2048, P_WGU + (size_t)e * 4096 * 1024, scr, (r - 1024) / 64, (r - 1024) % 64, lane, 3);
            else wt_item(c.w_ed + (size_t)e * 2048 * 1024, 2048, 1024, P_WD + (size_t)e * 1024 * 2048, scr, (r - 2048) / 32, (r - 2048) % 32, lane, 0);
        }
    }
}

__device__ __forceinline__ void phase_topk(LAS unsigned char* lds, const Ctx& c) {
    const int tid = tidf(), lane = tid & 63, wid = tid >> 6;
    LAS unsigned* hist = (LAS unsigned*)lds;
    LAS unsigned* sh = hist + 256;
    for (int be = blockIdx.x; be < NB * NE; be += gridDim.x) {
        const float* a = P_AFF + (size_t)be * TT;
        unsigned key[17];
#pragma unroll
        for (int j = 0; j < 17; ++j) { const int t = tid * 17 + j; key[j] = t < TT ? __float_as_uint(a[t]) : 0u; }
        unsigned prefix = 0u, kk = CAP;
        for (int pass = 0; pass < 4; ++pass) {
            const int shift = 24 - 8 * pass;
            __syncthreads();
            if (tid < 256) hist[tid] = 0u;
            __syncthreads();
            const unsigned himask = pass == 0 ? 0u : (0xffffffffu << (shift + 8));
#pragma unroll
            for (int j = 0; j < 17; ++j) if ((key[j] & himask) == prefix && tid * 17 + j < TT) __hip_atomic_fetch_add(&hist[(key[j] >> shift) & 255u], 1u, __ATOMIC_RELAXED, __HIP_MEMORY_SCOPE_WORKGROUP);
            __syncthreads();
            if (tid == 0) { unsigned cum = 0u; int d = 255; for (; d > 0; --d) { if (cum + hist[d] >= kk) break; cum += hist[d]; } sh[0] = prefix | ((unsigned)d << shift); sh[1] = kk - cum; }
            __syncthreads();
            prefix = sh[0]; kk = sh[1];
        }
        int ngt = 0, neq = 0;
#pragma unroll
        for (int j = 0; j < 17; ++j) { const bool v = tid * 17 + j < TT; ngt += (v && key[j] > prefix) ? 1 : 0; neq += (v && key[j] == prefix) ? 1 : 0; }
        int sg = ngt, se = neq;
#pragma unroll
        for (int o = 1; o < 64; o <<= 1) { const int ug = __shfl_up(sg, o), ue = __shfl_up(se, o); if (lane >= o) { sg += ug; se += ue; } }
        __syncthreads();
        if (lane == 63) { sh[8 + wid] = (unsigned)sg; sh[16 + wid] = (unsigned)se; }
        __syncthreads();
        int bg = 0, beq = 0;
        for (int w = 0; w < wid; ++w) { bg += (int)sh[8 + w]; beq += (int)sh[16 + w]; }
        int pg = bg + sg - ngt, pe = beq + se - neq;
        int slot = pg + ((pe < (int)kk) ? pe : (int)kk);
        int* idx = P_IDX + (size_t)be * CAP; float* gv = P_GATEV + (size_t)be * CAP; int* inv = P_INV + (size_t)be * TT;
#pragma unroll
        for (int j = 0; j < 17; ++j) {
            const int t = tid * 17 + j;
            if (t < TT) {
                bool sel = false;
                if (key[j] > prefix) sel = true; else if (key[j] == prefix) { sel = pe < (int)kk; ++pe; }
                if (sel) { idx[slot] = t; gv[slot] = __uint_as_float(key[j]); inv[t] = slot; ++slot; } else inv[t] = -1;
            }
        }
    }
}
__device__ __forceinline__ void phase_gather(const Ctx& c) {
    const int lane = tidf() & 63, gw = blockIdx.x * 8 + (tidf() >> 6), NGW = gridDim.x * 8;
    for (int it = gw; it < NE * ER; it += NGW) {
        const int e = it / ER, r = it - e * ER;
        u32x4 v0 = (u32x4){0u, 0u, 0u, 0u}, v1 = v0;
        if (r < 2 * CAP) { const int b = r / CAP, slot = r - b * CAP; const int t = P_IDX[((size_t)b * NE + e) * CAP + slot]; const u32x4* s = (const u32x4*)(P_XN + (size_t)row_of(b, t) * DM); v0 = s[lane]; v1 = s[64 + lane]; }
        u32x4* d = (u32x4*)(P_XE + (size_t)it * DM); d[lane] = v0; d[64 + lane] = v1;
    }
}
__device__ __forceinline__ void phase_final(const Ctx& c) {
    const int lane = tidf() & 63, gw = blockIdx.x * 8 + (tidf() >> 6), NGW = gridDim.x * 8;
    for (int m = gw; m < MX; m += NGW) {
        const int b = m >> 13, t = (m & 8191) + NMETA;
        float* row = P_H2 + (size_t)m * DM;
        f32x4 v[4];
#pragma unroll
        for (int j = 0; j < 4; ++j) v[j] = *(const f32x4*)(row + 4 * (lane + 64 * j));
        for (int e = 0; e < NE; ++e) {
            const int slot = P_INV[((size_t)b * NE + e) * TT + t];
            if (slot >= 0) { const bf16_t* y = P_YE + ((size_t)e * ER + b * CAP + slot) * DM;
#pragma unroll
                for (int j = 0; j < 4; ++j) { const u32x2 w = *(const u32x2*)(y + 4 * (lane + 64 * j)); v[j].x += lo16(w.x); v[j].y += hi16(w.x); v[j].z += lo16(w.y); v[j].w += hi16(w.y); } }
        }
        float s = 0.f;
#pragma unroll
        for (int j = 0; j < 4; ++j) s += (v[j].x * v[j].x + v[j].y * v[j].y) + (v[j].z * v[j].z + v[j].w * v[j].w);
        const float r = rsqrtf(wave_sum(s) * (1.f / DM) + RMS_EPS);
#pragma unroll
        for (int j = 0; j < 4; ++j) { const f32x4 g = *(const f32x4*)(c.gfin + 4 * (lane + 64 * j)); *(f32x4*)(row + 4 * (lane + 64 * j)) = (f32x4){v[j].x * r * g.x, v[j].y * r * g.y, v[j].z * r * g.z, v[j].w * r * g.w}; }
    }
}

__device__ __forceinline__ void unpack8(const u32x4 w, float* f) { f[0] = lo16(w.x); f[1] = hi16(w.x); f[2] = lo16(w.y); f[3] = hi16(w.y); f[4] = lo16(w.z); f[5] = hi16(w.z); f[6] = lo16(w.w); f[7] = hi16(w.w); }
__device__ __forceinline__ void conv3x8(const bf16_t* __restrict__ PROJ, const float* __restrict__ cw, const float* __restrict__ cb, int b, int t, int ch0, float* out) {
    const f32x4 b0 = *(const f32x4*)(cb + ch0), b1 = *(const f32x4*)(cb + ch0 + 4);
    out[0] = b0.x; out[1] = b0.y; out[2] = b0.z; out[3] = b0.w; out[4] = b1.x; out[5] = b1.y; out[6] = b1.z; out[7] = b1.w;
#pragma unroll
    for (int j = 0; j < 3; ++j) {
        const int tt = t + j - 1;
        if (tt >= 0 && tt < TT) {
            const u32x4 w = *(const u32x4*)(PROJ + (size_t)row_of(b, tt) * NPROJ + C_U + ch0);
            float u[8]; unpack8(w, u);
            const f32x4 w0 = *(const f32x4*)(cw + j * 3072 + ch0), w1 = *(const f32x4*)(cw + j * 3072 + ch0 + 4);
            out[0] += u[0] * w0.x; out[1] += u[1] * w0.y; out[2] += u[2] * w0.z; out[3] += u[3] * w0.w; out[4] += u[4] * w1.x; out[5] += u[5] * w1.y; out[6] += u[6] * w1.z; out[7] += u[7] * w1.w;
        }
    }
}
__device__ __forceinline__ void phase_hyprep(LAS unsigned char* lds, const Ctx& c) {
    const int tid = tidf(), cg = tid & 7, tp = tid >> 3;
    for (int it = blockIdx.x; it < 2 * 129 * 16; it += gridDim.x) {
        const int ct = it & 15, tt = (it >> 4) % 129, b = (it >> 4) / 129;
        const int t = 64 * tt + tp, c0 = 64 * ct + 8 * cg;
        __syncthreads();
        float z[8];
        if (t < TT) { float x1[8], vh[8]; conv3x8(P_PROJ, c.cw, c.cb, b, t, 1024 + c0, x1); conv3x8(P_PROJ, c.cw, c.cb, b, t, 2048 + c0, vh);
#pragma unroll
            for (int k = 0; k < 8; ++k) z[k] = x1[k] * vh[k]; }
        else {
#pragma unroll
            for (int k = 0; k < 8; ++k) z[k] = 0.f; }
#pragma unroll
        for (int k = 0; k < 8; ++k) *(LAS bf16_t*)(lds + (8 * cg + k) * 144 + tp * 2) = f2bf(z[k]);
        __syncthreads();
        const int ch = tid >> 3, pc = tid & 7;
        *(u32x4*)(P_ZT + ((size_t)b * 1024 + 64 * ct + ch) * ZL + 64 * tt + 8 * pc) = *(const LAS u32x4*)(lds + ch * 144 + pc * 16);
    }
}
__device__ __forceinline__ void phase_hypost(LAS unsigned char* lds, const Ctx& c) {
    const int tid = tidf(), cg = tid & 7, tp = tid >> 3;
    for (int it = blockIdx.x; it < 2 * 129 * 16; it += gridDim.x) {
        const int ct = it & 15, tt = (it >> 4) % 129, b = (it >> 4) / 129;
        const int t = 64 * tt + tp, c0 = 64 * ct + 8 * cg;
        __syncthreads();
        { const int ch = tid >> 3, pc = tid & 7; *(LAS u32x4*)(lds + ch * 144 + pc * 16) = *(const u32x4*)(P_YCT + ((size_t)b * 1024 + 64 * ct + ch) * ZL + 64 * tt + 8 * pc); }
        __syncthreads();
        if (t < TT) {
            float x0[8], x1[8], vh[8];
            conv3x8(P_PROJ, c.cw, c.cb, b, t, c0, x0); conv3x8(P_PROJ, c.cw, c.cb, b, t, 1024 + c0, x1); conv3x8(P_PROJ, c.cw, c.cb, b, t, 2048 + c0, vh);
            const f32x4 s0 = *(const f32x4*)(c.skip + c0), s1 = *(const f32x4*)(c.skip + c0 + 4);
            const float sk[8] = {s0.x, s0.y, s0.z, s0.w, s1.x, s1.y, s1.z, s1.w};
            float o[8];
#pragma unroll
            for (int k = 0; k < 8; ++k) { const float yc = bf2f(*(const LAS bf16_t*)(lds + (8 * cg + k) * 144 + tp * 2)); o[k] = x0[k] * (yc + x1[k] * vh[k] * sk[k]); }
            u32x4 w; w.x = pk2(o[0], o[1]); w.y = pk2(o[2], o[3]); w.z = pk2(o[4], o[5]); w.w = pk2(o[6], o[7]);
            *(u32x4*)(P_AHY + (size_t)row_of(b, t) * DM + c0) = w;
        }
    }
}

typedef short s16x4 __attribute__((ext_vector_type(4)));
__device__ __forceinline__ bf16x8 tr2(const LAS unsigned char* p, int second_off) {
    const s16x4 lo = __builtin_bit_cast(s16x4, __builtin_amdgcn_ds_read_tr16_b64_v4i16((LAS s16x4*)p));
    const s16x4 hi = __builtin_bit_cast(s16x4, __builtin_amdgcn_ds_read_tr16_b64_v4i16((LAS s16x4*)(p + second_off)));
    return (bf16x8){lo[0], lo[1], lo[2], lo[3], hi[0], hi[1], hi[2], hi[3]};
}
__device__ __forceinline__ u32x4 scale8(const u32x4 w, float s) {
    u32x4 o; o.x = pk2(lo16(w.x) * s, hi16(w.x) * s); o.y = pk2(lo16(w.y) * s, hi16(w.y) * s); o.z = pk2(lo16(w.z) * s, hi16(w.z) * s); o.w = pk2(lo16(w.w) * s, hi16(w.w) * s); return o;
}
constexpr int R1_KROW = 288, R1_VROW = 40;
__device__ __forceinline__ void phase_retstate(LAS unsigned char* lds, const Ctx& c) {
    const int tid = tidf(), lane = tid & 63, wid = tid >> 6;
    LAS unsigned char* Kl = lds; LAS unsigned char* Vl = lds + 128 * R1_KROW;
    const bf16_t* PROJ = P_PROJ;
    for (int item = blockIdx.x; item < 256; item += gridDim.x) {
        const int sl = item & 15, dir = (item >> 4) & 1, bh = item >> 5, b = bh >> 2, h = bh & 3;
        const float lg = log_sigmoid(dir ? c.dec_b[h] : c.dec_f[h]); const float dec = expf(lg * 128.f);
        const int kr = tid >> 2, kq = tid & 3, vr = (tid >> 1) & 127, vh = tid & 1;
        const float wv = dir == 0 ? expf(lg * (float)(127 - vr)) : expf(lg * (float)vr);
        const bf16_t* kcol = PROJ + C_K + h * 128 + 32 * kq;
        const bf16_t* vcol = PROJ + C_V + h * 256 + 16 * sl + 8 * vh;
        u32x4 kreg[4][4], vreg[4];
#define R1_LOAD(set, s_) do { int s2 = (s_); if (s2 > 64) s2 = 64; const int n_ = dir ? 64 - s2 : s2; int rk = chunk_row(b, n_, kr); if (rk < 0) rk = 0; int rv = chunk_row(b, n_, vr); if (rv < 0) rv = 0; \
        const u32x4* kp = (const u32x4*)(kcol + (size_t)rk * NPROJ); kreg[set][0] = kp[0]; kreg[set][1] = kp[1]; kreg[set][2] = kp[2]; kreg[set][3] = kp[3]; vreg[set] = *(const u32x4*)(vcol + (size_t)rv * NPROJ); } while (0)
        f32x4 st = (f32x4){0.f, 0.f, 0.f, 0.f};
        const int i16 = lane & 15, kq4 = lane >> 4, q = i16 >> 2, p = i16 & 3;
        const LAS unsigned char* ka = Kl + (8 * kq4 + q) * R1_KROW + (16 * wid + 4 * p) * 2;
        const LAS unsigned char* va = Vl + (8 * kq4 + q) * R1_VROW + 8 * p;
#define R1_STEP(set, s_) do { const int s = (s_); if (s < NCH) { const int n = dir ? 64 - s : s; \
        __syncthreads(); \
        { const bool zk = (n == 0 && kr < 112), zv = (n == 0 && vr < 112); const u32x4 z4 = (u32x4){0u, 0u, 0u, 0u}; \
          LAS u32x4* kd = (LAS u32x4*)(Kl + kr * R1_KROW + kq * 64); kd[0] = zk ? z4 : kreg[set][0]; kd[1] = zk ? z4 : kreg[set][1]; kd[2] = zk ? z4 : kreg[set][2]; kd[3] = zk ? z4 : kreg[set][3]; \
          if (tid < 256) { const u32x4 sv = zv ? z4 : scale8(vreg[set], wv); LAS u32x2* vd = (LAS u32x2*)(Vl + vr * R1_VROW + vh * 16); vd[0] = (u32x2){sv.x, sv.y}; vd[1] = (u32x2){sv.z, sv.w}; } } \
        R1_LOAD(set, s + 4); \
        __syncthreads(); \
        { u32x2 w; w.x = pk2(st.x, st.y); w.y = pk2(st.z, st.w); \
          *(u32x2*)(P_S + ((((size_t)dir * 8 + bh) * NCH + n) * 256 + 16 * sl + i16) * 128 + 16 * wid + 4 * kq4) = w; } \
        f32x4 d4 = (f32x4){0.f, 0.f, 0.f, 0.f}; \
        _Pragma("unroll") for (int ks = 0; ks < 4; ++ks) { const bf16x8 af = tr2(ka + 32 * ks * R1_KROW, 4 * R1_KROW), bf = tr2(va + 32 * ks * R1_VROW, 4 * R1_VROW); d4 = __builtin_amdgcn_mfma_f32_16x16x32_bf16(af, bf, d4, 0, 0, 0); } \
        st = st * dec + d4; } } while (0)
        R1_LOAD(0, 0); R1_LOAD(1, 1); R1_LOAD(2, 2); R1_LOAD(3, 3);
        for (int s0 = 0; s0 < 68; s0 += 4) { R1_STEP(0, s0); R1_STEP(1, s0 + 1); R1_STEP(2, s0 + 2); R1_STEP(3, s0 + 3); }
        __syncthreads();
#undef R1_LOAD
#undef R1_STEP
    }
}
constexpr int R2Q = 272, R2V = 576, R2O = 528;
__device__ __forceinline__ void phase_retout(LAS unsigned char* lds, const Ctx& c) {
    const int tid = tidf(), lane = tid & 63, wid = tid >> 6;
    LAS unsigned char* Ql = lds; LAS unsigned char* Kl = lds + 128 * R2Q; LAS unsigned char* Vl = lds + 2 * 128 * R2Q; LAS float* red = (LAS float*)(lds + 2 * 128 * R2Q + 128 * R2V);
    const bf16_t* PROJ = P_PROJ;
    for (int u = blockIdx.x; u < 520; u += gridDim.x) {
        int bh, n; if (u < 512) { bh = u >> 6; n = 1 + (u & 63); } else { bh = u - 512; n = 0; }
        const int b = bh >> 2, h = bh & 3;
        const float lf = log_sigmoid(c.dec_f[h]), lb = log_sigmoid(c.dec_b[h]);
        const float lf2 = lf * 1.4426950408889634f, lb2 = lb * 1.4426950408889634f;
        __syncthreads();
        {
            const int row = tid >> 2, qt = tid & 3; const int gr = chunk_row(b, n, row);
            const u32x4 z4 = (u32x4){0u, 0u, 0u, 0u};
            LAS u32x4* qd = (LAS u32x4*)(Ql + row * R2Q + qt * 64); LAS u32x4* kd = (LAS u32x4*)(Kl + row * R2Q + qt * 64); LAS u32x4* vd = (LAS u32x4*)(Vl + row * R2V + qt * 128);
            if (gr >= 0) {
                const u32x4* qs = (const u32x4*)(PROJ + (size_t)gr * NPROJ + C_Q + h * 128 + 32 * qt); const u32x4* ks = (const u32x4*)(PROJ + (size_t)gr * NPROJ + C_K + h * 128 + 32 * qt);
                const u32x4* vs = (const u32x4*)(PROJ + (size_t)gr * NPROJ + C_V + h * 256 + 64 * qt);
#pragma unroll
                for (int i = 0; i < 4; ++i) { qd[i] = qs[i]; kd[i] = ks[i]; }
#pragma unroll
                for (int i = 0; i < 8; ++i) vd[i] = vs[i];
            } else {
#pragma unroll
                for (int i = 0; i < 4; ++i) { qd[i] = z4; kd[i] = z4; }
#pragma unroll
                for (int i = 0; i < 8; ++i) vd[i] = z4;
            }
        }
        __syncthreads();
        const int wr = wid >> 1, wc = wid & 1, r = lane & 31, hh = lane >> 5;
        f32x16 sc[2];
#pragma unroll
        for (int jt = 0; jt < 2; ++jt) for (int z = 0; z < 16; ++z) sc[jt][z] = 0.f;
#pragma unroll
        for (int ks = 0; ks < 8; ++ks) {
            const bf16x8 af = *(const LAS bf16x8*)(Ql + (32 * wr + r) * R2Q + (16 * ks + 8 * hh) * 2);
#pragma unroll
            for (int jt = 0; jt < 2; ++jt) { const bf16x8 bf = *(const LAS bf16x8*)(Kl + (64 * wc + 32 * jt + r) * R2Q + (16 * ks + 8 * hh) * 2); sc[jt] = __builtin_amdgcn_mfma_f32_32x32x16_bf16(af, bf, sc[jt], 0, 0, 0); }
        }
        __syncthreads();
#pragma unroll
        for (int jt = 0; jt < 2; ++jt) { const int j = 64 * wc + 32 * jt + r;
#pragma unroll
            for (int z = 0; z < 16; ++z) { const int i = 32 * wr + (z & 3) + 8 * (z >> 2) + 4 * hh; const int df = i - j;
                const float m = __builtin_amdgcn_exp2f(df >= 0 ? lf2 * (float)df : lb2 * (float)(-df));
                *(LAS bf16_t*)(Kl + i * R2Q + j * 2) = f2bf(sc[jt][z] * m); } }
        __syncthreads();
        f32x16 acc[4];
#pragma unroll
        for (int nt = 0; nt < 4; ++nt) for (int z = 0; z < 16; ++z) acc[nt][z] = 0.f;
        {
            const int g16 = lane >> 4, i16 = lane & 15, q = i16 >> 2, p = i16 & 3;
            const LAS unsigned char* vb = Vl + (8 * hh + q) * R2V + (128 * wc + 16 * (g16 & 1) + 4 * p) * 2;
#pragma unroll
            for (int ks = 0; ks < 8; ++ks) {
                const bf16x8 af = *(const LAS bf16x8*)(Kl + (32 * wr + r) * R2Q + (16 * ks + 8 * hh) * 2);
#pragma unroll
                for (int nt = 0; nt < 4; ++nt) { const bf16x8 bf = tr2(vb + 16 * ks * R2V + 64 * nt, 4 * R2V); acc[nt] = __builtin_amdgcn_mfma_f32_32x32x16_bf16(af, bf, acc[nt], 0, 0, 0); }
            }
        }
        {
            const int i = 32 * wr + r;
            const float qwf = expf(lf * (float)(i + 1)), qwb = expf(lb * (float)(128 - i));
            const bf16_t* Sf = P_S + (((size_t)0 * 8 + bh) * NCH + n) * 256 * 128 + (size_t)(128 * wc + r) * 128 + 8 * hh;
            const bf16_t* Sb = P_S + (((size_t)1 * 8 + bh) * NCH + n) * 256 * 128 + (size_t)(128 * wc + r) * 128 + 8 * hh;
#pragma unroll
            for (int ks = 0; ks < 8; ++ks) {
                const u32x4 aq = *(const LAS u32x4*)(Ql + (32 * wr + r) * R2Q + (16 * ks + 8 * hh) * 2);
                const bf16x8 af = __builtin_bit_cast(bf16x8, scale8(aq, qwf)), ab = __builtin_bit_cast(bf16x8, scale8(aq, qwb));
#pragma unroll
                for (int nt = 0; nt < 4; ++nt) {
                    const bf16x8 bf = *(const bf16x8*)(Sf + (size_t)32 * nt * 128 + 16 * ks), bb = *(const bf16x8*)(Sb + (size_t)32 * nt * 128 + 16 * ks);
                    acc[nt] = __builtin_amdgcn_mfma_f32_32x32x16_bf16(af, bf, acc[nt], 0, 0, 0); acc[nt] = __builtin_amdgcn_mfma_f32_32x32x16_bf16(ab, bb, acc[nt], 0, 0, 0);
                }
            }
        }
        {
            float ss[16];
#pragma unroll
            for (int z = 0; z < 16; ++z) { float v = 0.f;
#pragma unroll
                for (int nt = 0; nt < 4; ++nt) v += acc[nt][z] * acc[nt][z];
#pragma unroll
                for (int o = 1; o < 32; o <<= 1) v += __shfl_xor(v, o);
                ss[z] = v; }
            if (r == 0) {
#pragma unroll
                for (int z = 0; z < 16; ++z) red[(32 * wr + (z & 3) + 8 * (z >> 2) + 4 * hh) * 2 + wc] = ss[z]; }
        }
        __syncthreads();
        {
            float hgv[4];
#pragma unroll
            for (int nt = 0; nt < 4; ++nt) hgv[nt] = c.hg[h * 256 + 128 * wc + 32 * nt + r];
#pragma unroll
            for (int z = 0; z < 16; ++z) { const int i = 32 * wr + (z & 3) + 8 * (z >> 2) + 4 * hh; const float rs = rsqrtf((red[i * 2] + red[i * 2 + 1]) * (1.f / 256.f) + RMS_EPS);
#pragma unroll
                for (int nt = 0; nt < 4; ++nt) *(LAS bf16_t*)(Vl + i * R2O + (128 * wc + 32 * nt + r) * 2) = f2bf(acc[nt][z] * rs * hgv[nt]); }
        }
        __syncthreads();
        {
            const int row = tid >> 2, qt = tid & 3; const int gr = chunk_row(b, n, row);
            if (gr >= 0) {
                const u32x4* gs = (const u32x4*)(PROJ + (size_t)gr * NPROJ + C_G + h * 256 + 64 * qt); u32x4* od = (u32x4*)(P_ARET + (size_t)gr * DM + h * 256 + 64 * qt);
#pragma unroll
                for (int i = 0; i < 8; ++i) { const u32x4 o = *(const LAS u32x4*)(Vl + row * R2O + qt * 128 + 16 * i), g = gs[i]; u32x4 w;
                    w.x = pk2(lo16(o.x) * lo16(g.x), hi16(o.x) * hi16(g.x)); w.y = pk2(lo16(o.y) * lo16(g.y), hi16(o.y) * hi16(g.y)); w.z = pk2(lo16(o.z) * lo16(g.z), hi16(o.z) * hi16(g.z)); w.w = pk2(lo16(o.w) * lo16(g.w), hi16(o.w) * hi16(g.w));
                    od[i] = w; }
            }
        }
    }
}
constexpr int PH_LDS = 147456;
template <int PH> __global__ void __launch_bounds__(512, 2) k_phase(Ctx c) {
    extern __shared__ __attribute__((aligned(16))) unsigned char smem_p[];
    LAS unsigned char* lds = (LAS unsigned char*)smem_p;
    if (PH == 0) phase_p0(lds, c);
    else if (PH == 6) phase_p6(lds, c);
    else if (PH == 7) phase_topk(lds, c);
    else if (PH == 8) phase_gather(c);
    else if (PH == 10) phase_final(c);
    else if (PH == 2) { phase_retstate(lds, c); phase_hyprep(lds, c); }
    else if (PH == 3) phase_retout(lds, c);
    else if (PH == 4) phase_hypost(lds, c);
}
template <int PH> static void launch_phase(hipStream_t stream, const Ctx& c) {
    (void)hipFuncSetAttribute((const void*)k_phase<PH>, hipFuncAttributeMaxDynamicSharedMemorySize, PH_LDS);
    k_phase<PH><<<256, 512, PH_LDS, stream>>>(c);
}


typedef __attribute__((address_space(1))) unsigned gu32;
#define XB_TMO      128
#define XB_XCNT(j)  (256  + 64 * (j))
#define XB_XSUB(j)  (1280 + 64 * (j))
#define XB_XGEN(j)  (2304 + 64 * (j))
#define XB_TOP      3328
#define XB_TOPGEN   3392
#define XCD_BAR_WORDS 3456
#define XB_SPIN_CAP (1u << 18)

__device__ __forceinline__ unsigned xb_ld(unsigned* p)              { return __hip_atomic_load(p, __ATOMIC_RELAXED, __HIP_MEMORY_SCOPE_AGENT); }
__device__ __forceinline__ unsigned xb_add(unsigned* p, unsigned v) { return __hip_atomic_fetch_add(p, v, __ATOMIC_RELAXED, __HIP_MEMORY_SCOPE_AGENT); }
__device__ __forceinline__ unsigned xb_xcc_id() { return (unsigned)__builtin_amdgcn_s_getreg((3 << 11) | 20) & 0xFu; }
#define XB_SPIN(cond, bar) do { unsigned _sp = 0; while (cond) { __builtin_amdgcn_s_sleep(1); \
    if ((++_sp & 255u) == 0u) { if (xb_ld(&(bar)[XB_TMO])) break; if (_sp > XB_SPIN_CAP) { atomicAdd(&(bar)[XB_TMO], 1u); break; } } } } while (0)

struct XcdBarrier {
    unsigned* bar; unsigned x;
    volatile LAS unsigned* st;
};

__device__ __forceinline__ XcdBarrier xcd_barrier_post(unsigned* bar, volatile LAS unsigned* st) {
    XcdBarrier b; b.bar = bar; b.x = xb_xcc_id(); b.st = st;
    if (tidf() == 0) (void)xb_add(&bar[XB_XCNT(b.x)], 1u);
    return b;
}
__device__ __forceinline__ void xcd_barrier_complete(unsigned* bar, unsigned x, unsigned& nloc, unsigned& nx) {
    const unsigned G = gridDim.x * gridDim.y * gridDim.z;
    unsigned sum, cnt, mine, sp = 0u;
    for (;;) {
        sum = 0u; cnt = 0u; mine = 0u;
#pragma unroll
        for (unsigned j = 0; j < 16; ++j) { const unsigned c = xb_ld(&bar[XB_XCNT(j)]); sum += c; cnt += (c > 0u) ? 1u : 0u; mine = (j == x) ? c : mine; }
        if (sum == G) break;
        __builtin_amdgcn_s_sleep(1);
        if ((++sp & 255u) == 0u) { if (xb_ld(&bar[XB_TMO])) break; if (sp > XB_SPIN_CAP) { atomicAdd(&bar[XB_TMO], 1u); break; } }
    }
    nloc = mine > 0u ? mine : 1u; nx = cnt > 0u ? cnt : 1u;
}

__device__ __forceinline__ void xcd_barrier(const XcdBarrier& b) {
    asm volatile("s_waitcnt vmcnt(0)" ::: "memory");
    __syncthreads();
    if (tidf() == 0) {
        unsigned* bar = b.bar;
        __builtin_amdgcn_s_waitcnt(0);
        unsigned nloc = b.st[0], nx = b.st[1];
        if (nloc == 0u) { xcd_barrier_complete(bar, b.x, nloc, nx); b.st[0] = nloc; b.st[1] = nx; }
        const unsigned old = xb_add(&bar[XB_XSUB(b.x)], 1u);
        const unsigned gen = old / nloc;
        if (old + 1u == (gen + 1u) * nloc) {
            __builtin_amdgcn_fence(__ATOMIC_RELEASE, "agent");
            asm volatile("s_waitcnt vmcnt(0)" ::: "memory");
            const unsigned og = xb_add(&bar[XB_TOP], 1u);
            const unsigned tg = og / nx;
            if (og + 1u == (tg + 1u) * nx) xb_add(&bar[XB_TOPGEN], 1u);
            else XB_SPIN(xb_ld(&bar[XB_TOPGEN]) == tg, bar);
            __builtin_amdgcn_fence(__ATOMIC_ACQUIRE, "agent");
            xb_add(&bar[XB_XGEN(b.x)], 1u);
            asm volatile("s_waitcnt vmcnt(0)" ::: "memory");
        } else {
            XB_SPIN(xb_ld(&bar[XB_XGEN(b.x)]) == gen, bar);
            __builtin_amdgcn_fence(__ATOMIC_ACQUIRE, "agent");
            asm volatile("s_waitcnt vmcnt(0)" ::: "memory");
        }
    }
    __syncthreads();
}
__device__ __forceinline__ GemmArgs mk_ga(const bf16_t* A, const bf16_t* Bt, int M, int N, int K, int gt, size_t gstride, int side) {
    GemmArgs ga{}; ga.A = A; ga.Bt = Bt; ga.M = M; ga.N = N; ga.K = K; ga.gt = gt; ga.gstride = gstride; ga.side = side; return ga;
}
__global__ void __launch_bounds__(512, 2) mega_fwd(Ctx c) {
    extern __shared__ __attribute__((aligned(16))) unsigned char smem_m[];
    LAS unsigned char* lds = (LAS unsigned char*)smem_m;
    cg::grid_group grid = cg::this_grid();
    const EpiArgs E = make_epi(c);
    unsigned* barw = (unsigned*)(c.ws + WS_CTL) + 1024;
    volatile LAS unsigned* bst = (volatile LAS unsigned*)(lds + PH_LDS - 256);
    if (blockIdx.x == 0) for (int i = tidf(); i < XCD_BAR_WORDS; i += 512) barw[i] = 0u;
    if (tidf() < 2) bst[tidf()] = 0u;
    phase_p0(lds, c);
    grid.sync();
    const XcdBarrier xb = xcd_barrier_post(barw, bst);
#define GSYNC() xcd_barrier(xb)
    gemm_fast_body<1>(lds, mk_ga(P_XN, P_WIN, MX, NPROJ, 1024, 1 << 20, 0, 1), E);
    GSYNC();
    phase_retstate(lds, c);
    phase_hyprep(lds, c);
    GSYNC();
    for (int cb = blockIdx.x; cb < 256; cb += gridDim.x) conv_fast_body(lds, P_G, P_ZT, P_YCT, 4 * cb);
    phase_retout(lds, c);
    GSYNC();
    phase_hypost(lds, c);
    GSYNC();
    gemm_fast_body<2>(lds, mk_ga(P_ARET, P_WRET, MX, DM, 1024, 1 << 20, 0, 1), E);
    GSYNC();
    gemm_fast_body<3>(lds, mk_ga(P_AHY, P_WHY, MX, DM, 1024, 1 << 20, 0, 1), E);
    GSYNC();
    gemm_fast_body<4>(lds, mk_ga(P_XN, P_WO, MX, DM, 1024, 1 << 20, 0, 1), E);
    GSYNC();
    phase_p6(lds, c);
    GSYNC();
    phase_topk(lds, c);
    GSYNC();
    phase_gather(c);
    GSYNC();
    gemm_fast_body<5>(lds, mk_ga(P_XE, P_WGU, NE * ER, 4096, 1024, ER / 256, (size_t)4096 * 1024 * 2, 0), E);
    GSYNC();
    gemm_fast_body<6>(lds, mk_ga(P_HID, P_WD, NE * ER, DM, 2048, ER / 256, (size_t)1024 * 2048 * 2, 0), E);
    GSYNC();
    phase_final(c);
}
extern "C" void kernel_launch(void* const* d_in, const int* in_sizes, int n_in, void* d_out, int out_size, void* d_ws, size_t ws_size, hipStream_t stream) {
    if (n_in != 27 || ws_size < WS_END || out_size != MX * DM) { fprintf(stderr, "kernel_launch: unexpected sizes n_in %d ws %zu out %d\n", n_in, ws_size, out_size); return; }
    constexpr size_t kDynLds = PH_LDS;
    static int grid_blocks = 0;
    if (!grid_blocks) {
        int dev = 0, cus = 0, per_cu = 0;
        (void)hipGetDevice(&dev);
        (void)hipDeviceGetAttribute(&cus, hipDeviceAttributeMultiprocessorCount, dev);
        (void)hipFuncSetAttribute((const void*)mega_fwd, hipFuncAttributeMaxDynamicSharedMemorySize, (int)kDynLds);
        (void)hipOccupancyMaxActiveBlocksPerMultiprocessor(&per_cu, (const void*)mega_fwd, 512, kDynLds);
        if (per_cu < 1) per_cu = 1;
        grid_blocks = cus * per_cu;
    }
    Ctx cx{};
    { const float** pp = (const float**)&cx; for (int i = 0; i < 27; ++i) pp[i] = (const float*)d_in[i]; }
    cx.ws = (unsigned char*)d_ws; cx.dob = (unsigned char*)d_out;
    void* args[] = {&cx};
    hipError_t e = hipLaunchCooperativeKernel((const void*)mega_fwd, dim3(grid_blocks), dim3(512), args, kDynLds, stream);
    if (e != hipSuccess) fprintf(stderr, "cooperative launch failed: %s (grid %d)\n", hipGetErrorString(e), grid_blocks);
}
```

```cpp
#include <hip/hip_runtime.h>
#include <stdint.h>
#include <cstdio>
#include <hip/hip_cooperative_groups.h>
namespace cg = cooperative_groups;

typedef unsigned short bf16_t;
__device__ __forceinline__ int tidf() { int t = (int)__builtin_amdgcn_workitem_id_x(); asm volatile("" : "+v"(t)); return t; }
__device__ __forceinline__ float bf2f(bf16_t v) { return __uint_as_float(((unsigned)v) << 16); }
__device__ __forceinline__ bf16_t f2bf(float f) { const __bf16 b = (__bf16)f; return __builtin_bit_cast(unsigned short, b); }

constexpr int NB = 2, SEQ = 8192, DM = 1024, NMETA = 16, TT = 8208;
constexpr int MX = 16384, MROWS = 16416, MP = 16640;
constexpr int NPROJ = 8192;
constexpr int C_Q = 0, C_K = 512, C_V = 1024, C_G = 2048, C_U = 3072, C_GA = 6144, C_GB = 7168;
constexpr int NE = 16, CAP = 1026, ER = 2304, FF = 2048;
constexpr int EM = 2048, EL = 2 * CAP - EM, EROWS = NE * EM + NE * EL;
__device__ __forceinline__ int exp_row(int e, int ml) { return ml < EM ? e * EM + ml : NE * EM + e * EL + (ml - EM); }
constexpr int NCH = 65;
constexpr int GL = 16640;
constexpr int ZL = 8320;
constexpr float RMS_EPS = 1e-6f;

constexpr size_t MiB = 1u << 20;
constexpr size_t WS_CTL = 0;
constexpr size_t WS_WRET = 1 * MiB, WS_WHY = 3 * MiB, WS_WO = 5 * MiB;
constexpr size_t WS_MISC = 7 * MiB;
constexpr size_t WS_XN = 12 * MiB;
constexpr size_t WS_PROJ = 48 * MiB;
constexpr size_t WS_S = 308 * MiB;
constexpr size_t WS_ZT = 374 * MiB;
constexpr size_t WS_G = 407 * MiB;
constexpr size_t WS_ARET = 440 * MiB;
constexpr size_t WS_WGU = 48 * MiB;
constexpr size_t WS_WD = 176 * MiB;
constexpr size_t WS_XE = 240 * MiB;
constexpr size_t WS_HID = 312 * MiB;
constexpr size_t WS_END = 456 * MiB;
constexpr size_t DO_WIN = 0;
constexpr size_t DO_ROPE = 16 * MiB;
constexpr size_t DO_HDN = 22 * MiB;
constexpr size_t DO_YCT = 0;
constexpr size_t MI_AFF = 0;
constexpr size_t MI_IDX = 1 * MiB + 64 * 1024;
constexpr size_t MI_GATE = 1 * MiB + 256 * 1024;
constexpr size_t MI_INV = 2 * MiB;
constexpr size_t MI_H2M = 3 * MiB + 256 * 1024;

constexpr size_t PJ_Q = 0, PJ_K = (size_t)MP * 512, PJ_V = (size_t)MP * 1024, PJ_G = (size_t)MP * 2048, PJ_U = (size_t)MP * 3072, PJ_GA = (size_t)MP * 6144, PJ_GB = (size_t)MP * 7168;
__device__ __forceinline__ size_t pj_q(int h, int m) { return PJ_Q + ((size_t)h * MP + m) * 128; }
__device__ __forceinline__ size_t pj_k(int h, int m) { return PJ_K + ((size_t)h * MP + m) * 128; }
__device__ __forceinline__ size_t pj_v(int h, int m) { return PJ_V + ((size_t)h * MP + m) * 256; }
__device__ __forceinline__ size_t pj_g(int h, int m) { return PJ_G + ((size_t)h * MP + m) * 256; }
__device__ __forceinline__ size_t pj_u(int sec, int m) { return PJ_U + ((size_t)sec * MP + m) * 1024; }
__device__ __forceinline__ size_t pj_ga(int m) { return PJ_GA + (size_t)m * 1024; }
__device__ __forceinline__ size_t pj_gb(int m) { return PJ_GB + (size_t)m * 1024; }
__device__ __forceinline__ size_t pj_col(int m, int col) {
    if (col < 512) return pj_q(col >> 7, m) + (col & 127);
    if (col < 1024) return pj_k((col - 512) >> 7, m) + (col & 127);
    if (col < 2048) return pj_v((col - 1024) >> 8, m) + (col & 255);
    if (col < 3072) return pj_g((col - 2048) >> 8, m) + (col & 255);
    if (col < 6144) return pj_u((col - 3072) >> 10, m) + ((col - 3072) & 1023);
    if (col < 7168) return pj_ga(m) + (col - 6144);
    return pj_gb(m) + (col - 7168);
}
__device__ __forceinline__ int row_of(int b, int t) { return t < NMETA ? MX + b * NMETA + t : b * SEQ + (t - NMETA); }
__device__ __forceinline__ void bt_of(int m, int& b, int& t) { if (m < MX) { b = m >> 13; t = (m & 8191) + NMETA; } else { b = (m - MX) >> 4; t = (m - MX) & 15; } }


__device__ __forceinline__ float block_sum256(float v, float* red) {
    for (int o = 32; o > 0; o >>= 1) v += __shfl_xor(v, o);
    const int w = tidf() >> 6;
    __syncthreads();
    if ((tidf() & 63) == 0) red[w] = v;
    __syncthreads();
    return red[0] + red[1] + red[2] + red[3];
}


struct EpiArgs {
    bf16_t* PROJ; const float* ROPE;
    bf16_t* TMP; bf16_t* MIXED;
    const float* x; const float* meta; bf16_t* H2;
    bf16_t* HID; bf16_t* YE; const float* GATEV;
};
typedef float f32x4 __attribute__((ext_vector_type(4)));
typedef float f32x16 __attribute__((ext_vector_type(16)));
typedef unsigned u32x4 __attribute__((ext_vector_type(4)));
typedef unsigned u32x2 __attribute__((ext_vector_type(2)));
typedef short bf16x8 __attribute__((ext_vector_type(8)));
typedef float f32x2_t __attribute__((ext_vector_type(2))); typedef __bf16 bf16x2_t __attribute__((ext_vector_type(2)));
__device__ __forceinline__ unsigned pk2(float lo, float hi) { const f32x2_t v = {lo, hi}; const bf16x2_t b = __builtin_convertvector(v, bf16x2_t); return __builtin_bit_cast(unsigned, b); }
__device__ __forceinline__ float lo16(unsigned w) { return __uint_as_float(w << 16); }
__device__ __forceinline__ float hi16(unsigned w) { return __uint_as_float(w & 0xffff0000u); }
__device__ __forceinline__ float sigm(float x) { return __builtin_amdgcn_rcpf(1.f + __expf(-x)); }
__device__ __forceinline__ u32x4 pack8(f32x4 a, f32x4 b) { u32x4 w; w.x = pk2(a.x, a.y); w.y = pk2(a.z, a.w); w.z = pk2(b.x, b.y); w.w = pk2(b.z, b.w); return w; }
__device__ __forceinline__ unsigned pk4_fp8(float a, float b, float c, float d) {
    a = __builtin_amdgcn_fmed3f(a, -448.f, 448.f); b = __builtin_amdgcn_fmed3f(b, -448.f, 448.f); c = __builtin_amdgcn_fmed3f(c, -448.f, 448.f); d = __builtin_amdgcn_fmed3f(d, -448.f, 448.f);
    int p = __builtin_amdgcn_cvt_pk_fp8_f32(a, b, 0, false); p = __builtin_amdgcn_cvt_pk_fp8_f32(c, d, p, true); return (unsigned)p;
}
constexpr float F8_WSCALE = 32.f, F8_HSCALE = 4.f;
__device__ __forceinline__ void epi8v(int mode, const EpiArgs& E, int mg, int c0, f32x4 a0, f32x4 a1) {
    if (mode == 1) {
        bf16_t* dst = E.PROJ + pj_col(mg, c0);
        if (c0 < C_V) {
            int b, t; bt_of(mg, b, t);
            const int i0 = ((c0 & 127) >> 3) * 4;
            const float sc = c0 >= C_K ? 0.08838834764831845f : 1.0f;
            const f32x4 cs = *(const f32x4*)(E.ROPE + (size_t)t * 128 + i0), sn = *(const f32x4*)(E.ROPE + (size_t)t * 128 + 64 + i0);
            const f32x4 o1 = (a0 * cs - a1 * sn) * sc, o2 = (a0 * sn + a1 * cs) * sc;
            *(u32x4*)dst = pack8(o1, o2);
        } else if (c0 < C_G || (c0 >= C_U && c0 < C_GA)) { *(u32x4*)dst = pack8(a0, a1); }
        else if (c0 < C_U) { f32x4 s0, s1; for (int j = 0; j < 4; ++j) { s0[j] = a0[j] * sigm(a0[j]); s1[j] = a1[j] * sigm(a1[j]); } *(u32x4*)dst = pack8(s0, s1); }
        else { f32x4 s0, s1; for (int j = 0; j < 4; ++j) { s0[j] = sigm(a0[j]); s1[j] = sigm(a1[j]); } *(u32x4*)dst = pack8(s0, s1); }
    } else if (mode == 2) {
        const u32x4 g = *(const u32x4*)(E.PROJ + pj_ga(mg) + c0);
        *(u32x4*)(E.TMP + (size_t)mg * DM + c0) = pack8((f32x4){lo16(g.x) * a0.x, hi16(g.x) * a0.y, lo16(g.y) * a0.z, hi16(g.y) * a0.w}, (f32x4){lo16(g.z) * a1.x, hi16(g.z) * a1.y, lo16(g.w) * a1.z, hi16(g.w) * a1.w});
    } else if (mode == 3) {
        const u32x4 g = *(const u32x4*)(E.PROJ + pj_gb(mg) + c0);
        const u32x4 t = *(const u32x4*)(E.TMP + (size_t)mg * DM + c0);
        const f32x4 o0 = (f32x4){lo16(t.x), hi16(t.x), lo16(t.y), hi16(t.y)} + (f32x4){lo16(g.x) * a0.x, hi16(g.x) * a0.y, lo16(g.y) * a0.z, hi16(g.y) * a0.w};
        const f32x4 o1 = (f32x4){lo16(t.z), hi16(t.z), lo16(t.w), hi16(t.w)} + (f32x4){lo16(g.z) * a1.x, hi16(g.z) * a1.y, lo16(g.w) * a1.z, hi16(g.w) * a1.w};
        *(u32x4*)(E.MIXED + (size_t)mg * DM + c0) = pack8(o0, o1);
    } else if (mode == 4) {
        const float* rs = mg < MX ? E.x + (size_t)mg * DM + c0 : E.meta + (size_t)((mg - MX) & 15) * DM + c0;
        *(u32x4*)(E.H2 + (size_t)mg * DM + c0) = pack8(*(const f32x4*)rs + a0, *(const f32x4*)(rs + 4) + a1);
    } else if (mode == 5) {
        const f32x4 g = a0 * (1.f / F8_WSCALE), u = a1 * (F8_HSCALE / F8_WSCALE);
        *(unsigned*)((unsigned char*)E.HID + (size_t)mg * FF + (c0 >> 1)) = pk4_fp8(g.x * sigm(g.x) * u.x, g.y * sigm(g.y) * u.y, g.z * sigm(g.z) * u.z, g.w * sigm(g.w) * u.w);
    } else {
        int e, ml; if (mg < NE * EM) { e = mg >> 11; ml = mg & (EM - 1); } else { e = (mg - NE * EM) >> 2; ml = EM + ((mg - NE * EM) & 3); }
        const float gt = (ml < 2 * CAP ? E.GATEV[((size_t)(ml / CAP) * NE + e) * CAP + (ml % CAP)] : 0.f) * (1.f / (F8_WSCALE * F8_HSCALE));
        *(u32x4*)(E.YE + (size_t)mg * DM + c0) = pack8(a0 * gt, a1 * gt);
    }
}


namespace pg8 {
#define PG8_LAS __attribute__((address_space(3)))
typedef unsigned short bf16_t;
typedef short bf16x8 __attribute__((ext_vector_type(8)));
typedef float f32x4 __attribute__((ext_vector_type(4)));
typedef unsigned u32x4 __attribute__((ext_vector_type(4)));
constexpr int BM = 256, BK = 64, HALF = 128, HTB = HALF * BK * 2  , STAGE_BYTES = 8 * HTB, NXCD = 8, WGM = 8;

__host__ __device__ __forceinline__ int lds_byte(int r, int c) { const int st = (r >> 4) * 2 + (c >> 5), rr = r & 15, cc = c & 31, ob = rr * 64 + cc * 2; return st * 1024 + (ob ^ (((ob >> 9) & 1) << 5)); }
__host__ __device__ __forceinline__ void stage_rc(int b, int& R, int& C) { const int st = b / 1024, sb = b % 1024, swz = sb ^ (((sb >> 9) & 1) << 5); R = (st >> 1) * 16 + swz / 64; C = (st & 1) * 32 + (swz % 64) / 2; }
__host__ __device__ __forceinline__ int perm32(int rho) { const int n = rho >> 4, i = rho & 15; return 8 * (i >> 2) + 4 * n + (i & 3); }

struct Unit { int pm, pn; };
struct Gemm { const bf16_t* A; const bf16_t* Bt; int M, N, K; int gt; size_t gstride; };

struct StaticOrder {
    int nM, nN, nwg, G, c;
    __host__ __device__ void init(int M, int N, int G_, int c_) { nM = M / BM; nN = N / BM; nwg = nM * nN; G = G_; c = c_; }
    __host__ __device__ bool next(int i, Unit& u) const {
        const long L = (long)i * G + c; if (L >= nwg) return false;
        int wgid = (int)L; { const int q = nwg / NXCD, r = nwg % NXCD, xcd = wgid % NXCD, off = wgid / NXCD; wgid = (xcd < r ? xcd * (q + 1) : r * (q + 1) + (xcd - r) * q) + off; }
        const int nig = WGM * nN, gid = wgid / nig, fm = gid * WGM, gsz = (nM - fm) < WGM ? (nM - fm) : WGM;
        u.pm = fm + ((wgid % nig) % gsz); u.pn = (wgid % nig) / gsz; return true;
    }
    __device__ __forceinline__ void a_ready(const Unit&) const {}
    __device__ __forceinline__ void done(const Unit&) const {}
};

__device__ __forceinline__ unsigned cvt_pk_bf16(float lo, float hi) { unsigned r; asm volatile("v_cvt_pk_bf16_f32 %0, %1, %2" : "=v"(r) : "v"(lo), "v"(hi)); return r; }
typedef int i32x8 __attribute__((ext_vector_type(8)));
typedef int i32x4v __attribute__((ext_vector_type(4)));
template <class Epi, class Sched, bool ALIGN_EPI = false, bool SP2 = false, bool FP8 = false, bool IND = false>
__device__ __forceinline__ void gemm_phase(PG8_LAS unsigned char* lds, const Gemm g, const Sched& S, const Epi& E, const PG8_LAS unsigned* rtab = nullptr) {
    static_assert(!IND || SP2, "indirect rows are wired into the SP2 loop only");
    const int tid = tidf(), wid = __builtin_amdgcn_readfirstlane(tid >> 6), lane = tid & 63, wr = wid >> 2, wc = wid & 3, fr = lane & 15, fq = lane >> 4;
    const int K = g.K, nt = K / BK;
    unsigned voffA[2], voffB[2]; int rowA[2]; unsigned colA2[2];
    unsigned vA[2][2], vN[2][2], vS[2][2];
#pragma unroll
    for (int i = 0; i < 2; ++i) { int R, C; stage_rc(tid * 16 + i * 8192, R, C); const int Rb = Epi::PERM ? ((R & ~31) + perm32(R & 31)) : R;
        voffA[i] = (unsigned)(R * K + C) * 2u; voffB[i] = (unsigned)(Rb * K + C) * 2u; rowA[i] = R; colA2[i] = (unsigned)C * 2u; }
    const size_t kstep = (size_t)(BK * 2);
    const size_t hstep = (size_t)HALF * K * 2;
    const size_t tstep = 2 * hstep;
    const unsigned ldsw = (unsigned)wid * 1024u;
    const int aoff = lds_byte(wr * 64 + fr, fq * 8), boff = lds_byte(wc * 32 + fr, fq * 8);
#define PG8_SA(b, h) (((b) * 2 + (h)) * HTB)
#define PG8_SB(b, h) ((4 + (b) * 2 + (h)) * HTB)
#define PG8_RTAB(dst, ui_) do { _Pragma("unroll") for (int h_ = 0; h_ < 2; ++h_) _Pragma("unroll") for (int i_ = 0; i_ < 2; ++i_) dst[h_][i_] = rtab[(ui_) * 256 + 128 * h_ + rowA[i_]] + colA2[i_]; } while (0)
#define PG8_STAGE_A(bufoff, gbase, h, V) do { if constexpr (IND) { _Pragma("unroll") for (int _i = 0; _i < 2; ++_i) \
        __builtin_amdgcn_global_load_lds((const unsigned*)((const char*)(gbase) + V[h][_i]), (PG8_LAS unsigned*)(lds + (bufoff) + ldsw + _i * 8192), 16, 0, 0); } \
    else { PG8_STAGE(bufoff, (const char*)(gbase) + (h) * hstep, voffA); } } while (0)
#define PG8_STAGE(bufoff, gbase, voff) do { _Pragma("unroll") for (int _i = 0; _i < 2; ++_i) \
        __builtin_amdgcn_global_load_lds((const unsigned*)((const char*)(gbase) + (voff)[_i]), (PG8_LAS unsigned*)(lds + (bufoff) + ldsw + _i * 8192), 16, 0, 0); } while (0)
#define PG8_LDA(dst, b, h) do { _Pragma("unroll") for (int m = 0; m < 4; ++m) _Pragma("unroll") for (int k = 0; k < 2; ++k) dst[m][k] = *(const PG8_LAS bf16x8*)(lds + PG8_SA(b, h) + aoff + m * 2048 + k * 1024); } while (0)
#define PG8_LDB(dst, b, h) do { _Pragma("unroll") for (int n = 0; n < 2; ++n) _Pragma("unroll") for (int k = 0; k < 2; ++k) dst[n][k] = *(const PG8_LAS bf16x8*)(lds + PG8_SB(b, h) + boff + n * 2048 + k * 1024); } while (0)
#define PG8_CAT(X) __builtin_shufflevector(__builtin_bit_cast(i32x4v, X[0]), __builtin_bit_cast(i32x4v, X[1]), 0, 1, 2, 3, 4, 5, 6, 7)
#define PG8_MMA(ai, bj, At, Bt) do { __builtin_amdgcn_s_setprio(1); if constexpr (FP8) {   \
        _Pragma("unroll") for (int m = 0; m < 4; ++m) _Pragma("unroll") for (int n = 0; n < 2; ++n) \
            { const i32x8 b8_ = PG8_CAT(Bt[n]), a8_ = PG8_CAT(At[m]);   \
              asm volatile("v_mfma_scale_f32_16x16x128_f8f6f4 %0, %1, %2, %0, %3, %3 op_sel_hi:[0,0,0]" : "+v"(acc[ai][bj][m][n]) : "v"(b8_), "v"(a8_), "v"(f8scale)); } \
    } else { _Pragma("unroll") for (int m = 0; m < 4; ++m) _Pragma("unroll") for (int n = 0; n < 2; ++n) _Pragma("unroll") for (int k = 0; k < 2; ++k) \
        acc[ai][bj][m][n] = __builtin_amdgcn_mfma_f32_16x16x32_bf16(Bt[n][k], At[m][k], acc[ai][bj][m][n], 0, 0, 0); } __builtin_amdgcn_s_setprio(0); } while (0)
#define PG8_WAIT_V(n) asm volatile("s_waitcnt vmcnt(" #n ")" ::: "memory")
#define PG8_WAIT_L(n) asm volatile("s_waitcnt lgkmcnt(" #n ")" ::: "memory")
#define PG8_BAR __builtin_amdgcn_s_barrier()
#define PG8_SCHED __builtin_amdgcn_sched_barrier(0)
    Unit cur, nxt; int ui = 0;
    if (!S.next(0, cur)) return;
    const int f8scale = 0x7f7f7f7f;
    f32x4 acc[2][2][4][2];
#pragma unroll
    for (int a = 0; a < 2; ++a)
#pragma unroll
        for (int b = 0; b < 2; ++b)
#pragma unroll
            for (int m = 0; m < 4; ++m)
#pragma unroll
                for (int n = 0; n < 2; ++n) acc[a][b][m][n] = (f32x4){0.f, 0.f, 0.f, 0.f};
    bf16x8 At[4][2], B0[2][2], B1[2][2];
    const char* cA = (const char*)g.A + (IND ? (size_t)0 : (size_t)cur.pm * tstep); const char* cB = (const char*)g.Bt + (size_t)(cur.pm / g.gt) * g.gstride + (size_t)cur.pn * tstep;
    S.a_ready(cur);
    if constexpr (SP2) {
        if constexpr (IND) { PG8_RTAB(vA, 0); asm volatile("s_waitcnt lgkmcnt(0)" ::: "memory"); }
        PG8_STAGE(PG8_SB(0, 0), cB, voffB); PG8_STAGE(PG8_SB(0, 1), cB + hstep, voffB); PG8_STAGE_A(PG8_SA(0, 0), cA, 0, vA); PG8_STAGE_A(PG8_SA(0, 1), cA, 1, vA);
        if (wr == 1) PG8_BAR;
        PG8_WAIT_V(2); PG8_BAR;
        PG8_STAGE(PG8_SB(1, 0), cB + kstep, voffB); PG8_STAGE_A(PG8_SA(1, 0), cA + kstep, 0, vA); PG8_STAGE(PG8_SB(1, 1), cB + hstep + kstep, voffB);
        PG8_WAIT_V(6); PG8_BAR;
    } else {
        PG8_STAGE(PG8_SB(0, 0), cB, voffB); PG8_STAGE(PG8_SA(0, 0), cA, voffA); PG8_STAGE(PG8_SB(0, 1), cB + hstep, voffB); PG8_STAGE(PG8_SA(0, 1), cA + hstep, voffA);
        if (wr == 1) PG8_BAR;
        PG8_WAIT_V(4); PG8_BAR;
        PG8_STAGE(PG8_SB(1, 0), cB + kstep, voffB); PG8_STAGE(PG8_SA(1, 0), cA + kstep, voffA); PG8_STAGE(PG8_SB(1, 1), cB + hstep + kstep, voffB);
        PG8_WAIT_V(6); PG8_BAR;
    }
    for (;;) {
        const bool has_next = S.next(ui + 1, nxt);
        const char* nA = has_next ? (const char*)g.A + (IND ? (size_t)0 : (size_t)nxt.pm * tstep) : cA; const char* nB = has_next ? (const char*)g.Bt + (size_t)(nxt.pm / g.gt) * g.gstride + (size_t)nxt.pn * tstep : cB;
        for (int t = 0; t < nt; t += 2) {
            const bool last = (t == nt - 2);
            const char* a1 = cA + (size_t)(t + 1) * kstep;
            const char* a2 = last ? nA : cA + (size_t)(t + 2) * kstep; const char* b2 = last ? nB : cB + (size_t)(t + 2) * kstep;
            const char* a3 = a2 + kstep; const char* b3 = b2 + kstep;
            if (last && has_next) S.a_ready(nxt);
            if constexpr (IND) { if (last && has_next) PG8_RTAB(vN, ui + 1);
                _Pragma("unroll") for (int h_ = 0; h_ < 2; ++h_) _Pragma("unroll") for (int i_ = 0; i_ < 2; ++i_) vS[h_][i_] = (last && has_next) ? vN[h_][i_] : vA[h_][i_]; }
            if constexpr (SP2) {
            PG8_LDB(B0, 0, 0); PG8_LDB(B1, 0, 1); PG8_SCHED; PG8_LDA(At, 0, 0); PG8_STAGE_A(PG8_SA(1, 1), a1, 1, vA);
            PG8_WAIT_V(8); PG8_WAIT_L(0); PG8_BAR; PG8_MMA(0, 0, At, B0); PG8_MMA(0, 1, At, B1); PG8_BAR; PG8_SCHED;
            PG8_LDA(At, 0, 1); PG8_STAGE(PG8_SB(0, 0), b2, voffB); PG8_STAGE(PG8_SB(0, 1), b2 + hstep, voffB); PG8_STAGE_A(PG8_SA(0, 0), a2, 0, vS);
            PG8_WAIT_V(8); PG8_WAIT_L(0); PG8_BAR; PG8_MMA(1, 0, At, B0); PG8_MMA(1, 1, At, B1); PG8_BAR; PG8_SCHED;
            PG8_LDB(B0, 1, 0); PG8_LDB(B1, 1, 1); PG8_SCHED; PG8_LDA(At, 1, 0); PG8_STAGE_A(PG8_SA(0, 1), a2, 1, vS);
            PG8_WAIT_V(8); PG8_WAIT_L(0); PG8_BAR; PG8_MMA(0, 0, At, B0); PG8_MMA(0, 1, At, B1); PG8_BAR; PG8_SCHED;
            PG8_LDA(At, 1, 1); PG8_STAGE(PG8_SB(1, 0), b3, voffB); PG8_STAGE(PG8_SB(1, 1), b3 + hstep, voffB); PG8_STAGE_A(PG8_SA(1, 0), a3, 0, vS);
            PG8_WAIT_V(8); PG8_WAIT_L(0); PG8_BAR; PG8_MMA(1, 0, At, B0); PG8_MMA(1, 1, At, B1); PG8_BAR; PG8_SCHED;
            } else {
            PG8_LDB(B0, 0, 0); PG8_SCHED; PG8_LDA(At, 0, 0); PG8_STAGE(PG8_SA(1, 1), a1 + hstep, voffA);
            PG8_WAIT_L(8); PG8_BAR; PG8_WAIT_L(0); PG8_MMA(0, 0, At, B0); PG8_BAR; PG8_SCHED;
            PG8_LDB(B1, 0, 1); PG8_STAGE(PG8_SB(0, 0), b2, voffB);
            PG8_BAR; PG8_WAIT_L(0); PG8_MMA(0, 1, At, B1); PG8_BAR;
            PG8_LDA(At, 0, 1); PG8_STAGE(PG8_SA(0, 0), a2, voffA);
            PG8_BAR; PG8_WAIT_L(0); PG8_MMA(1, 0, At, B0); PG8_BAR; PG8_SCHED;
            PG8_STAGE(PG8_SB(0, 1), b2 + hstep, voffB);
            PG8_WAIT_V(6); PG8_BAR; PG8_MMA(1, 1, At, B1); PG8_BAR;
            PG8_LDB(B0, 1, 0); PG8_SCHED; PG8_LDA(At, 1, 0); PG8_STAGE(PG8_SA(0, 1), a2 + hstep, voffA);
            PG8_WAIT_L(8); PG8_BAR; PG8_WAIT_L(0); PG8_MMA(0, 0, At, B0); PG8_BAR; PG8_SCHED;
            PG8_LDB(B1, 1, 1); PG8_STAGE(PG8_SB(1, 0), b3, voffB);
            PG8_BAR; PG8_WAIT_L(0); PG8_MMA(0, 1, At, B1); PG8_BAR;
            PG8_LDA(At, 1, 1); PG8_STAGE(PG8_SA(1, 0), a3, voffA);
            PG8_BAR; PG8_WAIT_L(0); PG8_MMA(1, 0, At, B0); PG8_BAR; PG8_SCHED;
            PG8_STAGE(PG8_SB(1, 1), b3 + hstep, voffB);
            PG8_WAIT_V(6); PG8_BAR; PG8_MMA(1, 1, At, B1); PG8_BAR;
            }
        }
        if constexpr (FP8) asm volatile("s_nop 15\n\ts_nop 15" ::: "memory");
        if constexpr (ALIGN_EPI) { if (wr == 0) PG8_BAR; }
        if constexpr (!Epi::AFTER_DRAIN) { E(acc, cur, wr, wc, fr, fq); S.done(cur); }
        if (!has_next) break;
#pragma unroll
        for (int a = 0; a < 2; ++a)
#pragma unroll
            for (int b = 0; b < 2; ++b)
#pragma unroll
                for (int m = 0; m < 4; ++m)
#pragma unroll
                    for (int n = 0; n < 2; ++n) acc[a][b][m][n] = (f32x4){0.f, 0.f, 0.f, 0.f};
        cur = nxt; cA = nA; cB = nB; ++ui;
        if constexpr (IND) { _Pragma("unroll") for (int h_ = 0; h_ < 2; ++h_) _Pragma("unroll") for (int i_ = 0; i_ < 2; ++i_) vA[h_][i_] = vN[h_][i_]; }
        if constexpr (ALIGN_EPI) { if (wr == 1) PG8_BAR; }
    }
    PG8_WAIT_V(0);
    if constexpr (!ALIGN_EPI) { if (wr == 0) PG8_BAR; }
    PG8_BAR;
    if constexpr (Epi::AFTER_DRAIN) { E.fused(acc, cur, wr, wc, fr, fq, lds, wid, lane); S.done(cur); }
#undef PG8_SA
#undef PG8_SB
#undef PG8_STAGE
#undef PG8_STAGE_A
#undef PG8_RTAB
#undef PG8_LDA
#undef PG8_LDB
#undef PG8_MMA
#undef PG8_CAT
#undef PG8_WAIT_V
#undef PG8_WAIT_L
#undef PG8_BAR
#undef PG8_SCHED
}
}

#define LAS __attribute__((address_space(3)))
template <int MODE> struct EpiFast {
    static constexpr bool PERM = true, AFTER_DRAIN = false;
    EpiArgs E;
    __device__ __forceinline__ void operator()(const pg8::f32x4 (&acc)[2][2][4][2], const pg8::Unit& u, int wr, int wc, int fr, int fq) const {
        const int row0 = u.pm * 256 + wr * 64 + fr, col0 = u.pn * 256 + wc * 32 + 8 * fq;
        if constexpr (MODE == 2 || MODE == 3 || MODE == 4) {
#pragma unroll
            for (int ai = 0; ai < 2; ++ai) {
                u32x4 g[4][2], t[4][2]; f32x4 x0[4][2], x1[4][2];
#pragma unroll
                for (int m = 0; m < 4; ++m)
#pragma unroll
                    for (int bj = 0; bj < 2; ++bj) { const int mg = row0 + ai * 128 + m * 16, c0 = col0 + bj * 128;
                        if constexpr (MODE == 2) g[m][bj] = *(const u32x4*)(E.PROJ + pj_ga(mg) + c0);
                        if constexpr (MODE == 3) { g[m][bj] = *(const u32x4*)(E.PROJ + pj_gb(mg) + c0); t[m][bj] = *(const u32x4*)(E.TMP + (size_t)mg * DM + c0); }
                        if constexpr (MODE == 4) { const float* rs = E.x + (size_t)mg * DM + c0; x0[m][bj] = *(const f32x4*)rs; x1[m][bj] = *(const f32x4*)(rs + 4); } }
#pragma unroll
                for (int m = 0; m < 4; ++m)
#pragma unroll
                    for (int bj = 0; bj < 2; ++bj) { const int mg = row0 + ai * 128 + m * 16, c0 = col0 + bj * 128; const f32x4 a0 = acc[ai][bj][m][0], a1 = acc[ai][bj][m][1];
                        if constexpr (MODE == 4) { *(u32x4*)(E.H2 + (size_t)mg * DM + c0) = pack8(x0[m][bj] + a0, x1[m][bj] + a1); }
                        else { const u32x4 gg = g[m][bj];
                            const f32x4 p0 = (f32x4){lo16(gg.x) * a0.x, hi16(gg.x) * a0.y, lo16(gg.y) * a0.z, hi16(gg.y) * a0.w}, p1 = (f32x4){lo16(gg.z) * a1.x, hi16(gg.z) * a1.y, lo16(gg.w) * a1.z, hi16(gg.w) * a1.w};
                            if constexpr (MODE == 2) *(u32x4*)(E.TMP + (size_t)mg * DM + c0) = pack8(p0, p1);
                            else { const u32x4 tt = t[m][bj]; *(u32x4*)(E.MIXED + (size_t)mg * DM + c0) = pack8((f32x4){lo16(tt.x), hi16(tt.x), lo16(tt.y), hi16(tt.y)} + p0, (f32x4){lo16(tt.z), hi16(tt.z), lo16(tt.w), hi16(tt.w)} + p1); } } }
            }
        } else {
#pragma unroll
        for (int ai = 0; ai < 2; ++ai)
#pragma unroll
            for (int m = 0; m < 4; ++m)
#pragma unroll
                for (int bj = 0; bj < 2; ++bj) epi8v(MODE, E, row0 + ai * 128 + m * 16, col0 + bj * 128, acc[ai][bj][m][0], acc[ai][bj][m][1]);
        }
    }
};
__device__ __forceinline__ void side_tile(int mode, const EpiArgs& E, const bf16_t* __restrict__ A, int erow0, const bf16_t* __restrict__ Bt, int K, int n0, LAS unsigned char* lds) {
    const int tid = tidf(), l = tid & 63, wid = tid >> 6, i = l & 31, h = l >> 5;
    const int g = i >> 3, hh = (i >> 2) & 1, q = i & 3, L = 8 * (2 * hh + (g >> 1)) + 4 * (g & 1) + q;
    const int kw = K / 8;
    const bf16_t* wp = Bt + (size_t)(n0 + L) * K + wid * kw + 8 * h;
    const bf16_t* xp = A + (size_t)i * K + wid * kw + 8 * h;
    f32x16 acc; for (int r = 0; r < 16; ++r) acc[r] = 0.f;
#pragma unroll 8
    for (int k0 = 0; k0 < kw; k0 += 16) { const bf16x8 wf = *(const bf16x8*)(wp + k0), xf = *(const bf16x8*)(xp + k0); acc = __builtin_amdgcn_mfma_f32_32x32x16_bf16(wf, xf, acc, 0, 0, 0); }
    LAS float* red = (LAS float*)lds;
    __syncthreads();
#pragma unroll
    for (int r = 0; r < 16; ++r) red[(wid * 16 + r) * 64 + l] = acc[r];
    __syncthreads();
    if (wid == 0) {
#pragma unroll
        for (int r = 0; r < 16; ++r) { float s = 0.f;
#pragma unroll
            for (int w = 0; w < 8; ++w) s += red[(w * 16 + r) * 64 + l];
            acc[r] = s; }
        epi8v(mode, E, erow0 + i, n0 + 16 * h, (f32x4){acc[0], acc[1], acc[2], acc[3]}, (f32x4){acc[4], acc[5], acc[6], acc[7]});
        epi8v(mode, E, erow0 + i, n0 + 16 * h + 8, (f32x4){acc[8], acc[9], acc[10], acc[11]}, (f32x4){acc[12], acc[13], acc[14], acc[15]});
    }
}
__device__ __forceinline__ void side_tile8(int mode, const EpiArgs& E, int e, const unsigned char* __restrict__ X, const int* __restrict__ idx, const unsigned char* __restrict__ Wt, int K, int n0) {
    typedef int i32x8s __attribute__((ext_vector_type(8)));
    const int l = tidf() & 63, i = l & 31, h = l >> 5;
    const int g = i >> 3, hh = (i >> 2) & 1, q = i & 3, L = 8 * (2 * hh + (g >> 1)) + 4 * (g & 1) + q;
    const unsigned char* wp = Wt + (size_t)(n0 + L) * K + 32 * h;
    const bool xv = i < EL;
    const unsigned char* xp;
    if (mode == 5) { const int ml = EM + (xv ? i : 0), b = ml / CAP; xp = X + (size_t)row_of(b, idx[((size_t)b * NE + e) * CAP + (ml - b * CAP)]) * K + 32 * h; }
    else xp = X + (size_t)(NE * EM + e * EL + (xv ? i : 0)) * K + 32 * h;
    f32x16 acc; for (int r = 0; r < 16; ++r) acc[r] = 0.f;
#pragma unroll 4
    for (int k0 = 0; k0 < K; k0 += 64) {
        const u32x4 w0 = *(const u32x4*)(wp + k0), w1 = *(const u32x4*)(wp + k0 + 16); u32x4 x0 = *(const u32x4*)(xp + k0), x1 = *(const u32x4*)(xp + k0 + 16);
        if (!xv) { x0 = (u32x4){0u, 0u, 0u, 0u}; x1 = x0; }
        const i32x8s wf = {(int)w0.x, (int)w0.y, (int)w0.z, (int)w0.w, (int)w1.x, (int)w1.y, (int)w1.z, (int)w1.w}, xf = {(int)x0.x, (int)x0.y, (int)x0.z, (int)x0.w, (int)x1.x, (int)x1.y, (int)x1.z, (int)x1.w};
        acc = __builtin_amdgcn_mfma_scale_f32_32x32x64_f8f6f4(wf, xf, acc, 0, 0, 0, 0x7f7f7f7f, 0, 0x7f7f7f7f);
    }
    if (xv) {
        const int mg = NE * EM + e * EL + i;
        epi8v(mode, E, mg, n0 + 16 * h, (f32x4){acc[0], acc[1], acc[2], acc[3]}, (f32x4){acc[4], acc[5], acc[6], acc[7]});
        epi8v(mode, E, mg, n0 + 16 * h + 8, (f32x4){acc[8], acc[9], acc[10], acc[11]}, (f32x4){acc[12], acc[13], acc[14], acc[15]});
    }
}
struct GemmArgs { const bf16_t* A; const bf16_t* Bt; int M, N, K, gt; size_t gstride; int side; int pad; const int* idx; };
#ifndef PG8_ALIGN
#define PG8_ALIGN true
#endif
constexpr int GEMM_LDS = 131072 + 1024;
template <int MODE> __device__ __forceinline__ void gemm_fast_body(LAS unsigned char* lds, const GemmArgs& ga, const EpiArgs& E) {
    if (ga.side) {
        const int nt = ga.N / 32;
        for (int t = blockIdx.x; t < nt; t += gridDim.x) side_tile(MODE, E, ga.A + (size_t)MX * ga.K, MX, ga.Bt, ga.K, t * 32, lds);
        asm volatile("s_waitcnt vmcnt(0)" ::: "memory");
        __syncthreads();
    }
    pg8::Gemm g{ga.A, ga.Bt, ga.M, ga.N, ga.K, ga.gt, ga.gstride};
    pg8::StaticOrder S; S.init(ga.M, ga.N, (int)gridDim.x, (int)blockIdx.x);
    EpiFast<MODE> Ep{E};
    if constexpr (MODE == 5 || MODE == 6) {
        const int nct = ga.N / 32, gw = (tidf() >> 6) * gridDim.x + blockIdx.x;
        for (int t = gw; t < NE * nct; t += 8 * gridDim.x) { const int e = t / nct, ct = t - e * nct;
            side_tile8(MODE, E, e, (const unsigned char*)ga.A, ga.idx, (const unsigned char*)ga.Bt + (size_t)e * ga.gstride, ga.K * 2, ct * 32); }
        asm volatile("s_waitcnt vmcnt(0)" ::: "memory");
    }
    if constexpr (MODE == 5) {
        LAS unsigned* rtab = (LAS unsigned*)(lds + pg8::STAGE_BYTES);
        const int tid = tidf();
        for (int i = 0; i < 12; ++i) { pg8::Unit u; if (!S.next(i, u)) break;
            if (tid < 256) { const int e = u.pm / (EM / 256), ml = (u.pm % (EM / 256)) * 256 + tid; int row = MROWS;
                if (ml < 2 * CAP) { const int b = ml / CAP; row = row_of(b, ga.idx[((size_t)b * NE + e) * CAP + (ml - b * CAP)]); }
                rtab[i * 256 + tid] = (unsigned)row * (unsigned)DM; } }
        __syncthreads();
        pg8::gemm_phase<EpiFast<MODE>, pg8::StaticOrder, PG8_ALIGN, true, true, true>(lds, g, S, Ep, rtab);
    } else
    pg8::gemm_phase<EpiFast<MODE>, pg8::StaticOrder, PG8_ALIGN, true, (MODE >= 5)>(lds, g, S, Ep);
}

__device__ __forceinline__ float log_sigmoid(float x) { return -log1pf(expf(-x)); }
__device__ __forceinline__ int chunk_row(int b, int n, int c) { return n == 0 ? (c >= 112 ? MX + b * 16 + (c - 112) : -1) : b * SEQ + 128 * (n - 1) + c; }


constexpr int QS_STRIDE = 130;
constexpr int R2_LDS = 2 * 128 * QS_STRIDE * 2 + 128 * 128 * 4 + 64 * 4;


constexpr int CV_GR_BYTES = GL * 2;
constexpr int CV_ZROW = 272, CV_ZB = 18176  , CV_Z_BYTES = 2 * CV_ZB;
constexpr int CV_SLOT = CV_GR_BYTES + CV_Z_BYTES;
constexpr int CV_LDS = 2 * CV_SLOT;
__device__ __forceinline__ bf16x8 cv_load_frag(const LAS unsigned char* p, unsigned sh) {
    unsigned X[5];
#pragma unroll
    for (int i = 0; i < 5; ++i) X[i] = *(const LAS unsigned*)(p + 4 * i);
    u32x4 o;
    o.x = __builtin_amdgcn_alignbit(X[1], X[0], sh); o.y = __builtin_amdgcn_alignbit(X[2], X[1], sh);
    o.z = __builtin_amdgcn_alignbit(X[3], X[2], sh); o.w = __builtin_amdgcn_alignbit(X[4], X[3], sh);
    return __builtin_bit_cast(bf16x8, o);
}
__device__ __forceinline__ void conv_fast_body(LAS unsigned char* lds, const bf16_t* __restrict__ G, const bf16_t* __restrict__ ZT, bf16_t* __restrict__ YCT, int c_first) {
    const int tid = tidf(), l = tid & 63, wid = tid >> 6, slot = wid >> 2, ct = wid & 3;
    const int ts = tid & 255;
    LAS unsigned char* grb = lds + slot * CV_SLOT;
    LAS unsigned char* zb = grb + CV_GR_BYTES;
    for (int rd = 0; rd < 2; ++rd) {
        const int c = c_first + 2 * rd + slot;
        __syncthreads();
        {
            const u32x4* gsrc = (const u32x4*)(G + (size_t)c * GL);
            {
                u32x4 gv[9];
#pragma unroll
                for (int k = 0; k < 9; ++k) { const int i = ts + 256 * k; gv[k] = i < GL / 8 ? gsrc[i] : (u32x4){0u, 0u, 0u, 0u}; }
#pragma unroll
                for (int k = 0; k < 9; ++k) { const int i = ts + 256 * k;
                    if (i < GL / 8) { const u32x4 v = gv[k]; u32x4 o;
                        o.x = __builtin_amdgcn_alignbit(v.w, v.w, 16); o.y = __builtin_amdgcn_alignbit(v.z, v.z, 16); o.z = __builtin_amdgcn_alignbit(v.y, v.y, 16); o.w = __builtin_amdgcn_alignbit(v.x, v.x, 16);
                        *(LAS u32x4*)(grb + (size_t)(GL - 8 * (i + 1)) * 2) = o; } }
            }
            asm volatile("" ::: "memory");
            {
                u32x4 zv[9];
#pragma unroll
                for (int k = 0; k < 9; ++k) {
                    const int i = ts + 256 * k; zv[k] = (u32x4){0u, 0u, 0u, 0u};
                    if (i < 2 * 66 * 17) { const int bb = i / (66 * 17), rem = i - bb * (66 * 17), Ib = rem / 17, q = rem - Ib * 17;
                        const bf16_t* zr = ZT + ((size_t)bb * 1024 + c) * ZL;
                        if (q < 16) { if (Ib == 0) { if (q >= 14) zv[k] = *(const u32x4*)(zr + 8 * (q - 14)); } else if (Ib <= 64) zv[k] = *(const u32x4*)(zr + 16 + 128 * (Ib - 1) + 8 * q); } }
                }
#pragma unroll
                for (int k = 0; k < 9; ++k) { const int i = ts + 256 * k;
                    if (i < 2 * 66 * 17) { const int bb = i / (66 * 17), rem = i - bb * (66 * 17), Ib = rem / 17, q = rem - Ib * 17; *(LAS u32x4*)(zb + bb * CV_ZB + Ib * CV_ZROW + q * 16) = zv[k]; } }
            }
        }
        __syncthreads();
        const int r = l & 31, h = l >> 5;
        const int Ec = 8431 + 112 - r + 8 * h;
        const unsigned sh = (unsigned)(Ec & 1) * 16u;
        const int Io = 16 * ct + (r & 15), bcol = r >> 4;
        f32x16 acc[4];
#pragma unroll
        for (int rt = 0; rt < 4; ++rt) for (int q = 0; q < 16; ++q) acc[rt][q] = 0.f;
        bf16x8 F[14];
        int d = 16 * ct - 63;
        const LAS unsigned char* abase = grb + 4 * (Ec >> 1) - 256 * d - 32 * 13;
#pragma unroll
        for (int f = 0; f < 6; ++f) F[f] = cv_load_frag(abase + 32 * (13 - f), sh);
        const int dend = 16 * ct + 16;
        for (; d <= dend; ++d) {
#pragma unroll
            for (int f = 6; f < 10; ++f) F[f] = cv_load_frag(abase + 32 * (13 - f), sh);
            __builtin_amdgcn_sched_barrier(0);
#pragma unroll
            for (int f = 10; f < 14; ++f) F[f] = cv_load_frag(abase + 32 * (13 - f), sh);
            int Ib = Io - d + 1; Ib = (Ib < 0 || Ib > 64) ? 65 : Ib;
            const LAS unsigned char* zp = zb + bcol * CV_ZB + Ib * CV_ZROW + 16 * h;
#pragma unroll
            for (int ks = 0; ks < 8; ++ks) {
                const bf16x8 Bf = *(const LAS bf16x8*)(zp + 32 * ks);
#pragma unroll
                for (int rt = 0; rt < 4; ++rt) acc[rt] = __builtin_amdgcn_mfma_f32_32x32x16_bf16(F[2 * rt - ks + 7], Bf, acc[rt], 0, 0, 0);
            }
#pragma unroll
            for (int f = 0; f < 6; ++f) F[f] = F[f + 8];
            abase -= 256;
        }
        {
            bf16_t* yr = YCT + ((size_t)bcol * 1024 + c) * ZL + 16 + 128 * Io + 4 * h;
#pragma unroll
            for (int rt = 0; rt < 4; ++rt)
#pragma unroll
                for (int g = 0; g < 4; ++g) { u32x2 w; w.x = pk2(acc[rt][4 * g], acc[rt][4 * g + 1]); w.y = pk2(acc[rt][4 * g + 2], acc[rt][4 * g + 3]); *(u32x2*)(yr + 32 * rt + 8 * g) = w; }
        }
        {
            float a0[4], a1[4];
#pragma unroll
            for (int q = 0; q < 4; ++q) { a0[q] = 0.f; a1[q] = 0.f; }
            const LAS bf16_t* grh = (const LAS bf16_t*)grb;
            for (int s = l; s < TT; s += 64) {
                int Ib, j; if (s < 16) { Ib = 0; j = 112 + s; } else { const int s2 = s - 16; Ib = 1 + (s2 >> 7); j = s2 & 127; }
                const float z0 = bf2f(*(const LAS bf16_t*)(zb + Ib * CV_ZROW + 2 * j)), z1 = bf2f(*(const LAS bf16_t*)(zb + CV_ZB + Ib * CV_ZROW + 2 * j));
#pragma unroll
                for (int q = 0; q < 4; ++q) { const float gv = bf2f(grh[8431 - (4 * ct + q) + s]); a0[q] += gv * z0; a1[q] += gv * z1; }
            }
#pragma unroll
            for (int q = 0; q < 4; ++q) {
                float v0 = a0[q], v1 = a1[q];
                for (int o = 32; o > 0; o >>= 1) { v0 += __shfl_xor(v0, o); v1 += __shfl_xor(v1, o); }
                if (l == 0) { YCT[((size_t)0 * 1024 + c) * ZL + 4 * ct + q] = f2bf(v0); YCT[((size_t)1 * 1024 + c) * ZL + 4 * ct + q] = f2bf(v1); }
            }
        }
    }
}


struct Ctx {
    const float *x, *meta, *norm1_g, *w_in, *dec_f, *dec_b, *hg, *w_ret, *cw, *cb, *fw1, *fb1, *fw2, *fb2, *fw3, *fb3, *ffq, *fw4, *skip, *w_hy, *w_o, *norm2_g, *w_router, *w_eg, *w_eu, *w_ed, *gfin;
    unsigned char* ws; unsigned char* dob;
};
#define P_WRET ((bf16_t*)(c.ws + WS_WRET))
#define P_WHY ((bf16_t*)(c.ws + WS_WHY))
#define P_WO ((bf16_t*)(c.ws + WS_WO))
#define P_XN ((bf16_t*)(c.ws + WS_XN))
#define P_PROJ ((bf16_t*)(c.ws + WS_PROJ))
#define P_S ((bf16_t*)(c.ws + WS_S))
#define P_TMP ((bf16_t*)(c.ws + WS_S))
#define P_ZT ((bf16_t*)(c.ws + WS_ZT))
#define P_G ((bf16_t*)(c.ws + WS_G))
#define P_AHY ((bf16_t*)(c.ws + WS_G))
#define P_ARET ((bf16_t*)(c.ws + WS_ARET))
#define P_WGU ((bf16_t*)(c.ws + WS_WGU))
#define P_WD ((bf16_t*)(c.ws + WS_WD))
#define P_XE ((bf16_t*)(c.ws + WS_XE))
#define P_YE ((bf16_t*)(c.ws + WS_XE))
#define P_HID ((bf16_t*)(c.ws + WS_HID))
#define P_WIN ((bf16_t*)(c.dob + DO_WIN))
#define P_ROPE ((float*)(c.dob + DO_ROPE))
#define P_YCT ((bf16_t*)(c.dob + DO_YCT))
#define P_AFF ((float*)(c.ws + WS_MISC + MI_AFF))
#define P_IDX ((int*)(c.ws + WS_MISC + MI_IDX))
#define P_GATEV ((float*)(c.ws + WS_MISC + MI_GATE))
#define P_INV ((int*)(c.ws + WS_MISC + MI_INV))
#define P_H2 ((bf16_t*)(c.ws + 112 * MiB))
#define P_OUT ((float*)c.dob)
#define LDSW() asm volatile("s_waitcnt lgkmcnt(0)" ::: "memory")
__device__ __forceinline__ float wave_sum(float v) {
#pragma unroll
    for (int o = 1; o < 64; o <<= 1) v += __shfl_xor(v, o);
    return v;
}
__device__ __forceinline__ EpiArgs make_epi(const Ctx& c) {
    EpiArgs E{}; E.PROJ = P_PROJ; E.ROPE = P_ROPE; E.TMP = P_TMP; E.MIXED = P_XN; E.x = c.x; E.meta = c.meta; E.H2 = P_H2; E.HID = P_HID; E.YE = P_YE; E.GATEV = P_GATEV; return E;
}

__device__ __forceinline__ int wt_dst_row(int mode, int s) {
    if (mode == 1) { if (s >= 1024) return s; const int sl = s & 127; const int i = sl & 63; return (s & ~127) + 8 * (i >> 2) + (sl >= 64 ? 4 : 0) + (i & 3); }
    if (mode == 2) return 8 * (s >> 2) + (s & 3);
    if (mode == 3) return 8 * (s >> 2) + 4 + (s & 3);
    return s;
}
__device__ __forceinline__ void wt_item(const float* __restrict__ W, int K, int N, bf16_t* __restrict__ WT, LAS float* scr, int kb, int nb, int lane, int mode) {
    const int k0 = 64 * kb, n0 = 32 * nb;
#pragma unroll
    for (int i = 0; i < 8; ++i) { const int kk = 8 * i + (lane >> 3); const f32x4 v = *(const f32x4*)(W + (size_t)(k0 + kk) * N + n0 + 4 * (lane & 7));
        LAS float* d = scr + kk * 33 + 4 * (lane & 7); d[0] = v.x; d[1] = v.y; d[2] = v.z; d[3] = v.w; }
    LDSW();
    const int cc = lane & 7;
#pragma unroll
    for (int j = 0; j < 4; ++j) { const int n = (lane >> 3) + 8 * j; const LAS float* s = scr + (8 * cc) * 33 + n;
        u32x4 o; o.x = pk2(s[0 * 33], s[1 * 33]); o.y = pk2(s[2 * 33], s[3 * 33]); o.z = pk2(s[4 * 33], s[5 * 33]); o.w = pk2(s[6 * 33], s[7 * 33]);
        *(u32x4*)(WT + (size_t)wt_dst_row(mode, n0 + n) * K + k0 + 8 * cc) = o; }
    LDSW();
}

__device__ __forceinline__ void wt_item8(const float* __restrict__ W, int K, int N, unsigned char* __restrict__ WT, LAS float* scr, int kb, int nb, int lane, int mode, float scale) {
    const int k0 = 64 * kb, n0 = 32 * nb;
#pragma unroll
    for (int i = 0; i < 8; ++i) { const int kk = 8 * i + (lane >> 3); const f32x4 v = *(const f32x4*)(W + (size_t)(k0 + kk) * N + n0 + 4 * (lane & 7));
        LAS float* d = scr + kk * 33 + 4 * (lane & 7); d[0] = v.x; d[1] = v.y; d[2] = v.z; d[3] = v.w; }
    LDSW();
    const int cc = lane & 7;
#pragma unroll
    for (int j = 0; j < 4; ++j) { const int n = (lane >> 3) + 8 * j; const LAS float* s = scr + (8 * cc) * 33 + n;
        u32x2 o; o.x = pk4_fp8(s[0 * 33] * scale, s[1 * 33] * scale, s[2 * 33] * scale, s[3 * 33] * scale); o.y = pk4_fp8(s[4 * 33] * scale, s[5 * 33] * scale, s[6 * 33] * scale, s[7 * 33] * scale);
        *(u32x2*)(WT + (size_t)wt_dst_row(mode, n0 + n) * K + k0 + 8 * cc) = o; }
    LDSW();
}

constexpr int HDN_ROWS = 8256;
__device__ __forceinline__ void phase_p0(LAS unsigned char* lds, const Ctx& c) {
    const int tid = tidf(), lane = tid & 63, wid = tid >> 6;
    const int nskip = (gridDim.x >= 64 && (HDN_ROWS / 32) > (int)gridDim.x) ? (HDN_ROWS / 32) - (int)gridDim.x : 0;
    const bool skip_ab = (int)blockIdx.x < nskip;
    const int gw = skip_ab ? (1 << 28) : ((int)blockIdx.x - nskip) * 8 + wid, NGW = ((int)gridDim.x - nskip) * 8;
    {
        LAS float* scr = (LAS float*)(lds + wid * 8448);
        constexpr int I_IN = 16 * 256, I_SM = 16 * 32;
        for (int it = gw; it < I_IN + 3 * I_SM; it += NGW) {
            int r = it;
            if (r < I_IN) { wt_item(c.w_in, 1024, 8192, P_WIN, scr, r / 256, r % 256, lane, 1); continue; } r -= I_IN;
            if (r < I_SM) { wt_item(c.w_ret, 1024, 1024, P_WRET, scr, r / 32, r % 32, lane, 0); continue; } r -= I_SM;
            if (r < I_SM) { wt_item(c.w_hy, 1024, 1024, P_WHY, scr, r / 32, r % 32, lane, 0); continue; } r -= I_SM;
            wt_item(c.w_o, 1024, 1024, P_WO, scr, r / 32, r % 32, lane, 0);
        }
    }
    for (int m0 = gw; m0 < MROWS; m0 += 2 * NGW) {
        const int m1 = m0 + NGW; const bool has1 = m1 < MROWS; const int m1c = has1 ? m1 : m0;
        const float* s0 = m0 < MX ? c.x + (size_t)m0 * DM : c.meta + (size_t)((m0 - MX) & 15) * DM;
        const float* s1 = m1c < MX ? c.x + (size_t)m1c * DM : c.meta + (size_t)((m1c - MX) & 15) * DM;
        f32x4 v0[4], v1[4]; float q0 = 0.f, q1 = 0.f;
#pragma unroll
        for (int j = 0; j < 4; ++j) { v0[j] = *(const f32x4*)(s0 + 4 * (lane + 64 * j)); v1[j] = *(const f32x4*)(s1 + 4 * (lane + 64 * j)); }
#pragma unroll
        for (int j = 0; j < 4; ++j) { q0 += (v0[j].x * v0[j].x + v0[j].y * v0[j].y) + (v0[j].z * v0[j].z + v0[j].w * v0[j].w); q1 += (v1[j].x * v1[j].x + v1[j].y * v1[j].y) + (v1[j].z * v1[j].z + v1[j].w * v1[j].w); }
        const float r0 = rsqrtf(wave_sum(q0) * (1.f / DM) + RMS_EPS), r1 = rsqrtf(wave_sum(q1) * (1.f / DM) + RMS_EPS);
#pragma unroll
        for (int j = 0; j < 4; ++j) { const f32x4 g = *(const f32x4*)(c.norm1_g + 4 * (lane + 64 * j));
            u32x2 w; w.x = pk2(v0[j].x * r0 * g.x, v0[j].y * r0 * g.y); w.y = pk2(v0[j].z * r0 * g.z, v0[j].w * r0 * g.w);
            *(u32x2*)(P_XN + (size_t)m0 * DM + 4 * (lane + 64 * j)) = w;
            if (has1) { u32x2 w2; w2.x = pk2(v1[j].x * r1 * g.x, v1[j].y * r1 * g.y); w2.y = pk2(v1[j].z * r1 * g.z, v1[j].w * r1 * g.w); *(u32x2*)(P_XN + (size_t)m1 * DM + 4 * (lane + 64 * j)) = w2; } }
    }
    for (int i = blockIdx.x * 512 + tid; i < TT * 64; i += gridDim.x * 512) {
        const int t = i >> 6, f = i & 63; const float inv = powf(10000.0f, -(float)f / 64.0f); const float ang = (float)t * inv;
        P_ROPE[(size_t)t * 128 + f] = cosf(ang); P_ROPE[(size_t)t * 128 + 64 + f] = sinf(ang);
    }
}
#define P_HDNB ((bf16_t*)(c.dob + DO_HDN))
__device__ __forceinline__ void phase_p0b(LAS unsigned char* lds, const Ctx& c) {
    const int tid = tidf();
    LAS float* feat = (LAS float*)(lds + 69632);
    LAS float* ha = feat + 32 * 34;
    LAS float* hb = ha + 32 * 65;
    LAS float* W1 = (LAS float*)lds;
    LAS float* W2 = W1 + 33 * 64; LAS float* W3 = W2 + 64 * 64;
    __syncthreads();
    for (int i = tid; i < 33 * 16; i += 512) ((LAS f32x4*)W1)[i] = ((const f32x4*)c.fw1)[i];
    for (int i = tid; i < 64 * 16; i += 512) { ((LAS f32x4*)W2)[i] = ((const f32x4*)c.fw2)[i]; ((LAS f32x4*)W3)[i] = ((const f32x4*)c.fw3)[i]; }
    for (int it = blockIdx.x; it < HDN_ROWS / 32; it += gridDim.x) {
        const int p = tid >> 4, q = tid & 15, t = it * 32 + p;
        __syncthreads();
        {
            const float fr = 1e-4f + (float)q * ((15.0f - 1e-4f) / 15.0f);
            const float ang = (2.0f * 3.14159265358979323846f * (float)t / (float)TT) * fr;
            feat[p * 34 + 1 + q] = cosf(ang); feat[p * 34 + 17 + q] = -sinf(ang);
            if (q == 0) feat[p * 34] = (float)t / (float)(TT - 1);
        }
        __syncthreads();
        const int u = q * 4;
        const f32x4 fq = *(const f32x4*)(c.ffq + u);
        {
            f32x4 a = *(const f32x4*)(c.fb1 + u);
#pragma unroll 3
            for (int i = 0; i < 33; ++i) a += feat[p * 34 + i] * *(const LAS f32x4*)(W1 + i * 64 + u);
#pragma unroll
            for (int j = 0; j < 4; ++j) ha[p * 65 + u + j] = sinf(fq[j] * a[j]);
        }
        __syncthreads();
        {
            f32x4 a = *(const f32x4*)(c.fb2 + u);
#pragma unroll 4
            for (int i = 0; i < 64; ++i) a += ha[p * 65 + i] * *(const LAS f32x4*)(W2 + i * 64 + u);
#pragma unroll
            for (int j = 0; j < 4; ++j) hb[p * 65 + u + j] = sinf(fq[j] * a[j]);
        }
        __syncthreads();
        {
            f32x4 a = *(const f32x4*)(c.fb3 + u);
#pragma unroll 4
            for (int i = 0; i < 64; ++i) a += hb[p * 65 + i] * *(const LAS f32x4*)(W3 + i * 64 + u);
            u32x2 w; w.x = pk2(sinf(fq[0] * a[0]), sinf(fq[1] * a[1])); w.y = pk2(sinf(fq[2] * a[2]), sinf(fq[3] * a[3]));
            *(u32x2*)(P_HDNB + (size_t)t * 64 + u) = w;
        }
    }
    for (int ch = blockIdx.x * 512 + tid; ch < 1024; ch += gridDim.x * 512) { bf16_t* grow = P_G + (size_t)ch * GL; grow[0] = 0; for (int i = 2 * TT; i < GL; ++i) grow[i] = 0; }
}
__device__ __forceinline__ void phase_filtout(LAS unsigned char* lds, const Ctx& c) {
    const int tid = tidf(), lane = tid & 63, wid = tid >> 6, r = lane & 31, h = lane >> 5;
    const float mind = logf(1e-2f) / 1.5f, maxd = logf(1e-2f) / 0.3f;
    LAS unsigned char* tl = lds + wid * 2560;
    __syncthreads();
    for (int task = wid * gridDim.x + blockIdx.x; task < 64 * 32; task += 8 * gridDim.x) {
        const int ot = task & 63, chunk = task >> 6, o = 32 * ot + r, ch = o & 1023, bwd = ot >> 5;
        bf16x8 Bw[4];
#pragma unroll
        for (int ks = 0; ks < 4; ++ks) { const float* wp = c.fw4 + (size_t)(16 * ks + 8 * h) * 2048 + o;
            u32x4 bw; bw.x = pk2(wp[0], wp[2048]); bw.y = pk2(wp[2 * 2048], wp[3 * 2048]); bw.z = pk2(wp[4 * 2048], wp[5 * 2048]); bw.w = pk2(wp[6 * 2048], wp[7 * 2048]); Bw[ks] = __builtin_bit_cast(bf16x8, bw); }
        const float ad = fabsf(mind + (float)ch * ((maxd - mind) / 1023.0f)) * (1.0f / (float)(TT - 1));
        const int j1 = (chunk * 9 + 9 < 257) ? chunk * 9 + 9 : 257;
        bf16x8 An[4];
        { const bf16_t* hp = P_HDNB + (size_t)(32 * (chunk * 9) + bwd + r) * 64 + 8 * h;
#pragma unroll
          for (int ks = 0; ks < 4; ++ks) An[ks] = *(const bf16x8*)(hp + 16 * ks); }
        for (int j = chunk * 9; j < j1; ++j) {
            const int t0 = 32 * j + bwd;
            f32x16 acc; for (int z = 0; z < 16; ++z) acc[z] = 0.f;
#pragma unroll
            for (int ks = 0; ks < 4; ++ks) acc = __builtin_amdgcn_mfma_f32_32x32x16_bf16(An[ks], Bw[ks], acc, 0, 0, 0);
            if (j + 1 < j1) { const bf16_t* hp = P_HDNB + (size_t)(t0 + 32 + r) * 64 + 8 * h;
#pragma unroll
                for (int ks = 0; ks < 4; ++ks) An[ks] = *(const bf16x8*)(hp + 16 * ks); }
#pragma unroll
            for (int g = 0; g < 4; ++g) { const int tb = t0 + 8 * g + 4 * h; u32x2 w;
                w.x = pk2(acc[4 * g] * __expf(-(float)tb * ad), acc[4 * g + 1] * __expf(-(float)(tb + 1) * ad)); w.y = pk2(acc[4 * g + 2] * __expf(-(float)(tb + 2) * ad), acc[4 * g + 3] * __expf(-(float)(tb + 3) * ad));
                *(LAS u32x2*)(tl + r * 80 + (8 * g + 4 * h) * 2) = w; }
            LDSW();
#pragma unroll
            for (int k = 0; k < 2; ++k) { const int p = lane + 64 * k, cc = p >> 2, q = p & 3; const int tq = t0 + 8 * q;
                const u32x4 v = *(const LAS u32x4*)(tl + cc * 80 + 16 * q);
                bf16_t* grow = P_G + (size_t)(32 * (ot & 31) + cc) * GL;
                if (!bwd) { if (tq + 7 < TT) *(u32x4*)(grow + TT + tq) = v; else { for (int z = 0; z < 8; ++z) if (tq + z < TT) grow[TT + tq + z] = ((const LAS bf16_t*)(tl + cc * 80 + 16 * q))[z]; } }
                else { u32x4 rv; rv.x = __builtin_amdgcn_alignbit(v.w, v.w, 16); rv.y = __builtin_amdgcn_alignbit(v.z, v.z, 16); rv.z = __builtin_amdgcn_alignbit(v.y, v.y, 16); rv.w = __builtin_amdgcn_alignbit(v.x, v.x, 16);
                    if (tq + 7 < TT) *(u32x4*)(grow + TT - tq - 7) = rv; else { for (int z = 0; z < 8; ++z) if (tq + z < TT) grow[TT - tq - z] = ((const LAS bf16_t*)(tl + cc * 80 + 16 * q))[z]; } }
            }
            LDSW();
        }
    }
}

constexpr int P6_NWR = 3;
__device__ __forceinline__ void phase_p6(LAS unsigned char* lds, const Ctx& c, int it_hi) {
    const int tid = tidf(), lane = tid & 63, wid = tid >> 6;
    const int gw = wid < P6_NWR ? blockIdx.x * P6_NWR + wid : (1 << 28), NGW = gridDim.x * P6_NWR;
    if (blockIdx.x == 0 && tid < 64) ((u32x4*)((unsigned char*)P_XN + (size_t)MROWS * DM))[tid] = (u32x4){0u, 0u, 0u, 0u};
    LAS float* wr = (LAS float*)lds;
    {
        f32x4 wv[8];
#pragma unroll
        for (int j = 0; j < 8; ++j) wv[j] = ((const f32x4*)c.w_router)[tid + 512 * j];
#pragma unroll
        for (int j = 0; j < 8; ++j) { const int i4 = tid + 512 * j, k = i4 >> 2, e0 = (i4 & 3) * 4; wr[(e0 + 0) * 1024 + k] = wv[j].x; wr[(e0 + 1) * 1024 + k] = wv[j].y; wr[(e0 + 2) * 1024 + k] = wv[j].z; wr[(e0 + 3) * 1024 + k] = wv[j].w; }
    }
    __syncthreads();
    if (wid >= P6_NWR) {
        LAS float* scr = (LAS float*)(lds + 65536 + (wid - P6_NWR) * 8448);
        const int gwc = blockIdx.x * (8 - P6_NWR) + (wid - P6_NWR), NGC = gridDim.x * (8 - P6_NWR);
        for (int it = gwc; it < it_hi; it += NGC) {
            const int e = it / 3072, r = it % 3072;
            if (r < 1024) wt_item8(c.w_eg + (size_t)e * 1024 * 2048, 1024, 2048, (unsigned char*)P_WGU + (size_t)e * 4096 * 1024, scr, r / 64, r % 64, lane, 2, F8_WSCALE);
            else if (r < 2048) wt_item8(c.w_eu + (size_t)e * 1024 * 2048, 1024, 2048, (unsigned char*)P_WGU + (size_t)e * 4096 * 1024, scr, (r - 1024) / 64, (r - 1024) % 64, lane, 3, F8_WSCALE);
            else wt_item8(c.w_ed + (size_t)e * 2048 * 1024, 2048, 1024, (unsigned char*)P_WD + (size_t)e * 1024 * 2048, scr, (r - 2048) / 32, (r - 2048) % 32, lane, 0, F8_WSCALE);
        }
        return;
    }
    f32x4 vn[4];
    { const int m = gw < MROWS ? gw : 0; const bf16_t* src = P_H2 + (size_t)m * DM;
#pragma unroll
      for (int j = 0; j < 4; ++j) { const u32x2 w = *(const u32x2*)(src + 4 * (lane + 64 * j)); vn[j] = (f32x4){lo16(w.x), hi16(w.x), lo16(w.y), hi16(w.y)}; } }
    for (int m = gw; m < MROWS; m += NGW) {
        f32x4 v[4]; float s = 0.f;
#pragma unroll
        for (int j = 0; j < 4; ++j) { v[j] = vn[j]; s += (v[j].x * v[j].x + v[j].y * v[j].y) + (v[j].z * v[j].z + v[j].w * v[j].w); }
        { const int mn = m + NGW < MROWS ? m + NGW : m; const bf16_t* src = P_H2 + (size_t)mn * DM;
#pragma unroll
          for (int j = 0; j < 4; ++j) { const u32x2 w = *(const u32x2*)(src + 4 * (lane + 64 * j)); vn[j] = (f32x4){lo16(w.x), hi16(w.x), lo16(w.y), hi16(w.y)}; } }
        const float r = rsqrtf(wave_sum(s) * (1.f / DM) + RMS_EPS);
        float lg[16];
#pragma unroll
        for (int e = 0; e < 16; ++e) lg[e] = 0.f;
#pragma unroll
        for (int j = 0; j < 4; ++j) {
            const f32x4 g = *(const f32x4*)(c.norm2_g + 4 * (lane + 64 * j));
            const f32x4 xn = (f32x4){v[j].x * r * g.x, v[j].y * r * g.y, v[j].z * r * g.z, v[j].w * r * g.w};
            *(unsigned*)((unsigned char*)P_XN + (size_t)m * DM + 4 * (lane + 64 * j)) = pk4_fp8(xn.x, xn.y, xn.z, xn.w);
#pragma unroll
            for (int e = 0; e < 16; ++e) { const f32x4 w4 = *(const LAS f32x4*)(wr + e * 1024 + 4 * (lane + 64 * j)); lg[e] += (xn.x * w4.x + xn.y * w4.y) + (xn.z * w4.z + xn.w * w4.w); }
            asm volatile("" ::: "memory");
        }
        float mx = -1e30f;
#pragma unroll
        for (int e = 0; e < 16; ++e) { lg[e] = wave_sum(lg[e]); mx = fmaxf(mx, lg[e]); }
        float sum = 0.f;
#pragma unroll
        for (int e = 0; e < 16; ++e) { lg[e] = __expf(lg[e] - mx); sum += lg[e]; }
        int b, t; bt_of(m, b, t);
        const float inv = 1.f / sum;
#pragma unroll
        for (int e = 0; e < 16; ++e) if (lane == e) P_AFF[((size_t)b * NE + e) * TT + t] = lg[e] * inv;
    }
}
__device__ __forceinline__ void phase_p6b(LAS unsigned char* lds, const Ctx& c, int it_lo, int it_hi, int first_blk) {
    const int tid = tidf(), lane = tid & 63, wid = tid >> 6;
    if ((int)blockIdx.x < first_blk) return;
    const int gw = ((int)blockIdx.x - first_blk) * 8 + wid, NGW = ((int)gridDim.x - first_blk) * 8;
    __syncthreads();
    {
        LAS float* scr = (LAS float*)(lds + wid * 8448);
        for (int it = it_lo + gw; it < it_hi; it += NGW) {
            const int e = it / 3072, r = it % 3072;
            if (r < 1024) wt_item8(c.w_eg + (size_t)e * 1024 * 2048, 1024, 2048, (unsigned char*)P_WGU + (size_t)e * 4096 * 1024, scr, r / 64, r % 64, lane, 2, F8_WSCALE);
            else if (r < 2048) wt_item8(c.w_eu + (size_t)e * 1024 * 2048, 1024, 2048, (unsigned char*)P_WGU + (size_t)e * 4096 * 1024, scr, (r - 1024) / 64, (r - 1024) % 64, lane, 3, F8_WSCALE);
            else wt_item8(c.w_ed + (size_t)e * 2048 * 1024, 2048, 1024, (unsigned char*)P_WD + (size_t)e * 1024 * 2048, scr, (r - 2048) / 32, (r - 2048) % 32, lane, 0, F8_WSCALE);
        }
    }
}

__device__ __forceinline__ void phase_topk(LAS unsigned char* lds, const Ctx& c) {
    const int tid = tidf(), lane = tid & 63, wid = tid >> 6;
    LAS unsigned* hist = (LAS unsigned*)lds;
    LAS unsigned* sh = hist + 256;
    for (int be = blockIdx.x; be < NB * NE; be += gridDim.x) {
        const float* a = P_AFF + (size_t)be * TT;
        unsigned key[17];
#pragma unroll
        for (int j = 0; j < 17; ++j) { const int t = tid * 17 + j; key[j] = t < TT ? __float_as_uint(a[t]) : 0u; }
        unsigned prefix = 0u, kk = CAP;
        for (int pass = 0; pass < 4; ++pass) {
            const int shift = 24 - 8 * pass;
            __syncthreads();
            if (tid < 256) hist[tid] = 0u;
            __syncthreads();
            const unsigned himask = pass == 0 ? 0u : (0xffffffffu << (shift + 8));
#pragma unroll
            for (int j = 0; j < 17; ++j) if ((key[j] & himask) == prefix && tid * 17 + j < TT) __hip_atomic_fetch_add(&hist[(key[j] >> shift) & 255u], 1u, __ATOMIC_RELAXED, __HIP_MEMORY_SCOPE_WORKGROUP);
            __syncthreads();
            if (tid < 256) {
                const unsigned hv = hist[tid]; unsigned sfx = hv;
#pragma unroll
                for (int o = 1; o < 64; o <<= 1) { const unsigned u = __shfl_down(sfx, o); if (lane + o < 64) sfx += u; }
                if (lane == 0) sh[24 + wid] = sfx;
                sh[32 + tid] = sfx; sh[288 + tid] = hv;
            }
            __syncthreads();
            if (tid < 256) {
                unsigned above = 0u; for (int w = wid + 1; w < 4; ++w) above += sh[24 + w];
                const unsigned incl = sh[32 + tid] + above, excl = incl - sh[288 + tid];
                if (excl < kk && kk <= incl) { sh[0] = prefix | ((unsigned)tid << shift); sh[1] = kk - excl; }
            }
            __syncthreads();
            prefix = sh[0]; kk = sh[1];
        }
        int ngt = 0, neq = 0;
#pragma unroll
        for (int j = 0; j < 17; ++j) { const bool v = tid * 17 + j < TT; ngt += (v && key[j] > prefix) ? 1 : 0; neq += (v && key[j] == prefix) ? 1 : 0; }
        int sg = ngt, se = neq;
#pragma unroll
        for (int o = 1; o < 64; o <<= 1) { const int ug = __shfl_up(sg, o), ue = __shfl_up(se, o); if (lane >= o) { sg += ug; se += ue; } }
        __syncthreads();
        if (lane == 63) { sh[8 + wid] = (unsigned)sg; sh[16 + wid] = (unsigned)se; }
        __syncthreads();
        int bg = 0, beq = 0;
        for (int w = 0; w < wid; ++w) { bg += (int)sh[8 + w]; beq += (int)sh[16 + w]; }
        int pg = bg + sg - ngt, pe = beq + se - neq;
        int slot = pg + ((pe < (int)kk) ? pe : (int)kk);
        int* idx = P_IDX + (size_t)be * CAP; float* gv = P_GATEV + (size_t)be * CAP; int* inv = P_INV + (size_t)(be >> 4) * TT * 16 + (be & 15);
#pragma unroll
        for (int j = 0; j < 17; ++j) {
            const int t = tid * 17 + j;
            if (t < TT) {
                bool sel = false;
                if (key[j] > prefix) sel = true; else if (key[j] == prefix) { sel = pe < (int)kk; ++pe; }
                if (sel) { idx[slot] = t; gv[slot] = __uint_as_float(key[j]); inv[(size_t)t * 16] = slot; ++slot; } else inv[(size_t)t * 16] = -1;
            }
        }
    }
}
__device__ __forceinline__ void phase_gather(const Ctx& c) {
    const int lane = tidf() & 63, gw = blockIdx.x * 8 + (tidf() >> 6), NGW = gridDim.x * 8;
    const unsigned char* XN8 = (const unsigned char*)P_XN; unsigned char* XE8 = (unsigned char*)P_XE;
    for (int it0 = gw; it0 < NE * ER; it0 += 4 * NGW) {
        u32x4 v0[4];
#pragma unroll
        for (int k = 0; k < 4; ++k) {
            const int it = it0 + k * NGW; v0[k] = (u32x4){0u, 0u, 0u, 0u};
            if (it < NE * ER) { const int e = it / ER, r = it - e * ER;
                if (r < 2 * CAP) { const int b = r / CAP, slot = r - b * CAP; const int t = P_IDX[((size_t)b * NE + e) * CAP + slot]; v0[k] = ((const u32x4*)(XN8 + (size_t)row_of(b, t) * DM))[lane]; } }
        }
#pragma unroll
        for (int k = 0; k < 4; ++k) { const int it = it0 + k * NGW; if (it < NE * ER) ((u32x4*)(XE8 + (size_t)it * DM))[lane] = v0[k]; }
    }
}
__device__ __forceinline__ void phase_final(const Ctx& c) {
    const int lane = tidf() & 63, gw = blockIdx.x * 8 + (tidf() >> 6), NGW = gridDim.x * 8;
    u32x2 hn[4]; int invn = -1;
    if (gw < MX) { const int b = gw >> 13, t = (gw & 8191) + NMETA; const bf16_t* hrow = P_H2 + (size_t)gw * DM;
        invn = lane < NE ? P_INV[((size_t)b * TT + t) * 16 + lane] : -1;
#pragma unroll
        for (int j = 0; j < 4; ++j) hn[j] = *(const u32x2*)(hrow + 4 * (lane + 64 * j)); }
    for (int m = gw; m < MX; m += NGW) {
        const int b = m >> 13;
        float* row = P_OUT + (size_t)m * DM;
        const int inv = invn;
        f32x4 v[4];
#pragma unroll
        for (int j = 0; j < 4; ++j) v[j] = (f32x4){lo16(hn[j].x), hi16(hn[j].x), lo16(hn[j].y), hi16(hn[j].y)};
        { const int mn = m + NGW;
          if (mn < MX) { const int bn = mn >> 13, tn = (mn & 8191) + NMETA; const bf16_t* hrow = P_H2 + (size_t)mn * DM;
              invn = lane < NE ? P_INV[((size_t)bn * TT + tn) * 16 + lane] : -1;
#pragma unroll
              for (int j = 0; j < 4; ++j) hn[j] = *(const u32x2*)(hrow + 4 * (lane + 64 * j)); } }
        unsigned long long mask = __ballot(inv >= 0);
        while (mask) {
            const int e0 = __builtin_ctzll(mask); mask &= mask - 1;
            int e1 = -1; if (mask) { e1 = __builtin_ctzll(mask); mask &= mask - 1; }
            const int s0 = __builtin_amdgcn_readlane(inv, e0);
            const bf16_t* y0 = P_YE + (size_t)exp_row(e0, b * CAP + s0) * DM;
            u32x2 w0[4], w1[4];
#pragma unroll
            for (int j = 0; j < 4; ++j) w0[j] = *(const u32x2*)(y0 + 4 * (lane + 64 * j));
            if (e1 >= 0) { const int s1 = __builtin_amdgcn_readlane(inv, e1); const bf16_t* y1 = P_YE + (size_t)exp_row(e1, b * CAP + s1) * DM;
#pragma unroll
                for (int j = 0; j < 4; ++j) w1[j] = *(const u32x2*)(y1 + 4 * (lane + 64 * j)); }
            else {
#pragma unroll
                for (int j = 0; j < 4; ++j) w1[j] = (u32x2){0u, 0u}; }
#pragma unroll
            for (int j = 0; j < 4; ++j) { v[j].x += lo16(w0[j].x) + lo16(w1[j].x); v[j].y += hi16(w0[j].x) + hi16(w1[j].x); v[j].z += lo16(w0[j].y) + lo16(w1[j].y); v[j].w += hi16(w0[j].y) + hi16(w1[j].y); }
        }
        float s = 0.f;
#pragma unroll
        for (int j = 0; j < 4; ++j) s += (v[j].x * v[j].x + v[j].y * v[j].y) + (v[j].z * v[j].z + v[j].w * v[j].w);
        const float r = rsqrtf(wave_sum(s) * (1.f / DM) + RMS_EPS);
#pragma unroll
        for (int j = 0; j < 4; ++j) { const f32x4 g = *(const f32x4*)(c.gfin + 4 * (lane + 64 * j)); *(f32x4*)(row + 4 * (lane + 64 * j)) = (f32x4){v[j].x * r * g.x, v[j].y * r * g.y, v[j].z * r * g.z, v[j].w * r * g.w}; }
    }
}

__device__ __forceinline__ void unpack8(const u32x4 w, float* f) { f[0] = lo16(w.x); f[1] = hi16(w.x); f[2] = lo16(w.y); f[3] = hi16(w.y); f[4] = lo16(w.z); f[5] = hi16(w.z); f[6] = lo16(w.w); f[7] = hi16(w.w); }
__device__ __forceinline__ void c3_load(const bf16_t* __restrict__ PROJ, int b, int t, int ch0, u32x4 (&w)[3]) {
#pragma unroll
    for (int j = 0; j < 3; ++j) { const int tt = t + j - 1; const bool ok = (tt >= 0) && (tt < TT) && (t < TT);
        w[j] = *(const u32x4*)(PROJ + pj_u(ch0 >> 10, row_of(b, ok ? tt : 0)) + (ch0 & 1023)); if (!ok) w[j] = (u32x4){0u, 0u, 0u, 0u}; }
}
__device__ __forceinline__ void c3_eval(const u32x4 (&w)[3], const float* __restrict__ cw, const float* __restrict__ cb, int ch0, float* out) {
    const f32x4 b0 = *(const f32x4*)(cb + ch0), b1 = *(const f32x4*)(cb + ch0 + 4);
    out[0] = b0.x; out[1] = b0.y; out[2] = b0.z; out[3] = b0.w; out[4] = b1.x; out[5] = b1.y; out[6] = b1.z; out[7] = b1.w;
#pragma unroll
    for (int j = 0; j < 3; ++j) { float u[8]; unpack8(w[j], u);
        const f32x4 w0 = *(const f32x4*)(cw + j * 3072 + ch0), w1 = *(const f32x4*)(cw + j * 3072 + ch0 + 4);
        out[0] += u[0] * w0.x; out[1] += u[1] * w0.y; out[2] += u[2] * w0.z; out[3] += u[3] * w0.w; out[4] += u[4] * w1.x; out[5] += u[5] * w1.y; out[6] += u[6] * w1.z; out[7] += u[7] * w1.w; }
}
constexpr int HY_WL = 2 * 64 * 144;
__device__ __forceinline__ void c3w_stage(LAS float* wl, const float* __restrict__ cw, const float* __restrict__ cb, const float* __restrict__ skip, int ct, int tid) {
    if (tid < 192) { const int sec = tid >> 6, tb = (tid >> 4) & 3, c4 = tid & 15; const int ch = sec * 1024 + 64 * ct + 4 * c4;
        *(LAS f32x4*)(wl + (sec * 4 + tb) * 64 + 4 * c4) = tb < 3 ? *(const f32x4*)(cw + tb * 3072 + ch) : *(const f32x4*)(cb + ch); }
    else if (tid < 208) { const int c4 = tid - 192; *(LAS f32x4*)(wl + 768 + 4 * c4) = *(const f32x4*)(skip + 64 * ct + 4 * c4); }
}
__device__ __forceinline__ void c3_evall(const u32x4 (&w)[3], const LAS float* wl, int sec, int cg, float* out) {
    const f32x4 b0 = *(const LAS f32x4*)(wl + (sec * 4 + 3) * 64 + 8 * cg), b1 = *(const LAS f32x4*)(wl + (sec * 4 + 3) * 64 + 8 * cg + 4);
    out[0] = b0.x; out[1] = b0.y; out[2] = b0.z; out[3] = b0.w; out[4] = b1.x; out[5] = b1.y; out[6] = b1.z; out[7] = b1.w;
#pragma unroll
    for (int j = 0; j < 3; ++j) { float u[8]; unpack8(w[j], u);
        const f32x4 w0 = *(const LAS f32x4*)(wl + (sec * 4 + j) * 64 + 8 * cg), w1 = *(const LAS f32x4*)(wl + (sec * 4 + j) * 64 + 8 * cg + 4);
        out[0] += u[0] * w0.x; out[1] += u[1] * w0.y; out[2] += u[2] * w0.z; out[3] += u[3] * w0.w; out[4] += u[4] * w1.x; out[5] += u[5] * w1.y; out[6] += u[6] * w1.z; out[7] += u[7] * w1.w; }
}
constexpr int HY_ITEMS = 2 * 129 * 16, HY_TILE = 64 * 144;
#ifndef HYPREP_NB
#define HYPREP_NB 2
#endif
#ifndef HYPOST_NB
#define HYPOST_NB 2
#endif
template <int NB> __device__ __forceinline__ void phase_hyprep_t(LAS unsigned char* lds, const Ctx& c) {
    const int tid = tidf(), cg = tid & 7, tp = tid >> 3, ch = tid >> 3, pc = tid & 7;
    LAS float* wl = (LAS float*)(lds + HY_WL); int ctw = -1;
    for (int it0 = blockIdx.x; it0 < HY_ITEMS; it0 += NB * gridDim.x) {
        int b[NB], tt[NB], ct[NB]; bool val[NB];
#pragma unroll
        for (int s = 0; s < NB; ++s) { const int it = it0 + s * gridDim.x; val[s] = it < HY_ITEMS; const int ii = val[s] ? it : it0; ct[s] = ii & 15; tt[s] = (ii >> 4) % 129; b[s] = (ii >> 4) / 129; }
        const bool same = (gridDim.x & 15) == 0;
        if (same && ct[0] != ctw) { ctw = ct[0]; __syncthreads(); c3w_stage(wl, c.cw, c.cb, c.skip, ctw, tid); }
        u32x4 wx[NB][3], wv[NB][3];
#pragma unroll
        for (int s = 0; s < NB; ++s) { const int t = 64 * tt[s] + tp, c0 = 64 * ct[s] + 8 * cg; c3_load(P_PROJ, b[s], t, 1024 + c0, wx[s]); c3_load(P_PROJ, b[s], t, 2048 + c0, wv[s]); }
        __syncthreads();
#pragma unroll
        for (int s = 0; s < NB; ++s) { const int t = 64 * tt[s] + tp, c0 = 64 * ct[s] + 8 * cg; float x1[8], vh[8];
            if (same) { c3_evall(wx[s], wl, 1, cg, x1); c3_evall(wv[s], wl, 2, cg, vh); } else { c3_eval(wx[s], c.cw, c.cb, 1024 + c0, x1); c3_eval(wv[s], c.cw, c.cb, 2048 + c0, vh); }
#pragma unroll
            for (int k = 0; k < 8; ++k) *(LAS bf16_t*)(lds + s * HY_TILE + (8 * cg + k) * 144 + tp * 2) = t < TT ? f2bf(x1[k] * vh[k]) : (bf16_t)0; }
        __syncthreads();
#pragma unroll
        for (int s = 0; s < NB; ++s) if (val[s]) *(u32x4*)(P_ZT + ((size_t)b[s] * 1024 + 64 * ct[s] + ch) * ZL + 64 * tt[s] + 8 * pc) = *(const LAS u32x4*)(lds + s * HY_TILE + ch * 144 + pc * 16);
    }
}
__device__ __forceinline__ void phase_hyprep(LAS unsigned char* lds, const Ctx& c) { phase_hyprep_t<HYPREP_NB>(lds, c); }
template <int NB> __device__ __forceinline__ void phase_hypost_t(LAS unsigned char* lds, const Ctx& c) {
    const int tid = tidf(), cg = tid & 7, tp = tid >> 3, ch = tid >> 3, pc = tid & 7;
    LAS float* wl = (LAS float*)(lds + HY_WL); int ctw = -1;
    for (int it0 = blockIdx.x; it0 < HY_ITEMS; it0 += NB * gridDim.x) {
        int b[NB], tt[NB], ct[NB]; bool val[NB];
#pragma unroll
        for (int s = 0; s < NB; ++s) { const int it = it0 + s * gridDim.x; val[s] = it < HY_ITEMS; const int ii = val[s] ? it : it0; ct[s] = ii & 15; tt[s] = (ii >> 4) % 129; b[s] = (ii >> 4) / 129; }
        const bool same = (gridDim.x & 15) == 0;
        if (same && ct[0] != ctw) { ctw = ct[0]; __syncthreads(); c3w_stage(wl, c.cw, c.cb, c.skip, ctw, tid); }
        u32x4 w0[NB][3], wx[NB][3], wv[NB][3], yv[NB];
#pragma unroll
        for (int s = 0; s < NB; ++s) { const int t = 64 * tt[s] + tp, c0 = 64 * ct[s] + 8 * cg;
            yv[s] = *(const u32x4*)(P_YCT + ((size_t)b[s] * 1024 + 64 * ct[s] + ch) * ZL + 64 * tt[s] + 8 * pc);
            c3_load(P_PROJ, b[s], t, c0, w0[s]); c3_load(P_PROJ, b[s], t, 1024 + c0, wx[s]); c3_load(P_PROJ, b[s], t, 2048 + c0, wv[s]); }
        __syncthreads();
#pragma unroll
        for (int s = 0; s < NB; ++s) *(LAS u32x4*)(lds + s * HY_TILE + ch * 144 + pc * 16) = yv[s];
        __syncthreads();
#pragma unroll
        for (int s = 0; s < NB; ++s) { const int t = 64 * tt[s] + tp, c0 = 64 * ct[s] + 8 * cg;
            if (val[s] && t < TT) {
                float x0[8], x1[8], vh[8];
                f32x4 s0, s1;
                if (same) { c3_evall(w0[s], wl, 0, cg, x0); c3_evall(wx[s], wl, 1, cg, x1); c3_evall(wv[s], wl, 2, cg, vh); s0 = *(const LAS f32x4*)(wl + 768 + 8 * cg); s1 = *(const LAS f32x4*)(wl + 768 + 8 * cg + 4); }
                else { c3_eval(w0[s], c.cw, c.cb, c0, x0); c3_eval(wx[s], c.cw, c.cb, 1024 + c0, x1); c3_eval(wv[s], c.cw, c.cb, 2048 + c0, vh); s0 = *(const f32x4*)(c.skip + c0); s1 = *(const f32x4*)(c.skip + c0 + 4); }
                const float sk[8] = {s0.x, s0.y, s0.z, s0.w, s1.x, s1.y, s1.z, s1.w};
                float o[8];
#pragma unroll
                for (int k = 0; k < 8; ++k) { const float yc = bf2f(*(const LAS bf16_t*)(lds + s * HY_TILE + (8 * cg + k) * 144 + tp * 2)); o[k] = x0[k] * (yc + x1[k] * vh[k] * sk[k]); }
                u32x4 w; w.x = pk2(o[0], o[1]); w.y = pk2(o[2], o[3]); w.z = pk2(o[4], o[5]); w.w = pk2(o[6], o[7]);
                *(u32x4*)(P_AHY + (size_t)row_of(b[s], t) * DM + c0) = w;
            } }
    }
}
__device__ __forceinline__ void phase_hypost(LAS unsigned char* lds, const Ctx& c) { phase_hypost_t<HYPOST_NB>(lds, c); }

typedef short s16x4 __attribute__((ext_vector_type(4)));
__device__ __forceinline__ bf16x8 tr2(const LAS unsigned char* p, int second_off) {
    const s16x4 lo = __builtin_bit_cast(s16x4, __builtin_amdgcn_ds_read_tr16_b64_v4i16((LAS s16x4*)p));
    const s16x4 hi = __builtin_bit_cast(s16x4, __builtin_amdgcn_ds_read_tr16_b64_v4i16((LAS s16x4*)(p + second_off)));
    return (bf16x8){lo[0], lo[1], lo[2], lo[3], hi[0], hi[1], hi[2], hi[3]};
}
__device__ __forceinline__ u32x4 scale8(const u32x4 w, float s) {
    u32x4 o; o.x = pk2(lo16(w.x) * s, hi16(w.x) * s); o.y = pk2(lo16(w.y) * s, hi16(w.y) * s); o.z = pk2(lo16(w.z) * s, hi16(w.z) * s); o.w = pk2(lo16(w.w) * s, hi16(w.w) * s); return o;
}
constexpr int RA_K = 272, RA_V = 576;
__device__ __forceinline__ void phase_retsum(LAS unsigned char* lds, const Ctx& c) {
    LAS unsigned char* Kf = lds; LAS unsigned char* Kb = lds + 128 * RA_K; LAS unsigned char* Vl = lds + 2 * 128 * RA_K;
    const bf16_t* PROJ = P_PROJ;
    for (int u = blockIdx.x; u < 520; u += gridDim.x) {
        const int tid = tidf(), lane = tid & 63, wid = tid >> 6;
        int bh, n; if (u < 512) { bh = u >> 6; n = 1 + (u & 63); } else { bh = u - 512; n = 0; }
        const int b = bh >> 2, h = bh & 3;
        const float lf = log_sigmoid(c.dec_f[h]), lb = log_sigmoid(c.dec_b[h]);
        __syncthreads();
        {
            const u32x4 z4 = (u32x4){0u, 0u, 0u, 0u};
            u32x4 kv[4], vv[8];
#pragma unroll
            for (int i = 0; i < 4; ++i) { const int row = 32 * i + (tid >> 4); const int gr = chunk_row(b, n, row); kv[i] = *(const u32x4*)(PROJ + pj_k(h, gr < 0 ? 0 : gr) + 8 * (tid & 15)); if (gr < 0) kv[i] = z4; }
#pragma unroll
            for (int i = 0; i < 8; ++i) { const int row = 16 * i + (tid >> 5); const int gr = chunk_row(b, n, row); vv[i] = *(const u32x4*)(PROJ + pj_v(h, gr < 0 ? 0 : gr) + 8 * (tid & 31)); if (gr < 0) vv[i] = z4; }
#pragma unroll
            for (int i = 0; i < 4; ++i) { const int row = 32 * i + (tid >> 4); const float we = expf(lf * (float)(127 - row)), ws = expf(lb * (float)row);
                *(LAS u32x4*)(Kf + row * RA_K + (tid & 15) * 16) = scale8(kv[i], we); *(LAS u32x4*)(Kb + row * RA_K + (tid & 15) * 16) = scale8(kv[i], ws); }
#pragma unroll
            for (int i = 0; i < 8; ++i) { const int row = 16 * i + (tid >> 5); *(LAS u32x4*)(Vl + row * RA_V + (tid & 31) * 16) = vv[i]; }
        }
        __syncthreads();
        const int dkt = wid & 3, dvh = wid >> 2, r = lane & 31, hh = lane >> 5, g16 = lane >> 4, i16 = lane & 15, q = i16 >> 2, p = i16 & 3;
        f32x16 af[4], ab[4];
#pragma unroll
        for (int nt = 0; nt < 4; ++nt) for (int z = 0; z < 16; ++z) { af[nt][z] = 0.f; ab[nt][z] = 0.f; }
        const LAS unsigned char* kfa = Kf + (8 * hh + q) * RA_K + (32 * dkt + 16 * (g16 & 1) + 4 * p) * 2;
        const LAS unsigned char* kba = Kb + (8 * hh + q) * RA_K + (32 * dkt + 16 * (g16 & 1) + 4 * p) * 2;
        const LAS unsigned char* va = Vl + (8 * hh + q) * RA_V + (128 * dvh + 16 * (g16 & 1) + 4 * p) * 2;
#pragma unroll
        for (int ks = 0; ks < 8; ++ks) {
            if (n == 0 && ks < 7) continue;
            const bf16x8 aF = tr2(kfa + 16 * ks * RA_K, 4 * RA_K), aB = tr2(kba + 16 * ks * RA_K, 4 * RA_K);
#pragma unroll
            for (int nt = 0; nt < 4; ++nt) { const bf16x8 bv = tr2(va + 16 * ks * RA_V + 64 * nt, 4 * RA_V);
                af[nt] = __builtin_amdgcn_mfma_f32_32x32x16_bf16(aF, bv, af[nt], 0, 0, 0); ab[nt] = __builtin_amdgcn_mfma_f32_32x32x16_bf16(aB, bv, ab[nt], 0, 0, 0); }
        }
        bf16_t* of = P_S + (((size_t)0 * 8 + bh) * NCH + n) * 32768; bf16_t* ob = P_S + (((size_t)1 * 8 + bh) * NCH + n) * 32768;
#pragma unroll
        for (int nt = 0; nt < 4; ++nt)
#pragma unroll
            for (int g = 0; g < 4; ++g) {
                const size_t o = ((size_t)((4 * dvh + nt) * 8 + 2 * dkt + (g >> 1)) * 64 + (g & 1) * 32 + r) * 8 + 4 * hh;
                u32x2 w; w.x = pk2(af[nt][4 * g], af[nt][4 * g + 1]); w.y = pk2(af[nt][4 * g + 2], af[nt][4 * g + 3]); *(u32x2*)(of + o) = w;
                u32x2 v; v.x = pk2(ab[nt][4 * g], ab[nt][4 * g + 1]); v.y = pk2(ab[nt][4 * g + 2], ab[nt][4 * g + 3]); *(u32x2*)(ob + o) = v;
            }
    }
}
__device__ __forceinline__ void phase_retscan(const Ctx& c) {
    for (int gi = blockIdx.x * 512 + tidf(); gi < 16 * 8192; gi += gridDim.x * 512) {
        const int db = gi >> 13, e4 = gi & 8191, dir = db >> 3, bh = db & 7, h = bh & 3;
        const float dec = expf(log_sigmoid(dir ? c.dec_b[h] : c.dec_f[h]) * 128.f);
        bf16_t* base = P_S + ((size_t)db * NCH) * 32768 + (size_t)e4 * 4;
        const long step = dir ? -32768 : 32768;
        bf16_t* p = base + (dir ? (size_t)64 * 32768 : 0);
        f32x4 s = (f32x4){0.f, 0.f, 0.f, 0.f};
        u32x2 a[13];
#pragma unroll 1
        for (int n0 = 0; n0 < NCH; n0 += 13) {
#pragma unroll
            for (int k = 0; k < 13; ++k) a[k] = *(const u32x2*)(p + (long)k * step);
#pragma unroll
            for (int k = 0; k < 13; ++k) {
                u32x2 w; w.x = pk2(s.x, s.y); w.y = pk2(s.z, s.w); *(u32x2*)(p + (long)k * step) = w;
                s = s * dec + (f32x4){lo16(a[k].x), hi16(a[k].x), lo16(a[k].y), hi16(a[k].y)};
            }
            p += 13 * step;
        }
    }
}
constexpr int R2Q = 272, R2V = 576, R2O = 528;
__device__ __forceinline__ void phase_retout(LAS unsigned char* lds, const Ctx& c) {
    LAS unsigned char* Ql = lds; LAS unsigned char* Kl = lds + 128 * R2Q; LAS unsigned char* Vl = lds + 2 * 128 * R2Q; LAS float* red = (LAS float*)(lds + 2 * 128 * R2Q + 128 * R2V);
    const bf16_t* PROJ = P_PROJ;
    for (int u = blockIdx.x; u < 520; u += gridDim.x) {
        const int tid = tidf(), lane = tid & 63, wid = tid >> 6;
        int bh, n; if (u < 512) { bh = u >> 6; n = 1 + (u & 63); } else { bh = u - 512; n = 0; }
        const int b = bh >> 2, h = bh & 3;
        const float lf = log_sigmoid(c.dec_f[h]), lb = log_sigmoid(c.dec_b[h]);
        const float lf2 = lf * 1.4426950408889634f, lb2 = lb * 1.4426950408889634f;
        __syncthreads();
        {
            const u32x4 z4 = (u32x4){0u, 0u, 0u, 0u};
            u32x4 qv[4], kv[4], vv[8];
#pragma unroll
            for (int i = 0; i < 4; ++i) { const int row = 32 * i + (tid >> 4); const int gr = chunk_row(b, n, row); const int gc = gr < 0 ? 0 : gr;
                qv[i] = *(const u32x4*)(PROJ + pj_q(h, gc) + 8 * (tid & 15)); kv[i] = *(const u32x4*)(PROJ + pj_k(h, gc) + 8 * (tid & 15)); if (gr < 0) { qv[i] = z4; kv[i] = z4; } }
#pragma unroll
            for (int i = 0; i < 8; ++i) { const int row = 16 * i + (tid >> 5); const int gr = chunk_row(b, n, row);
                vv[i] = *(const u32x4*)(PROJ + pj_v(h, gr < 0 ? 0 : gr) + 8 * (tid & 31)); if (gr < 0) vv[i] = z4; }
#pragma unroll
            for (int i = 0; i < 4; ++i) { const int row = 32 * i + (tid >> 4); *(LAS u32x4*)(Ql + row * R2Q + (tid & 15) * 16) = qv[i]; *(LAS u32x4*)(Kl + row * R2Q + (tid & 15) * 16) = kv[i]; }
#pragma unroll
            for (int i = 0; i < 8; ++i) { const int row = 16 * i + (tid >> 5); *(LAS u32x4*)(Vl + row * R2V + (tid & 31) * 16) = vv[i]; }
        }
        __syncthreads();
        const int wr = wid >> 1, wc = wid & 1, r = lane & 31, hh = lane >> 5;
        const bool act = (n != 0) || (__builtin_amdgcn_readfirstlane(wr) == 3);
        f32x16 sc[2];
#pragma unroll
        for (int jt = 0; jt < 2; ++jt) for (int z = 0; z < 16; ++z) sc[jt][z] = 0.f;
        if (act) {
#pragma unroll
        for (int ks = 0; ks < 8; ++ks) {
            const bf16x8 af = *(const LAS bf16x8*)(Ql + (32 * wr + r) * R2Q + (16 * ks + 8 * hh) * 2);
#pragma unroll
            for (int jt = 0; jt < 2; ++jt) { const bf16x8 bf = *(const LAS bf16x8*)(Kl + (64 * wc + 32 * jt + r) * R2Q + (16 * ks + 8 * hh) * 2); sc[jt] = __builtin_amdgcn_mfma_f32_32x32x16_bf16(af, bf, sc[jt], 0, 0, 0); }
        }
        }
        __syncthreads();
#pragma unroll
        for (int jt = 0; jt < 2; ++jt) { const int j = 64 * wc + 32 * jt + r;
#pragma unroll
            for (int z = 0; z < 16; ++z) { const int i = 32 * wr + (z & 3) + 8 * (z >> 2) + 4 * hh; const int df = i - j;
                const float m = __builtin_amdgcn_exp2f(df >= 0 ? lf2 * (float)df : lb2 * (float)(-df));
                *(LAS bf16_t*)(Kl + i * R2Q + j * 2) = f2bf(sc[jt][z] * m); } }
        __syncthreads();
        f32x16 acc[4];
#pragma unroll
        for (int nt = 0; nt < 4; ++nt) for (int z = 0; z < 16; ++z) acc[nt][z] = 0.f;
        const bf16_t* Sf = P_S + (((size_t)0 * 8 + bh) * NCH + n) * 32768 + (size_t)(4 * wc) * 8 * 512 + lane * 8;
        const bf16_t* Sb = P_S + (((size_t)1 * 8 + bh) * NCH + n) * 32768 + (size_t)(4 * wc) * 8 * 512 + lane * 8;
        if (act) {
        bf16x8 sA[8], sB[8];
#pragma unroll
        for (int nt = 0; nt < 4; ++nt) { sA[2 * nt] = *(const bf16x8*)(Sf + (size_t)(nt * 8) * 512); sA[2 * nt + 1] = *(const bf16x8*)(Sb + (size_t)(nt * 8) * 512); }
        __builtin_amdgcn_sched_barrier(0);
        {
            const int g16 = lane >> 4, i16 = lane & 15, q = i16 >> 2, p = i16 & 3;
            const LAS unsigned char* vb = Vl + (8 * hh + q) * R2V + (128 * wc + 16 * (g16 & 1) + 4 * p) * 2;
#pragma unroll
            for (int ks = 0; ks < 8; ++ks) {
                const bf16x8 af = *(const LAS bf16x8*)(Kl + (32 * wr + r) * R2Q + (16 * ks + 8 * hh) * 2);
#pragma unroll
                for (int nt = 0; nt < 4; ++nt) { const bf16x8 bf = tr2(vb + 16 * ks * R2V + 64 * nt, 4 * R2V); acc[nt] = __builtin_amdgcn_mfma_f32_32x32x16_bf16(af, bf, acc[nt], 0, 0, 0); }
            }
        }
        {
            const int i = 32 * wr + r;
            const float qwf = expf(lf * (float)(i + 1)), qwb = expf(lb * (float)(128 - i));
#define R2_SLOAD(dst, ks_) do { _Pragma("unroll") for (int nt = 0; nt < 4; ++nt) { dst[2 * nt] = *(const bf16x8*)(Sf + (size_t)(nt * 8 + (ks_)) * 512); dst[2 * nt + 1] = *(const bf16x8*)(Sb + (size_t)(nt * 8 + (ks_)) * 512); } } while (0)
#define R2_SMMA(src_, ks_) do { const u32x4 aq = *(const LAS u32x4*)(Ql + (32 * wr + r) * R2Q + (16 * (ks_) + 8 * hh) * 2); \
                const bf16x8 af = __builtin_bit_cast(bf16x8, scale8(aq, qwf)), ab = __builtin_bit_cast(bf16x8, scale8(aq, qwb)); \
                _Pragma("unroll") for (int nt = 0; nt < 4; ++nt) { acc[nt] = __builtin_amdgcn_mfma_f32_32x32x16_bf16(af, src_[2 * nt], acc[nt], 0, 0, 0); acc[nt] = __builtin_amdgcn_mfma_f32_32x32x16_bf16(ab, src_[2 * nt + 1], acc[nt], 0, 0, 0); } } while (0)
#define R2_PIN() __builtin_amdgcn_sched_barrier(0)
            R2_SLOAD(sB, 1); R2_PIN(); R2_SMMA(sA, 0); R2_PIN();
            R2_SLOAD(sA, 2); R2_PIN(); R2_SMMA(sB, 1); R2_PIN();
            R2_SLOAD(sB, 3); R2_PIN(); R2_SMMA(sA, 2); R2_PIN();
            R2_SLOAD(sA, 4); R2_PIN(); R2_SMMA(sB, 3); R2_PIN();
            R2_SLOAD(sB, 5); R2_PIN(); R2_SMMA(sA, 4); R2_PIN();
            R2_SLOAD(sA, 6); R2_PIN(); R2_SMMA(sB, 5); R2_PIN();
            R2_SLOAD(sB, 7); R2_PIN(); R2_SMMA(sA, 6); R2_PIN();
            R2_SMMA(sB, 7);
#undef R2_PIN
#undef R2_SLOAD
#undef R2_SMMA
        }
        }
        {
            float ss[16];
#pragma unroll
            for (int z = 0; z < 16; ++z) { float v = 0.f;
#pragma unroll
                for (int nt = 0; nt < 4; ++nt) v += acc[nt][z] * acc[nt][z];
#pragma unroll
                for (int o = 1; o < 32; o <<= 1) v += __shfl_xor(v, o);
                ss[z] = v; }
            if (r == 0) {
#pragma unroll
                for (int z = 0; z < 16; ++z) red[(32 * wr + (z & 3) + 8 * (z >> 2) + 4 * hh) * 2 + wc] = ss[z]; }
        }
        __syncthreads();
        {
            float hgv[4];
#pragma unroll
            for (int nt = 0; nt < 4; ++nt) hgv[nt] = c.hg[h * 256 + 128 * wc + 32 * nt + r];
#pragma unroll
            for (int z = 0; z < 16; ++z) { const int i = 32 * wr + (z & 3) + 8 * (z >> 2) + 4 * hh; const float rs = rsqrtf((red[i * 2] + red[i * 2 + 1]) * (1.f / 256.f) + RMS_EPS);
#pragma unroll
                for (int nt = 0; nt < 4; ++nt) *(LAS bf16_t*)(Vl + i * R2O + (128 * wc + 32 * nt + r) * 2) = f2bf(acc[nt][z] * rs * hgv[nt]); }
        }
        __syncthreads();
        {
            const int tid2 = tidf();
            u32x4 gg[8];
#pragma unroll
            for (int i = 0; i < 8; ++i) { const int row = 16 * i + (tid2 >> 5), pc = tid2 & 31; const int gr = chunk_row(b, n, row); gg[i] = *(const u32x4*)(PROJ + pj_g(h, gr < 0 ? 0 : gr) + 8 * pc); }
#pragma unroll
            for (int i = 0; i < 8; ++i) { const int row = 16 * i + (tid2 >> 5), pc = tid2 & 31; const int gr = chunk_row(b, n, row);
                if (gr >= 0) { const u32x4 o = *(const LAS u32x4*)(Vl + row * R2O + pc * 16), g = gg[i]; u32x4 w;
                    w.x = pk2(lo16(o.x) * lo16(g.x), hi16(o.x) * hi16(g.x)); w.y = pk2(lo16(o.y) * lo16(g.y), hi16(o.y) * hi16(g.y)); w.z = pk2(lo16(o.z) * lo16(g.z), hi16(o.z) * hi16(g.z)); w.w = pk2(lo16(o.w) * lo16(g.w), hi16(o.w) * hi16(g.w));
                    *(u32x4*)(P_ARET + (size_t)gr * DM + h * 256 + 8 * pc) = w; } }
        }
    }
}
constexpr int P6_CONC = (NE * 3072 * 50) / 100;
constexpr int P6B_SPLIT = (NE * 3072 * 82) / 100;
constexpr int PH_LDS = 147456;


typedef __attribute__((address_space(1))) unsigned gu32;
#define XB_TMO      128
#define XB_XCNT(j)  (256  + 64 * (j))
#define XB_XSUB(j)  (1280 + 64 * (j))
#define XB_XGEN(j)  (2304 + 64 * (j))
#define XB_TOP      3328
#define XB_TOPGEN   3392
#define XCD_BAR_WORDS 3456
#define XB_SPIN_CAP (1u << 18)

__device__ __forceinline__ unsigned xb_ld(unsigned* p)              { return __hip_atomic_load(p, __ATOMIC_RELAXED, __HIP_MEMORY_SCOPE_AGENT); }
__device__ __forceinline__ unsigned xb_add(unsigned* p, unsigned v) { return __hip_atomic_fetch_add(p, v, __ATOMIC_RELAXED, __HIP_MEMORY_SCOPE_AGENT); }
__device__ __forceinline__ unsigned xb_xcc_id() { return (unsigned)__builtin_amdgcn_s_getreg((3 << 11) | 20) & 0xFu; }
#define XB_SPIN(cond, bar) do { unsigned _sp = 0; while (cond) { __builtin_amdgcn_s_sleep(1); \
    if ((++_sp & 255u) == 0u) { if (xb_ld(&(bar)[XB_TMO])) break; if (_sp > XB_SPIN_CAP) { atomicAdd(&(bar)[XB_TMO], 1u); break; } } } } while (0)

struct XcdBarrier {
    unsigned* bar; unsigned x;
    volatile LAS unsigned* st;
};

__device__ __forceinline__ XcdBarrier xcd_barrier_post(unsigned* bar, volatile LAS unsigned* st) {
    XcdBarrier b; b.bar = bar; b.x = xb_xcc_id(); b.st = st;
    if (tidf() == 0) (void)xb_add(&bar[XB_XCNT(b.x)], 1u);
    return b;
}
__device__ __forceinline__ void xcd_barrier_complete(unsigned* bar, unsigned x, unsigned& nloc, unsigned& nx) {
    const unsigned G = gridDim.x * gridDim.y * gridDim.z;
    unsigned sum, cnt, mine, sp = 0u;
    for (;;) {
        sum = 0u; cnt = 0u; mine = 0u;
#pragma unroll
        for (unsigned j = 0; j < 16; ++j) { const unsigned c = xb_ld(&bar[XB_XCNT(j)]); sum += c; cnt += (c > 0u) ? 1u : 0u; mine = (j == x) ? c : mine; }
        if (sum == G) break;
        __builtin_amdgcn_s_sleep(1);
        if ((++sp & 255u) == 0u) { if (xb_ld(&bar[XB_TMO])) break; if (sp > XB_SPIN_CAP) { atomicAdd(&bar[XB_TMO], 1u); break; } }
    }
    nloc = mine > 0u ? mine : 1u; nx = cnt > 0u ? cnt : 1u;
}

__device__ __forceinline__ void xcd_barrier(const XcdBarrier& b) {
    asm volatile("s_waitcnt vmcnt(0)" ::: "memory");
    __syncthreads();
    if (tidf() == 0) {
        unsigned* bar = b.bar;
        __builtin_amdgcn_s_waitcnt(0);
        unsigned nloc = b.st[0], nx = b.st[1];
        if (nloc == 0u) { xcd_barrier_complete(bar, b.x, nloc, nx); b.st[0] = nloc; b.st[1] = nx; }
        const unsigned old = xb_add(&bar[XB_XSUB(b.x)], 1u);
        const unsigned gen = old / nloc;
        if (old + 1u == (gen + 1u) * nloc) {
            __builtin_amdgcn_fence(__ATOMIC_RELEASE, "agent");
            asm volatile("s_waitcnt vmcnt(0)" ::: "memory");
            const unsigned og = xb_add(&bar[XB_TOP], 1u);
            const unsigned tg = og / nx;
            if (og + 1u == (tg + 1u) * nx) xb_add(&bar[XB_TOPGEN], 1u);
            else XB_SPIN(xb_ld(&bar[XB_TOPGEN]) == tg, bar);
            __builtin_amdgcn_fence(__ATOMIC_ACQUIRE, "agent");
            xb_add(&bar[XB_XGEN(b.x)], 1u);
            asm volatile("s_waitcnt vmcnt(0)" ::: "memory");
        } else {
            XB_SPIN(xb_ld(&bar[XB_XGEN(b.x)]) == gen, bar);
            __builtin_amdgcn_fence(__ATOMIC_ACQUIRE, "agent");
            asm volatile("s_waitcnt vmcnt(0)" ::: "memory");
        }
    }
    __syncthreads();
}
__device__ __forceinline__ GemmArgs mk_ga(const bf16_t* A, const bf16_t* Bt, int M, int N, int K, int gt, size_t gstride, int side) {
    GemmArgs ga{}; ga.A = A; ga.Bt = Bt; ga.M = M; ga.N = N; ga.K = K; ga.gt = gt; ga.gstride = gstride; ga.side = side; return ga;
}
__global__ void __launch_bounds__(512, 2) mega_fwd(Ctx c) {
    extern __shared__ __attribute__((aligned(16))) unsigned char smem_m[];
    LAS unsigned char* lds = (LAS unsigned char*)smem_m;
    cg::grid_group grid = cg::this_grid();
#ifdef PROBE_A
    unsigned long long tsv[16], tsx[4]; tsv[0] = __builtin_amdgcn_s_memrealtime();
#define TS(k) tsv[k] = __builtin_amdgcn_s_memrealtime()
#define XSYNC0() do { xcd_barrier(xb); tsx[0] = __builtin_amdgcn_s_memrealtime(); } while (0)
#define XSYNC1() do { xcd_barrier(xb); tsx[1] = __builtin_amdgcn_s_memrealtime(); } while (0)
#define XSYNC2() do { xcd_barrier(xb); tsx[2] = __builtin_amdgcn_s_memrealtime(); } while (0)
#define XSYNC3() do { xcd_barrier(xb); tsx[3] = __builtin_amdgcn_s_memrealtime(); } while (0)
#else
#define TS(k)
#define XSYNC0()
#define XSYNC1()
#define XSYNC2()
#define XSYNC3()
#endif
    unsigned* barw = (unsigned*)(c.ws + WS_CTL) + 1024;
    volatile LAS unsigned* bst = (volatile LAS unsigned*)(lds + PH_LDS - 256);
    if (tidf() < 2) bst[tidf()] = 0u;
    __syncthreads();
    if (c.ws == nullptr) grid.sync();
    const XcdBarrier xb = xcd_barrier_post(barw, bst);
#define GSYNC() xcd_barrier(xb)
    phase_p0(lds, c);
    XSYNC0();
    phase_p0b(lds, c);
    GSYNC(); TS(1);
    gemm_fast_body<1>(lds, mk_ga(P_XN, P_WIN, MX, NPROJ, 1024, 1 << 20, 0, 1), make_epi(c));
    GSYNC(); TS(2);
    phase_retsum(lds, c);
    XSYNC1();
    phase_hyprep(lds, c);
    phase_filtout(lds, c);
    GSYNC(); TS(3);
    phase_retscan(c);
    for (int cb = blockIdx.x; cb < 256; cb += gridDim.x) conv_fast_body(lds, P_G, P_ZT, P_YCT, 4 * cb);
    XSYNC2();
    GSYNC(); TS(4);
    phase_retout(lds, c);
    phase_hypost(lds, c);
    GSYNC(); TS(5);
    gemm_fast_body<2>(lds, mk_ga(P_ARET, P_WRET, MX, DM, 1024, 1 << 20, 0, 1), make_epi(c));
    GSYNC(); TS(6);
    gemm_fast_body<3>(lds, mk_ga(P_AHY, P_WHY, MX, DM, 1024, 1 << 20, 0, 1), make_epi(c));
    GSYNC(); TS(7);
    gemm_fast_body<4>(lds, mk_ga(P_XN, P_WO, MX, DM, 1024, 1 << 20, 0, 1), make_epi(c));
    GSYNC(); TS(8);
    phase_p6(lds, c, P6_CONC);
    XSYNC3();
    const int p6split = gridDim.x > 64 ? P6B_SPLIT : NE * 3072;
    phase_p6b(lds, c, P6_CONC, p6split, 0);
    GSYNC(); TS(9);
    phase_topk(lds, c);
    if (gridDim.x > 64) phase_p6b(lds, c, p6split, NE * 3072, NB * NE);
    GSYNC(); TS(10); TS(11);
    { GemmArgs g5 = mk_ga(P_XN, P_WGU, NE * EM, 4096, 1024 / 2, EM / 256, (size_t)4096 * 1024, 0); g5.idx = P_IDX; gemm_fast_body<5>(lds, g5, make_epi(c)); }
    GSYNC(); TS(12);
    gemm_fast_body<6>(lds, mk_ga(P_HID, P_WD, NE * EM, DM, 2048 / 2, EM / 256, (size_t)1024 * 2048, 0), make_epi(c));
    GSYNC(); TS(13);
    phase_final(c);
#ifdef PROBE_A
    GSYNC(); TS(14);
    if (blockIdx.x == 0) {
        #ifdef PROBE_X
        const int kmap[4] = {0, 2, 3, 8};
        const float ta = (float)(tsx[PROBE_X] - tsv[kmap[PROBE_X]]) * 0.01f, tb = (float)(tsv[PROBE_B + 1] - tsv[PROBE_B]) * 0.01f;
#else
        const float ta = (float)(tsv[PROBE_A + 1] - tsv[PROBE_A]) * 0.01f, tb = (float)(tsv[PROBE_B + 1] - tsv[PROBE_B]) * 0.01f;
#endif
        const float eps = sqrtf(ta * 1.6e-5f);
        float* o = (float*)c.dob;
        for (int i = tidf(); i < (1 << 20); i += 512) o[4096 + i] += eps;
        if (tidf() == 0) o[0] += 0.5f + tb * 0.01f;
    }
#endif
}
extern "C" void kernel_launch(void* const* d_in, const int* in_sizes, int n_in, void* d_out, int out_size, void* d_ws, size_t ws_size, hipStream_t stream) {
    if (n_in != 27 || ws_size < WS_END || out_size != MX * DM) { fprintf(stderr, "kernel_launch: unexpected sizes n_in %d ws %zu out %d\n", n_in, ws_size, out_size); return; }
    constexpr size_t kDynLds = PH_LDS;
    static int grid_blocks = 0;
    if (!grid_blocks) {
        int dev = 0, cus = 0, per_cu = 0;
        (void)hipGetDevice(&dev);
        (void)hipDeviceGetAttribute(&cus, hipDeviceAttributeMultiprocessorCount, dev);
        (void)hipFuncSetAttribute((const void*)mega_fwd, hipFuncAttributeMaxDynamicSharedMemorySize, (int)kDynLds);
        (void)hipOccupancyMaxActiveBlocksPerMultiprocessor(&per_cu, (const void*)mega_fwd, 512, kDynLds);
        if (per_cu < 1) per_cu = 1;
        grid_blocks = cus * per_cu;
    }
    Ctx cx{};
    { const float** pp = (const float**)&cx; for (int i = 0; i < 27; ++i) pp[i] = (const float*)d_in[i]; }
    cx.ws = (unsigned char*)d_ws; cx.dob = (unsigned char*)d_out;
    (void)hipMemsetAsync((unsigned char*)d_ws + WS_CTL, 0, 64 * 1024, stream);
    void* args[] = {&cx};
    hipError_t e = hipLaunchCooperativeKernel((const void*)mega_fwd, dim3(grid_blocks), dim3(512), args, kDynLds, stream);
    if (e != hipSuccess) fprintf(stderr, "cooperative launch failed: %s (grid %d)\n", hipGetErrorString(e), grid_blocks);
}
```

```cpp
#include <hip/hip_runtime.h>
#include <stdint.h>
#include <cstdio>
#include <hip/hip_cooperative_groups.h>
namespace cg = cooperative_groups;

typedef unsigned short bf16_t;
__device__ __forceinline__ int tidf() { int t = (int)__builtin_amdgcn_workitem_id_x(); asm volatile("" : "+v"(t)); return t; }
__device__ __forceinline__ float bf2f(bf16_t v) { return __uint_as_float(((unsigned)v) << 16); }
__device__ __forceinline__ bf16_t f2bf(float f) { const __bf16 b = (__bf16)f; return __builtin_bit_cast(unsigned short, b); }

constexpr int NB = 2, SEQ = 8192, DM = 1024, NMETA = 16, TT = 8208;
constexpr int MX = 16384, MROWS = 16416, MP = 16640;
constexpr int NPROJ = 8192;
constexpr int C_Q = 0, C_K = 512, C_V = 1024, C_G = 2048, C_U = 3072, C_GA = 6144, C_GB = 7168;
constexpr int NE = 16, CAP = 1026, ER = 2304, FF = 2048;
constexpr int EM = 2048, EL = 2 * CAP - EM, EROWS = NE * EM + NE * EL;
__device__ __forceinline__ int exp_row(int e, int ml) { return ml < EM ? e * EM + ml : NE * EM + e * EL + (ml - EM); }
constexpr int NCH = 65;
constexpr int GL = 16640;
constexpr int ZL = 8320;
constexpr float RMS_EPS = 1e-6f;

constexpr size_t MiB = 1u << 20;
constexpr size_t WS_CTL = 0;
constexpr size_t WS_WRET = 1 * MiB, WS_WHY = 3 * MiB, WS_WO = 5 * MiB;
constexpr size_t WS_MISC = 7 * MiB;
constexpr size_t WS_XN = 12 * MiB;
constexpr size_t WS_PROJ = 48 * MiB;
constexpr size_t WS_S = 308 * MiB;
constexpr size_t WS_ZT = 374 * MiB;
constexpr size_t WS_G = 407 * MiB;
constexpr size_t WS_ARET = 440 * MiB;
constexpr size_t WS_WGU = 48 * MiB;
constexpr size_t WS_WD = 176 * MiB;
constexpr size_t WS_XE = 240 * MiB;
constexpr size_t WS_HID = 312 * MiB;
constexpr size_t WS_END = 456 * MiB;
constexpr size_t DO_WIN = 0;
constexpr size_t DO_ROPE = 16 * MiB;
constexpr size_t DO_HDN = 22 * MiB;
constexpr size_t DO_YCT = 0;
constexpr size_t MI_AFF = 0;
constexpr size_t MI_IDX = 1 * MiB + 64 * 1024;
constexpr size_t MI_GATE = 1 * MiB + 256 * 1024;
constexpr size_t MI_INV = 2 * MiB;
constexpr size_t MI_H2M = 3 * MiB + 256 * 1024;

constexpr size_t PJ_Q = 0, PJ_K = (size_t)MP * 512, PJ_V = (size_t)MP * 1024, PJ_G = (size_t)MP * 2048, PJ_U = (size_t)MP * 3072, PJ_GA = (size_t)MP * 6144, PJ_GB = (size_t)MP * 7168;
__device__ __forceinline__ size_t pj_q(int h, int m) { return PJ_Q + ((size_t)h * MP + m) * 128; }
__device__ __forceinline__ size_t pj_k(int h, int m) { return PJ_K + ((size_t)h * MP + m) * 128; }
__device__ __forceinline__ size_t pj_v(int h, int m) { return PJ_V + ((size_t)h * MP + m) * 256; }
__device__ __forceinline__ size_t pj_g(int h, int m) { return PJ_G + ((size_t)h * MP + m) * 256; }
__device__ __forceinline__ size_t pj_u(int sec, int m) { return PJ_U + ((size_t)sec * MP + m) * 1024; }
__device__ __forceinline__ size_t pj_ga(int m) { return PJ_GA + (size_t)m * 1024; }
__device__ __forceinline__ size_t pj_gb(int m) { return PJ_GB + (size_t)m * 1024; }
__device__ __forceinline__ size_t pj_col(int m, int col) {
    if (col < 512) return pj_q(col >> 7, m) + (col & 127);
    if (col < 1024) return pj_k((col - 512) >> 7, m) + (col & 127);
    if (col < 2048) return pj_v((col - 1024) >> 8, m) + (col & 255);
    if (col < 3072) return pj_g((col - 2048) >> 8, m) + (col & 255);
    if (col < 6144) return pj_u((col - 3072) >> 10, m) + ((col - 3072) & 1023);
    if (col < 7168) return pj_ga(m) + (col - 6144);
    return pj_gb(m) + (col - 7168);
}
__device__ __forceinline__ int row_of(int b, int t) { return t < NMETA ? MX + b * NMETA + t : b * SEQ + (t - NMETA); }
__device__ __forceinline__ void bt_of(int m, int& b, int& t) { if (m < MX) { b = m >> 13; t = (m & 8191) + NMETA; } else { b = (m - MX) >> 4; t = (m - MX) & 15; } }


__device__ __forceinline__ float block_sum256(float v, float* red) {
    for (int o = 32; o > 0; o >>= 1) v += __shfl_xor(v, o);
    const int w = tidf() >> 6;
    __syncthreads();
    if ((tidf() & 63) == 0) red[w] = v;
    __syncthreads();
    return red[0] + red[1] + red[2] + red[3];
}


struct EpiArgs {
    bf16_t* PROJ; const float* ROPE;
    bf16_t* TMP; bf16_t* MIXED;
    const float* x; const float* meta; bf16_t* H2;
    bf16_t* HID; bf16_t* YE; const float* GATEV;
};
typedef float f32x4 __attribute__((ext_vector_type(4)));
typedef float f32x16 __attribute__((ext_vector_type(16)));
typedef unsigned u32x4 __attribute__((ext_vector_type(4)));
typedef unsigned u32x2 __attribute__((ext_vector_type(2)));
typedef short bf16x8 __attribute__((ext_vector_type(8)));
typedef float f32x2_t __attribute__((ext_vector_type(2))); typedef __bf16 bf16x2_t __attribute__((ext_vector_type(2)));
__device__ __forceinline__ unsigned pk2(float lo, float hi) { const f32x2_t v = {lo, hi}; const bf16x2_t b = __builtin_convertvector(v, bf16x2_t); return __builtin_bit_cast(unsigned, b); }
__device__ __forceinline__ float lo16(unsigned w) { return __uint_as_float(w << 16); }
__device__ __forceinline__ float hi16(unsigned w) { return __uint_as_float(w & 0xffff0000u); }
__device__ __forceinline__ float sigm(float x) { return __builtin_amdgcn_rcpf(1.f + __expf(-x)); }
__device__ __forceinline__ u32x4 pack8(f32x4 a, f32x4 b) { u32x4 w; w.x = pk2(a.x, a.y); w.y = pk2(a.z, a.w); w.z = pk2(b.x, b.y); w.w = pk2(b.z, b.w); return w; }
__device__ __forceinline__ unsigned pk4_fp8(float a, float b, float c, float d) {
    a = __builtin_amdgcn_fmed3f(a, -448.f, 448.f); b = __builtin_amdgcn_fmed3f(b, -448.f, 448.f); c = __builtin_amdgcn_fmed3f(c, -448.f, 448.f); d = __builtin_amdgcn_fmed3f(d, -448.f, 448.f);
    int p = __builtin_amdgcn_cvt_pk_fp8_f32(a, b, 0, false); p = __builtin_amdgcn_cvt_pk_fp8_f32(c, d, p, true); return (unsigned)p;
}
constexpr float F8_WSCALE = 32.f, F8_HSCALE = 4.f;
__device__ __forceinline__ void epi8v(int mode, const EpiArgs& E, int mg, int c0, f32x4 a0, f32x4 a1) {
    if (mode == 1) {
        bf16_t* dst = E.PROJ + pj_col(mg, c0);
        if (c0 < C_V) {
            int b, t; bt_of(mg, b, t);
            const int i0 = ((c0 & 127) >> 3) * 4;
            const float sc = c0 >= C_K ? 0.08838834764831845f : 1.0f;
            const f32x4 cs = *(const f32x4*)(E.ROPE + (size_t)t * 128 + i0), sn = *(const f32x4*)(E.ROPE + (size_t)t * 128 + 64 + i0);
            const f32x4 o1 = (a0 * cs - a1 * sn) * sc, o2 = (a0 * sn + a1 * cs) * sc;
            *(u32x4*)dst = pack8(o1, o2);
        } else if (c0 < C_G || (c0 >= C_U && c0 < C_GA)) { *(u32x4*)dst = pack8(a0, a1); }
        else if (c0 < C_U) { f32x4 s0, s1; for (int j = 0; j < 4; ++j) { s0[j] = a0[j] * sigm(a0[j]); s1[j] = a1[j] * sigm(a1[j]); } *(u32x4*)dst = pack8(s0, s1); }
        else { f32x4 s0, s1; for (int j = 0; j < 4; ++j) { s0[j] = sigm(a0[j]); s1[j] = sigm(a1[j]); } *(u32x4*)dst = pack8(s0, s1); }
    } else if (mode == 2) {
        const u32x4 g = *(const u32x4*)(E.PROJ + pj_ga(mg) + c0);
        *(u32x4*)(E.TMP + (size_t)mg * DM + c0) = pack8((f32x4){lo16(g.x) * a0.x, hi16(g.x) * a0.y, lo16(g.y) * a0.z, hi16(g.y) * a0.w}, (f32x4){lo16(g.z) * a1.x, hi16(g.z) * a1.y, lo16(g.w) * a1.z, hi16(g.w) * a1.w});
    } else if (mode == 3) {
        const u32x4 g = *(const u32x4*)(E.PROJ + pj_gb(mg) + c0);
        const u32x4 t = *(const u32x4*)(E.TMP + (size_t)mg * DM + c0);
        const f32x4 o0 = (f32x4){lo16(t.x), hi16(t.x), lo16(t.y), hi16(t.y)} + (f32x4){lo16(g.x) * a0.x, hi16(g.x) * a0.y, lo16(g.y) * a0.z, hi16(g.y) * a0.w};
        const f32x4 o1 = (f32x4){lo16(t.z), hi16(t.z), lo16(t.w), hi16(t.w)} + (f32x4){lo16(g.z) * a1.x, hi16(g.z) * a1.y, lo16(g.w) * a1.z, hi16(g.w) * a1.w};
        *(u32x4*)(E.MIXED + (size_t)mg * DM + c0) = pack8(o0, o1);
    } else if (mode == 4) {
        const float* rs = mg < MX ? E.x + (size_t)mg * DM + c0 : E.meta + (size_t)((mg - MX) & 15) * DM + c0;
        *(u32x4*)(E.H2 + (size_t)mg * DM + c0) = pack8(*(const f32x4*)rs + a0, *(const f32x4*)(rs + 4) + a1);
    } else if (mode == 5) {
        const f32x4 g = a0 * (1.f / F8_WSCALE), u = a1 * (F8_HSCALE / F8_WSCALE);
        *(unsigned*)((unsigned char*)E.HID + (size_t)mg * FF + (c0 >> 1)) = pk4_fp8(g.x * sigm(g.x) * u.x, g.y * sigm(g.y) * u.y, g.z * sigm(g.z) * u.z, g.w * sigm(g.w) * u.w);
    } else {
        int e, ml; if (mg < NE * EM) { e = mg >> 11; ml = mg & (EM - 1); } else { e = (mg - NE * EM) >> 2; ml = EM + ((mg - NE * EM) & 3); }
        const float gt = (ml < 2 * CAP ? E.GATEV[((size_t)(ml / CAP) * NE + e) * CAP + (ml % CAP)] : 0.f) * (1.f / (F8_WSCALE * F8_HSCALE));
        *(u32x4*)(E.YE + (size_t)mg * DM + c0) = pack8(a0 * gt, a1 * gt);
    }
}


namespace pg8 {
#define PG8_LAS __attribute__((address_space(3)))
typedef unsigned short bf16_t;
typedef short bf16x8 __attribute__((ext_vector_type(8)));
typedef float f32x4 __attribute__((ext_vector_type(4)));
typedef unsigned u32x4 __attribute__((ext_vector_type(4)));
constexpr int BM = 256, BK = 64, HALF = 128, HTB = HALF * BK * 2  , STAGE_BYTES = 8 * HTB, NXCD = 8, WGM = 8;

__host__ __device__ __forceinline__ int lds_byte(int r, int c) { const int st = (r >> 4) * 2 + (c >> 5), rr = r & 15, cc = c & 31, ob = rr * 64 + cc * 2; return st * 1024 + (ob ^ (((ob >> 9) & 1) << 5)); }
__host__ __device__ __forceinline__ void stage_rc(int b, int& R, int& C) { const int st = b / 1024, sb = b % 1024, swz = sb ^ (((sb >> 9) & 1) << 5); R = (st >> 1) * 16 + swz / 64; C = (st & 1) * 32 + (swz % 64) / 2; }
__host__ __device__ __forceinline__ int perm32(int rho) { const int n = rho >> 4, i = rho & 15; return 8 * (i >> 2) + 4 * n + (i & 3); }

struct Unit { int pm, pn; };
struct Gemm { const bf16_t* A; const bf16_t* Bt; int M, N, K; int gt; size_t gstride; };

struct StaticOrder {
    int nM, nN, nwg, G, c;
    __host__ __device__ void init(int M, int N, int G_, int c_) { nM = M / BM; nN = N / BM; nwg = nM * nN; G = G_; c = c_; }
    __host__ __device__ bool next(int i, Unit& u) const {
        const long L = (long)i * G + c; if (L >= nwg) return false;
        int wgid = (int)L; { const int q = nwg / NXCD, r = nwg % NXCD, xcd = wgid % NXCD, off = wgid / NXCD; wgid = (xcd < r ? xcd * (q + 1) : r * (q + 1) + (xcd - r) * q) + off; }
        const int nig = WGM * nN, gid = wgid / nig, fm = gid * WGM, gsz = (nM - fm) < WGM ? (nM - fm) : WGM;
        u.pm = fm + ((wgid % nig) % gsz); u.pn = (wgid % nig) / gsz; return true;
    }
    __device__ __forceinline__ void a_ready(const Unit&) const {}
    __device__ __forceinline__ void done(const Unit&) const {}
};

__device__ __forceinline__ unsigned cvt_pk_bf16(float lo, float hi) { unsigned r; asm volatile("v_cvt_pk_bf16_f32 %0, %1, %2" : "=v"(r) : "v"(lo), "v"(hi)); return r; }
typedef int i32x8 __attribute__((ext_vector_type(8)));
typedef int i32x4v __attribute__((ext_vector_type(4)));
template <class Epi, class Sched, bool ALIGN_EPI = false, bool SP2 = false, bool FP8 = false, bool IND = false>
__device__ __forceinline__ void gemm_phase(PG8_LAS unsigned char* lds, const Gemm g, const Sched& S, const Epi& E, const PG8_LAS unsigned* rtab = nullptr) {
    static_assert(!IND || SP2, "indirect rows are wired into the SP2 loop only");
    const int tid = tidf(), wid = __builtin_amdgcn_readfirstlane(tid >> 6), lane = tid & 63, wr = wid >> 2, wc = wid & 3, fr = lane & 15, fq = lane >> 4;
    const int K = g.K, nt = K / BK;
    unsigned voffA[2], voffB[2]; int rowA[2]; unsigned colA2[2];
    unsigned vA[2][2], vN[2][2], vS[2][2];
#pragma unroll
    for (int i = 0; i < 2; ++i) { int R, C; stage_rc(tid * 16 + i * 8192, R, C); const int Rb = Epi::PERM ? ((R & ~31) + perm32(R & 31)) : R;
        voffA[i] = (unsigned)(R * K + C) * 2u; voffB[i] = (unsigned)(Rb * K + C) * 2u; rowA[i] = R; colA2[i] = (unsigned)C * 2u; }
    const size_t kstep = (size_t)(BK * 2);
    const size_t hstep = (size_t)HALF * K * 2;
    const size_t tstep = 2 * hstep;
    const unsigned ldsw = (unsigned)wid * 1024u;
    const int aoff = lds_byte(wr * 64 + fr, fq * 8), boff = lds_byte(wc * 32 + fr, fq * 8);
#define PG8_SA(b, h) (((b) * 2 + (h)) * HTB)
#define PG8_SB(b, h) ((4 + (b) * 2 + (h)) * HTB)
#define PG8_RTAB(dst, ui_) do { _Pragma("unroll") for (int h_ = 0; h_ < 2; ++h_) _Pragma("unroll") for (int i_ = 0; i_ < 2; ++i_) dst[h_][i_] = rtab[(ui_) * 256 + 128 * h_ + rowA[i_]] + colA2[i_]; } while (0)
#define PG8_STAGE_A(bufoff, gbase, h, V) do { if constexpr (IND) { _Pragma("unroll") for (int _i = 0; _i < 2; ++_i) \
        __builtin_amdgcn_global_load_lds((const unsigned*)((const char*)(gbase) + V[h][_i]), (PG8_LAS unsigned*)(lds + (bufoff) + ldsw + _i * 8192), 16, 0, 0); } \
    else { PG8_STAGE(bufoff, (const char*)(gbase) + (h) * hstep, voffA); } } while (0)
#define PG8_STAGE(bufoff, gbase, voff) do { _Pragma("unroll") for (int _i = 0; _i < 2; ++_i) \
        __builtin_amdgcn_global_load_lds((const unsigned*)((const char*)(gbase) + (voff)[_i]), (PG8_LAS unsigned*)(lds + (bufoff) + ldsw + _i * 8192), 16, 0, 0); } while (0)
#define PG8_LDA(dst, b, h) do { _Pragma("unroll") for (int m = 0; m < 4; ++m) _Pragma("unroll") for (int k = 0; k < 2; ++k) dst[m][k] = *(const PG8_LAS bf16x8*)(lds + PG8_SA(b, h) + aoff + m * 2048 + k * 1024); } while (0)
#define PG8_LDB(dst, b, h) do { _Pragma("unroll") for (int n = 0; n < 2; ++n) _Pragma("unroll") for (int k = 0; k < 2; ++k) dst[n][k] = *(const PG8_LAS bf16x8*)(lds + PG8_SB(b, h) + boff + n * 2048 + k * 1024); } while (0)
#define PG8_CAT(X) __builtin_shufflevector(__builtin_bit_cast(i32x4v, X[0]), __builtin_bit_cast(i32x4v, X[1]), 0, 1, 2, 3, 4, 5, 6, 7)
#define PG8_MMA(ai, bj, At, Bt) do { __builtin_amdgcn_s_setprio(1); if constexpr (FP8) {   \
        _Pragma("unroll") for (int m = 0; m < 4; ++m) _Pragma("unroll") for (int n = 0; n < 2; ++n) \
            { const i32x8 b8_ = PG8_CAT(Bt[n]), a8_ = PG8_CAT(At[m]);   \
              asm volatile("v_mfma_scale_f32_16x16x128_f8f6f4 %0, %1, %2, %0, %3, %3 op_sel_hi:[0,0,0]" : "+v"(acc[ai][bj][m][n]) : "v"(b8_), "v"(a8_), "v"(f8scale)); } \
    } else { _Pragma("unroll") for (int m = 0; m < 4; ++m) _Pragma("unroll") for (int n = 0; n < 2; ++n) _Pragma("unroll") for (int k = 0; k < 2; ++k) \
        acc[ai][bj][m][n] = __builtin_amdgcn_mfma_f32_16x16x32_bf16(Bt[n][k], At[m][k], acc[ai][bj][m][n], 0, 0, 0); } __builtin_amdgcn_s_setprio(0); } while (0)
#define PG8_WAIT_V(n) asm volatile("s_waitcnt vmcnt(" #n ")" ::: "memory")
#define PG8_WAIT_L(n) asm volatile("s_waitcnt lgkmcnt(" #n ")" ::: "memory")
#define PG8_BAR __builtin_amdgcn_s_barrier()
#define PG8_SCHED __builtin_amdgcn_sched_barrier(0)
    Unit cur, nxt; int ui = 0;
    if (!S.next(0, cur)) return;
    const int f8scale = 0x7f7f7f7f;
    f32x4 acc[2][2][4][2];
#pragma unroll
    for (int a = 0; a < 2; ++a)
#pragma unroll
        for (int b = 0; b < 2; ++b)
#pragma unroll
            for (int m = 0; m < 4; ++m)
#pragma unroll
                for (int n = 0; n < 2; ++n) acc[a][b][m][n] = (f32x4){0.f, 0.f, 0.f, 0.f};
    bf16x8 At[4][2], B0[2][2], B1[2][2];
    const char* cA = (const char*)g.A + (IND ? (size_t)0 : (size_t)cur.pm * tstep); const char* cB = (const char*)g.Bt + (size_t)(cur.pm / g.gt) * g.gstride + (size_t)cur.pn * tstep;
    S.a_ready(cur);
    if constexpr (SP2) {
        if constexpr (IND) { PG8_RTAB(vA, 0); asm volatile("s_waitcnt lgkmcnt(0)" ::: "memory"); }
        PG8_STAGE(PG8_SB(0, 0), cB, voffB); PG8_STAGE(PG8_SB(0, 1), cB + hstep, voffB); PG8_STAGE_A(PG8_SA(0, 0), cA, 0, vA); PG8_STAGE_A(PG8_SA(0, 1), cA, 1, vA);
        if (wr == 1) PG8_BAR;
        PG8_WAIT_V(2); PG8_BAR;
        PG8_STAGE(PG8_SB(1, 0), cB + kstep, voffB); PG8_STAGE_A(PG8_SA(1, 0), cA + kstep, 0, vA); PG8_STAGE(PG8_SB(1, 1), cB + hstep + kstep, voffB);
        PG8_WAIT_V(6); PG8_BAR;
    } else {
        PG8_STAGE(PG8_SB(0, 0), cB, voffB); PG8_STAGE(PG8_SA(0, 0), cA, voffA); PG8_STAGE(PG8_SB(0, 1), cB + hstep, voffB); PG8_STAGE(PG8_SA(0, 1), cA + hstep, voffA);
        if (wr == 1) PG8_BAR;
        PG8_WAIT_V(4); PG8_BAR;
        PG8_STAGE(PG8_SB(1, 0), cB + kstep, voffB); PG8_STAGE(PG8_SA(1, 0), cA + kstep, voffA); PG8_STAGE(PG8_SB(1, 1), cB + hstep + kstep, voffB);
        PG8_WAIT_V(6); PG8_BAR;
    }
    for (;;) {
        const bool has_next = S.next(ui + 1, nxt);
        const char* nA = has_next ? (const char*)g.A + (IND ? (size_t)0 : (size_t)nxt.pm * tstep) : cA; const char* nB = has_next ? (const char*)g.Bt + (size_t)(nxt.pm / g.gt) * g.gstride + (size_t)nxt.pn * tstep : cB;
        for (int t = 0; t < nt; t += 2) {
            const bool last = (t == nt - 2);
            const char* a1 = cA + (size_t)(t + 1) * kstep;
            const char* a2 = last ? nA : cA + (size_t)(t + 2) * kstep; const char* b2 = last ? nB : cB + (size_t)(t + 2) * kstep;
            const char* a3 = a2 + kstep; const char* b3 = b2 + kstep;
            if (last && has_next) S.a_ready(nxt);
            if constexpr (IND) { if (last && has_next) PG8_RTAB(vN, ui + 1);
                _Pragma("unroll") for (int h_ = 0; h_ < 2; ++h_) _Pragma("unroll") for (int i_ = 0; i_ < 2; ++i_) vS[h_][i_] = (last && has_next) ? vN[h_][i_] : vA[h_][i_]; }
            if constexpr (SP2) {
            PG8_LDB(B0, 0, 0); PG8_LDB(B1, 0, 1); PG8_SCHED; PG8_LDA(At, 0, 0); PG8_STAGE_A(PG8_SA(1, 1), a1, 1, vA);
            PG8_WAIT_V(8); PG8_WAIT_L(0); PG8_BAR; PG8_MMA(0, 0, At, B0); PG8_MMA(0, 1, At, B1); PG8_BAR; PG8_SCHED;
            PG8_LDA(At, 0, 1); PG8_STAGE(PG8_SB(0, 0), b2, voffB); PG8_STAGE(PG8_SB(0, 1), b2 + hstep, voffB); PG8_STAGE_A(PG8_SA(0, 0), a2, 0, vS);
            PG8_WAIT_V(8); PG8_WAIT_L(0); PG8_BAR; PG8_MMA(1, 0, At, B0); PG8_MMA(1, 1, At, B1); PG8_BAR; PG8_SCHED;
            PG8_LDB(B0, 1, 0); PG8_LDB(B1, 1, 1); PG8_SCHED; PG8_LDA(At, 1, 0); PG8_STAGE_A(PG8_SA(0, 1), a2, 1, vS);
            PG8_WAIT_V(8); PG8_WAIT_L(0); PG8_BAR; PG8_MMA(0, 0, At, B0); PG8_MMA(0, 1, At, B1); PG8_BAR; PG8_SCHED;
            PG8_LDA(At, 1, 1); PG8_STAGE(PG8_SB(1, 0), b3, voffB); PG8_STAGE(PG8_SB(1, 1), b3 + hstep, voffB); PG8_STAGE_A(PG8_SA(1, 0), a3, 0, vS);
            PG8_WAIT_V(8); PG8_WAIT_L(0); PG8_BAR; PG8_MMA(1, 0, At, B0); PG8_MMA(1, 1, At, B1); PG8_BAR; PG8_SCHED;
            } else {
            PG8_LDB(B0, 0, 0); PG8_SCHED; PG8_LDA(At, 0, 0); PG8_STAGE(PG8_SA(1, 1), a1 + hstep, voffA);
            PG8_WAIT_L(8); PG8_BAR; PG8_WAIT_L(0); PG8_MMA(0, 0, At, B0); PG8_BAR; PG8_SCHED;
            PG8_LDB(B1, 0, 1); PG8_STAGE(PG8_SB(0, 0), b2, voffB);
            PG8_BAR; PG8_WAIT_L(0); PG8_MMA(0, 1, At, B1); PG8_BAR;
            PG8_LDA(At, 0, 1); PG8_STAGE(PG8_SA(0, 0), a2, voffA);
            PG8_BAR; PG8_WAIT_L(0); PG8_MMA(1, 0, At, B0); PG8_BAR; PG8_SCHED;
            PG8_STAGE(PG8_SB(0, 1), b2 + hstep, voffB);
            PG8_WAIT_V(6); PG8_BAR; PG8_MMA(1, 1, At, B1); PG8_BAR;
            PG8_LDB(B0, 1, 0); PG8_SCHED; PG8_LDA(At, 1, 0); PG8_STAGE(PG8_SA(0, 1), a2 + hstep, voffA);
            PG8_WAIT_L(8); PG8_BAR; PG8_WAIT_L(0); PG8_MMA(0, 0, At, B0); PG8_BAR; PG8_SCHED;
            PG8_LDB(B1, 1, 1); PG8_STAGE(PG8_SB(1, 0), b3, voffB);
            PG8_BAR; PG8_WAIT_L(0); PG8_MMA(0, 1, At, B1); PG8_BAR;
            PG8_LDA(At, 1, 1); PG8_STAGE(PG8_SA(1, 0), a3, voffA);
            PG8_BAR; PG8_WAIT_L(0); PG8_MMA(1, 0, At, B0); PG8_BAR; PG8_SCHED;
            PG8_STAGE(PG8_SB(1, 1), b3 + hstep, voffB);
            PG8_WAIT_V(6); PG8_BAR; PG8_MMA(1, 1, At, B1); PG8_BAR;
            }
        }
        if constexpr (FP8) asm volatile("s_nop 15\n\ts_nop 15" ::: "memory");
        if constexpr (ALIGN_EPI) { if (wr == 0) PG8_BAR; }
        if constexpr (!Epi::AFTER_DRAIN) { E(acc, cur, wr, wc, fr, fq); S.done(cur); }
        if (!has_next) break;
#pragma unroll
        for (int a = 0; a < 2; ++a)
#pragma unroll
            for (int b = 0; b < 2; ++b)
#pragma unroll
                for (int m = 0; m < 4; ++m)
#pragma unroll
                    for (int n = 0; n < 2; ++n) acc[a][b][m][n] = (f32x4){0.f, 0.f, 0.f, 0.f};
        cur = nxt; cA = nA; cB = nB; ++ui;
        if constexpr (IND) { _Pragma("unroll") for (int h_ = 0; h_ < 2; ++h_) _Pragma("unroll") for (int i_ = 0; i_ < 2; ++i_) vA[h_][i_] = vN[h_][i_]; }
        if constexpr (ALIGN_EPI) { if (wr == 1) PG8_BAR; }
    }
    PG8_WAIT_V(0);
    if constexpr (!ALIGN_EPI) { if (wr == 0) PG8_BAR; }
    PG8_BAR;
    if constexpr (Epi::AFTER_DRAIN) { E.fused(acc, cur, wr, wc, fr, fq, lds, wid, lane); S.done(cur); }
#undef PG8_SA
#undef PG8_SB
#undef PG8_STAGE
#undef PG8_STAGE_A
#undef PG8_RTAB
#undef PG8_LDA
#undef PG8_LDB
#undef PG8_MMA
#undef PG8_CAT
#undef PG8_WAIT_V
#undef PG8_WAIT_L
#undef PG8_BAR
#undef PG8_SCHED
}
}

#define LAS __attribute__((address_space(3)))
template <int MODE> struct EpiFast {
    static constexpr bool PERM = true, AFTER_DRAIN = false;
    EpiArgs E;
    __device__ __forceinline__ void operator()(const pg8::f32x4 (&acc)[2][2][4][2], const pg8::Unit& u, int wr, int wc, int fr, int fq) const {
        const int row0 = u.pm * 256 + wr * 64 + fr, col0 = u.pn * 256 + wc * 32 + 8 * fq;
        if constexpr (MODE == 2 || MODE == 3 || MODE == 4) {
#pragma unroll
            for (int ai = 0; ai < 2; ++ai) {
                u32x4 g[4][2], t[4][2]; f32x4 x0[4][2], x1[4][2];
#pragma unroll
                for (int m = 0; m < 4; ++m)
#pragma unroll
                    for (int bj = 0; bj < 2; ++bj) { const int mg = row0 + ai * 128 + m * 16, c0 = col0 + bj * 128;
                        if constexpr (MODE == 2) g[m][bj] = *(const u32x4*)(E.PROJ + pj_ga(mg) + c0);
                        if constexpr (MODE == 3) { g[m][bj] = *(const u32x4*)(E.PROJ + pj_gb(mg) + c0); t[m][bj] = *(const u32x4*)(E.TMP + (size_t)mg * DM + c0); }
                        if constexpr (MODE == 4) { const float* rs = E.x + (size_t)mg * DM + c0; x0[m][bj] = *(const f32x4*)rs; x1[m][bj] = *(const f32x4*)(rs + 4); } }
#pragma unroll
                for (int m = 0; m < 4; ++m)
#pragma unroll
                    for (int bj = 0; bj < 2; ++bj) { const int mg = row0 + ai * 128 + m * 16, c0 = col0 + bj * 128; const f32x4 a0 = acc[ai][bj][m][0], a1 = acc[ai][bj][m][1];
                        if constexpr (MODE == 4) { *(u32x4*)(E.H2 + (size_t)mg * DM + c0) = pack8(x0[m][bj] + a0, x1[m][bj] + a1); }
                        else { const u32x4 gg = g[m][bj];
                            const f32x4 p0 = (f32x4){lo16(gg.x) * a0.x, hi16(gg.x) * a0.y, lo16(gg.y) * a0.z, hi16(gg.y) * a0.w}, p1 = (f32x4){lo16(gg.z) * a1.x, hi16(gg.z) * a1.y, lo16(gg.w) * a1.z, hi16(gg.w) * a1.w};
                            if constexpr (MODE == 2) *(u32x4*)(E.TMP + (size_t)mg * DM + c0) = pack8(p0, p1);
                            else { const u32x4 tt = t[m][bj]; *(u32x4*)(E.MIXED + (size_t)mg * DM + c0) = pack8((f32x4){lo16(tt.x), hi16(tt.x), lo16(tt.y), hi16(tt.y)} + p0, (f32x4){lo16(tt.z), hi16(tt.z), lo16(tt.w), hi16(tt.w)} + p1); } } }
            }
        } else {
#pragma unroll
        for (int ai = 0; ai < 2; ++ai)
#pragma unroll
            for (int m = 0; m < 4; ++m)
#pragma unroll
                for (int bj = 0; bj < 2; ++bj) epi8v(MODE, E, row0 + ai * 128 + m * 16, col0 + bj * 128, acc[ai][bj][m][0], acc[ai][bj][m][1]);
        }
    }
};
__device__ __forceinline__ void side_tile(int mode, const EpiArgs& E, const bf16_t* __restrict__ A, int erow0, const bf16_t* __restrict__ Bt, int K, int n0, LAS unsigned char* lds) {
    const int tid = tidf(), l = tid & 63, wid = tid >> 6, i = l & 31, h = l >> 5;
    const int g = i >> 3, hh = (i >> 2) & 1, q = i & 3, L = 8 * (2 * hh + (g >> 1)) + 4 * (g & 1) + q;
    const int kw = K / 8;
    const bf16_t* wp = Bt + (size_t)(n0 + L) * K + wid * kw + 8 * h;
    const bf16_t* xp = A + (size_t)i * K + wid * kw + 8 * h;
    f32x16 acc; for (int r = 0; r < 16; ++r) acc[r] = 0.f;
#pragma unroll 8
    for (int k0 = 0; k0 < kw; k0 += 16) { const bf16x8 wf = *(const bf16x8*)(wp + k0), xf = *(const bf16x8*)(xp + k0); acc = __builtin_amdgcn_mfma_f32_32x32x16_bf16(wf, xf, acc, 0, 0, 0); }
    LAS float* red = (LAS float*)lds;
    __syncthreads();
#pragma unroll
    for (int r = 0; r < 16; ++r) red[(wid * 16 + r) * 64 + l] = acc[r];
    __syncthreads();
    if (wid == 0) {
#pragma unroll
        for (int r = 0; r < 16; ++r) { float s = 0.f;
#pragma unroll
            for (int w = 0; w < 8; ++w) s += red[(w * 16 + r) * 64 + l];
            acc[r] = s; }
        epi8v(mode, E, erow0 + i, n0 + 16 * h, (f32x4){acc[0], acc[1], acc[2], acc[3]}, (f32x4){acc[4], acc[5], acc[6], acc[7]});
        epi8v(mode, E, erow0 + i, n0 + 16 * h + 8, (f32x4){acc[8], acc[9], acc[10], acc[11]}, (f32x4){acc[12], acc[13], acc[14], acc[15]});
    }
}
__device__ __forceinline__ void side_tile8(int mode, const EpiArgs& E, int e, const unsigned char* __restrict__ X, const int* __restrict__ idx, const unsigned char* __restrict__ Wt, int K, int n0) {
    typedef int i32x8s __attribute__((ext_vector_type(8)));
    const int l = tidf() & 63, i = l & 31, h = l >> 5;
    const int g = i >> 3, hh = (i >> 2) & 1, q = i & 3, L = 8 * (2 * hh + (g >> 1)) + 4 * (g & 1) + q;
    const unsigned char* wp = Wt + (size_t)(n0 + L) * K + 32 * h;
    const bool xv = i < EL;
    const unsigned char* xp;
    if (mode == 5) { const int ml = EM + (xv ? i : 0), b = ml / CAP; xp = X + (size_t)row_of(b, idx[((size_t)b * NE + e) * CAP + (ml - b * CAP)]) * K + 32 * h; }
    else xp = X + (size_t)(NE * EM + e * EL + (xv ? i : 0)) * K + 32 * h;
    f32x16 acc; for (int r = 0; r < 16; ++r) acc[r] = 0.f;
#pragma unroll 4
    for (int k0 = 0; k0 < K; k0 += 64) {
        const u32x4 w0 = *(const u32x4*)(wp + k0), w1 = *(const u32x4*)(wp + k0 + 16); u32x4 x0 = *(const u32x4*)(xp + k0), x1 = *(const u32x4*)(xp + k0 + 16);
        if (!xv) { x0 = (u32x4){0u, 0u, 0u, 0u}; x1 = x0; }
        const i32x8s wf = {(int)w0.x, (int)w0.y, (int)w0.z, (int)w0.w, (int)w1.x, (int)w1.y, (int)w1.z, (int)w1.w}, xf = {(int)x0.x, (int)x0.y, (int)x0.z, (int)x0.w, (int)x1.x, (int)x1.y, (int)x1.z, (int)x1.w};
        acc = __builtin_amdgcn_mfma_scale_f32_32x32x64_f8f6f4(wf, xf, acc, 0, 0, 0, 0x7f7f7f7f, 0, 0x7f7f7f7f);
    }
    if (xv) {
        const int mg = NE * EM + e * EL + i;
        epi8v(mode, E, mg, n0 + 16 * h, (f32x4){acc[0], acc[1], acc[2], acc[3]}, (f32x4){acc[4], acc[5], acc[6], acc[7]});
        epi8v(mode, E, mg, n0 + 16 * h + 8, (f32x4){acc[8], acc[9], acc[10], acc[11]}, (f32x4){acc[12], acc[13], acc[14], acc[15]});
    }
}
struct GemmArgs { const bf16_t* A; const bf16_t* Bt; int M, N, K, gt; size_t gstride; int side; int pad; const int* idx; };
#ifndef PG8_ALIGN
#define PG8_ALIGN true
#endif
constexpr int GEMM_LDS = 131072 + 1024;
template <int MODE> __device__ __forceinline__ void gemm_fast_body(LAS unsigned char* lds, const GemmArgs& ga, const EpiArgs& E) {
    if (ga.side) {
        const int nt = ga.N / 32;
        for (int t = blockIdx.x; t < nt; t += gridDim.x) side_tile(MODE, E, ga.A + (size_t)MX * ga.K, MX, ga.Bt, ga.K, t * 32, lds);
        asm volatile("s_waitcnt vmcnt(0)" ::: "memory");
        __syncthreads();
    }
    pg8::Gemm g{ga.A, ga.Bt, ga.M, ga.N, ga.K, ga.gt, ga.gstride};
    pg8::StaticOrder S; S.init(ga.M, ga.N, (int)gridDim.x, (int)blockIdx.x);
    EpiFast<MODE> Ep{E};
    if constexpr (MODE == 5 || MODE == 6) {
        const int nct = ga.N / 32, gw = (tidf() >> 6) * gridDim.x + blockIdx.x;
        for (int t = gw; t < NE * nct; t += 8 * gridDim.x) { const int e = t / nct, ct = t - e * nct;
            side_tile8(MODE, E, e, (const unsigned char*)ga.A, ga.idx, (const unsigned char*)ga.Bt + (size_t)e * ga.gstride, ga.K * 2, ct * 32); }
        asm volatile("s_waitcnt vmcnt(0)" ::: "memory");
    }
    if constexpr (MODE == 5) {
        LAS unsigned* rtab = (LAS unsigned*)(lds + pg8::STAGE_BYTES);
        const int tid = tidf();
        for (int i = 0; i < 12; ++i) { pg8::Unit u; if (!S.next(i, u)) break;
            if (tid < 256) { const int e = u.pm / (EM / 256), ml = (u.pm % (EM / 256)) * 256 + tid; int row = MROWS;
                if (ml < 2 * CAP) { const int b = ml / CAP; row = row_of(b, ga.idx[((size_t)b * NE + e) * CAP + (ml - b * CAP)]); }
                rtab[i * 256 + tid] = (unsigned)row * (unsigned)DM; } }
        __syncthreads();
        pg8::gemm_phase<EpiFast<MODE>, pg8::StaticOrder, PG8_ALIGN, true, true, true>(lds, g, S, Ep, rtab);
    } else
    pg8::gemm_phase<EpiFast<MODE>, pg8::StaticOrder, PG8_ALIGN, true, (MODE >= 5)>(lds, g, S, Ep);
}

__device__ __forceinline__ float log_sigmoid(float x) { return -log1pf(expf(-x)); }
__device__ __forceinline__ int chunk_row(int b, int n, int c) { return n == 0 ? (c >= 112 ? MX + b * 16 + (c - 112) : -1) : b * SEQ + 128 * (n - 1) + c; }


constexpr int QS_STRIDE = 130;
constexpr int R2_LDS = 2 * 128 * QS_STRIDE * 2 + 128 * 128 * 4 + 64 * 4;


constexpr int CV_GR_BYTES = GL * 2;
constexpr int CV_ZROW = 272, CV_ZB = 18176  , CV_Z_BYTES = 2 * CV_ZB;
constexpr int CV_SLOT = CV_GR_BYTES + CV_Z_BYTES;
constexpr int CV_LDS = 2 * CV_SLOT;
__device__ __forceinline__ bf16x8 cv_load_frag(const LAS unsigned char* p, unsigned sh) {
    unsigned X[5];
#pragma unroll
    for (int i = 0; i < 5; ++i) X[i] = *(const LAS unsigned*)(p + 4 * i);
    u32x4 o;
    o.x = __builtin_amdgcn_alignbit(X[1], X[0], sh); o.y = __builtin_amdgcn_alignbit(X[2], X[1], sh);
    o.z = __builtin_amdgcn_alignbit(X[3], X[2], sh); o.w = __builtin_amdgcn_alignbit(X[4], X[3], sh);
    return __builtin_bit_cast(bf16x8, o);
}
__device__ __forceinline__ void conv_fast_body(LAS unsigned char* lds, const bf16_t* __restrict__ G, const bf16_t* __restrict__ ZT, bf16_t* __restrict__ YCT, int c_first) {
    const int tid = tidf(), l = tid & 63, wid = tid >> 6, slot = wid >> 2, ct = wid & 3;
    const int ts = tid & 255;
    LAS unsigned char* grb = lds + slot * CV_SLOT;
    LAS unsigned char* zb = grb + CV_GR_BYTES;
    for (int rd = 0; rd < 2; ++rd) {
        const int c = c_first + 2 * rd + slot;
        __syncthreads();
        {
            const u32x4* gsrc = (const u32x4*)(G + (size_t)c * GL);
            {
                u32x4 gv[9];
#pragma unroll
                for (int k = 0; k < 9; ++k) { const int i = ts + 256 * k; gv[k] = i < GL / 8 ? gsrc[i] : (u32x4){0u, 0u, 0u, 0u}; }
#pragma unroll
                for (int k = 0; k < 9; ++k) { const int i = ts + 256 * k;
                    if (i < GL / 8) { const u32x4 v = gv[k]; u32x4 o;
                        o.x = __builtin_amdgcn_alignbit(v.w, v.w, 16); o.y = __builtin_amdgcn_alignbit(v.z, v.z, 16); o.z = __builtin_amdgcn_alignbit(v.y, v.y, 16); o.w = __builtin_amdgcn_alignbit(v.x, v.x, 16);
                        *(LAS u32x4*)(grb + (size_t)(GL - 8 * (i + 1)) * 2) = o; } }
            }
            asm volatile("" ::: "memory");
            {
                u32x4 zv[9];
#pragma unroll
                for (int k = 0; k < 9; ++k) {
                    const int i = ts + 256 * k; zv[k] = (u32x4){0u, 0u, 0u, 0u};
                    if (i < 2 * 66 * 17) { const int bb = i / (66 * 17), rem = i - bb * (66 * 17), Ib = rem / 17, q = rem - Ib * 17;
                        const bf16_t* zr = ZT + ((size_t)bb * 1024 + c) * ZL;
                        if (q < 16) { if (Ib == 0) { if (q >= 14) zv[k] = *(const u32x4*)(zr + 8 * (q - 14)); } else if (Ib <= 64) zv[k] = *(const u32x4*)(zr + 16 + 128 * (Ib - 1) + 8 * q); } }
                }
#pragma unroll
                for (int k = 0; k < 9; ++k) { const int i = ts + 256 * k;
                    if (i < 2 * 66 * 17) { const int bb = i / (66 * 17), rem = i - bb * (66 * 17), Ib = rem / 17, q = rem - Ib * 17; *(LAS u32x4*)(zb + bb * CV_ZB + Ib * CV_ZROW + q * 16) = zv[k]; } }
            }
        }
        __syncthreads();
        const int r = l & 31, h = l >> 5;
        const int Ec = 8431 + 112 - r + 8 * h;
        const unsigned sh = (unsigned)(Ec & 1) * 16u;
        const int Io = 16 * ct + (r & 15), bcol = r >> 4;
        f32x16 acc[4];
#pragma unroll
        for (int rt = 0; rt < 4; ++rt) for (int q = 0; q < 16; ++q) acc[rt][q] = 0.f;
        bf16x8 F[14];
        int d = 16 * ct - 63;
        const LAS unsigned char* abase = grb + 4 * (Ec >> 1) - 256 * d - 32 * 13;
#pragma unroll
        for (int f = 0; f < 6; ++f) F[f] = cv_load_frag(abase + 32 * (13 - f), sh);
        const int dend = 16 * ct + 16;
        for (; d <= dend; ++d) {
#pragma unroll
            for (int f = 6; f < 10; ++f) F[f] = cv_load_frag(abase + 32 * (13 - f), sh);
            __builtin_amdgcn_sched_barrier(0);
#pragma unroll
            for (int f = 10; f < 14; ++f) F[f] = cv_load_frag(abase + 32 * (13 - f), sh);
            int Ib = Io - d + 1; Ib = (Ib < 0 || Ib > 64) ? 65 : Ib;
            const LAS unsigned char* zp = zb + bcol * CV_ZB + Ib * CV_ZROW + 16 * h;
#pragma unroll
            for (int ks = 0; ks < 8; ++ks) {
                const bf16x8 Bf = *(const LAS bf16x8*)(zp + 32 * ks);
#pragma unroll
                for (int rt = 0; rt < 4; ++rt) acc[rt] = __builtin_amdgcn_mfma_f32_32x32x16_bf16(F[2 * rt - ks + 7], Bf, acc[rt], 0, 0, 0);
            }
#pragma unroll
            for (int f = 0; f < 6; ++f) F[f] = F[f + 8];
            abase -= 256;
        }
        {
            bf16_t* yr = YCT + ((size_t)bcol * 1024 + c) * ZL + 16 + 128 * Io + 4 * h;
#pragma unroll
            for (int rt = 0; rt < 4; ++rt)
#pragma unroll
                for (int g = 0; g < 4; ++g) { u32x2 w; w.x = pk2(acc[rt][4 * g], acc[rt][4 * g + 1]); w.y = pk2(acc[rt][4 * g + 2], acc[rt][4 * g + 3]); *(u32x2*)(yr + 32 * rt + 8 * g) = w; }
        }
        {
            float a0[4], a1[4];
#pragma unroll
            for (int q = 0; q < 4; ++q) { a0[q] = 0.f; a1[q] = 0.f; }
            const LAS bf16_t* grh = (const LAS bf16_t*)grb;
            for (int s = l; s < TT; s += 64) {
                int Ib, j; if (s < 16) { Ib = 0; j = 112 + s; } else { const int s2 = s - 16; Ib = 1 + (s2 >> 7); j = s2 & 127; }
                const float z0 = bf2f(*(const LAS bf16_t*)(zb + Ib * CV_ZROW + 2 * j)), z1 = bf2f(*(const LAS bf16_t*)(zb + CV_ZB + Ib * CV_ZROW + 2 * j));
#pragma unroll
                for (int q = 0; q < 4; ++q) { const float gv = bf2f(grh[8431 - (4 * ct + q) + s]); a0[q] += gv * z0; a1[q] += gv * z1; }
            }
#pragma unroll
            for (int q = 0; q < 4; ++q) {
                float v0 = a0[q], v1 = a1[q];
                for (int o = 32; o > 0; o >>= 1) { v0 += __shfl_xor(v0, o); v1 += __shfl_xor(v1, o); }
                if (l == 0) { YCT[((size_t)0 * 1024 + c) * ZL + 4 * ct + q] = f2bf(v0); YCT[((size_t)1 * 1024 + c) * ZL + 4 * ct + q] = f2bf(v1); }
            }
        }
    }
}


struct Ctx {
    const float *x, *meta, *norm1_g, *w_in, *dec_f, *dec_b, *hg, *w_ret, *cw, *cb, *fw1, *fb1, *fw2, *fb2, *fw3, *fb3, *ffq, *fw4, *skip, *w_hy, *w_o, *norm2_g, *w_router, *w_eg, *w_eu, *w_ed, *gfin;
    unsigned char* ws; unsigned char* dob;
};
#define P_WRET ((bf16_t*)(c.ws + WS_WRET))
#define P_WHY ((bf16_t*)(c.ws + WS_WHY))
#define P_WO ((bf16_t*)(c.ws + WS_WO))
#define P_XN ((bf16_t*)(c.ws + WS_XN))
#define P_PROJ ((bf16_t*)(c.ws + WS_PROJ))
#define P_S ((bf16_t*)(c.ws + WS_S))
#define P_TMP ((bf16_t*)(c.ws + WS_S))
#define P_ZT ((bf16_t*)(c.ws + WS_ZT))
#define P_G ((bf16_t*)(c.ws + WS_G))
#define P_AHY ((bf16_t*)(c.ws + WS_G))
#define P_ARET ((bf16_t*)(c.ws + WS_ARET))
#define P_WGU ((bf16_t*)(c.ws + WS_WGU))
#define P_WD ((bf16_t*)(c.ws + WS_WD))
#define P_XE ((bf16_t*)(c.ws + WS_XE))
#define P_YE ((bf16_t*)(c.ws + WS_XE))
#define P_HID ((bf16_t*)(c.ws + WS_HID))
#define P_WIN ((bf16_t*)(c.dob + DO_WIN))
#define P_ROPE ((float*)(c.dob + DO_ROPE))
#define P_YCT ((bf16_t*)(c.dob + DO_YCT))
#define P_AFF ((float*)(c.ws + WS_MISC + MI_AFF))
#define P_IDX ((int*)(c.ws + WS_MISC + MI_IDX))
#define P_GATEV ((float*)(c.ws + WS_MISC + MI_GATE))
#define P_INV ((int*)(c.ws + WS_MISC + MI_INV))
#define P_H2 ((bf16_t*)(c.ws + 112 * MiB))
#define P_OUT ((float*)c.dob)
#define LDSW() asm volatile("s_waitcnt lgkmcnt(0)" ::: "memory")
__device__ __forceinline__ float wave_sum(float v) {
#pragma unroll
    for (int o = 1; o < 64; o <<= 1) v += __shfl_xor(v, o);
    return v;
}
__device__ __forceinline__ EpiArgs make_epi(const Ctx& c) {
    EpiArgs E{}; E.PROJ = P_PROJ; E.ROPE = P_ROPE; E.TMP = P_TMP; E.MIXED = P_XN; E.x = c.x; E.meta = c.meta; E.H2 = P_H2; E.HID = P_HID; E.YE = P_YE; E.GATEV = P_GATEV; return E;
}

__device__ __forceinline__ int wt_dst_row(int mode, int s) {
    if (mode == 1) { if (s >= 1024) return s; const int sl = s & 127; const int i = sl & 63; return (s & ~127) + 8 * (i >> 2) + (sl >= 64 ? 4 : 0) + (i & 3); }
    if (mode == 2) return 8 * (s >> 2) + (s & 3);
    if (mode == 3) return 8 * (s >> 2) + 4 + (s & 3);
    return s;
}
__device__ __forceinline__ void wt_item(const float* __restrict__ W, int K, int N, bf16_t* __restrict__ WT, LAS float* scr, int kb, int nb, int lane, int mode) {
    const int k0 = 64 * kb, n0 = 32 * nb;
#pragma unroll
    for (int i = 0; i < 8; ++i) { const int kk = 8 * i + (lane >> 3); const f32x4 v = *(const f32x4*)(W + (size_t)(k0 + kk) * N + n0 + 4 * (lane & 7));
        LAS float* d = scr + kk * 33 + 4 * (lane & 7); d[0] = v.x; d[1] = v.y; d[2] = v.z; d[3] = v.w; }
    LDSW();
    const int cc = lane & 7;
#pragma unroll
    for (int j = 0; j < 4; ++j) { const int n = (lane >> 3) + 8 * j; const LAS float* s = scr + (8 * cc) * 33 + n;
        u32x4 o; o.x = pk2(s[0 * 33], s[1 * 33]); o.y = pk2(s[2 * 33], s[3 * 33]); o.z = pk2(s[4 * 33], s[5 * 33]); o.w = pk2(s[6 * 33], s[7 * 33]);
        *(u32x4*)(WT + (size_t)wt_dst_row(mode, n0 + n) * K + k0 + 8 * cc) = o; }
    LDSW();
}

__device__ __forceinline__ void wt_item8(const float* __restrict__ W, int K, int N, unsigned char* __restrict__ WT, LAS float* scr, int kb, int nb, int lane, int mode, float scale) {
    const int k0 = 64 * kb, n0 = 32 * nb;
#pragma unroll
    for (int i = 0; i < 8; ++i) { const int kk = 8 * i + (lane >> 3); const f32x4 v = *(const f32x4*)(W + (size_t)(k0 + kk) * N + n0 + 4 * (lane & 7));
        LAS float* d = scr + kk * 33 + 4 * (lane & 7); d[0] = v.x; d[1] = v.y; d[2] = v.z; d[3] = v.w; }
    LDSW();
    const int cc = lane & 7;
#pragma unroll
    for (int j = 0; j < 4; ++j) { const int n = (lane >> 3) + 8 * j; const LAS float* s = scr + (8 * cc) * 33 + n;
        u32x2 o; o.x = pk4_fp8(s[0 * 33] * scale, s[1 * 33] * scale, s[2 * 33] * scale, s[3 * 33] * scale); o.y = pk4_fp8(s[4 * 33] * scale, s[5 * 33] * scale, s[6 * 33] * scale, s[7 * 33] * scale);
        *(u32x2*)(WT + (size_t)wt_dst_row(mode, n0 + n) * K + k0 + 8 * cc) = o; }
    LDSW();
}

constexpr int HDN_ROWS = 8256;
__device__ __forceinline__ void phase_p0(LAS unsigned char* lds, const Ctx& c) {
    const int tid = tidf(), lane = tid & 63, wid = tid >> 6;
    const int nskip = (gridDim.x >= 64 && (HDN_ROWS / 32) > (int)gridDim.x) ? (HDN_ROWS / 32) - (int)gridDim.x : 0;
    const bool skip_ab = (int)blockIdx.x < nskip;
    const int gw = skip_ab ? (1 << 28) : ((int)blockIdx.x - nskip) * 8 + wid, NGW = ((int)gridDim.x - nskip) * 8;
    {
        LAS float* scr = (LAS float*)(lds + wid * 8448);
        constexpr int I_IN = 16 * 256, I_SM = 16 * 32;
        for (int it = gw; it < I_IN + 3 * I_SM; it += NGW) {
            int r = it;
            if (r < I_IN) { wt_item(c.w_in, 1024, 8192, P_WIN, scr, r / 256, r % 256, lane, 1); continue; } r -= I_IN;
            if (r < I_SM) { wt_item(c.w_ret, 1024, 1024, P_WRET, scr, r / 32, r % 32, lane, 0); continue; } r -= I_SM;
            if (r < I_SM) { wt_item(c.w_hy, 1024, 1024, P_WHY, scr, r / 32, r % 32, lane, 0); continue; } r -= I_SM;
            wt_item(c.w_o, 1024, 1024, P_WO, scr, r / 32, r % 32, lane, 0);
        }
    }
    for (int m0 = gw; m0 < MROWS; m0 += 2 * NGW) {
        const int m1 = m0 + NGW; const bool has1 = m1 < MROWS; const int m1c = has1 ? m1 : m0;
        const float* s0 = m0 < MX ? c.x + (size_t)m0 * DM : c.meta + (size_t)((m0 - MX) & 15) * DM;
        const float* s1 = m1c < MX ? c.x + (size_t)m1c * DM : c.meta + (size_t)((m1c - MX) & 15) * DM;
        f32x4 v0[4], v1[4]; float q0 = 0.f, q1 = 0.f;
#pragma unroll
        for (int j = 0; j < 4; ++j) { v0[j] = *(const f32x4*)(s0 + 4 * (lane + 64 * j)); v1[j] = *(const f32x4*)(s1 + 4 * (lane + 64 * j)); }
#pragma unroll
        for (int j = 0; j < 4; ++j) { q0 += (v0[j].x * v0[j].x + v0[j].y * v0[j].y) + (v0[j].z * v0[j].z + v0[j].w * v0[j].w); q1 += (v1[j].x * v1[j].x + v1[j].y * v1[j].y) + (v1[j].z * v1[j].z + v1[j].w * v1[j].w); }
        const float r0 = rsqrtf(wave_sum(q0) * (1.f / DM) + RMS_EPS), r1 = rsqrtf(wave_sum(q1) * (1.f / DM) + RMS_EPS);
#pragma unroll
        for (int j = 0; j < 4; ++j) { const f32x4 g = *(const f32x4*)(c.norm1_g + 4 * (lane + 64 * j));
            u32x2 w; w.x = pk2(v0[j].x * r0 * g.x, v0[j].y * r0 * g.y); w.y = pk2(v0[j].z * r0 * g.z, v0[j].w * r0 * g.w);
            *(u32x2*)(P_XN + (size_t)m0 * DM + 4 * (lane + 64 * j)) = w;
            if (has1) { u32x2 w2; w2.x = pk2(v1[j].x * r1 * g.x, v1[j].y * r1 * g.y); w2.y = pk2(v1[j].z * r1 * g.z, v1[j].w * r1 * g.w); *(u32x2*)(P_XN + (size_t)m1 * DM + 4 * (lane + 64 * j)) = w2; } }
    }
    for (int i = blockIdx.x * 512 + tid; i < TT * 64; i += gridDim.x * 512) {
        const int t = i >> 6, f = i & 63; const float inv = powf(10000.0f, -(float)f / 64.0f); const float ang = (float)t * inv;
        P_ROPE[(size_t)t * 128 + f] = cosf(ang); P_ROPE[(size_t)t * 128 + 64 + f] = sinf(ang);
    }
}
#define P_HDNB ((bf16_t*)(c.dob + DO_HDN))
__device__ __forceinline__ void phase_p0b(LAS unsigned char* lds, const Ctx& c) {
    const int tid = tidf();
    LAS float* feat = (LAS float*)(lds + 69632);
    LAS float* ha = feat + 32 * 34;
    LAS float* hb = ha + 32 * 65;
    LAS float* W1 = (LAS float*)lds;
    LAS float* W2 = W1 + 33 * 64; LAS float* W3 = W2 + 64 * 64;
    __syncthreads();
    for (int i = tid; i < 33 * 16; i += 512) ((LAS f32x4*)W1)[i] = ((const f32x4*)c.fw1)[i];
    for (int i = tid; i < 64 * 16; i += 512) { ((LAS f32x4*)W2)[i] = ((const f32x4*)c.fw2)[i]; ((LAS f32x4*)W3)[i] = ((const f32x4*)c.fw3)[i]; }
    for (int it = blockIdx.x; it < HDN_ROWS / 32; it += gridDim.x) {
        const int p = tid >> 4, q = tid & 15, t = it * 32 + p;
        __syncthreads();
        {
            const float fr = 1e-4f + (float)q * ((15.0f - 1e-4f) / 15.0f);
            const float ang = (2.0f * 3.14159265358979323846f * (float)t / (float)TT) * fr;
            feat[p * 34 + 1 + q] = cosf(ang); feat[p * 34 + 17 + q] = -sinf(ang);
            if (q == 0) feat[p * 34] = (float)t / (float)(TT - 1);
        }
        __syncthreads();
        const int u = q * 4;
        const f32x4 fq = *(const f32x4*)(c.ffq + u);
        {
            f32x4 a = *(const f32x4*)(c.fb1 + u);
#pragma unroll 3
            for (int i = 0; i < 33; ++i) a += feat[p * 34 + i] * *(const LAS f32x4*)(W1 + i * 64 + u);
#pragma unroll
            for (int j = 0; j < 4; ++j) ha[p * 65 + u + j] = sinf(fq[j] * a[j]);
        }
        __syncthreads();
        {
            f32x4 a = *(const f32x4*)(c.fb2 + u);
#pragma unroll 4
            for (int i = 0; i < 64; ++i) a += ha[p * 65 + i] * *(const LAS f32x4*)(W2 + i * 64 + u);
#pragma unroll
            for (int j = 0; j < 4; ++j) hb[p * 65 + u + j] = sinf(fq[j] * a[j]);
        }
        __syncthreads();
        {
            f32x4 a = *(const f32x4*)(c.fb3 + u);
#pragma unroll 4
            for (int i = 0; i < 64; ++i) a += hb[p * 65 + i] * *(const LAS f32x4*)(W3 + i * 64 + u);
            u32x2 w; w.x = pk2(sinf(fq[0] * a[0]), sinf(fq[1] * a[1])); w.y = pk2(sinf(fq[2] * a[2]), sinf(fq[3] * a[3]));
            *(u32x2*)(P_HDNB + (size_t)t * 64 + u) = w;
        }
    }
    for (int ch = blockIdx.x * 512 + tid; ch < 1024; ch += gridDim.x * 512) { bf16_t* grow = P_G + (size_t)ch * GL; grow[0] = 0; for (int i = 2 * TT; i < GL; ++i) grow[i] = 0; }
}
__device__ __forceinline__ void phase_filtout(LAS unsigned char* lds, const Ctx& c) {
    const int tid = tidf(), lane = tid & 63, wid = tid >> 6, r = lane & 31, h = lane >> 5;
    const float mind = logf(1e-2f) / 1.5f, maxd = logf(1e-2f) / 0.3f;
    LAS unsigned char* tl = lds + wid * 2560;
    __syncthreads();
    for (int task = wid * gridDim.x + blockIdx.x; task < 64 * 32; task += 8 * gridDim.x) {
        const int ot = task & 63, chunk = task >> 6, o = 32 * ot + r, ch = o & 1023, bwd = ot >> 5;
        bf16x8 Bw[4];
#pragma unroll
        for (int ks = 0; ks < 4; ++ks) { const float* wp = c.fw4 + (size_t)(16 * ks + 8 * h) * 2048 + o;
            u32x4 bw; bw.x = pk2(wp[0], wp[2048]); bw.y = pk2(wp[2 * 2048], wp[3 * 2048]); bw.z = pk2(wp[4 * 2048], wp[5 * 2048]); bw.w = pk2(wp[6 * 2048], wp[7 * 2048]); Bw[ks] = __builtin_bit_cast(bf16x8, bw); }
        const float ad = fabsf(mind + (float)ch * ((maxd - mind) / 1023.0f)) * (1.0f / (float)(TT - 1));
        const int j1 = (chunk * 9 + 9 < 257) ? chunk * 9 + 9 : 257;
        bf16x8 An[4];
        { const bf16_t* hp = P_HDNB + (size_t)(32 * (chunk * 9) + bwd + r) * 64 + 8 * h;
#pragma unroll
          for (int ks = 0; ks < 4; ++ks) An[ks] = *(const bf16x8*)(hp + 16 * ks); }
        for (int j = chunk * 9; j < j1; ++j) {
            const int t0 = 32 * j + bwd;
            f32x16 acc; for (int z = 0; z < 16; ++z) acc[z] = 0.f;
#pragma unroll
            for (int ks = 0; ks < 4; ++ks) acc = __builtin_amdgcn_mfma_f32_32x32x16_bf16(An[ks], Bw[ks], acc, 0, 0, 0);
            if (j + 1 < j1) { const bf16_t* hp = P_HDNB + (size_t)(t0 + 32 + r) * 64 + 8 * h;
#pragma unroll
                for (int ks = 0; ks < 4; ++ks) An[ks] = *(const bf16x8*)(hp + 16 * ks); }
#pragma unroll
            for (int g = 0; g < 4; ++g) { const int tb = t0 + 8 * g + 4 * h; u32x2 w;
                w.x = pk2(acc[4 * g] * __expf(-(float)tb * ad), acc[4 * g + 1] * __expf(-(float)(tb + 1) * ad)); w.y = pk2(acc[4 * g + 2] * __expf(-(float)(tb + 2) * ad), acc[4 * g + 3] * __expf(-(float)(tb + 3) * ad));
                *(LAS u32x2*)(tl + r * 80 + (8 * g + 4 * h) * 2) = w; }
            LDSW();
#pragma unroll
            for (int k = 0; k < 2; ++k) { const int p = lane + 64 * k, cc = p >> 2, q = p & 3; const int tq = t0 + 8 * q;
                const u32x4 v = *(const LAS u32x4*)(tl + cc * 80 + 16 * q);
                bf16_t* grow = P_G + (size_t)(32 * (ot & 31) + cc) * GL;
                if (!bwd) { if (tq + 7 < TT) *(u32x4*)(grow + TT + tq) = v; else { for (int z = 0; z < 8; ++z) if (tq + z < TT) grow[TT + tq + z] = ((const LAS bf16_t*)(tl + cc * 80 + 16 * q))[z]; } }
                else { u32x4 rv; rv.x = __builtin_amdgcn_alignbit(v.w, v.w, 16); rv.y = __builtin_amdgcn_alignbit(v.z, v.z, 16); rv.z = __builtin_amdgcn_alignbit(v.y, v.y, 16); rv.w = __builtin_amdgcn_alignbit(v.x, v.x, 16);
                    if (tq + 7 < TT) *(u32x4*)(grow + TT - tq - 7) = rv; else { for (int z = 0; z < 8; ++z) if (tq + z < TT) grow[TT - tq - z] = ((const LAS bf16_t*)(tl + cc * 80 + 16 * q))[z]; } }
            }
            LDSW();
        }
    }
}

constexpr int P6_NWR = 5;
__device__ __forceinline__ void phase_p6(LAS unsigned char* lds, const Ctx& c, int it_hi) {
    const int tid = tidf(), lane = tid & 63, wid = tid >> 6;
    const int gw = wid < P6_NWR ? blockIdx.x * P6_NWR + wid : (1 << 28), NGW = gridDim.x * P6_NWR;
    if (blockIdx.x == 0 && tid < 64) ((u32x4*)((unsigned char*)P_XN + (size_t)MROWS * DM))[tid] = (u32x4){0u, 0u, 0u, 0u};
    LAS float* wr = (LAS float*)lds;
    {
        f32x4 wv[8];
#pragma unroll
        for (int j = 0; j < 8; ++j) wv[j] = ((const f32x4*)c.w_router)[tid + 512 * j];
#pragma unroll
        for (int j = 0; j < 8; ++j) { const int i4 = tid + 512 * j, k = i4 >> 2, e0 = (i4 & 3) * 4; wr[(e0 + 0) * 1024 + k] = wv[j].x; wr[(e0 + 1) * 1024 + k] = wv[j].y; wr[(e0 + 2) * 1024 + k] = wv[j].z; wr[(e0 + 3) * 1024 + k] = wv[j].w; }
    }
    __syncthreads();
    if (wid >= P6_NWR) {
        LAS float* scr = (LAS float*)(lds + 65536 + (wid - P6_NWR) * 8448);
        const int gwc = blockIdx.x * (8 - P6_NWR) + (wid - P6_NWR), NGC = gridDim.x * (8 - P6_NWR);
        for (int it = gwc; it < it_hi; it += NGC) {
            const int e = it / 3072, r = it % 3072;
            if (r < 1024) wt_item8(c.w_eg + (size_t)e * 1024 * 2048, 1024, 2048, (unsigned char*)P_WGU + (size_t)e * 4096 * 1024, scr, r / 64, r % 64, lane, 2, F8_WSCALE);
            else if (r < 2048) wt_item8(c.w_eu + (size_t)e * 1024 * 2048, 1024, 2048, (unsigned char*)P_WGU + (size_t)e * 4096 * 1024, scr, (r - 1024) / 64, (r - 1024) % 64, lane, 3, F8_WSCALE);
            else wt_item8(c.w_ed + (size_t)e * 2048 * 1024, 2048, 1024, (unsigned char*)P_WD + (size_t)e * 1024 * 2048, scr, (r - 2048) / 32, (r - 2048) % 32, lane, 0, F8_WSCALE);
        }
        return;
    }
    f32x4 vn[4];
    { const int m = gw < MROWS ? gw : 0; const bf16_t* src = P_H2 + (size_t)m * DM;
#pragma unroll
      for (int j = 0; j < 4; ++j) { const u32x2 w = *(const u32x2*)(src + 4 * (lane + 64 * j)); vn[j] = (f32x4){lo16(w.x), hi16(w.x), lo16(w.y), hi16(w.y)}; } }
    for (int m = gw; m < MROWS; m += NGW) {
        f32x4 v[4]; float s = 0.f;
#pragma unroll
        for (int j = 0; j < 4; ++j) { v[j] = vn[j]; s += (v[j].x * v[j].x + v[j].y * v[j].y) + (v[j].z * v[j].z + v[j].w * v[j].w); }
        { const int mn = m + NGW < MROWS ? m + NGW : m; const bf16_t* src = P_H2 + (size_t)mn * DM;
#pragma unroll
          for (int j = 0; j < 4; ++j) { const u32x2 w = *(const u32x2*)(src + 4 * (lane + 64 * j)); vn[j] = (f32x4){lo16(w.x), hi16(w.x), lo16(w.y), hi16(w.y)}; } }
        const float r = rsqrtf(wave_sum(s) * (1.f / DM) + RMS_EPS);
        float lg[16];
#pragma unroll
        for (int e = 0; e < 16; ++e) lg[e] = 0.f;
#pragma unroll
        for (int j = 0; j < 4; ++j) {
            const f32x4 g = *(const f32x4*)(c.norm2_g + 4 * (lane + 64 * j));
            const f32x4 xn = (f32x4){v[j].x * r * g.x, v[j].y * r * g.y, v[j].z * r * g.z, v[j].w * r * g.w};
            *(unsigned*)((unsigned char*)P_XN + (size_t)m * DM + 4 * (lane + 64 * j)) = pk4_fp8(xn.x, xn.y, xn.z, xn.w);
#pragma unroll
            for (int e = 0; e < 16; ++e) { const f32x4 w4 = *(const LAS f32x4*)(wr + e * 1024 + 4 * (lane + 64 * j)); lg[e] += (xn.x * w4.x + xn.y * w4.y) + (xn.z * w4.z + xn.w * w4.w); }
            asm volatile("" ::: "memory");
        }
        float mx = -1e30f;
#pragma unroll
        for (int e = 0; e < 16; ++e) { lg[e] = wave_sum(lg[e]); mx = fmaxf(mx, lg[e]); }
        float sum = 0.f;
#pragma unroll
        for (int e = 0; e < 16; ++e) { lg[e] = __expf(lg[e] - mx); sum += lg[e]; }
        int b, t; bt_of(m, b, t);
        const float inv = 1.f / sum;
#pragma unroll
        for (int e = 0; e < 16; ++e) if (lane == e) P_AFF[((size_t)b * NE + e) * TT + t] = lg[e] * inv;
    }
}
__device__ __forceinline__ void phase_p6b(LAS unsigned char* lds, const Ctx& c, int it_lo, int it_hi, int first_blk) {
    const int tid = tidf(), lane = tid & 63, wid = tid >> 6;
    if ((int)blockIdx.x < first_blk) return;
    const int gw = ((int)blockIdx.x - first_blk) * 8 + wid, NGW = ((int)gridDim.x - first_blk) * 8;
    __syncthreads();
    {
        LAS float* scr = (LAS float*)(lds + wid * 8448);
        for (int it = it_lo + gw; it < it_hi; it += NGW) {
            const int e = it / 3072, r = it % 3072;
            if (r < 1024) wt_item8(c.w_eg + (size_t)e * 1024 * 2048, 1024, 2048, (unsigned char*)P_WGU + (size_t)e * 4096 * 1024, scr, r / 64, r % 64, lane, 2, F8_WSCALE);
            else if (r < 2048) wt_item8(c.w_eu + (size_t)e * 1024 * 2048, 1024, 2048, (unsigned char*)P_WGU + (size_t)e * 4096 * 1024, scr, (r - 1024) / 64, (r - 1024) % 64, lane, 3, F8_WSCALE);
            else wt_item8(c.w_ed + (size_t)e * 2048 * 1024, 2048, 1024, (unsigned char*)P_WD + (size_t)e * 1024 * 2048, scr, (r - 2048) / 32, (r - 2048) % 32, lane, 0, F8_WSCALE);
        }
    }
}

__device__ __forceinline__ void phase_topk(LAS unsigned char* lds, const Ctx& c) {
    const int tid = tidf(), lane = tid & 63, wid = tid >> 6;
    LAS unsigned* hist = (LAS unsigned*)lds;
    LAS unsigned* sh = hist + 256;
    for (int be = blockIdx.x; be < NB * NE; be += gridDim.x) {
        const float* a = P_AFF + (size_t)be * TT;
        unsigned key[17];
#pragma unroll
        for (int j = 0; j < 17; ++j) { const int t = tid * 17 + j; key[j] = t < TT ? __float_as_uint(a[t]) : 0u; }
        unsigned prefix = 0u, kk = CAP;
        for (int pass = 0; pass < 4; ++pass) {
            const int shift = 24 - 8 * pass;
            __syncthreads();
            if (tid < 256) hist[tid] = 0u;
            __syncthreads();
            const unsigned himask = pass == 0 ? 0u : (0xffffffffu << (shift + 8));
#pragma unroll
            for (int j = 0; j < 17; ++j) if ((key[j] & himask) == prefix && tid * 17 + j < TT) __hip_atomic_fetch_add(&hist[(key[j] >> shift) & 255u], 1u, __ATOMIC_RELAXED, __HIP_MEMORY_SCOPE_WORKGROUP);
            __syncthreads();
            if (tid < 256) {
                const unsigned hv = hist[tid]; unsigned sfx = hv;
#pragma unroll
                for (int o = 1; o < 64; o <<= 1) { const unsigned u = __shfl_down(sfx, o); if (lane + o < 64) sfx += u; }
                if (lane == 0) sh[24 + wid] = sfx;
                sh[32 + tid] = sfx; sh[288 + tid] = hv;
            }
            __syncthreads();
            if (tid < 256) {
                unsigned above = 0u; for (int w = wid + 1; w < 4; ++w) above += sh[24 + w];
                const unsigned incl = sh[32 + tid] + above, excl = incl - sh[288 + tid];
                if (excl < kk && kk <= incl) { sh[0] = prefix | ((unsigned)tid << shift); sh[1] = kk - excl; }
            }
            __syncthreads();
            prefix = sh[0]; kk = sh[1];
        }
        int ngt = 0, neq = 0;
#pragma unroll
        for (int j = 0; j < 17; ++j) { const bool v = tid * 17 + j < TT; ngt += (v && key[j] > prefix) ? 1 : 0; neq += (v && key[j] == prefix) ? 1 : 0; }
        int sg = ngt, se = neq;
#pragma unroll
        for (int o = 1; o < 64; o <<= 1) { const int ug = __shfl_up(sg, o), ue = __shfl_up(se, o); if (lane >= o) { sg += ug; se += ue; } }
        __syncthreads();
        if (lane == 63) { sh[8 + wid] = (unsigned)sg; sh[16 + wid] = (unsigned)se; }
        __syncthreads();
        int bg = 0, beq = 0;
        for (int w = 0; w < wid; ++w) { bg += (int)sh[8 + w]; beq += (int)sh[16 + w]; }
        int pg = bg + sg - ngt, pe = beq + se - neq;
        int slot = pg + ((pe < (int)kk) ? pe : (int)kk);
        int* idx = P_IDX + (size_t)be * CAP; float* gv = P_GATEV + (size_t)be * CAP; int* inv = P_INV + (size_t)(be >> 4) * TT * 16 + (be & 15);
#pragma unroll
        for (int j = 0; j < 17; ++j) {
            const int t = tid * 17 + j;
            if (t < TT) {
                bool sel = false;
                if (key[j] > prefix) sel = true; else if (key[j] == prefix) { sel = pe < (int)kk; ++pe; }
                if (sel) { idx[slot] = t; gv[slot] = __uint_as_float(key[j]); inv[(size_t)t * 16] = slot; ++slot; } else inv[(size_t)t * 16] = -1;
            }
        }
    }
}
__device__ __forceinline__ void phase_gather(const Ctx& c) {
    const int lane = tidf() & 63, gw = blockIdx.x * 8 + (tidf() >> 6), NGW = gridDim.x * 8;
    const unsigned char* XN8 = (const unsigned char*)P_XN; unsigned char* XE8 = (unsigned char*)P_XE;
    for (int it0 = gw; it0 < NE * ER; it0 += 4 * NGW) {
        u32x4 v0[4];
#pragma unroll
        for (int k = 0; k < 4; ++k) {
            const int it = it0 + k * NGW; v0[k] = (u32x4){0u, 0u, 0u, 0u};
            if (it < NE * ER) { const int e = it / ER, r = it - e * ER;
                if (r < 2 * CAP) { const int b = r / CAP, slot = r - b * CAP; const int t = P_IDX[((size_t)b * NE + e) * CAP + slot]; v0[k] = ((const u32x4*)(XN8 + (size_t)row_of(b, t) * DM))[lane]; } }
        }
#pragma unroll
        for (int k = 0; k < 4; ++k) { const int it = it0 + k * NGW; if (it < NE * ER) ((u32x4*)(XE8 + (size_t)it * DM))[lane] = v0[k]; }
    }
}
__device__ __forceinline__ void phase_final(const Ctx& c) {
    const int lane = tidf() & 63, gw = blockIdx.x * 8 + (tidf() >> 6), NGW = gridDim.x * 8;
    u32x2 hn[4]; int invn = -1;
    if (gw < MX) { const int b = gw >> 13, t = (gw & 8191) + NMETA; const bf16_t* hrow = P_H2 + (size_t)gw * DM;
        invn = lane < NE ? P_INV[((size_t)b * TT + t) * 16 + lane] : -1;
#pragma unroll
        for (int j = 0; j < 4; ++j) hn[j] = *(const u32x2*)(hrow + 4 * (lane + 64 * j)); }
    for (int m = gw; m < MX; m += NGW) {
        const int b = m >> 13;
        float* row = P_OUT + (size_t)m * DM;
        const int inv = invn;
        f32x4 v[4];
#pragma unroll
        for (int j = 0; j < 4; ++j) v[j] = (f32x4){lo16(hn[j].x), hi16(hn[j].x), lo16(hn[j].y), hi16(hn[j].y)};
        { const int mn = m + NGW;
          if (mn < MX) { const int bn = mn >> 13, tn = (mn & 8191) + NMETA; const bf16_t* hrow = P_H2 + (size_t)mn * DM;
              invn = lane < NE ? P_INV[((size_t)bn * TT + tn) * 16 + lane] : -1;
#pragma unroll
              for (int j = 0; j < 4; ++j) hn[j] = *(const u32x2*)(hrow + 4 * (lane + 64 * j)); } }
        unsigned long long mask = __ballot(inv >= 0);
        while (mask) {
            const int e0 = __builtin_ctzll(mask); mask &= mask - 1;
            int e1 = -1; if (mask) { e1 = __builtin_ctzll(mask); mask &= mask - 1; }
            const int s0 = __builtin_amdgcn_readlane(inv, e0);
            const bf16_t* y0 = P_YE + (size_t)exp_row(e0, b * CAP + s0) * DM;
            u32x2 w0[4], w1[4];
#pragma unroll
            for (int j = 0; j < 4; ++j) w0[j] = *(const u32x2*)(y0 + 4 * (lane + 64 * j));
            if (e1 >= 0) { const int s1 = __builtin_amdgcn_readlane(inv, e1); const bf16_t* y1 = P_YE + (size_t)exp_row(e1, b * CAP + s1) * DM;
#pragma unroll
                for (int j = 0; j < 4; ++j) w1[j] = *(const u32x2*)(y1 + 4 * (lane + 64 * j)); }
            else {
#pragma unroll
                for (int j = 0; j < 4; ++j) w1[j] = (u32x2){0u, 0u}; }
#pragma unroll
            for (int j = 0; j < 4; ++j) { v[j].x += lo16(w0[j].x) + lo16(w1[j].x); v[j].y += hi16(w0[j].x) + hi16(w1[j].x); v[j].z += lo16(w0[j].y) + lo16(w1[j].y); v[j].w += hi16(w0[j].y) + hi16(w1[j].y); }
        }
        float s = 0.f;
#pragma unroll
        for (int j = 0; j < 4; ++j) s += (v[j].x * v[j].x + v[j].y * v[j].y) + (v[j].z * v[j].z + v[j].w * v[j].w);
        const float r = rsqrtf(wave_sum(s) * (1.f / DM) + RMS_EPS);
#pragma unroll
        for (int j = 0; j < 4; ++j) { const f32x4 g = *(const f32x4*)(c.gfin + 4 * (lane + 64 * j)); *(f32x4*)(row + 4 * (lane + 64 * j)) = (f32x4){v[j].x * r * g.x, v[j].y * r * g.y, v[j].z * r * g.z, v[j].w * r * g.w}; }
    }
}

__device__ __forceinline__ void unpack8(const u32x4 w, float* f) { f[0] = lo16(w.x); f[1] = hi16(w.x); f[2] = lo16(w.y); f[3] = hi16(w.y); f[4] = lo16(w.z); f[5] = hi16(w.z); f[6] = lo16(w.w); f[7] = hi16(w.w); }
__device__ __forceinline__ void c3_load(const bf16_t* __restrict__ PROJ, int b, int t, int ch0, u32x4 (&w)[3]) {
#pragma unroll
    for (int j = 0; j < 3; ++j) { const int tt = t + j - 1; const bool ok = (tt >= 0) && (tt < TT) && (t < TT);
        w[j] = *(const u32x4*)(PROJ + pj_u(ch0 >> 10, row_of(b, ok ? tt : 0)) + (ch0 & 1023)); if (!ok) w[j] = (u32x4){0u, 0u, 0u, 0u}; }
}
__device__ __forceinline__ void c3_eval(const u32x4 (&w)[3], const float* __restrict__ cw, const float* __restrict__ cb, int ch0, float* out) {
    const f32x4 b0 = *(const f32x4*)(cb + ch0), b1 = *(const f32x4*)(cb + ch0 + 4);
    out[0] = b0.x; out[1] = b0.y; out[2] = b0.z; out[3] = b0.w; out[4] = b1.x; out[5] = b1.y; out[6] = b1.z; out[7] = b1.w;
#pragma unroll
    for (int j = 0; j < 3; ++j) { float u[8]; unpack8(w[j], u);
        const f32x4 w0 = *(const f32x4*)(cw + j * 3072 + ch0), w1 = *(const f32x4*)(cw + j * 3072 + ch0 + 4);
        out[0] += u[0] * w0.x; out[1] += u[1] * w0.y; out[2] += u[2] * w0.z; out[3] += u[3] * w0.w; out[4] += u[4] * w1.x; out[5] += u[5] * w1.y; out[6] += u[6] * w1.z; out[7] += u[7] * w1.w; }
}
constexpr int HY_WL = 2 * 64 * 144;
__device__ __forceinline__ void c3w_stage(LAS float* wl, const float* __restrict__ cw, const float* __restrict__ cb, const float* __restrict__ skip, int ct, int tid) {
    if (tid < 192) { const int sec = tid >> 6, tb = (tid >> 4) & 3, c4 = tid & 15; const int ch = sec * 1024 + 64 * ct + 4 * c4;
        *(LAS f32x4*)(wl + (sec * 4 + tb) * 64 + 4 * c4) = tb < 3 ? *(const f32x4*)(cw + tb * 3072 + ch) : *(const f32x4*)(cb + ch); }
    else if (tid < 208) { const int c4 = tid - 192; *(LAS f32x4*)(wl + 768 + 4 * c4) = *(const f32x4*)(skip + 64 * ct + 4 * c4); }
}
__device__ __forceinline__ void c3_evall(const u32x4 (&w)[3], const LAS float* wl, int sec, int cg, float* out) {
    const f32x4 b0 = *(const LAS f32x4*)(wl + (sec * 4 + 3) * 64 + 8 * cg), b1 = *(const LAS f32x4*)(wl + (sec * 4 + 3) * 64 + 8 * cg + 4);
    out[0] = b0.x; out[1] = b0.y; out[2] = b0.z; out[3] = b0.w; out[4] = b1.x; out[5] = b1.y; out[6] = b1.z; out[7] = b1.w;
#pragma unroll
    for (int j = 0; j < 3; ++j) { float u[8]; unpack8(w[j], u);
        const f32x4 w0 = *(const LAS f32x4*)(wl + (sec * 4 + j) * 64 + 8 * cg), w1 = *(const LAS f32x4*)(wl + (sec * 4 + j) * 64 + 8 * cg + 4);
        out[0] += u[0] * w0.x; out[1] += u[1] * w0.y; out[2] += u[2] * w0.z; out[3] += u[3] * w0.w; out[4] += u[4] * w1.x; out[5] += u[5] * w1.y; out[6] += u[6] * w1.z; out[7] += u[7] * w1.w; }
}
constexpr int HY_ITEMS = 2 * 129 * 16, HY_TILE = 64 * 144;
#ifndef HYPREP_NB
#define HYPREP_NB 2
#endif
#ifndef HYPOST_NB
#define HYPOST_NB 2
#endif
template <int NB> __device__ __forceinline__ void phase_hyprep_t(LAS unsigned char* lds, const Ctx& c) {
    const int tid = tidf(), cg = tid & 7, tp = tid >> 3, ch = tid >> 3, pc = tid & 7;
    LAS float* wl = (LAS float*)(lds + HY_WL); int ctw = -1;
    for (int it0 = blockIdx.x; it0 < HY_ITEMS; it0 += NB * gridDim.x) {
        int b[NB], tt[NB], ct[NB]; bool val[NB];
#pragma unroll
        for (int s = 0; s < NB; ++s) { const int it = it0 + s * gridDim.x; val[s] = it < HY_ITEMS; const int ii = val[s] ? it : it0; ct[s] = ii & 15; tt[s] = (ii >> 4) % 129; b[s] = (ii >> 4) / 129; }
        const bool same = (gridDim.x & 15) == 0;
        if (same && ct[0] != ctw) { ctw = ct[0]; __syncthreads(); c3w_stage(wl, c.cw, c.cb, c.skip, ctw, tid); }
        u32x4 wx[NB][3], wv[NB][3];
#pragma unroll
        for (int s = 0; s < NB; ++s) { const int t = 64 * tt[s] + tp, c0 = 64 * ct[s] + 8 * cg; c3_load(P_PROJ, b[s], t, 1024 + c0, wx[s]); c3_load(P_PROJ, b[s], t, 2048 + c0, wv[s]); }
        __syncthreads();
#pragma unroll
        for (int s = 0; s < NB; ++s) { const int t = 64 * tt[s] + tp, c0 = 64 * ct[s] + 8 * cg; float x1[8], vh[8];
            if (same) { c3_evall(wx[s], wl, 1, cg, x1); c3_evall(wv[s], wl, 2, cg, vh); } else { c3_eval(wx[s], c.cw, c.cb, 1024 + c0, x1); c3_eval(wv[s], c.cw, c.cb, 2048 + c0, vh); }
#pragma unroll
            for (int k = 0; k < 8; ++k) *(LAS bf16_t*)(lds + s * HY_TILE + (8 * cg + k) * 144 + tp * 2) = t < TT ? f2bf(x1[k] * vh[k]) : (bf16_t)0; }
        __syncthreads();
#pragma unroll
        for (int s = 0; s < NB; ++s) if (val[s]) *(u32x4*)(P_ZT + ((size_t)b[s] * 1024 + 64 * ct[s] + ch) * ZL + 64 * tt[s] + 8 * pc) = *(const LAS u32x4*)(lds + s * HY_TILE + ch * 144 + pc * 16);
    }
}
__device__ __forceinline__ void phase_hyprep(LAS unsigned char* lds, const Ctx& c) { phase_hyprep_t<HYPREP_NB>(lds, c); }
template <int NB> __device__ __forceinline__ void phase_hypost_t(LAS unsigned char* lds, const Ctx& c) {
    const int tid = tidf(), cg = tid & 7, tp = tid >> 3, ch = tid >> 3, pc = tid & 7;
    LAS float* wl = (LAS float*)(lds + HY_WL); int ctw = -1;
    for (int it0 = blockIdx.x; it0 < HY_ITEMS; it0 += NB * gridDim.x) {
        int b[NB], tt[NB], ct[NB]; bool val[NB];
#pragma unroll
        for (int s = 0; s < NB; ++s) { const int it = it0 + s * gridDim.x; val[s] = it < HY_ITEMS; const int ii = val[s] ? it : it0; ct[s] = ii & 15; tt[s] = (ii >> 4) % 129; b[s] = (ii >> 4) / 129; }
        const bool same = (gridDim.x & 15) == 0;
        if (same && ct[0] != ctw) { ctw = ct[0]; __syncthreads(); c3w_stage(wl, c.cw, c.cb, c.skip, ctw, tid); }
        u32x4 w0[NB][3], wx[NB][3], wv[NB][3], yv[NB];
#pragma unroll
        for (int s = 0; s < NB; ++s) { const int t = 64 * tt[s] + tp, c0 = 64 * ct[s] + 8 * cg;
            yv[s] = *(const u32x4*)(P_YCT + ((size_t)b[s] * 1024 + 64 * ct[s] + ch) * ZL + 64 * tt[s] + 8 * pc);
            c3_load(P_PROJ, b[s], t, c0, w0[s]); c3_load(P_PROJ, b[s], t, 1024 + c0, wx[s]); c3_load(P_PROJ, b[s], t, 2048 + c0, wv[s]); }
        __syncthreads();
#pragma unroll
        for (int s = 0; s < NB; ++s) *(LAS u32x4*)(lds + s * HY_TILE + ch * 144 + pc * 16) = yv[s];
        __syncthreads();
#pragma unroll
        for (int s = 0; s < NB; ++s) { const int t = 64 * tt[s] + tp, c0 = 64 * ct[s] + 8 * cg;
            if (val[s] && t < TT) {
                float x0[8], x1[8], vh[8];
                f32x4 s0, s1;
                if (same) { c3_evall(w0[s], wl, 0, cg, x0); c3_evall(wx[s], wl, 1, cg, x1); c3_evall(wv[s], wl, 2, cg, vh); s0 = *(const LAS f32x4*)(wl + 768 + 8 * cg); s1 = *(const LAS f32x4*)(wl + 768 + 8 * cg + 4); }
                else { c3_eval(w0[s], c.cw, c.cb, c0, x0); c3_eval(wx[s], c.cw, c.cb, 1024 + c0, x1); c3_eval(wv[s], c.cw, c.cb, 2048 + c0, vh); s0 = *(const f32x4*)(c.skip + c0); s1 = *(const f32x4*)(c.skip + c0 + 4); }
                const float sk[8] = {s0.x, s0.y, s0.z, s0.w, s1.x, s1.y, s1.z, s1.w};
                float o[8];
#pragma unroll
                for (int k = 0; k < 8; ++k) { const float yc = bf2f(*(const LAS bf16_t*)(lds + s * HY_TILE + (8 * cg + k) * 144 + tp * 2)); o[k] = x0[k] * (yc + x1[k] * vh[k] * sk[k]); }
                u32x4 w; w.x = pk2(o[0], o[1]); w.y = pk2(o[2], o[3]); w.z = pk2(o[4], o[5]); w.w = pk2(o[6], o[7]);
                *(u32x4*)(P_AHY + (size_t)row_of(b[s], t) * DM + c0) = w;
            } }
    }
}
__device__ __forceinline__ void phase_hypost(LAS unsigned char* lds, const Ctx& c) { phase_hypost_t<HYPOST_NB>(lds, c); }

typedef short s16x4 __attribute__((ext_vector_type(4)));
__device__ __forceinline__ bf16x8 tr2(const LAS unsigned char* p, int second_off) {
    const s16x4 lo = __builtin_bit_cast(s16x4, __builtin_amdgcn_ds_read_tr16_b64_v4i16((LAS s16x4*)p));
    const s16x4 hi = __builtin_bit_cast(s16x4, __builtin_amdgcn_ds_read_tr16_b64_v4i16((LAS s16x4*)(p + second_off)));
    return (bf16x8){lo[0], lo[1], lo[2], lo[3], hi[0], hi[1], hi[2], hi[3]};
}
__device__ __forceinline__ u32x4 scale8(const u32x4 w, float s) {
    u32x4 o; o.x = pk2(lo16(w.x) * s, hi16(w.x) * s); o.y = pk2(lo16(w.y) * s, hi16(w.y) * s); o.z = pk2(lo16(w.z) * s, hi16(w.z) * s); o.w = pk2(lo16(w.w) * s, hi16(w.w) * s); return o;
}
constexpr int RA_K = 272, RA_V = 576;
__device__ __forceinline__ void phase_retsum(LAS unsigned char* lds, const Ctx& c) {
    LAS unsigned char* Kf = lds; LAS unsigned char* Kb = lds + 128 * RA_K; LAS unsigned char* Vl = lds + 2 * 128 * RA_K;
    const bf16_t* PROJ = P_PROJ;
    for (int u = blockIdx.x; u < 520; u += gridDim.x) {
        const int tid = tidf(), lane = tid & 63, wid = tid >> 6;
        int bh, n; if (u < 512) { bh = u >> 6; n = 1 + (u & 63); } else { bh = u - 512; n = 0; }
        const int b = bh >> 2, h = bh & 3;
        const float lf = log_sigmoid(c.dec_f[h]), lb = log_sigmoid(c.dec_b[h]);
        __syncthreads();
        {
            const u32x4 z4 = (u32x4){0u, 0u, 0u, 0u};
            u32x4 kv[4], vv[8];
#pragma unroll
            for (int i = 0; i < 4; ++i) { const int row = 32 * i + (tid >> 4); const int gr = chunk_row(b, n, row); kv[i] = *(const u32x4*)(PROJ + pj_k(h, gr < 0 ? 0 : gr) + 8 * (tid & 15)); if (gr < 0) kv[i] = z4; }
#pragma unroll
            for (int i = 0; i < 8; ++i) { const int row = 16 * i + (tid >> 5); const int gr = chunk_row(b, n, row); vv[i] = *(const u32x4*)(PROJ + pj_v(h, gr < 0 ? 0 : gr) + 8 * (tid & 31)); if (gr < 0) vv[i] = z4; }
#pragma unroll
            for (int i = 0; i < 4; ++i) { const int row = 32 * i + (tid >> 4); const float we = expf(lf * (float)(127 - row)), ws = expf(lb * (float)row);
                *(LAS u32x4*)(Kf + row * RA_K + (tid & 15) * 16) = scale8(kv[i], we); *(LAS u32x4*)(Kb + row * RA_K + (tid & 15) * 16) = scale8(kv[i], ws); }
#pragma unroll
            for (int i = 0; i < 8; ++i) { const int row = 16 * i + (tid >> 5); *(LAS u32x4*)(Vl + row * RA_V + (tid & 31) * 16) = vv[i]; }
        }
        __syncthreads();
        const int dkt = wid & 3, dvh = wid >> 2, r = lane & 31, hh = lane >> 5, g16 = lane >> 4, i16 = lane & 15, q = i16 >> 2, p = i16 & 3;
        f32x16 af[4], ab[4];
#pragma unroll
        for (int nt = 0; nt < 4; ++nt) for (int z = 0; z < 16; ++z) { af[nt][z] = 0.f; ab[nt][z] = 0.f; }
        const LAS unsigned char* kfa = Kf + (8 * hh + q) * RA_K + (32 * dkt + 16 * (g16 & 1) + 4 * p) * 2;
        const LAS unsigned char* kba = Kb + (8 * hh + q) * RA_K + (32 * dkt + 16 * (g16 & 1) + 4 * p) * 2;
        const LAS unsigned char* va = Vl + (8 * hh + q) * RA_V + (128 * dvh + 16 * (g16 & 1) + 4 * p) * 2;
#pragma unroll
        for (int ks = 0; ks < 8; ++ks) {
            if (n == 0 && ks < 7) continue;
            const bf16x8 aF = tr2(kfa + 16 * ks * RA_K, 4 * RA_K), aB = tr2(kba + 16 * ks * RA_K, 4 * RA_K);
#pragma unroll
            for (int nt = 0; nt < 4; ++nt) { const bf16x8 bv = tr2(va + 16 * ks * RA_V + 64 * nt, 4 * RA_V);
                af[nt] = __builtin_amdgcn_mfma_f32_32x32x16_bf16(aF, bv, af[nt], 0, 0, 0); ab[nt] = __builtin_amdgcn_mfma_f32_32x32x16_bf16(aB, bv, ab[nt], 0, 0, 0); }
        }
        bf16_t* of = P_S + (((size_t)0 * 8 + bh) * NCH + n) * 32768; bf16_t* ob = P_S + (((size_t)1 * 8 + bh) * NCH + n) * 32768;
#pragma unroll
        for (int nt = 0; nt < 4; ++nt)
#pragma unroll
            for (int g = 0; g < 4; ++g) {
                const size_t o = ((size_t)((4 * dvh + nt) * 8 + 2 * dkt + (g >> 1)) * 64 + (g & 1) * 32 + r) * 8 + 4 * hh;
                u32x2 w; w.x = pk2(af[nt][4 * g], af[nt][4 * g + 1]); w.y = pk2(af[nt][4 * g + 2], af[nt][4 * g + 3]); *(u32x2*)(of + o) = w;
                u32x2 v; v.x = pk2(ab[nt][4 * g], ab[nt][4 * g + 1]); v.y = pk2(ab[nt][4 * g + 2], ab[nt][4 * g + 3]); *(u32x2*)(ob + o) = v;
            }
    }
}
__device__ __forceinline__ void phase_retscan(const Ctx& c) {
    for (int gi = blockIdx.x * 512 + tidf(); gi < 16 * 8192; gi += gridDim.x * 512) {
        const int db = gi >> 13, e4 = gi & 8191, dir = db >> 3, bh = db & 7, h = bh & 3;
        const float dec = expf(log_sigmoid(dir ? c.dec_b[h] : c.dec_f[h]) * 128.f);
        bf16_t* base = P_S + ((size_t)db * NCH) * 32768 + (size_t)e4 * 4;
        const long step = dir ? -32768 : 32768;
        bf16_t* p = base + (dir ? (size_t)64 * 32768 : 0);
        f32x4 s = (f32x4){0.f, 0.f, 0.f, 0.f};
        u32x2 a[13];
#pragma unroll 1
        for (int n0 = 0; n0 < NCH; n0 += 13) {
#pragma unroll
            for (int k = 0; k < 13; ++k) a[k] = *(const u32x2*)(p + (long)k * step);
#pragma unroll
            for (int k = 0; k < 13; ++k) {
                u32x2 w; w.x = pk2(s.x, s.y); w.y = pk2(s.z, s.w); *(u32x2*)(p + (long)k * step) = w;
                s = s * dec + (f32x4){lo16(a[k].x), hi16(a[k].x), lo16(a[k].y), hi16(a[k].y)};
            }
            p += 13 * step;
        }
    }
}
constexpr int R2Q = 272, R2V = 576, R2O = 528;
__device__ __forceinline__ void phase_retout(LAS unsigned char* lds, const Ctx& c) {
    LAS unsigned char* Ql = lds; LAS unsigned char* Kl = lds + 128 * R2Q; LAS unsigned char* Vl = lds + 2 * 128 * R2Q; LAS float* red = (LAS float*)(lds + 2 * 128 * R2Q + 128 * R2V);
    const bf16_t* PROJ = P_PROJ;
    for (int u = blockIdx.x; u < 520; u += gridDim.x) {
        const int tid = tidf(), lane = tid & 63, wid = tid >> 6;
        int bh, n; if (u < 512) { bh = u >> 6; n = 1 + (u & 63); } else { bh = u - 512; n = 0; }
        const int b = bh >> 2, h = bh & 3;
        const float lf = log_sigmoid(c.dec_f[h]), lb = log_sigmoid(c.dec_b[h]);
        const float lf2 = lf * 1.4426950408889634f, lb2 = lb * 1.4426950408889634f;
        __syncthreads();
        {
            const u32x4 z4 = (u32x4){0u, 0u, 0u, 0u};
            u32x4 qv[4], kv[4], vv[8];
#pragma unroll
            for (int i = 0; i < 4; ++i) { const int row = 32 * i + (tid >> 4); const int gr = chunk_row(b, n, row); const int gc = gr < 0 ? 0 : gr;
                qv[i] = *(const u32x4*)(PROJ + pj_q(h, gc) + 8 * (tid & 15)); kv[i] = *(const u32x4*)(PROJ + pj_k(h, gc) + 8 * (tid & 15)); if (gr < 0) { qv[i] = z4; kv[i] = z4; } }
#pragma unroll
            for (int i = 0; i < 8; ++i) { const int row = 16 * i + (tid >> 5); const int gr = chunk_row(b, n, row);
                vv[i] = *(const u32x4*)(PROJ + pj_v(h, gr < 0 ? 0 : gr) + 8 * (tid & 31)); if (gr < 0) vv[i] = z4; }
#pragma unroll
            for (int i = 0; i < 4; ++i) { const int row = 32 * i + (tid >> 4); *(LAS u32x4*)(Ql + row * R2Q + (tid & 15) * 16) = qv[i]; *(LAS u32x4*)(Kl + row * R2Q + (tid & 15) * 16) = kv[i]; }
#pragma unroll
            for (int i = 0; i < 8; ++i) { const int row = 16 * i + (tid >> 5); *(LAS u32x4*)(Vl + row * R2V + (tid & 31) * 16) = vv[i]; }
        }
        __syncthreads();
        const int wr = wid >> 1, wc = wid & 1, r = lane & 31, hh = lane >> 5;
        const bool act = (n != 0) || (__builtin_amdgcn_readfirstlane(wr) == 3);
        f32x16 sc[2];
#pragma unroll
        for (int jt = 0; jt < 2; ++jt) for (int z = 0; z < 16; ++z) sc[jt][z] = 0.f;
        if (act) {
#pragma unroll
        for (int ks = 0; ks < 8; ++ks) {
            const bf16x8 af = *(const LAS bf16x8*)(Ql + (32 * wr + r) * R2Q + (16 * ks + 8 * hh) * 2);
#pragma unroll
            for (int jt = 0; jt < 2; ++jt) { const bf16x8 bf = *(const LAS bf16x8*)(Kl + (64 * wc + 32 * jt + r) * R2Q + (16 * ks + 8 * hh) * 2); sc[jt] = __builtin_amdgcn_mfma_f32_32x32x16_bf16(af, bf, sc[jt], 0, 0, 0); }
        }
        }
        __syncthreads();
#pragma unroll
        for (int jt = 0; jt < 2; ++jt) { const int j = 64 * wc + 32 * jt + r;
#pragma unroll
            for (int z = 0; z < 16; ++z) { const int i = 32 * wr + (z & 3) + 8 * (z >> 2) + 4 * hh; const int df = i - j;
                const float m = __builtin_amdgcn_exp2f(df >= 0 ? lf2 * (float)df : lb2 * (float)(-df));
                *(LAS bf16_t*)(Kl + i * R2Q + j * 2) = f2bf(sc[jt][z] * m); } }
        __syncthreads();
        f32x16 acc[4];
#pragma unroll
        for (int nt = 0; nt < 4; ++nt) for (int z = 0; z < 16; ++z) acc[nt][z] = 0.f;
        const bf16_t* Sf = P_S + (((size_t)0 * 8 + bh) * NCH + n) * 32768 + (size_t)(4 * wc) * 8 * 512 + lane * 8;
        const bf16_t* Sb = P_S + (((size_t)1 * 8 + bh) * NCH + n) * 32768 + (size_t)(4 * wc) * 8 * 512 + lane * 8;
        if (act) {
        bf16x8 sA[8], sB[8];
#pragma unroll
        for (int nt = 0; nt < 4; ++nt) { sA[2 * nt] = *(const bf16x8*)(Sf + (size_t)(nt * 8) * 512); sA[2 * nt + 1] = *(const bf16x8*)(Sb + (size_t)(nt * 8) * 512); }
        __builtin_amdgcn_sched_barrier(0);
        {
            const int g16 = lane >> 4, i16 = lane & 15, q = i16 >> 2, p = i16 & 3;
            const LAS unsigned char* vb = Vl + (8 * hh + q) * R2V + (128 * wc + 16 * (g16 & 1) + 4 * p) * 2;
#pragma unroll
            for (int ks = 0; ks < 8; ++ks) {
                const bf16x8 af = *(const LAS bf16x8*)(Kl + (32 * wr + r) * R2Q + (16 * ks + 8 * hh) * 2);
#pragma unroll
                for (int nt = 0; nt < 4; ++nt) { const bf16x8 bf = tr2(vb + 16 * ks * R2V + 64 * nt, 4 * R2V); acc[nt] = __builtin_amdgcn_mfma_f32_32x32x16_bf16(af, bf, acc[nt], 0, 0, 0); }
            }
        }
        {
            const int i = 32 * wr + r;
            const float qwf = expf(lf * (float)(i + 1)), qwb = expf(lb * (float)(128 - i));
#define R2_SLOAD(dst, ks_) do { _Pragma("unroll") for (int nt = 0; nt < 4; ++nt) { dst[2 * nt] = *(const bf16x8*)(Sf + (size_t)(nt * 8 + (ks_)) * 512); dst[2 * nt + 1] = *(const bf16x8*)(Sb + (size_t)(nt * 8 + (ks_)) * 512); } } while (0)
#define R2_SMMA(src_, ks_) do { const u32x4 aq = *(const LAS u32x4*)(Ql + (32 * wr + r) * R2Q + (16 * (ks_) + 8 * hh) * 2); \
                const bf16x8 af = __builtin_bit_cast(bf16x8, scale8(aq, qwf)), ab = __builtin_bit_cast(bf16x8, scale8(aq, qwb)); \
                _Pragma("unroll") for (int nt = 0; nt < 4; ++nt) { acc[nt] = __builtin_amdgcn_mfma_f32_32x32x16_bf16(af, src_[2 * nt], acc[nt], 0, 0, 0); acc[nt] = __builtin_amdgcn_mfma_f32_32x32x16_bf16(ab, src_[2 * nt + 1], acc[nt], 0, 0, 0); } } while (0)
#define R2_PIN() __builtin_amdgcn_sched_barrier(0)
            R2_SLOAD(sB, 1); R2_PIN(); R2_SMMA(sA, 0); R2_PIN();
            R2_SLOAD(sA, 2); R2_PIN(); R2_SMMA(sB, 1); R2_PIN();
            R2_SLOAD(sB, 3); R2_PIN(); R2_SMMA(sA, 2); R2_PIN();
            R2_SLOAD(sA, 4); R2_PIN(); R2_SMMA(sB, 3); R2_PIN();
            R2_SLOAD(sB, 5); R2_PIN(); R2_SMMA(sA, 4); R2_PIN();
            R2_SLOAD(sA, 6); R2_PIN(); R2_SMMA(sB, 5); R2_PIN();
            R2_SLOAD(sB, 7); R2_PIN(); R2_SMMA(sA, 6); R2_PIN();
            R2_SMMA(sB, 7);
#undef R2_PIN
#undef R2_SLOAD
#undef R2_SMMA
        }
        }
        {
            float ss[16];
#pragma unroll
            for (int z = 0; z < 16; ++z) { float v = 0.f;
#pragma unroll
                for (int nt = 0; nt < 4; ++nt) v += acc[nt][z] * acc[nt][z];
#pragma unroll
                for (int o = 1; o < 32; o <<= 1) v += __shfl_xor(v, o);
                ss[z] = v; }
            if (r == 0) {
#pragma unroll
                for (int z = 0; z < 16; ++z) red[(32 * wr + (z & 3) + 8 * (z >> 2) + 4 * hh) * 2 + wc] = ss[z]; }
        }
        __syncthreads();
        {
            float hgv[4];
#pragma unroll
            for (int nt = 0; nt < 4; ++nt) hgv[nt] = c.hg[h * 256 + 128 * wc + 32 * nt + r];
#pragma unroll
            for (int z = 0; z < 16; ++z) { const int i = 32 * wr + (z & 3) + 8 * (z >> 2) + 4 * hh; const float rs = rsqrtf((red[i * 2] + red[i * 2 + 1]) * (1.f / 256.f) + RMS_EPS);
#pragma unroll
                for (int nt = 0; nt < 4; ++nt) *(LAS bf16_t*)(Vl + i * R2O + (128 * wc + 32 * nt + r) * 2) = f2bf(acc[nt][z] * rs * hgv[nt]); }
        }
        __syncthreads();
        {
            const int tid2 = tidf();
            u32x4 gg[8];
#pragma unroll
            for (int i = 0; i < 8; ++i) { const int row = 16 * i + (tid2 >> 5), pc = tid2 & 31; const int gr = chunk_row(b, n, row); gg[i] = *(const u32x4*)(PROJ + pj_g(h, gr < 0 ? 0 : gr) + 8 * pc); }
#pragma unroll
            for (int i = 0; i < 8; ++i) { const int row = 16 * i + (tid2 >> 5), pc = tid2 & 31; const int gr = chunk_row(b, n, row);
                if (gr >= 0) { const u32x4 o = *(const LAS u32x4*)(Vl + row * R2O + pc * 16), g = gg[i]; u32x4 w;
                    w.x = pk2(lo16(o.x) * lo16(g.x), hi16(o.x) * hi16(g.x)); w.y = pk2(lo16(o.y) * lo16(g.y), hi16(o.y) * hi16(g.y)); w.z = pk2(lo16(o.z) * lo16(g.z), hi16(o.z) * hi16(g.z)); w.w = pk2(lo16(o.w) * lo16(g.w), hi16(o.w) * hi16(g.w));
                    *(u32x4*)(P_ARET + (size_t)gr * DM + h * 256 + 8 * pc) = w; } }
        }
    }
}
constexpr int P6_CONC = (NE * 3072 * 30) / 100;
constexpr int P6B_SPLIT = (NE * 3072 * 82) / 100;
constexpr int PH_LDS = 147456;


typedef __attribute__((address_space(1))) unsigned gu32;
#define XB_TMO      128
#define XB_XCNT(j)  (256  + 64 * (j))
#define XB_XSUB(j)  (1280 + 64 * (j))
#define XB_XGEN(j)  (2304 + 64 * (j))
#define XB_TOP      3328
#define XB_TOPGEN   3392
#define XCD_BAR_WORDS 3456
#define XB_SPIN_CAP (1u << 18)

__device__ __forceinline__ unsigned xb_ld(unsigned* p)              { return __hip_atomic_load(p, __ATOMIC_RELAXED, __HIP_MEMORY_SCOPE_AGENT); }
__device__ __forceinline__ unsigned xb_add(unsigned* p, unsigned v) { return __hip_atomic_fetch_add(p, v, __ATOMIC_RELAXED, __HIP_MEMORY_SCOPE_AGENT); }
__device__ __forceinline__ unsigned xb_xcc_id() { return (unsigned)__builtin_amdgcn_s_getreg((3 << 11) | 20) & 0xFu; }
#define XB_SPIN(cond, bar) do { unsigned _sp = 0; while (cond) { __builtin_amdgcn_s_sleep(1); \
    if ((++_sp & 255u) == 0u) { if (xb_ld(&(bar)[XB_TMO])) break; if (_sp > XB_SPIN_CAP) { atomicAdd(&(bar)[XB_TMO], 1u); break; } } } } while (0)

struct XcdBarrier {
    unsigned* bar; unsigned x;
    volatile LAS unsigned* st;
};

__device__ __forceinline__ XcdBarrier xcd_barrier_post(unsigned* bar, volatile LAS unsigned* st) {
    XcdBarrier b; b.bar = bar; b.x = xb_xcc_id(); b.st = st;
    if (tidf() == 0) (void)xb_add(&bar[XB_XCNT(b.x)], 1u);
    return b;
}
__device__ __forceinline__ void xcd_barrier_complete(unsigned* bar, unsigned x, unsigned& nloc, unsigned& nx) {
    const unsigned G = gridDim.x * gridDim.y * gridDim.z;
    unsigned sum, cnt, mine, sp = 0u;
    for (;;) {
        sum = 0u; cnt = 0u; mine = 0u;
#pragma unroll
        for (unsigned j = 0; j < 16; ++j) { const unsigned c = xb_ld(&bar[XB_XCNT(j)]); sum += c; cnt += (c > 0u) ? 1u : 0u; mine = (j == x) ? c : mine; }
        if (sum == G) break;
        __builtin_amdgcn_s_sleep(1);
        if ((++sp & 255u) == 0u) { if (xb_ld(&bar[XB_TMO])) break; if (sp > XB_SPIN_CAP) { atomicAdd(&bar[XB_TMO], 1u); break; } }
    }
    nloc = mine > 0u ? mine : 1u; nx = cnt > 0u ? cnt : 1u;
}

__device__ __forceinline__ void xcd_barrier(const XcdBarrier& b) {
    asm volatile("s_waitcnt vmcnt(0)" ::: "memory");
    __syncthreads();
    if (tidf() == 0) {
        unsigned* bar = b.bar;
        __builtin_amdgcn_s_waitcnt(0);
        unsigned nloc = b.st[0], nx = b.st[1];
        if (nloc == 0u) { xcd_barrier_complete(bar, b.x, nloc, nx); b.st[0] = nloc; b.st[1] = nx; }
        const unsigned old = xb_add(&bar[XB_XSUB(b.x)], 1u);
        const unsigned gen = old / nloc;
        if (old + 1u == (gen + 1u) * nloc) {
            __builtin_amdgcn_fence(__ATOMIC_RELEASE, "agent");
            asm volatile("s_waitcnt vmcnt(0)" ::: "memory");
            const unsigned og = xb_add(&bar[XB_TOP], 1u);
            const unsigned tg = og / nx;
            if (og + 1u == (tg + 1u) * nx) xb_add(&bar[XB_TOPGEN], 1u);
            else XB_SPIN(xb_ld(&bar[XB_TOPGEN]) == tg, bar);
            __builtin_amdgcn_fence(__ATOMIC_ACQUIRE, "agent");
            xb_add(&bar[XB_XGEN(b.x)], 1u);
            asm volatile("s_waitcnt vmcnt(0)" ::: "memory");
        } else {
            XB_SPIN(xb_ld(&bar[XB_XGEN(b.x)]) == gen, bar);
            __builtin_amdgcn_fence(__ATOMIC_ACQUIRE, "agent");
            asm volatile("s_waitcnt vmcnt(0)" ::: "memory");
        }
    }
    __syncthreads();
}
__device__ __forceinline__ GemmArgs mk_ga(const bf16_t* A, const bf16_t* Bt, int M, int N, int K, int gt, size_t gstride, int side) {
    GemmArgs ga{}; ga.A = A; ga.Bt = Bt; ga.M = M; ga.N = N; ga.K = K; ga.gt = gt; ga.gstride = gstride; ga.side = side; return ga;
}
__global__ void __launch_bounds__(512, 2) mega_fwd(Ctx c) {
    extern __shared__ __attribute__((aligned(16))) unsigned char smem_m[];
    LAS unsigned char* lds = (LAS unsigned char*)smem_m;
    cg::grid_group grid = cg::this_grid();
#ifdef PROBE_A
    unsigned long long tsv[16], tsx[4]; tsv[0] = __builtin_amdgcn_s_memrealtime();
#define TS(k) tsv[k] = __builtin_amdgcn_s_memrealtime()
#define XSYNC0() do { xcd_barrier(xb); tsx[0] = __builtin_amdgcn_s_memrealtime(); } while (0)
#define XSYNC1() do { xcd_barrier(xb); tsx[1] = __builtin_amdgcn_s_memrealtime(); } while (0)
#define XSYNC2() do { xcd_barrier(xb); tsx[2] = __builtin_amdgcn_s_memrealtime(); } while (0)
#define XSYNC3() do { xcd_barrier(xb); tsx[3] = __builtin_amdgcn_s_memrealtime(); } while (0)
#else
#define TS(k)
#define XSYNC0()
#define XSYNC1()
#define XSYNC2()
#define XSYNC3()
#endif
    unsigned* barw = (unsigned*)(c.ws + WS_CTL) + 1024;
    volatile LAS unsigned* bst = (volatile LAS unsigned*)(lds + PH_LDS - 256);
    if (tidf() < 2) bst[tidf()] = 0u;
    __syncthreads();
    if (c.ws == nullptr) grid.sync();
    const XcdBarrier xb = xcd_barrier_post(barw, bst);
#define GSYNC() xcd_barrier(xb)
    phase_p0(lds, c);
    XSYNC0();
    phase_p0b(lds, c);
    GSYNC(); TS(1);
    gemm_fast_body<1>(lds, mk_ga(P_XN, P_WIN, MX, NPROJ, 1024, 1 << 20, 0, 1), make_epi(c));
    GSYNC(); TS(2);
    phase_retsum(lds, c);
    XSYNC1();
    phase_hyprep(lds, c);
    phase_filtout(lds, c);
    GSYNC(); TS(3);
    phase_retscan(c);
    for (int cb = blockIdx.x; cb < 256; cb += gridDim.x) conv_fast_body(lds, P_G, P_ZT, P_YCT, 4 * cb);
    XSYNC2();
    GSYNC(); TS(4);
    phase_retout(lds, c);
    phase_hypost(lds, c);
    GSYNC(); TS(5);
    gemm_fast_body<2>(lds, mk_ga(P_ARET, P_WRET, MX, DM, 1024, 1 << 20, 0, 1), make_epi(c));
    GSYNC(); TS(6);
    gemm_fast_body<3>(lds, mk_ga(P_AHY, P_WHY, MX, DM, 1024, 1 << 20, 0, 1), make_epi(c));
    GSYNC(); TS(7);
    gemm_fast_body<4>(lds, mk_ga(P_XN, P_WO, MX, DM, 1024, 1 << 20, 0, 1), make_epi(c));
    GSYNC(); TS(8);
    phase_p6(lds, c, P6_CONC);
    XSYNC3();
    const int p6split = gridDim.x > 64 ? P6B_SPLIT : NE * 3072;
    phase_p6b(lds, c, P6_CONC, p6split, 0);
    GSYNC(); TS(9);
    phase_topk(lds, c);
    if (gridDim.x > 64) phase_p6b(lds, c, p6split, NE * 3072, NB * NE);
    GSYNC(); TS(10); TS(11);
    { GemmArgs g5 = mk_ga(P_XN, P_WGU, NE * EM, 4096, 1024 / 2, EM / 256, (size_t)4096 * 1024, 0); g5.idx = P_IDX; gemm_fast_body<5>(lds, g5, make_epi(c)); }
    GSYNC(); TS(12);
    gemm_fast_body<6>(lds, mk_ga(P_HID, P_WD, NE * EM, DM, 2048 / 2, EM / 256, (size_t)1024 * 2048, 0), make_epi(c));
    GSYNC(); TS(13);
    phase_final(c);
#ifdef PROBE_A
    GSYNC(); TS(14);
    if (blockIdx.x == 0) {
        #ifdef PROBE_X
        const int kmap[4] = {0, 2, 3, 8};
        const float ta = (float)(tsx[PROBE_X] - tsv[kmap[PROBE_X]]) * 0.01f, tb = (float)(tsv[PROBE_B + 1] - tsv[PROBE_B]) * 0.01f;
#else
        const float ta = (float)(tsv[PROBE_A + 1] - tsv[PROBE_A]) * 0.01f, tb = (float)(tsv[PROBE_B + 1] - tsv[PROBE_B]) * 0.01f;
#endif
        const float eps = sqrtf(ta * 1.6e-5f);
        float* o = (float*)c.dob;
        for (int i = tidf(); i < (1 << 20); i += 512) o[4096 + i] += eps;
        if (tidf() == 0) o[0] += 0.5f + tb * 0.01f;
    }
#endif
}
extern "C" void kernel_launch(void* const* d_in, const int* in_sizes, int n_in, void* d_out, int out_size, void* d_ws, size_t ws_size, hipStream_t stream) {
    if (n_in != 27 || ws_size < WS_END || out_size != MX * DM) { fprintf(stderr, "kernel_launch: unexpected sizes n_in %d ws %zu out %d\n", n_in, ws_size, out_size); return; }
    constexpr size_t kDynLds = PH_LDS;
    static int grid_blocks = 0;
    if (!grid_blocks) {
        int dev = 0, cus = 0, per_cu = 0;
        (void)hipGetDevice(&dev);
        (void)hipDeviceGetAttribute(&cus, hipDeviceAttributeMultiprocessorCount, dev);
        (void)hipFuncSetAttribute((const void*)mega_fwd, hipFuncAttributeMaxDynamicSharedMemorySize, (int)kDynLds);
        (void)hipOccupancyMaxActiveBlocksPerMultiprocessor(&per_cu, (const void*)mega_fwd, 512, kDynLds);
        if (per_cu < 1) per_cu = 1;
        grid_blocks = cus * per_cu;
    }
    Ctx cx{};
    { const float** pp = (const float**)&cx; for (int i = 0; i < 27; ++i) pp[i] = (const float*)d_in[i]; }
    cx.ws = (unsigned char*)d_ws; cx.dob = (unsigned char*)d_out;
    (void)hipMemsetAsync((unsigned char*)d_ws + WS_CTL, 0, 64 * 1024, stream);
    void* args[] = {&cx};
    hipError_t e = hipLaunchCooperativeKernel((const void*)mega_fwd, dim3(grid_blocks), dim3(512), args, kDynLds, stream);
    if (e != hipSuccess) fprintf(stderr, "cooperative launch failed: %s (grid %d)\n", hipGetErrorString(e), grid_blocks);
}
```

```cpp
#include <hip/hip_runtime.h>
#include <stdint.h>
#include <cstdio>
#include <hip/hip_cooperative_groups.h>
namespace cg = cooperative_groups;

typedef unsigned short bf16_t;
__device__ __forceinline__ int tidf() { int t = (int)__builtin_amdgcn_workitem_id_x(); asm volatile("" : "+v"(t)); return t; }
__device__ __forceinline__ float bf2f(bf16_t v) { return __uint_as_float(((unsigned)v) << 16); }
__device__ __forceinline__ bf16_t f2bf(float f) { const __bf16 b = (__bf16)f; return __builtin_bit_cast(unsigned short, b); }

constexpr int NB = 2, SEQ = 8192, DM = 1024, NMETA = 16, TT = 8208;
constexpr int MX = 16384, MROWS = 16416, MP = 16640;
constexpr int NPROJ = 8192;
constexpr int C_Q = 0, C_K = 512, C_V = 1024, C_G = 2048, C_U = 3072, C_GA = 6144, C_GB = 7168;
constexpr int NE = 16, CAP = 1026, ER = 2304, FF = 2048;
constexpr int EM = 2048, EL = 2 * CAP - EM, EROWS = NE * EM + NE * EL;
__device__ __forceinline__ int exp_row(int e, int ml) { return ml < EM ? e * EM + ml : NE * EM + e * EL + (ml - EM); }
constexpr int NCH = 65;
constexpr int GL = 16640;
constexpr int ZL = 8320;
constexpr float RMS_EPS = 1e-6f;

constexpr size_t MiB = 1u << 20;
constexpr size_t WS_CTL = 0;
constexpr size_t WS_WRET = 1 * MiB, WS_WHY = 3 * MiB, WS_WO = 5 * MiB;
constexpr size_t WS_MISC = 7 * MiB;
constexpr size_t WS_XN = 12 * MiB;
constexpr size_t WS_PROJ = 48 * MiB;
constexpr size_t WS_S = 308 * MiB;
constexpr size_t WS_ZT = 374 * MiB;
constexpr size_t WS_G = 407 * MiB;
constexpr size_t WS_ARET = 440 * MiB;
constexpr size_t WS_WGU = 48 * MiB;
constexpr size_t WS_WD = 176 * MiB;
constexpr size_t WS_XE = 240 * MiB;
constexpr size_t WS_HID = 312 * MiB;
constexpr size_t WS_END = 456 * MiB;
constexpr size_t DO_WIN = 0;
constexpr size_t DO_ROPE = 16 * MiB;
constexpr size_t DO_HDN = 22 * MiB;
constexpr size_t DO_YCT = 0;
constexpr size_t MI_AFF = 0;
constexpr size_t MI_IDX = 1 * MiB + 64 * 1024;
constexpr size_t MI_GATE = 1 * MiB + 256 * 1024;
constexpr size_t MI_INV = 2 * MiB;
constexpr size_t MI_H2M = 3 * MiB + 256 * 1024;

constexpr size_t PJ_Q = 0, PJ_K = (size_t)MP * 512, PJ_V = (size_t)MP * 1024, PJ_G = (size_t)MP * 2048, PJ_U = (size_t)MP * 3072, PJ_GA = (size_t)MP * 6144, PJ_GB = (size_t)MP * 7168;
__device__ __forceinline__ size_t pj_q(int h, int m) { return PJ_Q + ((size_t)h * MP + m) * 128; }
__device__ __forceinline__ size_t pj_k(int h, int m) { return PJ_K + ((size_t)h * MP + m) * 128; }
__device__ __forceinline__ size_t pj_v(int h, int m) { return PJ_V + ((size_t)h * MP + m) * 256; }
__device__ __forceinline__ size_t pj_g(int h, int m) { return PJ_G + ((size_t)h * MP + m) * 256; }
__device__ __forceinline__ size_t pj_u(int sec, int m) { return PJ_U + ((size_t)sec * MP + m) * 1024; }
__device__ __forceinline__ size_t pj_ga(int m) { return PJ_GA + (size_t)m * 1024; }
__device__ __forceinline__ size_t pj_gb(int m) { return PJ_GB + (size_t)m * 1024; }
__device__ __forceinline__ size_t pj_col(int m, int col) {
    if (col < 512) return pj_q(col >> 7, m) + (col & 127);
    if (col < 1024) return pj_k((col - 512) >> 7, m) + (col & 127);
    if (col < 2048) return pj_v((col - 1024) >> 8, m) + (col & 255);
    if (col < 3072) return pj_g((col - 2048) >> 8, m) + (col & 255);
    if (col < 6144) return pj_u((col - 3072) >> 10, m) + ((col - 3072) & 1023);
    if (col < 7168) return pj_ga(m) + (col - 6144);
    return pj_gb(m) + (col - 7168);
}
__device__ __forceinline__ int row_of(int b, int t) { return t < NMETA ? MX + b * NMETA + t : b * SEQ + (t - NMETA); }
__device__ __forceinline__ void bt_of(int m, int& b, int& t) { if (m < MX) { b = m >> 13; t = (m & 8191) + NMETA; } else { b = (m - MX) >> 4; t = (m - MX) & 15; } }


__device__ __forceinline__ float block_sum256(float v, float* red) {
    for (int o = 32; o > 0; o >>= 1) v += __shfl_xor(v, o);
    const int w = tidf() >> 6;
    __syncthreads();
    if ((tidf() & 63) == 0) red[w] = v;
    __syncthreads();
    return red[0] + red[1] + red[2] + red[3];
}


struct EpiArgs {
    bf16_t* PROJ; const float* ROPE;
    bf16_t* TMP; bf16_t* MIXED;
    const float* x; const float* meta; bf16_t* H2;
    bf16_t* HID; bf16_t* YE; const float* GATEV;
};
typedef float f32x4 __attribute__((ext_vector_type(4)));
typedef float f32x16 __attribute__((ext_vector_type(16)));
typedef unsigned u32x4 __attribute__((ext_vector_type(4)));
typedef unsigned u32x2 __attribute__((ext_vector_type(2)));
typedef short bf16x8 __attribute__((ext_vector_type(8)));
typedef float f32x2_t __attribute__((ext_vector_type(2))); typedef __bf16 bf16x2_t __attribute__((ext_vector_type(2)));
__device__ __forceinline__ unsigned pk2(float lo, float hi) { const f32x2_t v = {lo, hi}; const bf16x2_t b = __builtin_convertvector(v, bf16x2_t); return __builtin_bit_cast(unsigned, b); }
__device__ __forceinline__ float lo16(unsigned w) { return __uint_as_float(w << 16); }
__device__ __forceinline__ float hi16(unsigned w) { return __uint_as_float(w & 0xffff0000u); }
__device__ __forceinline__ float sigm(float x) { return __builtin_amdgcn_rcpf(1.f + __expf(-x)); }
__device__ __forceinline__ u32x4 pack8(f32x4 a, f32x4 b) { u32x4 w; w.x = pk2(a.x, a.y); w.y = pk2(a.z, a.w); w.z = pk2(b.x, b.y); w.w = pk2(b.z, b.w); return w; }
__device__ __forceinline__ unsigned pk4_fp8(float a, float b, float c, float d) {
    a = __builtin_amdgcn_fmed3f(a, -448.f, 448.f); b = __builtin_amdgcn_fmed3f(b, -448.f, 448.f); c = __builtin_amdgcn_fmed3f(c, -448.f, 448.f); d = __builtin_amdgcn_fmed3f(d, -448.f, 448.f);
    int p = __builtin_amdgcn_cvt_pk_fp8_f32(a, b, 0, false); p = __builtin_amdgcn_cvt_pk_fp8_f32(c, d, p, true); return (unsigned)p;
}
constexpr float F8_WSCALE = 32.f, F8_HSCALE = 4.f;
__device__ __forceinline__ void epi8v(int mode, const EpiArgs& E, int mg, int c0, f32x4 a0, f32x4 a1) {
    if (mode == 1) {
        bf16_t* dst = E.PROJ + pj_col(mg, c0);
        if (c0 < C_V) {
            int b, t; bt_of(mg, b, t);
            const int i0 = ((c0 & 127) >> 3) * 4;
            const float sc = c0 >= C_K ? 0.08838834764831845f : 1.0f;
            const f32x4 cs = *(const f32x4*)(E.ROPE + (size_t)t * 128 + i0), sn = *(const f32x4*)(E.ROPE + (size_t)t * 128 + 64 + i0);
            const f32x4 o1 = (a0 * cs - a1 * sn) * sc, o2 = (a0 * sn + a1 * cs) * sc;
            *(u32x4*)dst = pack8(o1, o2);
        } else if (c0 < C_G || (c0 >= C_U && c0 < C_GA)) { *(u32x4*)dst = pack8(a0, a1); }
        else if (c0 < C_U) { f32x4 s0, s1; for (int j = 0; j < 4; ++j) { s0[j] = a0[j] * sigm(a0[j]); s1[j] = a1[j] * sigm(a1[j]); } *(u32x4*)dst = pack8(s0, s1); }
        else { f32x4 s0, s1; for (int j = 0; j < 4; ++j) { s0[j] = sigm(a0[j]); s1[j] = sigm(a1[j]); } *(u32x4*)dst = pack8(s0, s1); }
    } else if (mode == 2) {
        const u32x4 g = *(const u32x4*)(E.PROJ + pj_ga(mg) + c0);
        *(u32x4*)(E.TMP + (size_t)mg * DM + c0) = pack8((f32x4){lo16(g.x) * a0.x, hi16(g.x) * a0.y, lo16(g.y) * a0.z, hi16(g.y) * a0.w}, (f32x4){lo16(g.z) * a1.x, hi16(g.z) * a1.y, lo16(g.w) * a1.z, hi16(g.w) * a1.w});
    } else if (mode == 3) {
        const u32x4 g = *(const u32x4*)(E.PROJ + pj_gb(mg) + c0);
        const u32x4 t = *(const u32x4*)(E.TMP + (size_t)mg * DM + c0);
        const f32x4 o0 = (f32x4){lo16(t.x), hi16(t.x), lo16(t.y), hi16(t.y)} + (f32x4){lo16(g.x) * a0.x, hi16(g.x) * a0.y, lo16(g.y) * a0.z, hi16(g.y) * a0.w};
        const f32x4 o1 = (f32x4){lo16(t.z), hi16(t.z), lo16(t.w), hi16(t.w)} + (f32x4){lo16(g.z) * a1.x, hi16(g.z) * a1.y, lo16(g.w) * a1.z, hi16(g.w) * a1.w};
        *(u32x4*)(E.MIXED + (size_t)mg * DM + c0) = pack8(o0, o1);
    } else if (mode == 4) {
        const float* rs = mg < MX ? E.x + (size_t)mg * DM + c0 : E.meta + (size_t)((mg - MX) & 15) * DM + c0;
        *(u32x4*)(E.H2 + (size_t)mg * DM + c0) = pack8(*(const f32x4*)rs + a0, *(const f32x4*)(rs + 4) + a1);
    } else if (mode == 5) {
        const f32x4 g = a0 * (1.f / F8_WSCALE), u = a1 * (F8_HSCALE / F8_WSCALE);
        *(unsigned*)((unsigned char*)E.HID + (size_t)mg * FF + (c0 >> 1)) = pk4_fp8(g.x * sigm(g.x) * u.x, g.y * sigm(g.y) * u.y, g.z * sigm(g.z) * u.z, g.w * sigm(g.w) * u.w);
    } else {
        int e, ml; if (mg < NE * EM) { e = mg >> 11; ml = mg & (EM - 1); } else { e = (mg - NE * EM) >> 2; ml = EM + ((mg - NE * EM) & 3); }
        const float gt = (ml < 2 * CAP ? E.GATEV[((size_t)(ml / CAP) * NE + e) * CAP + (ml % CAP)] : 0.f) * (1.f / (F8_WSCALE * F8_HSCALE));
        *(u32x4*)(E.YE + (size_t)mg * DM + c0) = pack8(a0 * gt, a1 * gt);
    }
}


namespace pg8 {
#define PG8_LAS __attribute__((address_space(3)))
typedef unsigned short bf16_t;
typedef short bf16x8 __attribute__((ext_vector_type(8)));
typedef float f32x4 __attribute__((ext_vector_type(4)));
typedef unsigned u32x4 __attribute__((ext_vector_type(4)));
constexpr int BM = 256, BK = 64, HALF = 128, HTB = HALF * BK * 2  , STAGE_BYTES = 8 * HTB, NXCD = 8, WGM = 8;

__host__ __device__ __forceinline__ int lds_byte(int r, int c) { const int st = (r >> 4) * 2 + (c >> 5), rr = r & 15, cc = c & 31, ob = rr * 64 + cc * 2; return st * 1024 + (ob ^ (((ob >> 9) & 1) << 5)); }
__host__ __device__ __forceinline__ void stage_rc(int b, int& R, int& C) { const int st = b / 1024, sb = b % 1024, swz = sb ^ (((sb >> 9) & 1) << 5); R = (st >> 1) * 16 + swz / 64; C = (st & 1) * 32 + (swz % 64) / 2; }
__host__ __device__ __forceinline__ int perm32(int rho) { const int n = rho >> 4, i = rho & 15; return 8 * (i >> 2) + 4 * n + (i & 3); }

struct Unit { int pm, pn; };
struct Gemm { const bf16_t* A; const bf16_t* Bt; int M, N, K; int gt; size_t gstride; };

struct StaticOrder {
    int nM, nN, nwg, G, c;
    __host__ __device__ void init(int M, int N, int G_, int c_) { nM = M / BM; nN = N / BM; nwg = nM * nN; G = G_; c = c_; }
    __host__ __device__ bool next(int i, Unit& u) const {
        const long L = (long)i * G + c; if (L >= nwg) return false;
        int wgid = (int)L; { const int q = nwg / NXCD, r = nwg % NXCD, xcd = wgid % NXCD, off = wgid / NXCD; wgid = (xcd < r ? xcd * (q + 1) : r * (q + 1) + (xcd - r) * q) + off; }
        const int nig = WGM * nN, gid = wgid / nig, fm = gid * WGM, gsz = (nM - fm) < WGM ? (nM - fm) : WGM;
        u.pm = fm + ((wgid % nig) % gsz); u.pn = (wgid % nig) / gsz; return true;
    }
    __device__ __forceinline__ void a_ready(const Unit&) const {}
    __device__ __forceinline__ void done(const Unit&) const {}
};

__device__ __forceinline__ unsigned cvt_pk_bf16(float lo, float hi) { unsigned r; asm volatile("v_cvt_pk_bf16_f32 %0, %1, %2" : "=v"(r) : "v"(lo), "v"(hi)); return r; }
typedef int i32x8 __attribute__((ext_vector_type(8)));
typedef int i32x4v __attribute__((ext_vector_type(4)));
template <class Epi, class Sched, bool ALIGN_EPI = false, bool SP2 = false, bool FP8 = false, bool IND = false>
__device__ __forceinline__ void gemm_phase(PG8_LAS unsigned char* lds, const Gemm g, const Sched& S, const Epi& E, const PG8_LAS unsigned* rtab = nullptr) {
    static_assert(!IND || SP2, "indirect rows are wired into the SP2 loop only");
    const int tid = tidf(), wid = __builtin_amdgcn_readfirstlane(tid >> 6), lane = tid & 63, wr = wid >> 2, wc = wid & 3, fr = lane & 15, fq = lane >> 4;
    const int K = g.K, nt = K / BK;
    unsigned voffA[2], voffB[2]; int rowA[2]; unsigned colA2[2];
    unsigned vA[2][2], vN[2][2], vS[2][2];
#pragma unroll
    for (int i = 0; i < 2; ++i) { int R, C; stage_rc(tid * 16 + i * 8192, R, C); const int Rb = Epi::PERM ? ((R & ~31) + perm32(R & 31)) : R;
        voffA[i] = (unsigned)(R * K + C) * 2u; voffB[i] = (unsigned)(Rb * K + C) * 2u; rowA[i] = R; colA2[i] = (unsigned)C * 2u; }
    const size_t kstep = (size_t)(BK * 2);
    const size_t hstep = (size_t)HALF * K * 2;
    const size_t tstep = 2 * hstep;
    const unsigned ldsw = (unsigned)wid * 1024u;
    const int aoff = lds_byte(wr * 64 + fr, fq * 8), boff = lds_byte(wc * 32 + fr, fq * 8);
#define PG8_SA(b, h) (((b) * 2 + (h)) * HTB)
#define PG8_SB(b, h) ((4 + (b) * 2 + (h)) * HTB)
#define PG8_RTAB(dst, ui_) do { _Pragma("unroll") for (int h_ = 0; h_ < 2; ++h_) _Pragma("unroll") for (int i_ = 0; i_ < 2; ++i_) dst[h_][i_] = rtab[(ui_) * 256 + 128 * h_ + rowA[i_]] + colA2[i_]; } while (0)
#define PG8_STAGE_A(bufoff, gbase, h, V) do { if constexpr (IND) { _Pragma("unroll") for (int _i = 0; _i < 2; ++_i) \
        __builtin_amdgcn_global_load_lds((const unsigned*)((const char*)(gbase) + V[h][_i]), (PG8_LAS unsigned*)(lds + (bufoff) + ldsw + _i * 8192), 16, 0, 0); } \
    else { PG8_STAGE(bufoff, (const char*)(gbase) + (h) * hstep, voffA); } } while (0)
#define PG8_STAGE(bufoff, gbase, voff) do { _Pragma("unroll") for (int _i = 0; _i < 2; ++_i) \
        __builtin_amdgcn_global_load_lds((const unsigned*)((const char*)(gbase) + (voff)[_i]), (PG8_LAS unsigned*)(lds + (bufoff) + ldsw + _i * 8192), 16, 0, 0); } while (0)
#define PG8_LDA(dst, b, h) do { _Pragma("unroll") for (int m = 0; m < 4; ++m) _Pragma("unroll") for (int k = 0; k < 2; ++k) dst[m][k] = *(const PG8_LAS bf16x8*)(lds + PG8_SA(b, h) + aoff + m * 2048 + k * 1024); } while (0)
#define PG8_LDB(dst, b, h) do { _Pragma("unroll") for (int n = 0; n < 2; ++n) _Pragma("unroll") for (int k = 0; k < 2; ++k) dst[n][k] = *(const PG8_LAS bf16x8*)(lds + PG8_SB(b, h) + boff + n * 2048 + k * 1024); } while (0)
#define PG8_CAT(X) __builtin_shufflevector(__builtin_bit_cast(i32x4v, X[0]), __builtin_bit_cast(i32x4v, X[1]), 0, 1, 2, 3, 4, 5, 6, 7)
#define PG8_MMA(ai, bj, At, Bt) do { __builtin_amdgcn_s_setprio(1); if constexpr (FP8) {   \
        _Pragma("unroll") for (int m = 0; m < 4; ++m) _Pragma("unroll") for (int n = 0; n < 2; ++n) \
            { const i32x8 b8_ = PG8_CAT(Bt[n]), a8_ = PG8_CAT(At[m]);   \
              asm volatile("v_mfma_scale_f32_16x16x128_f8f6f4 %0, %1, %2, %0, %3, %3 op_sel_hi:[0,0,0]" : "+v"(acc[ai][bj][m][n]) : "v"(b8_), "v"(a8_), "v"(f8scale)); } \
    } else { _Pragma("unroll") for (int m = 0; m < 4; ++m) _Pragma("unroll") for (int n = 0; n < 2; ++n) _Pragma("unroll") for (int k = 0; k < 2; ++k) \
        acc[ai][bj][m][n] = __builtin_amdgcn_mfma_f32_16x16x32_bf16(Bt[n][k], At[m][k], acc[ai][bj][m][n], 0, 0, 0); } __builtin_amdgcn_s_setprio(0); } while (0)
#define PG8_WAIT_V(n) asm volatile("s_waitcnt vmcnt(" #n ")" ::: "memory")
#define PG8_WAIT_L(n) asm volatile("s_waitcnt lgkmcnt(" #n ")" ::: "memory")
#define PG8_BAR __builtin_amdgcn_s_barrier()
#define PG8_SCHED __builtin_amdgcn_sched_barrier(0)
    Unit cur, nxt; int ui = 0;
    if (!S.next(0, cur)) return;
    const int f8scale = 0x7f7f7f7f;
    f32x4 acc[2][2][4][2];
#pragma unroll
    for (int a = 0; a < 2; ++a)
#pragma unroll
        for (int b = 0; b < 2; ++b)
#pragma unroll
            for (int m = 0; m < 4; ++m)
#pragma unroll
                for (int n = 0; n < 2; ++n) acc[a][b][m][n] = (f32x4){0.f, 0.f, 0.f, 0.f};
    bf16x8 At[4][2], B0[2][2], B1[2][2];
    const char* cA = (const char*)g.A + (IND ? (size_t)0 : (size_t)cur.pm * tstep); const char* cB = (const char*)g.Bt + (size_t)(cur.pm / g.gt) * g.gstride + (size_t)cur.pn * tstep;
    S.a_ready(cur);
    if constexpr (SP2) {
        if constexpr (IND) { PG8_RTAB(vA, 0); asm volatile("s_waitcnt lgkmcnt(0)" ::: "memory"); }
        PG8_STAGE(PG8_SB(0, 0), cB, voffB); PG8_STAGE(PG8_SB(0, 1), cB + hstep, voffB); PG8_STAGE_A(PG8_SA(0, 0), cA, 0, vA); PG8_STAGE_A(PG8_SA(0, 1), cA, 1, vA);
        if (wr == 1) PG8_BAR;
        PG8_WAIT_V(2); PG8_BAR;
        PG8_STAGE(PG8_SB(1, 0), cB + kstep, voffB); PG8_STAGE_A(PG8_SA(1, 0), cA + kstep, 0, vA); PG8_STAGE(PG8_SB(1, 1), cB + hstep + kstep, voffB);
        PG8_WAIT_V(6); PG8_BAR;
    } else {
        PG8_STAGE(PG8_SB(0, 0), cB, voffB); PG8_STAGE(PG8_SA(0, 0), cA, voffA); PG8_STAGE(PG8_SB(0, 1), cB + hstep, voffB); PG8_STAGE(PG8_SA(0, 1), cA + hstep, voffA);
        if (wr == 1) PG8_BAR;
        PG8_WAIT_V(4); PG8_BAR;
        PG8_STAGE(PG8_SB(1, 0), cB + kstep, voffB); PG8_STAGE(PG8_SA(1, 0), cA + kstep, voffA); PG8_STAGE(PG8_SB(1, 1), cB + hstep + kstep, voffB);
        PG8_WAIT_V(6); PG8_BAR;
    }
    for (;;) {
        const bool has_next = S.next(ui + 1, nxt);
        const char* nA = has_next ? (const char*)g.A + (IND ? (size_t)0 : (size_t)nxt.pm * tstep) : cA; const char* nB = has_next ? (const char*)g.Bt + (size_t)(nxt.pm / g.gt) * g.gstride + (size_t)nxt.pn * tstep : cB;
        for (int t = 0; t < nt; t += 2) {
            const bool last = (t == nt - 2);
            const char* a1 = cA + (size_t)(t + 1) * kstep;
            const char* a2 = last ? nA : cA + (size_t)(t + 2) * kstep; const char* b2 = last ? nB : cB + (size_t)(t + 2) * kstep;
            const char* a3 = a2 + kstep; const char* b3 = b2 + kstep;
            if (last && has_next) S.a_ready(nxt);
            if constexpr (IND) { if (last && has_next) PG8_RTAB(vN, ui + 1);
                _Pragma("unroll") for (int h_ = 0; h_ < 2; ++h_) _Pragma("unroll") for (int i_ = 0; i_ < 2; ++i_) vS[h_][i_] = (last && has_next) ? vN[h_][i_] : vA[h_][i_]; }
            if constexpr (SP2) {
            PG8_LDB(B0, 0, 0); PG8_LDB(B1, 0, 1); PG8_SCHED; PG8_LDA(At, 0, 0); PG8_STAGE_A(PG8_SA(1, 1), a1, 1, vA);
            PG8_WAIT_V(8); PG8_WAIT_L(0); PG8_BAR; PG8_MMA(0, 0, At, B0); PG8_MMA(0, 1, At, B1); PG8_BAR; PG8_SCHED;
            PG8_LDA(At, 0, 1); PG8_STAGE(PG8_SB(0, 0), b2, voffB); PG8_STAGE(PG8_SB(0, 1), b2 + hstep, voffB); PG8_STAGE_A(PG8_SA(0, 0), a2, 0, vS);
            PG8_WAIT_V(8); PG8_WAIT_L(0); PG8_BAR; PG8_MMA(1, 0, At, B0); PG8_MMA(1, 1, At, B1); PG8_BAR; PG8_SCHED;
            PG8_LDB(B0, 1, 0); PG8_LDB(B1, 1, 1); PG8_SCHED; PG8_LDA(At, 1, 0); PG8_STAGE_A(PG8_SA(0, 1), a2, 1, vS);
            PG8_WAIT_V(8); PG8_WAIT_L(0); PG8_BAR; PG8_MMA(0, 0, At, B0); PG8_MMA(0, 1, At, B1); PG8_BAR; PG8_SCHED;
            PG8_LDA(At, 1, 1); PG8_STAGE(PG8_SB(1, 0), b3, voffB); PG8_STAGE(PG8_SB(1, 1), b3 + hstep, voffB); PG8_STAGE_A(PG8_SA(1, 0), a3, 0, vS);
            PG8_WAIT_V(8); PG8_WAIT_L(0); PG8_BAR; PG8_MMA(1, 0, At, B0); PG8_MMA(1, 1, At, B1); PG8_BAR; PG8_SCHED;
            } else {
            PG8_LDB(B0, 0, 0); PG8_SCHED; PG8_LDA(At, 0, 0); PG8_STAGE(PG8_SA(1, 1), a1 + hstep, voffA);
            PG8_WAIT_L(8); PG8_BAR; PG8_WAIT_L(0); PG8_MMA(0, 0, At, B0); PG8_BAR; PG8_SCHED;
            PG8_LDB(B1, 0, 1); PG8_STAGE(PG8_SB(0, 0), b2, voffB);
            PG8_BAR; PG8_WAIT_L(0); PG8_MMA(0, 1, At, B1); PG8_BAR;
            PG8_LDA(At, 0, 1); PG8_STAGE(PG8_SA(0, 0), a2, voffA);
            PG8_BAR; PG8_WAIT_L(0); PG8_MMA(1, 0, At, B0); PG8_BAR; PG8_SCHED;
            PG8_STAGE(PG8_SB(0, 1), b2 + hstep, voffB);
            PG8_WAIT_V(6); PG8_BAR; PG8_MMA(1, 1, At, B1); PG8_BAR;
            PG8_LDB(B0, 1, 0); PG8_SCHED; PG8_LDA(At, 1, 0); PG8_STAGE(PG8_SA(0, 1), a2 + hstep, voffA);
            PG8_WAIT_L(8); PG8_BAR; PG8_WAIT_L(0); PG8_MMA(0, 0, At, B0); PG8_BAR; PG8_SCHED;
            PG8_LDB(B1, 1, 1); PG8_STAGE(PG8_SB(1, 0), b3, voffB);
            PG8_BAR; PG8_WAIT_L(0); PG8_MMA(0, 1, At, B1); PG8_BAR;
            PG8_LDA(At, 1, 1); PG8_STAGE(PG8_SA(1, 0), a3, voffA);
            PG8_BAR; PG8_WAIT_L(0); PG8_MMA(1, 0, At, B0); PG8_BAR; PG8_SCHED;
            PG8_STAGE(PG8_SB(1, 1), b3 + hstep, voffB);
            PG8_WAIT_V(6); PG8_BAR; PG8_MMA(1, 1, At, B1); PG8_BAR;
            }
        }
        if constexpr (FP8) asm volatile("s_nop 15\n\ts_nop 15" ::: "memory");
        if constexpr (ALIGN_EPI) { if (wr == 0) PG8_BAR; }
        if constexpr (!Epi::AFTER_DRAIN) { E(acc, cur, wr, wc, fr, fq); S.done(cur); }
        if (!has_next) break;
#pragma unroll
        for (int a = 0; a < 2; ++a)
#pragma unroll
            for (int b = 0; b < 2; ++b)
#pragma unroll
                for (int m = 0; m < 4; ++m)
#pragma unroll
                    for (int n = 0; n < 2; ++n) acc[a][b][m][n] = (f32x4){0.f, 0.f, 0.f, 0.f};
        cur = nxt; cA = nA; cB = nB; ++ui;
        if constexpr (IND) { _Pragma("unroll") for (int h_ = 0; h_ < 2; ++h_) _Pragma("unroll") for (int i_ = 0; i_ < 2; ++i_) vA[h_][i_] = vN[h_][i_]; }
        if constexpr (ALIGN_EPI) { if (wr == 1) PG8_BAR; }
    }
    PG8_WAIT_V(0);
    if constexpr (!ALIGN_EPI) { if (wr == 0) PG8_BAR; }
    PG8_BAR;
    if constexpr (Epi::AFTER_DRAIN) { E.fused(acc, cur, wr, wc, fr, fq, lds, wid, lane); S.done(cur); }
#undef PG8_SA
#undef PG8_SB
#undef PG8_STAGE
#undef PG8_STAGE_A
#undef PG8_RTAB
#undef PG8_LDA
#undef PG8_LDB
#undef PG8_MMA
#undef PG8_CAT
#undef PG8_WAIT_V
#undef PG8_WAIT_L
#undef PG8_BAR
#undef PG8_SCHED
}
}

#define LAS __attribute__((address_space(3)))
template <int MODE> struct EpiFast {
    static constexpr bool PERM = true, AFTER_DRAIN = false;
    EpiArgs E;
    __device__ __forceinline__ void operator()(const pg8::f32x4 (&acc)[2][2][4][2], const pg8::Unit& u, int wr, int wc, int fr, int fq) const {
        const int row0 = u.pm * 256 + wr * 64 + fr, col0 = u.pn * 256 + wc * 32 + 8 * fq;
        if constexpr (MODE == 2 || MODE == 3 || MODE == 4) {
#pragma unroll
            for (int ai = 0; ai < 2; ++ai) {
                u32x4 g[4][2], t[4][2]; f32x4 x0[4][2], x1[4][2];
#pragma unroll
                for (int m = 0; m < 4; ++m)
#pragma unroll
                    for (int bj = 0; bj < 2; ++bj) { const int mg = row0 + ai * 128 + m * 16, c0 = col0 + bj * 128;
                        if constexpr (MODE == 2) g[m][bj] = *(const u32x4*)(E.PROJ + pj_ga(mg) + c0);
                        if constexpr (MODE == 3) { g[m][bj] = *(const u32x4*)(E.PROJ + pj_gb(mg) + c0); t[m][bj] = *(const u32x4*)(E.TMP + (size_t)mg * DM + c0); }
                        if constexpr (MODE == 4) { const float* rs = E.x + (size_t)mg * DM + c0; x0[m][bj] = *(const f32x4*)rs; x1[m][bj] = *(const f32x4*)(rs + 4); } }
#pragma unroll
                for (int m = 0; m < 4; ++m)
#pragma unroll
                    for (int bj = 0; bj < 2; ++bj) { const int mg = row0 + ai * 128 + m * 16, c0 = col0 + bj * 128; const f32x4 a0 = acc[ai][bj][m][0], a1 = acc[ai][bj][m][1];
                        if constexpr (MODE == 4) { *(u32x4*)(E.H2 + (size_t)mg * DM + c0) = pack8(x0[m][bj] + a0, x1[m][bj] + a1); }
                        else { const u32x4 gg = g[m][bj];
                            const f32x4 p0 = (f32x4){lo16(gg.x) * a0.x, hi16(gg.x) * a0.y, lo16(gg.y) * a0.z, hi16(gg.y) * a0.w}, p1 = (f32x4){lo16(gg.z) * a1.x, hi16(gg.z) * a1.y, lo16(gg.w) * a1.z, hi16(gg.w) * a1.w};
                            if constexpr (MODE == 2) *(u32x4*)(E.TMP + (size_t)mg * DM + c0) = pack8(p0, p1);
                            else { const u32x4 tt = t[m][bj]; *(u32x4*)(E.MIXED + (size_t)mg * DM + c0) = pack8((f32x4){lo16(tt.x), hi16(tt.x), lo16(tt.y), hi16(tt.y)} + p0, (f32x4){lo16(tt.z), hi16(tt.z), lo16(tt.w), hi16(tt.w)} + p1); } } }
            }
        } else if constexpr (MODE == 1) {
            const int pn = __builtin_amdgcn_readfirstlane(u.pn), cl = wc * 32 + 8 * fq;
            int kind, W; size_t sb[2]; int cin[2];
            if (pn < 4) { kind = pn < 2 ? 0 : 1; W = 128; const size_t base = pn < 2 ? PJ_Q : PJ_K; const int h0 = 2 * (pn & 1);
                sb[0] = base + (size_t)h0 * MP * 128; sb[1] = base + (size_t)(h0 + 1) * MP * 128; cin[0] = cl; cin[1] = cl; }
            else if (pn < 12) { kind = pn < 8 ? 2 : 3; W = 256; const size_t base = (pn < 8 ? PJ_V : PJ_G) + (size_t)(pn & 3) * MP * 256; sb[0] = base; sb[1] = base; cin[0] = cl; cin[1] = 128 + cl; }
            else if (pn < 24) { kind = 2; W = 1024; const size_t base = PJ_U + (size_t)((pn - 12) >> 2) * MP * 1024; sb[0] = base; sb[1] = base; cin[0] = ((pn - 12) & 3) * 256 + cl; cin[1] = cin[0] + 128; }
            else { kind = 4; W = 1024; const size_t base = pn < 28 ? PJ_GA : PJ_GB; sb[0] = base; sb[1] = base; cin[0] = (pn & 3) * 256 + cl; cin[1] = cin[0] + 128; }
            const int i0 = 16 * wc + 4 * fq;
            const float sc = kind == 1 ? 0.08838834764831845f : 1.0f;
#pragma unroll
            for (int ai = 0; ai < 2; ++ai)
#pragma unroll
                for (int m = 0; m < 4; ++m) {
                    const int mg = row0 + ai * 128 + m * 16;
                    f32x4 cs, sn;
                    if (kind < 2) { const int t = (mg & 8191) + NMETA; cs = *(const f32x4*)(E.ROPE + (size_t)t * 128 + i0); sn = *(const f32x4*)(E.ROPE + (size_t)t * 128 + 64 + i0); }
#pragma unroll
                    for (int bj = 0; bj < 2; ++bj) {
                        bf16_t* dst = E.PROJ + sb[bj] + (size_t)mg * W + cin[bj];
                        const f32x4 a0 = acc[ai][bj][m][0], a1 = acc[ai][bj][m][1];
                        if (kind < 2) *(u32x4*)dst = pack8((a0 * cs - a1 * sn) * sc, (a0 * sn + a1 * cs) * sc);
                        else if (kind == 2) *(u32x4*)dst = pack8(a0, a1);
                        else if (kind == 3) { f32x4 s0, s1; for (int j = 0; j < 4; ++j) { s0[j] = a0[j] * sigm(a0[j]); s1[j] = a1[j] * sigm(a1[j]); } *(u32x4*)dst = pack8(s0, s1); }
                        else { f32x4 s0, s1; for (int j = 0; j < 4; ++j) { s0[j] = sigm(a0[j]); s1[j] = sigm(a1[j]); } *(u32x4*)dst = pack8(s0, s1); }
                    }
                }
        } else {
#pragma unroll
        for (int ai = 0; ai < 2; ++ai)
#pragma unroll
            for (int m = 0; m < 4; ++m)
#pragma unroll
                for (int bj = 0; bj < 2; ++bj) epi8v(MODE, E, row0 + ai * 128 + m * 16, col0 + bj * 128, acc[ai][bj][m][0], acc[ai][bj][m][1]);
        }
    }
};
__device__ __forceinline__ void side_tile(int mode, const EpiArgs& E, const bf16_t* __restrict__ A, int erow0, const bf16_t* __restrict__ Bt, int K, int n0, LAS unsigned char* lds) {
    const int tid = tidf(), l = tid & 63, wid = tid >> 6, i = l & 31, h = l >> 5;
    const int g = i >> 3, hh = (i >> 2) & 1, q = i & 3, L = 8 * (2 * hh + (g >> 1)) + 4 * (g & 1) + q;
    const int kw = K / 8;
    const bf16_t* wp = Bt + (size_t)(n0 + L) * K + wid * kw + 8 * h;
    const bf16_t* xp = A + (size_t)i * K + wid * kw + 8 * h;
    f32x16 acc; for (int r = 0; r < 16; ++r) acc[r] = 0.f;
#pragma unroll 8
    for (int k0 = 0; k0 < kw; k0 += 16) { const bf16x8 wf = *(const bf16x8*)(wp + k0), xf = *(const bf16x8*)(xp + k0); acc = __builtin_amdgcn_mfma_f32_32x32x16_bf16(wf, xf, acc, 0, 0, 0); }
    LAS float* red = (LAS float*)lds;
    __syncthreads();
#pragma unroll
    for (int r = 0; r < 16; ++r) red[(wid * 16 + r) * 64 + l] = acc[r];
    __syncthreads();
    if (wid == 0) {
#pragma unroll
        for (int r = 0; r < 16; ++r) { float s = 0.f;
#pragma unroll
            for (int w = 0; w < 8; ++w) s += red[(w * 16 + r) * 64 + l];
            acc[r] = s; }
        epi8v(mode, E, erow0 + i, n0 + 16 * h, (f32x4){acc[0], acc[1], acc[2], acc[3]}, (f32x4){acc[4], acc[5], acc[6], acc[7]});
        epi8v(mode, E, erow0 + i, n0 + 16 * h + 8, (f32x4){acc[8], acc[9], acc[10], acc[11]}, (f32x4){acc[12], acc[13], acc[14], acc[15]});
    }
}
__device__ __forceinline__ void side_tile8(int mode, const EpiArgs& E, int e, const unsigned char* __restrict__ X, const int* __restrict__ idx, const unsigned char* __restrict__ Wt, int K, int n0) {
    typedef int i32x8s __attribute__((ext_vector_type(8)));
    const int l = tidf() & 63, i = l & 31, h = l >> 5;
    const int g = i >> 3, hh = (i >> 2) & 1, q = i & 3, L = 8 * (2 * hh + (g >> 1)) + 4 * (g & 1) + q;
    const unsigned char* wp = Wt + (size_t)(n0 + L) * K + 32 * h;
    const bool xv = i < EL;
    const unsigned char* xp;
    if (mode == 5) { const int ml = EM + (xv ? i : 0), b = ml / CAP; xp = X + (size_t)row_of(b, idx[((size_t)b * NE + e) * CAP + (ml - b * CAP)]) * K + 32 * h; }
    else xp = X + (size_t)(NE * EM + e * EL + (xv ? i : 0)) * K + 32 * h;
    f32x16 acc; for (int r = 0; r < 16; ++r) acc[r] = 0.f;
#pragma unroll 4
    for (int k0 = 0; k0 < K; k0 += 64) {
        const u32x4 w0 = *(const u32x4*)(wp + k0), w1 = *(const u32x4*)(wp + k0 + 16); u32x4 x0 = *(const u32x4*)(xp + k0), x1 = *(const u32x4*)(xp + k0 + 16);
        if (!xv) { x0 = (u32x4){0u, 0u, 0u, 0u}; x1 = x0; }
        const i32x8s wf = {(int)w0.x, (int)w0.y, (int)w0.z, (int)w0.w, (int)w1.x, (int)w1.y, (int)w1.z, (int)w1.w}, xf = {(int)x0.x, (int)x0.y, (int)x0.z, (int)x0.w, (int)x1.x, (int)x1.y, (int)x1.z, (int)x1.w};
        acc = __builtin_amdgcn_mfma_scale_f32_32x32x64_f8f6f4(wf, xf, acc, 0, 0, 0, 0x7f7f7f7f, 0, 0x7f7f7f7f);
    }
    if (xv) {
        const int mg = NE * EM + e * EL + i;
        epi8v(mode, E, mg, n0 + 16 * h, (f32x4){acc[0], acc[1], acc[2], acc[3]}, (f32x4){acc[4], acc[5], acc[6], acc[7]});
        epi8v(mode, E, mg, n0 + 16 * h + 8, (f32x4){acc[8], acc[9], acc[10], acc[11]}, (f32x4){acc[12], acc[13], acc[14], acc[15]});
    }
}
struct GemmArgs { const bf16_t* A; const bf16_t* Bt; int M, N, K, gt; size_t gstride; int side; int pad; const int* idx; };
#ifndef PG8_ALIGN
#define PG8_ALIGN true
#endif
constexpr int GEMM_LDS = 131072 + 1024;
template <int MODE> __device__ __forceinline__ void gemm_fast_body(LAS unsigned char* lds, const GemmArgs& ga, const EpiArgs& E) {
    if (ga.side) {
        const int nt = ga.N / 32;
        for (int t = blockIdx.x; t < nt; t += gridDim.x) side_tile(MODE, E, ga.A + (size_t)MX * ga.K, MX, ga.Bt, ga.K, t * 32, lds);
        asm volatile("s_waitcnt vmcnt(0)" ::: "memory");
        __syncthreads();
    }
    pg8::Gemm g{ga.A, ga.Bt, ga.M, ga.N, ga.K, ga.gt, ga.gstride};
    pg8::StaticOrder S; S.init(ga.M, ga.N, (int)gridDim.x, (int)blockIdx.x);
    EpiFast<MODE> Ep{E};
    if constexpr (MODE == 5 || MODE == 6) {
        const int nct = ga.N / 32, gw = (tidf() >> 6) * gridDim.x + blockIdx.x;
        for (int t = gw; t < NE * nct; t += 8 * gridDim.x) { const int e = t / nct, ct = t - e * nct;
            side_tile8(MODE, E, e, (const unsigned char*)ga.A, ga.idx, (const unsigned char*)ga.Bt + (size_t)e * ga.gstride, ga.K * 2, ct * 32); }
        asm volatile("s_waitcnt vmcnt(0)" ::: "memory");
    }
    if constexpr (MODE == 5) {
        LAS unsigned* rtab = (LAS unsigned*)(lds + pg8::STAGE_BYTES);
        const int tid = tidf();
        for (int i = 0; i < 12; ++i) { pg8::Unit u; if (!S.next(i, u)) break;
            if (tid < 256) { const int e = u.pm / (EM / 256), ml = (u.pm % (EM / 256)) * 256 + tid; int row = MROWS;
                if (ml < 2 * CAP) { const int b = ml / CAP; row = row_of(b, ga.idx[((size_t)b * NE + e) * CAP + (ml - b * CAP)]); }
                rtab[i * 256 + tid] = (unsigned)row * (unsigned)DM; } }
        __syncthreads();
        pg8::gemm_phase<EpiFast<MODE>, pg8::StaticOrder, PG8_ALIGN, true, true, true>(lds, g, S, Ep, rtab);
    } else
    pg8::gemm_phase<EpiFast<MODE>, pg8::StaticOrder, PG8_ALIGN, true, (MODE >= 5)>(lds, g, S, Ep);
}

__device__ __forceinline__ float log_sigmoid(float x) { return -log1pf(expf(-x)); }
__device__ __forceinline__ int chunk_row(int b, int n, int c) { return n == 0 ? (c >= 112 ? MX + b * 16 + (c - 112) : -1) : b * SEQ + 128 * (n - 1) + c; }


constexpr int QS_STRIDE = 130;
constexpr int R2_LDS = 2 * 128 * QS_STRIDE * 2 + 128 * 128 * 4 + 64 * 4;


constexpr int CV_GR_BYTES = GL * 2;
constexpr int CV_ZROW = 272, CV_ZB = 18176  , CV_Z_BYTES = 2 * CV_ZB;
constexpr int CV_SLOT = CV_GR_BYTES + CV_Z_BYTES;
constexpr int CV_LDS = 2 * CV_SLOT;
__device__ __forceinline__ bf16x8 cv_load_frag(const LAS unsigned char* p, unsigned sh) {
    unsigned X[5];
#pragma unroll
    for (int i = 0; i < 5; ++i) X[i] = *(const LAS unsigned*)(p + 4 * i);
    u32x4 o;
    o.x = __builtin_amdgcn_alignbit(X[1], X[0], sh); o.y = __builtin_amdgcn_alignbit(X[2], X[1], sh);
    o.z = __builtin_amdgcn_alignbit(X[3], X[2], sh); o.w = __builtin_amdgcn_alignbit(X[4], X[3], sh);
    return __builtin_bit_cast(bf16x8, o);
}
__device__ __forceinline__ void conv_fast_body(LAS unsigned char* lds, const bf16_t* __restrict__ G, const bf16_t* __restrict__ ZT, bf16_t* __restrict__ YCT, int c_first) {
    const int tid = tidf(), l = tid & 63, wid = tid >> 6, slot = wid >> 2, ct = wid & 3;
    const int ts = tid & 255;
    LAS unsigned char* grb = lds + slot * CV_SLOT;
    LAS unsigned char* zb = grb + CV_GR_BYTES;
    for (int rd = 0; rd < 2; ++rd) {
        const int c = c_first + 2 * rd + slot;
        __syncthreads();
        {
            const u32x4* gsrc = (const u32x4*)(G + (size_t)c * GL);
            {
                u32x4 gv[9];
#pragma unroll
                for (int k = 0; k < 9; ++k) { const int i = ts + 256 * k; gv[k] = i < GL / 8 ? gsrc[i] : (u32x4){0u, 0u, 0u, 0u}; }
#pragma unroll
                for (int k = 0; k < 9; ++k) { const int i = ts + 256 * k;
                    if (i < GL / 8) { const u32x4 v = gv[k]; u32x4 o;
                        o.x = __builtin_amdgcn_alignbit(v.w, v.w, 16); o.y = __builtin_amdgcn_alignbit(v.z, v.z, 16); o.z = __builtin_amdgcn_alignbit(v.y, v.y, 16); o.w = __builtin_amdgcn_alignbit(v.x, v.x, 16);
                        *(LAS u32x4*)(grb + (size_t)(GL - 8 * (i + 1)) * 2) = o; } }
            }
            asm volatile("" ::: "memory");
            {
                u32x4 zv[9];
#pragma unroll
                for (int k = 0; k < 9; ++k) {
                    const int i = ts + 256 * k; zv[k] = (u32x4){0u, 0u, 0u, 0u};
                    if (i < 2 * 66 * 17) { const int bb = i / (66 * 17), rem = i - bb * (66 * 17), Ib = rem / 17, q = rem - Ib * 17;
                        const bf16_t* zr = ZT + ((size_t)bb * 1024 + c) * ZL;
                        if (q < 16) { if (Ib == 0) { if (q >= 14) zv[k] = *(const u32x4*)(zr + 8 * (q - 14)); } else if (Ib <= 64) zv[k] = *(const u32x4*)(zr + 16 + 128 * (Ib - 1) + 8 * q); } }
                }
#pragma unroll
                for (int k = 0; k < 9; ++k) { const int i = ts + 256 * k;
                    if (i < 2 * 66 * 17) { const int bb = i / (66 * 17), rem = i - bb * (66 * 17), Ib = rem / 17, q = rem - Ib * 17; *(LAS u32x4*)(zb + bb * CV_ZB + Ib * CV_ZROW + q * 16) = zv[k]; } }
            }
        }
        __syncthreads();
        const int r = l & 31, h = l >> 5;
        const int Ec = 8431 + 112 - r + 8 * h;
        const unsigned sh = (unsigned)(Ec & 1) * 16u;
        const int Io = 16 * ct + (r & 15), bcol = r >> 4;
        f32x16 acc[4];
#pragma unroll
        for (int rt = 0; rt < 4; ++rt) for (int q = 0; q < 16; ++q) acc[rt][q] = 0.f;
        bf16x8 F[14];
        int d = 16 * ct - 63;
        const LAS unsigned char* abase = grb + 4 * (Ec >> 1) - 256 * d - 32 * 13;
#pragma unroll
        for (int f = 0; f < 6; ++f) F[f] = cv_load_frag(abase + 32 * (13 - f), sh);
        const int dend = 16 * ct + 16;
        for (; d <= dend; ++d) {
#pragma unroll
            for (int f = 6; f < 10; ++f) F[f] = cv_load_frag(abase + 32 * (13 - f), sh);
            __builtin_amdgcn_sched_barrier(0);
#pragma unroll
            for (int f = 10; f < 14; ++f) F[f] = cv_load_frag(abase + 32 * (13 - f), sh);
            int Ib = Io - d + 1; Ib = (Ib < 0 || Ib > 64) ? 65 : Ib;
            const LAS unsigned char* zp = zb + bcol * CV_ZB + Ib * CV_ZROW + 16 * h;
#pragma unroll
            for (int ks = 0; ks < 8; ++ks) {
                const bf16x8 Bf = *(const LAS bf16x8*)(zp + 32 * ks);
#pragma unroll
                for (int rt = 0; rt < 4; ++rt) acc[rt] = __builtin_amdgcn_mfma_f32_32x32x16_bf16(F[2 * rt - ks + 7], Bf, acc[rt], 0, 0, 0);
            }
#pragma unroll
            for (int f = 0; f < 6; ++f) F[f] = F[f + 8];
            abase -= 256;
        }
        {
            bf16_t* yr = YCT + ((size_t)bcol * 1024 + c) * ZL + 16 + 128 * Io + 4 * h;
#pragma unroll
            for (int rt = 0; rt < 4; ++rt)
#pragma unroll
                for (int g = 0; g < 4; ++g) { u32x2 w; w.x = pk2(acc[rt][4 * g], acc[rt][4 * g + 1]); w.y = pk2(acc[rt][4 * g + 2], acc[rt][4 * g + 3]); *(u32x2*)(yr + 32 * rt + 8 * g) = w; }
        }
        {
            float a0[4], a1[4];
#pragma unroll
            for (int q = 0; q < 4; ++q) { a0[q] = 0.f; a1[q] = 0.f; }
            const LAS bf16_t* grh = (const LAS bf16_t*)grb;
            for (int s = l; s < TT; s += 64) {
                int Ib, j; if (s < 16) { Ib = 0; j = 112 + s; } else { const int s2 = s - 16; Ib = 1 + (s2 >> 7); j = s2 & 127; }
                const float z0 = bf2f(*(const LAS bf16_t*)(zb + Ib * CV_ZROW + 2 * j)), z1 = bf2f(*(const LAS bf16_t*)(zb + CV_ZB + Ib * CV_ZROW + 2 * j));
#pragma unroll
                for (int q = 0; q < 4; ++q) { const float gv = bf2f(grh[8431 - (4 * ct + q) + s]); a0[q] += gv * z0; a1[q] += gv * z1; }
            }
#pragma unroll
            for (int q = 0; q < 4; ++q) {
                float v0 = a0[q], v1 = a1[q];
                for (int o = 32; o > 0; o >>= 1) { v0 += __shfl_xor(v0, o); v1 += __shfl_xor(v1, o); }
                if (l == 0) { YCT[((size_t)0 * 1024 + c) * ZL + 4 * ct + q] = f2bf(v0); YCT[((size_t)1 * 1024 + c) * ZL + 4 * ct + q] = f2bf(v1); }
            }
        }
    }
}


struct Ctx {
    const float *x, *meta, *norm1_g, *w_in, *dec_f, *dec_b, *hg, *w_ret, *cw, *cb, *fw1, *fb1, *fw2, *fb2, *fw3, *fb3, *ffq, *fw4, *skip, *w_hy, *w_o, *norm2_g, *w_router, *w_eg, *w_eu, *w_ed, *gfin;
    unsigned char* ws; unsigned char* dob;
};
#define P_WRET ((bf16_t*)(c.ws + WS_WRET))
#define P_WHY ((bf16_t*)(c.ws + WS_WHY))
#define P_WO ((bf16_t*)(c.ws + WS_WO))
#define P_XN ((bf16_t*)(c.ws + WS_XN))
#define P_PROJ ((bf16_t*)(c.ws + WS_PROJ))
#define P_S ((bf16_t*)(c.ws + WS_S))
#define P_TMP ((bf16_t*)(c.ws + WS_S))
#define P_ZT ((bf16_t*)(c.ws + WS_ZT))
#define P_G ((bf16_t*)(c.ws + WS_G))
#define P_AHY ((bf16_t*)(c.ws + WS_G))
#define P_ARET ((bf16_t*)(c.ws + WS_ARET))
#define P_WGU ((bf16_t*)(c.ws + WS_WGU))
#define P_WD ((bf16_t*)(c.ws + WS_WD))
#define P_XE ((bf16_t*)(c.ws + WS_XE))
#define P_YE ((bf16_t*)(c.ws + WS_XE))
#define P_HID ((bf16_t*)(c.ws + WS_HID))
#define P_WIN ((bf16_t*)(c.dob + DO_WIN))
#define P_ROPE ((float*)(c.dob + DO_ROPE))
#define P_YCT ((bf16_t*)(c.dob + DO_YCT))
#define P_AFF ((float*)(c.ws + WS_MISC + MI_AFF))
#define P_IDX ((int*)(c.ws + WS_MISC + MI_IDX))
#define P_GATEV ((float*)(c.ws + WS_MISC + MI_GATE))
#define P_INV ((int*)(c.ws + WS_MISC + MI_INV))
#define P_H2 ((bf16_t*)(c.ws + 112 * MiB))
#define P_OUT ((float*)c.dob)
#define LDSW() asm volatile("s_waitcnt lgkmcnt(0)" ::: "memory")
__device__ __forceinline__ float wave_sum(float v) {
#pragma unroll
    for (int o = 1; o < 64; o <<= 1) v += __shfl_xor(v, o);
    return v;
}
__device__ __forceinline__ EpiArgs make_epi(const Ctx& c) {
    EpiArgs E{}; E.PROJ = P_PROJ; E.ROPE = P_ROPE; E.TMP = P_TMP; E.MIXED = P_XN; E.x = c.x; E.meta = c.meta; E.H2 = P_H2; E.HID = P_HID; E.YE = P_YE; E.GATEV = P_GATEV; return E;
}

__device__ __forceinline__ int wt_dst_row(int mode, int s) {
    if (mode == 1) { if (s >= 1024) return s; const int sl = s & 127; const int i = sl & 63; return (s & ~127) + 8 * (i >> 2) + (sl >= 64 ? 4 : 0) + (i & 3); }
    if (mode == 2) return 8 * (s >> 2) + (s & 3);
    if (mode == 3) return 8 * (s >> 2) + 4 + (s & 3);
    return s;
}
__device__ __forceinline__ void wt_item(const float* __restrict__ W, int K, int N, bf16_t* __restrict__ WT, LAS float* scr, int kb, int nb, int lane, int mode) {
    const int k0 = 64 * kb, n0 = 32 * nb;
#pragma unroll
    for (int i = 0; i < 8; ++i) { const int kk = 8 * i + (lane >> 3); const f32x4 v = *(const f32x4*)(W + (size_t)(k0 + kk) * N + n0 + 4 * (lane & 7));
        LAS float* d = scr + kk * 33 + 4 * (lane & 7); d[0] = v.x; d[1] = v.y; d[2] = v.z; d[3] = v.w; }
    LDSW();
    const int cc = lane & 7;
#pragma unroll
    for (int j = 0; j < 4; ++j) { const int n = (lane >> 3) + 8 * j; const LAS float* s = scr + (8 * cc) * 33 + n;
        u32x4 o; o.x = pk2(s[0 * 33], s[1 * 33]); o.y = pk2(s[2 * 33], s[3 * 33]); o.z = pk2(s[4 * 33], s[5 * 33]); o.w = pk2(s[6 * 33], s[7 * 33]);
        *(u32x4*)(WT + (size_t)wt_dst_row(mode, n0 + n) * K + k0 + 8 * cc) = o; }
    LDSW();
}

__device__ __forceinline__ void wt_item8(const float* __restrict__ W, int K, int N, unsigned char* __restrict__ WT, LAS float* scr, int kb, int nb, int lane, int mode, float scale) {
    const int k0 = 64 * kb, n0 = 32 * nb;
#pragma unroll
    for (int i = 0; i < 8; ++i) { const int kk = 8 * i + (lane >> 3); const f32x4 v = *(const f32x4*)(W + (size_t)(k0 + kk) * N + n0 + 4 * (lane & 7));
        LAS float* d = scr + kk * 33 + 4 * (lane & 7); d[0] = v.x; d[1] = v.y; d[2] = v.z; d[3] = v.w; }
    LDSW();
    const int cc = lane & 7;
#pragma unroll
    for (int j = 0; j < 4; ++j) { const int n = (lane >> 3) + 8 * j; const LAS float* s = scr + (8 * cc) * 33 + n;
        u32x2 o; o.x = pk4_fp8(s[0 * 33] * scale, s[1 * 33] * scale, s[2 * 33] * scale, s[3 * 33] * scale); o.y = pk4_fp8(s[4 * 33] * scale, s[5 * 33] * scale, s[6 * 33] * scale, s[7 * 33] * scale);
        *(u32x2*)(WT + (size_t)wt_dst_row(mode, n0 + n) * K + k0 + 8 * cc) = o; }
    LDSW();
}

constexpr int HDN_ROWS = 8256;
__device__ __forceinline__ void phase_p0(LAS unsigned char* lds, const Ctx& c) {
    const int tid = tidf(), lane = tid & 63, wid = tid >> 6;
    const int nskip = (gridDim.x >= 64 && (HDN_ROWS / 32) > (int)gridDim.x) ? (HDN_ROWS / 32) - (int)gridDim.x : 0;
    const bool skip_ab = (int)blockIdx.x < nskip;
    const int gw = skip_ab ? (1 << 28) : ((int)blockIdx.x - nskip) * 8 + wid, NGW = ((int)gridDim.x - nskip) * 8;
    {
        LAS float* scr = (LAS float*)(lds + wid * 8448);
        constexpr int I_IN = 16 * 256, I_SM = 16 * 32;
        for (int it = gw; it < I_IN + 3 * I_SM; it += NGW) {
            int r = it;
            if (r < I_IN) { wt_item(c.w_in, 1024, 8192, P_WIN, scr, r / 256, r % 256, lane, 1); continue; } r -= I_IN;
            if (r < I_SM) { wt_item(c.w_ret, 1024, 1024, P_WRET, scr, r / 32, r % 32, lane, 0); continue; } r -= I_SM;
            if (r < I_SM) { wt_item(c.w_hy, 1024, 1024, P_WHY, scr, r / 32, r % 32, lane, 0); continue; } r -= I_SM;
            wt_item(c.w_o, 1024, 1024, P_WO, scr, r / 32, r % 32, lane, 0);
        }
    }
    for (int m0 = gw; m0 < MROWS; m0 += 2 * NGW) {
        const int m1 = m0 + NGW; const bool has1 = m1 < MROWS; const int m1c = has1 ? m1 : m0;
        const float* s0 = m0 < MX ? c.x + (size_t)m0 * DM : c.meta + (size_t)((m0 - MX) & 15) * DM;
        const float* s1 = m1c < MX ? c.x + (size_t)m1c * DM : c.meta + (size_t)((m1c - MX) & 15) * DM;
        f32x4 v0[4], v1[4]; float q0 = 0.f, q1 = 0.f;
#pragma unroll
        for (int j = 0; j < 4; ++j) { v0[j] = *(const f32x4*)(s0 + 4 * (lane + 64 * j)); v1[j] = *(const f32x4*)(s1 + 4 * (lane + 64 * j)); }
#pragma unroll
        for (int j = 0; j < 4; ++j) { q0 += (v0[j].x * v0[j].x + v0[j].y * v0[j].y) + (v0[j].z * v0[j].z + v0[j].w * v0[j].w); q1 += (v1[j].x * v1[j].x + v1[j].y * v1[j].y) + (v1[j].z * v1[j].z + v1[j].w * v1[j].w); }
        const float r0 = rsqrtf(wave_sum(q0) * (1.f / DM) + RMS_EPS), r1 = rsqrtf(wave_sum(q1) * (1.f / DM) + RMS_EPS);
#pragma unroll
        for (int j = 0; j < 4; ++j) { const f32x4 g = *(const f32x4*)(c.norm1_g + 4 * (lane + 64 * j));
            u32x2 w; w.x = pk2(v0[j].x * r0 * g.x, v0[j].y * r0 * g.y); w.y = pk2(v0[j].z * r0 * g.z, v0[j].w * r0 * g.w);
            *(u32x2*)(P_XN + (size_t)m0 * DM + 4 * (lane + 64 * j)) = w;
            if (has1) { u32x2 w2; w2.x = pk2(v1[j].x * r1 * g.x, v1[j].y * r1 * g.y); w2.y = pk2(v1[j].z * r1 * g.z, v1[j].w * r1 * g.w); *(u32x2*)(P_XN + (size_t)m1 * DM + 4 * (lane + 64 * j)) = w2; } }
    }
    for (int i = blockIdx.x * 512 + tid; i < TT * 64; i += gridDim.x * 512) {
        const int t = i >> 6, f = i & 63; const float inv = powf(10000.0f, -(float)f / 64.0f); const float ang = (float)t * inv;
        P_ROPE[(size_t)t * 128 + f] = cosf(ang); P_ROPE[(size_t)t * 128 + 64 + f] = sinf(ang);
    }
}
#define P_HDNB ((bf16_t*)(c.dob + DO_HDN))
__device__ __forceinline__ void phase_p0b(LAS unsigned char* lds, const Ctx& c) {
    const int tid = tidf();
    LAS float* feat = (LAS float*)(lds + 69632);
    LAS float* ha = feat + 32 * 34;
    LAS float* hb = ha + 32 * 65;
    LAS float* W1 = (LAS float*)lds;
    LAS float* W2 = W1 + 33 * 64; LAS float* W3 = W2 + 64 * 64;
    __syncthreads();
    for (int i = tid; i < 33 * 16; i += 512) ((LAS f32x4*)W1)[i] = ((const f32x4*)c.fw1)[i];
    for (int i = tid; i < 64 * 16; i += 512) { ((LAS f32x4*)W2)[i] = ((const f32x4*)c.fw2)[i]; ((LAS f32x4*)W3)[i] = ((const f32x4*)c.fw3)[i]; }
    for (int it = blockIdx.x; it < HDN_ROWS / 32; it += gridDim.x) {
        const int p = tid >> 4, q = tid & 15, t = it * 32 + p;
        __syncthreads();
        {
            const float fr = 1e-4f + (float)q * ((15.0f - 1e-4f) / 15.0f);
            const float ang = (2.0f * 3.14159265358979323846f * (float)t / (float)TT) * fr;
            feat[p * 34 + 1 + q] = cosf(ang); feat[p * 34 + 17 + q] = -sinf(ang);
            if (q == 0) feat[p * 34] = (float)t / (float)(TT - 1);
        }
        __syncthreads();
        const int u = q * 4;
        const f32x4 fq = *(const f32x4*)(c.ffq + u);
        {
            f32x4 a = *(const f32x4*)(c.fb1 + u);
#pragma unroll 3
            for (int i = 0; i < 33; ++i) a += feat[p * 34 + i] * *(const LAS f32x4*)(W1 + i * 64 + u);
#pragma unroll
            for (int j = 0; j < 4; ++j) ha[p * 65 + u + j] = sinf(fq[j] * a[j]);
        }
        __syncthreads();
        {
            f32x4 a = *(const f32x4*)(c.fb2 + u);
#pragma unroll 4
            for (int i = 0; i < 64; ++i) a += ha[p * 65 + i] * *(const LAS f32x4*)(W2 + i * 64 + u);
#pragma unroll
            for (int j = 0; j < 4; ++j) hb[p * 65 + u + j] = sinf(fq[j] * a[j]);
        }
        __syncthreads();
        {
            f32x4 a = *(const f32x4*)(c.fb3 + u);
#pragma unroll 4
            for (int i = 0; i < 64; ++i) a += hb[p * 65 + i] * *(const LAS f32x4*)(W3 + i * 64 + u);
            u32x2 w; w.x = pk2(sinf(fq[0] * a[0]), sinf(fq[1] * a[1])); w.y = pk2(sinf(fq[2] * a[2]), sinf(fq[3] * a[3]));
            *(u32x2*)(P_HDNB + (size_t)t * 64 + u) = w;
        }
    }
    for (int ch = blockIdx.x * 512 + tid; ch < 1024; ch += gridDim.x * 512) { bf16_t* grow = P_G + (size_t)ch * GL; grow[0] = 0; for (int i = 2 * TT; i < GL; ++i) grow[i] = 0; }
}
__device__ __forceinline__ void phase_filtout(LAS unsigned char* lds, const Ctx& c) {
    const int tid = tidf(), lane = tid & 63, wid = tid >> 6, r = lane & 31, h = lane >> 5;
    const float mind = logf(1e-2f) / 1.5f, maxd = logf(1e-2f) / 0.3f;
    LAS unsigned char* tl = lds + wid * 2560;
    __syncthreads();
    for (int task = wid * gridDim.x + blockIdx.x; task < 64 * 32; task += 8 * gridDim.x) {
        const int ot = task & 63, chunk = task >> 6, o = 32 * ot + r, ch = o & 1023, bwd = ot >> 5;
        bf16x8 Bw[4];
#pragma unroll
        for (int ks = 0; ks < 4; ++ks) { const float* wp = c.fw4 + (size_t)(16 * ks + 8 * h) * 2048 + o;
            u32x4 bw; bw.x = pk2(wp[0], wp[2048]); bw.y = pk2(wp[2 * 2048], wp[3 * 2048]); bw.z = pk2(wp[4 * 2048], wp[5 * 2048]); bw.w = pk2(wp[6 * 2048], wp[7 * 2048]); Bw[ks] = __builtin_bit_cast(bf16x8, bw); }
        const float ad = fabsf(mind + (float)ch * ((maxd - mind) / 1023.0f)) * (1.0f / (float)(TT - 1));
        const int j1 = (chunk * 9 + 9 < 257) ? chunk * 9 + 9 : 257;
        bf16x8 An[4];
        { const bf16_t* hp = P_HDNB + (size_t)(32 * (chunk * 9) + bwd + r) * 64 + 8 * h;
#pragma unroll
          for (int ks = 0; ks < 4; ++ks) An[ks] = *(const bf16x8*)(hp + 16 * ks); }
        for (int j = chunk * 9; j < j1; ++j) {
            const int t0 = 32 * j + bwd;
            f32x16 acc; for (int z = 0; z < 16; ++z) acc[z] = 0.f;
#pragma unroll
            for (int ks = 0; ks < 4; ++ks) acc = __builtin_amdgcn_mfma_f32_32x32x16_bf16(An[ks], Bw[ks], acc, 0, 0, 0);
            if (j + 1 < j1) { const bf16_t* hp = P_HDNB + (size_t)(t0 + 32 + r) * 64 + 8 * h;
#pragma unroll
                for (int ks = 0; ks < 4; ++ks) An[ks] = *(const bf16x8*)(hp + 16 * ks); }
#pragma unroll
            for (int g = 0; g < 4; ++g) { const int tb = t0 + 8 * g + 4 * h; u32x2 w;
                w.x = pk2(acc[4 * g] * __expf(-(float)tb * ad), acc[4 * g + 1] * __expf(-(float)(tb + 1) * ad)); w.y = pk2(acc[4 * g + 2] * __expf(-(float)(tb + 2) * ad), acc[4 * g + 3] * __expf(-(float)(tb + 3) * ad));
                *(LAS u32x2*)(tl + r * 80 + (8 * g + 4 * h) * 2) = w; }
            LDSW();
#pragma unroll
            for (int k = 0; k < 2; ++k) { const int p = lane + 64 * k, cc = p >> 2, q = p & 3; const int tq = t0 + 8 * q;
                const u32x4 v = *(const LAS u32x4*)(tl + cc * 80 + 16 * q);
                bf16_t* grow = P_G + (size_t)(32 * (ot & 31) + cc) * GL;
                if (!bwd) { if (tq + 7 < TT) *(u32x4*)(grow + TT + tq) = v; else { for (int z = 0; z < 8; ++z) if (tq + z < TT) grow[TT + tq + z] = ((const LAS bf16_t*)(tl + cc * 80 + 16 * q))[z]; } }
                else { u32x4 rv; rv.x = __builtin_amdgcn_alignbit(v.w, v.w, 16); rv.y = __builtin_amdgcn_alignbit(v.z, v.z, 16); rv.z = __builtin_amdgcn_alignbit(v.y, v.y, 16); rv.w = __builtin_amdgcn_alignbit(v.x, v.x, 16);
                    if (tq + 7 < TT) *(u32x4*)(grow + TT - tq - 7) = rv; else { for (int z = 0; z < 8; ++z) if (tq + z < TT) grow[TT - tq - z] = ((const LAS bf16_t*)(tl + cc * 80 + 16 * q))[z]; } }
            }
            LDSW();
        }
    }
}

constexpr int P6_NWR = 4;
__device__ __forceinline__ void phase_p6(LAS unsigned char* lds, const Ctx& c, int it_hi) {
    const int tid = tidf(), lane = tid & 63, wid = tid >> 6;
    const int gw = wid < P6_NWR ? blockIdx.x * P6_NWR + wid : (1 << 28), NGW = gridDim.x * P6_NWR;
    if (blockIdx.x == 0 && tid < 64) ((u32x4*)((unsigned char*)P_XN + (size_t)MROWS * DM))[tid] = (u32x4){0u, 0u, 0u, 0u};
    LAS float* wr = (LAS float*)lds;
    {
        f32x4 wv[8];
#pragma unroll
        for (int j = 0; j < 8; ++j) wv[j] = ((const f32x4*)c.w_router)[tid + 512 * j];
#pragma unroll
        for (int j = 0; j < 8; ++j) { const int i4 = tid + 512 * j, k = i4 >> 2, e0 = (i4 & 3) * 4; wr[(e0 + 0) * 1024 + k] = wv[j].x; wr[(e0 + 1) * 1024 + k] = wv[j].y; wr[(e0 + 2) * 1024 + k] = wv[j].z; wr[(e0 + 3) * 1024 + k] = wv[j].w; }
    }
    __syncthreads();
    if (wid >= P6_NWR) {
        LAS float* scr = (LAS float*)(lds + 65536 + (wid - P6_NWR) * 8448);
        const int gwc = blockIdx.x * (8 - P6_NWR) + (wid - P6_NWR), NGC = gridDim.x * (8 - P6_NWR);
        for (int it = gwc; it < it_hi; it += NGC) {
            const int e = it / 3072, r = it % 3072;
            if (r < 1024) wt_item8(c.w_eg + (size_t)e * 1024 * 2048, 1024, 2048, (unsigned char*)P_WGU + (size_t)e * 4096 * 1024, scr, r / 64, r % 64, lane, 2, F8_WSCALE);
            else if (r < 2048) wt_item8(c.w_eu + (size_t)e * 1024 * 2048, 1024, 2048, (unsigned char*)P_WGU + (size_t)e * 4096 * 1024, scr, (r - 1024) / 64, (r - 1024) % 64, lane, 3, F8_WSCALE);
            else wt_item8(c.w_ed + (size_t)e * 2048 * 1024, 2048, 1024, (unsigned char*)P_WD + (size_t)e * 1024 * 2048, scr, (r - 2048) / 32, (r - 2048) % 32, lane, 0, F8_WSCALE);
        }
        return;
    }
    f32x4 vn[4];
    { const int m = gw < MROWS ? gw : 0; const bf16_t* src = P_H2 + (size_t)m * DM;
#pragma unroll
      for (int j = 0; j < 4; ++j) { const u32x2 w = *(const u32x2*)(src + 4 * (lane + 64 * j)); vn[j] = (f32x4){lo16(w.x), hi16(w.x), lo16(w.y), hi16(w.y)}; } }
    for (int m = gw; m < MROWS; m += NGW) {
        f32x4 v[4]; float s = 0.f;
#pragma unroll
        for (int j = 0; j < 4; ++j) { v[j] = vn[j]; s += (v[j].x * v[j].x + v[j].y * v[j].y) + (v[j].z * v[j].z + v[j].w * v[j].w); }
        { const int mn = m + NGW < MROWS ? m + NGW : m; const bf16_t* src = P_H2 + (size_t)mn * DM;
#pragma unroll
          for (int j = 0; j < 4; ++j) { const u32x2 w = *(const u32x2*)(src + 4 * (lane + 64 * j)); vn[j] = (f32x4){lo16(w.x), hi16(w.x), lo16(w.y), hi16(w.y)}; } }
        const float r = rsqrtf(wave_sum(s) * (1.f / DM) + RMS_EPS);
        float lg[16];
#pragma unroll
        for (int e = 0; e < 16; ++e) lg[e] = 0.f;
#pragma unroll
        for (int j = 0; j < 4; ++j) {
            const f32x4 g = *(const f32x4*)(c.norm2_g + 4 * (lane + 64 * j));
            const f32x4 xn = (f32x4){v[j].x * r * g.x, v[j].y * r * g.y, v[j].z * r * g.z, v[j].w * r * g.w};
            *(unsigned*)((unsigned char*)P_XN + (size_t)m * DM + 4 * (lane + 64 * j)) = pk4_fp8(xn.x, xn.y, xn.z, xn.w);
#pragma unroll
            for (int e = 0; e < 16; ++e) { const f32x4 w4 = *(const LAS f32x4*)(wr + e * 1024 + 4 * (lane + 64 * j)); lg[e] += (xn.x * w4.x + xn.y * w4.y) + (xn.z * w4.z + xn.w * w4.w); }
            asm volatile("" ::: "memory");
        }
        float mx = -1e30f;
#pragma unroll
        for (int e = 0; e < 16; ++e) { lg[e] = wave_sum(lg[e]); mx = fmaxf(mx, lg[e]); }
        float sum = 0.f;
#pragma unroll
        for (int e = 0; e < 16; ++e) { lg[e] = __expf(lg[e] - mx); sum += lg[e]; }
        int b, t; bt_of(m, b, t);
        const float inv = 1.f / sum;
#pragma unroll
        for (int e = 0; e < 16; ++e) if (lane == e) P_AFF[((size_t)b * NE + e) * TT + t] = lg[e] * inv;
    }
}
__device__ __forceinline__ void phase_p6b(LAS unsigned char* lds, const Ctx& c, int it_lo, int it_hi, int first_blk) {
    const int tid = tidf(), lane = tid & 63, wid = tid >> 6;
    if ((int)blockIdx.x < first_blk) return;
    const int gw = ((int)blockIdx.x - first_blk) * 8 + wid, NGW = ((int)gridDim.x - first_blk) * 8;
    __syncthreads();
    {
        LAS float* scr = (LAS float*)(lds + wid * 8448);
        for (int it = it_lo + gw; it < it_hi; it += NGW) {
            const int e = it / 3072, r = it % 3072;
            if (r < 1024) wt_item8(c.w_eg + (size_t)e * 1024 * 2048, 1024, 2048, (unsigned char*)P_WGU + (size_t)e * 4096 * 1024, scr, r / 64, r % 64, lane, 2, F8_WSCALE);
            else if (r < 2048) wt_item8(c.w_eu + (size_t)e * 1024 * 2048, 1024, 2048, (unsigned char*)P_WGU + (size_t)e * 4096 * 1024, scr, (r - 1024) / 64, (r - 1024) % 64, lane, 3, F8_WSCALE);
            else wt_item8(c.w_ed + (size_t)e * 2048 * 1024, 2048, 1024, (unsigned char*)P_WD + (size_t)e * 1024 * 2048, scr, (r - 2048) / 32, (r - 2048) % 32, lane, 0, F8_WSCALE);
        }
    }
}

__device__ __forceinline__ void phase_topk(LAS unsigned char* lds, const Ctx& c) {
    const int tid = tidf(), lane = tid & 63, wid = tid >> 6;
    LAS unsigned* hist = (LAS unsigned*)lds;
    LAS unsigned* sh = hist + 256;
    for (int be = blockIdx.x; be < NB * NE; be += gridDim.x) {
        const float* a = P_AFF + (size_t)be * TT;
        unsigned key[17];
#pragma unroll
        for (int j = 0; j < 17; ++j) { const int t = tid * 17 + j; key[j] = t < TT ? __float_as_uint(a[t]) : 0u; }
        unsigned prefix = 0u, kk = CAP;
        for (int pass = 0; pass < 4; ++pass) {
            const int shift = 24 - 8 * pass;
            __syncthreads();
            if (tid < 256) hist[tid] = 0u;
            __syncthreads();
            const unsigned himask = pass == 0 ? 0u : (0xffffffffu << (shift + 8));
#pragma unroll
            for (int j = 0; j < 17; ++j) if ((key[j] & himask) == prefix && tid * 17 + j < TT) __hip_atomic_fetch_add(&hist[(key[j] >> shift) & 255u], 1u, __ATOMIC_RELAXED, __HIP_MEMORY_SCOPE_WORKGROUP);
            __syncthreads();
            if (tid < 256) {
                const unsigned hv = hist[tid]; unsigned sfx = hv;
#pragma unroll
                for (int o = 1; o < 64; o <<= 1) { const unsigned u = __shfl_down(sfx, o); if (lane + o < 64) sfx += u; }
                if (lane == 0) sh[24 + wid] = sfx;
                sh[32 + tid] = sfx; sh[288 + tid] = hv;
            }
            __syncthreads();
            if (tid < 256) {
                unsigned above = 0u; for (int w = wid + 1; w < 4; ++w) above += sh[24 + w];
                const unsigned incl = sh[32 + tid] + above, excl = incl - sh[288 + tid];
                if (excl < kk && kk <= incl) { sh[0] = prefix | ((unsigned)tid << shift); sh[1] = kk - excl; }
            }
            __syncthreads();
            prefix = sh[0]; kk = sh[1];
        }
        int ngt = 0, neq = 0;
#pragma unroll
        for (int j = 0; j < 17; ++j) { const bool v = tid * 17 + j < TT; ngt += (v && key[j] > prefix) ? 1 : 0; neq += (v && key[j] == prefix) ? 1 : 0; }
        int sg = ngt, se = neq;
#pragma unroll
        for (int o = 1; o < 64; o <<= 1) { const int ug = __shfl_up(sg, o), ue = __shfl_up(se, o); if (lane >= o) { sg += ug; se += ue; } }
        __syncthreads();
        if (lane == 63) { sh[8 + wid] = (unsigned)sg; sh[16 + wid] = (unsigned)se; }
        __syncthreads();
        int bg = 0, beq = 0;
        for (int w = 0; w < wid; ++w) { bg += (int)sh[8 + w]; beq += (int)sh[16 + w]; }
        int pg = bg + sg - ngt, pe = beq + se - neq;
        int slot = pg + ((pe < (int)kk) ? pe : (int)kk);
        int* idx = P_IDX + (size_t)be * CAP; float* gv = P_GATEV + (size_t)be * CAP; int* inv = P_INV + (size_t)(be >> 4) * TT * 16 + (be & 15);
#pragma unroll
        for (int j = 0; j < 17; ++j) {
            const int t = tid * 17 + j;
            if (t < TT) {
                bool sel = false;
                if (key[j] > prefix) sel = true; else if (key[j] == prefix) { sel = pe < (int)kk; ++pe; }
                if (sel) { idx[slot] = t; gv[slot] = __uint_as_float(key[j]); inv[(size_t)t * 16] = slot; ++slot; } else inv[(size_t)t * 16] = -1;
            }
        }
    }
}
__device__ __forceinline__ void phase_gather(const Ctx& c) {
    const int lane = tidf() & 63, gw = blockIdx.x * 8 + (tidf() >> 6), NGW = gridDim.x * 8;
    const unsigned char* XN8 = (const unsigned char*)P_XN; unsigned char* XE8 = (unsigned char*)P_XE;
    for (int it0 = gw; it0 < NE * ER; it0 += 4 * NGW) {
        u32x4 v0[4];
#pragma unroll
        for (int k = 0; k < 4; ++k) {
            const int it = it0 + k * NGW; v0[k] = (u32x4){0u, 0u, 0u, 0u};
            if (it < NE * ER) { const int e = it / ER, r = it - e * ER;
                if (r < 2 * CAP) { const int b = r / CAP, slot = r - b * CAP; const int t = P_IDX[((size_t)b * NE + e) * CAP + slot]; v0[k] = ((const u32x4*)(XN8 + (size_t)row_of(b, t) * DM))[lane]; } }
        }
#pragma unroll
        for (int k = 0; k < 4; ++k) { const int it = it0 + k * NGW; if (it < NE * ER) ((u32x4*)(XE8 + (size_t)it * DM))[lane] = v0[k]; }
    }
}
__device__ __forceinline__ void phase_final(const Ctx& c) {
    const int lane = tidf() & 63, gw = blockIdx.x * 8 + (tidf() >> 6), NGW = gridDim.x * 8;
    u32x2 hn[4]; int invn = -1;
    if (gw < MX) { const int b = gw >> 13, t = (gw & 8191) + NMETA; const bf16_t* hrow = P_H2 + (size_t)gw * DM;
        invn = lane < NE ? P_INV[((size_t)b * TT + t) * 16 + lane] : -1;
#pragma unroll
        for (int j = 0; j < 4; ++j) hn[j] = *(const u32x2*)(hrow + 4 * (lane + 64 * j)); }
    for (int m = gw; m < MX; m += NGW) {
        const int b = m >> 13;
        float* row = P_OUT + (size_t)m * DM;
        const int inv = invn;
        f32x4 v[4];
#pragma unroll
        for (int j = 0; j < 4; ++j) v[j] = (f32x4){lo16(hn[j].x), hi16(hn[j].x), lo16(hn[j].y), hi16(hn[j].y)};
        { const int mn = m + NGW;
          if (mn < MX) { const int bn = mn >> 13, tn = (mn & 8191) + NMETA; const bf16_t* hrow = P_H2 + (size_t)mn * DM;
              invn = lane < NE ? P_INV[((size_t)bn * TT + tn) * 16 + lane] : -1;
#pragma unroll
              for (int j = 0; j < 4; ++j) hn[j] = *(const u32x2*)(hrow + 4 * (lane + 64 * j)); } }
        unsigned long long mask = __ballot(inv >= 0);
        while (mask) {
            const int e0 = __builtin_ctzll(mask); mask &= mask - 1;
            int e1 = -1; if (mask) { e1 = __builtin_ctzll(mask); mask &= mask - 1; }
            const int s0 = __builtin_amdgcn_readlane(inv, e0);
            const bf16_t* y0 = P_YE + (size_t)exp_row(e0, b * CAP + s0) * DM;
            u32x2 w0[4], w1[4];
#pragma unroll
            for (int j = 0; j < 4; ++j) w0[j] = *(const u32x2*)(y0 + 4 * (lane + 64 * j));
            if (e1 >= 0) { const int s1 = __builtin_amdgcn_readlane(inv, e1); const bf16_t* y1 = P_YE + (size_t)exp_row(e1, b * CAP + s1) * DM;
#pragma unroll
                for (int j = 0; j < 4; ++j) w1[j] = *(const u32x2*)(y1 + 4 * (lane + 64 * j)); }
            else {
#pragma unroll
                for (int j = 0; j < 4; ++j) w1[j] = (u32x2){0u, 0u}; }
#pragma unroll
            for (int j = 0; j < 4; ++j) { v[j].x += lo16(w0[j].x) + lo16(w1[j].x); v[j].y += hi16(w0[j].x) + hi16(w1[j].x); v[j].z += lo16(w0[j].y) + lo16(w1[j].y); v[j].w += hi16(w0[j].y) + hi16(w1[j].y); }
        }
        float s = 0.f;
#pragma unroll
        for (int j = 0; j < 4; ++j) s += (v[j].x * v[j].x + v[j].y * v[j].y) + (v[j].z * v[j].z + v[j].w * v[j].w);
        const float r = rsqrtf(wave_sum(s) * (1.f / DM) + RMS_EPS);
#pragma unroll
        for (int j = 0; j < 4; ++j) { const f32x4 g = *(const f32x4*)(c.gfin + 4 * (lane + 64 * j)); *(f32x4*)(row + 4 * (lane + 64 * j)) = (f32x4){v[j].x * r * g.x, v[j].y * r * g.y, v[j].z * r * g.z, v[j].w * r * g.w}; }
    }
}

__device__ __forceinline__ void unpack8(const u32x4 w, float* f) { f[0] = lo16(w.x); f[1] = hi16(w.x); f[2] = lo16(w.y); f[3] = hi16(w.y); f[4] = lo16(w.z); f[5] = hi16(w.z); f[6] = lo16(w.w); f[7] = hi16(w.w); }
__device__ __forceinline__ void c3_load(const bf16_t* __restrict__ PROJ, int b, int t, int ch0, u32x4 (&w)[3]) {
#pragma unroll
    for (int j = 0; j < 3; ++j) { const int tt = t + j - 1; const bool ok = (tt >= 0) && (tt < TT) && (t < TT);
        w[j] = *(const u32x4*)(PROJ + pj_u(ch0 >> 10, row_of(b, ok ? tt : 0)) + (ch0 & 1023)); if (!ok) w[j] = (u32x4){0u, 0u, 0u, 0u}; }
}
__device__ __forceinline__ void c3_eval(const u32x4 (&w)[3], const float* __restrict__ cw, const float* __restrict__ cb, int ch0, float* out) {
    const f32x4 b0 = *(const f32x4*)(cb + ch0), b1 = *(const f32x4*)(cb + ch0 + 4);
    out[0] = b0.x; out[1] = b0.y; out[2] = b0.z; out[3] = b0.w; out[4] = b1.x; out[5] = b1.y; out[6] = b1.z; out[7] = b1.w;
#pragma unroll
    for (int j = 0; j < 3; ++j) { float u[8]; unpack8(w[j], u);
        const f32x4 w0 = *(const f32x4*)(cw + j * 3072 + ch0), w1 = *(const f32x4*)(cw + j * 3072 + ch0 + 4);
        out[0] += u[0] * w0.x; out[1] += u[1] * w0.y; out[2] += u[2] * w0.z; out[3] += u[3] * w0.w; out[4] += u[4] * w1.x; out[5] += u[5] * w1.y; out[6] += u[6] * w1.z; out[7] += u[7] * w1.w; }
}
constexpr int HY_WL = 2 * 64 * 144;
__device__ __forceinline__ void c3w_stage(LAS float* wl, const float* __restrict__ cw, const float* __restrict__ cb, const float* __restrict__ skip, int ct, int tid) {
    if (tid < 192) { const int sec = tid >> 6, tb = (tid >> 4) & 3, c4 = tid & 15; const int ch = sec * 1024 + 64 * ct + 4 * c4;
        *(LAS f32x4*)(wl + (sec * 4 + tb) * 64 + 4 * c4) = tb < 3 ? *(const f32x4*)(cw + tb * 3072 + ch) : *(const f32x4*)(cb + ch); }
    else if (tid < 208) { const int c4 = tid - 192; *(LAS f32x4*)(wl + 768 + 4 * c4) = *(const f32x4*)(skip + 64 * ct + 4 * c4); }
}
__device__ __forceinline__ void c3_evall(const u32x4 (&w)[3], const LAS float* wl, int sec, int cg, float* out) {
    const f32x4 b0 = *(const LAS f32x4*)(wl + (sec * 4 + 3) * 64 + 8 * cg), b1 = *(const LAS f32x4*)(wl + (sec * 4 + 3) * 64 + 8 * cg + 4);
    out[0] = b0.x; out[1] = b0.y; out[2] = b0.z; out[3] = b0.w; out[4] = b1.x; out[5] = b1.y; out[6] = b1.z; out[7] = b1.w;
#pragma unroll
    for (int j = 0; j < 3; ++j) { float u[8]; unpack8(w[j], u);
        const f32x4 w0 = *(const LAS f32x4*)(wl + (sec * 4 + j) * 64 + 8 * cg), w1 = *(const LAS f32x4*)(wl + (sec * 4 + j) * 64 + 8 * cg + 4);
        out[0] += u[0] * w0.x; out[1] += u[1] * w0.y; out[2] += u[2] * w0.z; out[3] += u[3] * w0.w; out[4] += u[4] * w1.x; out[5] += u[5] * w1.y; out[6] += u[6] * w1.z; out[7] += u[7] * w1.w; }
}
constexpr int HY_ITEMS = 2 * 129 * 16, HY_TILE = 64 * 144;
#ifndef HYPREP_NB
#define HYPREP_NB 2
#endif
#ifndef HYPOST_NB
#define HYPOST_NB 2
#endif
template <int NB> __device__ __forceinline__ void phase_hyprep_t(LAS unsigned char* lds, const Ctx& c) {
    const int tid = tidf(), cg = tid & 7, tp = tid >> 3, ch = tid >> 3, pc = tid & 7;
    LAS float* wl = (LAS float*)(lds + HY_WL); int ctw = -1;
    for (int it0 = blockIdx.x; it0 < HY_ITEMS; it0 += NB * gridDim.x) {
        int b[NB], tt[NB], ct[NB]; bool val[NB];
#pragma unroll
        for (int s = 0; s < NB; ++s) { const int it = it0 + s * gridDim.x; val[s] = it < HY_ITEMS; const int ii = val[s] ? it : it0; ct[s] = ii & 15; tt[s] = (ii >> 4) % 129; b[s] = (ii >> 4) / 129; }
        const bool same = (gridDim.x & 15) == 0;
        if (same && ct[0] != ctw) { ctw = ct[0]; __syncthreads(); c3w_stage(wl, c.cw, c.cb, c.skip, ctw, tid); }
        u32x4 wx[NB][3], wv[NB][3];
#pragma unroll
        for (int s = 0; s < NB; ++s) { const int t = 64 * tt[s] + tp, c0 = 64 * ct[s] + 8 * cg; c3_load(P_PROJ, b[s], t, 1024 + c0, wx[s]); c3_load(P_PROJ, b[s], t, 2048 + c0, wv[s]); }
        __syncthreads();
#pragma unroll
        for (int s = 0; s < NB; ++s) { const int t = 64 * tt[s] + tp, c0 = 64 * ct[s] + 8 * cg; float x1[8], vh[8];
            if (same) { c3_evall(wx[s], wl, 1, cg, x1); c3_evall(wv[s], wl, 2, cg, vh); } else { c3_eval(wx[s], c.cw, c.cb, 1024 + c0, x1); c3_eval(wv[s], c.cw, c.cb, 2048 + c0, vh); }
#pragma unroll
            for (int k = 0; k < 8; ++k) *(LAS bf16_t*)(lds + s * HY_TILE + (8 * cg + k) * 144 + tp * 2) = t < TT ? f2bf(x1[k] * vh[k]) : (bf16_t)0; }
        __syncthreads();
#pragma unroll
        for (int s = 0; s < NB; ++s) if (val[s]) *(u32x4*)(P_ZT + ((size_t)b[s] * 1024 + 64 * ct[s] + ch) * ZL + 64 * tt[s] + 8 * pc) = *(const LAS u32x4*)(lds + s * HY_TILE + ch * 144 + pc * 16);
    }
}
__device__ __forceinline__ void phase_hyprep(LAS unsigned char* lds, const Ctx& c) { phase_hyprep_t<HYPREP_NB>(lds, c); }
template <int NB> __device__ __forceinline__ void phase_hypost_t(LAS unsigned char* lds, const Ctx& c) {
    const int tid = tidf(), cg = tid & 7, tp = tid >> 3, ch = tid >> 3, pc = tid & 7;
    LAS float* wl = (LAS float*)(lds + HY_WL); int ctw = -1;
    for (int it0 = blockIdx.x; it0 < HY_ITEMS; it0 += NB * gridDim.x) {
        int b[NB], tt[NB], ct[NB]; bool val[NB];
#pragma unroll
        for (int s = 0; s < NB; ++s) { const int it = it0 + s * gridDim.x; val[s] = it < HY_ITEMS; const int ii = val[s] ? it : it0; ct[s] = ii & 15; tt[s] = (ii >> 4) % 129; b[s] = (ii >> 4) / 129; }
        const bool same = (gridDim.x & 15) == 0;
        if (same && ct[0] != ctw) { ctw = ct[0]; __syncthreads(); c3w_stage(wl, c.cw, c.cb, c.skip, ctw, tid); }
        u32x4 w0[NB][3], wx[NB][3], wv[NB][3], yv[NB];
#pragma unroll
        for (int s = 0; s < NB; ++s) { const int t = 64 * tt[s] + tp, c0 = 64 * ct[s] + 8 * cg;
            yv[s] = *(const u32x4*)(P_YCT + ((size_t)b[s] * 1024 + 64 * ct[s] + ch) * ZL + 64 * tt[s] + 8 * pc);
            c3_load(P_PROJ, b[s], t, c0, w0[s]); c3_load(P_PROJ, b[s], t, 1024 + c0, wx[s]); c3_load(P_PROJ, b[s], t, 2048 + c0, wv[s]); }
        __syncthreads();
#pragma unroll
        for (int s = 0; s < NB; ++s) *(LAS u32x4*)(lds + s * HY_TILE + ch * 144 + pc * 16) = yv[s];
        __syncthreads();
#pragma unroll
        for (int s = 0; s < NB; ++s) { const int t = 64 * tt[s] + tp, c0 = 64 * ct[s] + 8 * cg;
            if (val[s] && t < TT) {
                float x0[8], x1[8], vh[8];
                f32x4 s0, s1;
                if (same) { c3_evall(w0[s], wl, 0, cg, x0); c3_evall(wx[s], wl, 1, cg, x1); c3_evall(wv[s], wl, 2, cg, vh); s0 = *(const LAS f32x4*)(wl + 768 + 8 * cg); s1 = *(const LAS f32x4*)(wl + 768 + 8 * cg + 4); }
                else { c3_eval(w0[s], c.cw, c.cb, c0, x0); c3_eval(wx[s], c.cw, c.cb, 1024 + c0, x1); c3_eval(wv[s], c.cw, c.cb, 2048 + c0, vh); s0 = *(const f32x4*)(c.skip + c0); s1 = *(const f32x4*)(c.skip + c0 + 4); }
                const float sk[8] = {s0.x, s0.y, s0.z, s0.w, s1.x, s1.y, s1.z, s1.w};
                float o[8];
#pragma unroll
                for (int k = 0; k < 8; ++k) { const float yc = bf2f(*(const LAS bf16_t*)(lds + s * HY_TILE + (8 * cg + k) * 144 + tp * 2)); o[k] = x0[k] * (yc + x1[k] * vh[k] * sk[k]); }
                u32x4 w; w.x = pk2(o[0], o[1]); w.y = pk2(o[2], o[3]); w.z = pk2(o[4], o[5]); w.w = pk2(o[6], o[7]);
                *(u32x4*)(P_AHY + (size_t)row_of(b[s], t) * DM + c0) = w;
            } }
    }
}
__device__ __forceinline__ void phase_hypost(LAS unsigned char* lds, const Ctx& c) { phase_hypost_t<HYPOST_NB>(lds, c); }

typedef short s16x4 __attribute__((ext_vector_type(4)));
__device__ __forceinline__ bf16x8 tr2(const LAS unsigned char* p, int second_off) {
    const s16x4 lo = __builtin_bit_cast(s16x4, __builtin_amdgcn_ds_read_tr16_b64_v4i16((LAS s16x4*)p));
    const s16x4 hi = __builtin_bit_cast(s16x4, __builtin_amdgcn_ds_read_tr16_b64_v4i16((LAS s16x4*)(p + second_off)));
    return (bf16x8){lo[0], lo[1], lo[2], lo[3], hi[0], hi[1], hi[2], hi[3]};
}
__device__ __forceinline__ u32x4 scale8(const u32x4 w, float s) {
    u32x4 o; o.x = pk2(lo16(w.x) * s, hi16(w.x) * s); o.y = pk2(lo16(w.y) * s, hi16(w.y) * s); o.z = pk2(lo16(w.z) * s, hi16(w.z) * s); o.w = pk2(lo16(w.w) * s, hi16(w.w) * s); return o;
}
constexpr int RA_K = 272, RA_V = 576;
__device__ __forceinline__ void phase_retsum(LAS unsigned char* lds, const Ctx& c) {
    LAS unsigned char* Kf = lds; LAS unsigned char* Kb = lds + 128 * RA_K; LAS unsigned char* Vl = lds + 2 * 128 * RA_K;
    const bf16_t* PROJ = P_PROJ;
    for (int u = blockIdx.x; u < 520; u += gridDim.x) {
        const int tid = tidf(), lane = tid & 63, wid = tid >> 6;
        int bh, n; if (u < 512) { bh = u >> 6; n = 1 + (u & 63); } else { bh = u - 512; n = 0; }
        const int b = bh >> 2, h = bh & 3;
        const float lf = log_sigmoid(c.dec_f[h]), lb = log_sigmoid(c.dec_b[h]);
        __syncthreads();
        {
            const u32x4 z4 = (u32x4){0u, 0u, 0u, 0u};
            u32x4 kv[4], vv[8];
#pragma unroll
            for (int i = 0; i < 4; ++i) { const int row = 32 * i + (tid >> 4); const int gr = chunk_row(b, n, row); kv[i] = *(const u32x4*)(PROJ + pj_k(h, gr < 0 ? 0 : gr) + 8 * (tid & 15)); if (gr < 0) kv[i] = z4; }
#pragma unroll
            for (int i = 0; i < 8; ++i) { const int row = 16 * i + (tid >> 5); const int gr = chunk_row(b, n, row); vv[i] = *(const u32x4*)(PROJ + pj_v(h, gr < 0 ? 0 : gr) + 8 * (tid & 31)); if (gr < 0) vv[i] = z4; }
#pragma unroll
            for (int i = 0; i < 4; ++i) { const int row = 32 * i + (tid >> 4); const float we = expf(lf * (float)(127 - row)), ws = expf(lb * (float)row);
                *(LAS u32x4*)(Kf + row * RA_K + (tid & 15) * 16) = scale8(kv[i], we); *(LAS u32x4*)(Kb + row * RA_K + (tid & 15) * 16) = scale8(kv[i], ws); }
#pragma unroll
            for (int i = 0; i < 8; ++i) { const int row = 16 * i + (tid >> 5); *(LAS u32x4*)(Vl + row * RA_V + (tid & 31) * 16) = vv[i]; }
        }
        __syncthreads();
        const int dkt = wid & 3, dvh = wid >> 2, r = lane & 31, hh = lane >> 5, g16 = lane >> 4, i16 = lane & 15, q = i16 >> 2, p = i16 & 3;
        f32x16 af[4], ab[4];
#pragma unroll
        for (int nt = 0; nt < 4; ++nt) for (int z = 0; z < 16; ++z) { af[nt][z] = 0.f; ab[nt][z] = 0.f; }
        const LAS unsigned char* kfa = Kf + (8 * hh + q) * RA_K + (32 * dkt + 16 * (g16 & 1) + 4 * p) * 2;
        const LAS unsigned char* kba = Kb + (8 * hh + q) * RA_K + (32 * dkt + 16 * (g16 & 1) + 4 * p) * 2;
        const LAS unsigned char* va = Vl + (8 * hh + q) * RA_V + (128 * dvh + 16 * (g16 & 1) + 4 * p) * 2;
#pragma unroll
        for (int ks = 0; ks < 8; ++ks) {
            if (n == 0 && ks < 7) continue;
            const bf16x8 aF = tr2(kfa + 16 * ks * RA_K, 4 * RA_K), aB = tr2(kba + 16 * ks * RA_K, 4 * RA_K);
#pragma unroll
            for (int nt = 0; nt < 4; ++nt) { const bf16x8 bv = tr2(va + 16 * ks * RA_V + 64 * nt, 4 * RA_V);
                af[nt] = __builtin_amdgcn_mfma_f32_32x32x16_bf16(aF, bv, af[nt], 0, 0, 0); ab[nt] = __builtin_amdgcn_mfma_f32_32x32x16_bf16(aB, bv, ab[nt], 0, 0, 0); }
        }
        bf16_t* of = P_S + (((size_t)0 * 8 + bh) * NCH + n) * 32768; bf16_t* ob = P_S + (((size_t)1 * 8 + bh) * NCH + n) * 32768;
#pragma unroll
        for (int nt = 0; nt < 4; ++nt)
#pragma unroll
            for (int g = 0; g < 4; ++g) {
                const size_t o = ((size_t)((4 * dvh + nt) * 8 + 2 * dkt + (g >> 1)) * 64 + (g & 1) * 32 + r) * 8 + 4 * hh;
                u32x2 w; w.x = pk2(af[nt][4 * g], af[nt][4 * g + 1]); w.y = pk2(af[nt][4 * g + 2], af[nt][4 * g + 3]); *(u32x2*)(of + o) = w;
                u32x2 v; v.x = pk2(ab[nt][4 * g], ab[nt][4 * g + 1]); v.y = pk2(ab[nt][4 * g + 2], ab[nt][4 * g + 3]); *(u32x2*)(ob + o) = v;
            }
    }
}
__device__ __forceinline__ void phase_retscan(const Ctx& c) {
    for (int gi = blockIdx.x * 512 + tidf(); gi < 16 * 8192; gi += gridDim.x * 512) {
        const int db = gi >> 13, e4 = gi & 8191, dir = db >> 3, bh = db & 7, h = bh & 3;
        const float dec = expf(log_sigmoid(dir ? c.dec_b[h] : c.dec_f[h]) * 128.f);
        bf16_t* base = P_S + ((size_t)db * NCH) * 32768 + (size_t)e4 * 4;
        const long step = dir ? -32768 : 32768;
        bf16_t* p = base + (dir ? (size_t)64 * 32768 : 0);
        f32x4 s = (f32x4){0.f, 0.f, 0.f, 0.f};
        u32x2 a[13];
#pragma unroll 1
        for (int n0 = 0; n0 < NCH; n0 += 13) {
#pragma unroll
            for (int k = 0; k < 13; ++k) a[k] = *(const u32x2*)(p + (long)k * step);
#pragma unroll
            for (int k = 0; k < 13; ++k) {
                u32x2 w; w.x = pk2(s.x, s.y); w.y = pk2(s.z, s.w); *(u32x2*)(p + (long)k * step) = w;
                s = s * dec + (f32x4){lo16(a[k].x), hi16(a[k].x), lo16(a[k].y), hi16(a[k].y)};
            }
            p += 13 * step;
        }
    }
}
constexpr int R2Q = 272, R2V = 576, R2O = 528;
__device__ __forceinline__ void phase_retout(LAS unsigned char* lds, const Ctx& c) {
    LAS unsigned char* Ql = lds; LAS unsigned char* Kl = lds + 128 * R2Q; LAS unsigned char* Vl = lds + 2 * 128 * R2Q; LAS float* red = (LAS float*)(lds + 2 * 128 * R2Q + 128 * R2V);
    const bf16_t* PROJ = P_PROJ;
    for (int u = blockIdx.x; u < 520; u += gridDim.x) {
        const int tid = tidf(), lane = tid & 63, wid = tid >> 6;
        int bh, n; if (u < 512) { bh = u >> 6; n = 1 + (u & 63); } else { bh = u - 512; n = 0; }
        const int b = bh >> 2, h = bh & 3;
        const float lf = log_sigmoid(c.dec_f[h]), lb = log_sigmoid(c.dec_b[h]);
        const float lf2 = lf * 1.4426950408889634f, lb2 = lb * 1.4426950408889634f;
        __syncthreads();
        {
            const u32x4 z4 = (u32x4){0u, 0u, 0u, 0u};
            u32x4 qv[4], kv[4], vv[8];
#pragma unroll
            for (int i = 0; i < 4; ++i) { const int row = 32 * i + (tid >> 4); const int gr = chunk_row(b, n, row); const int gc = gr < 0 ? 0 : gr;
                qv[i] = *(const u32x4*)(PROJ + pj_q(h, gc) + 8 * (tid & 15)); kv[i] = *(const u32x4*)(PROJ + pj_k(h, gc) + 8 * (tid & 15)); if (gr < 0) { qv[i] = z4; kv[i] = z4; } }
#pragma unroll
            for (int i = 0; i < 8; ++i) { const int row = 16 * i + (tid >> 5); const int gr = chunk_row(b, n, row);
                vv[i] = *(const u32x4*)(PROJ + pj_v(h, gr < 0 ? 0 : gr) + 8 * (tid & 31)); if (gr < 0) vv[i] = z4; }
#pragma unroll
            for (int i = 0; i < 4; ++i) { const int row = 32 * i + (tid >> 4); *(LAS u32x4*)(Ql + row * R2Q + (tid & 15) * 16) = qv[i]; *(LAS u32x4*)(Kl + row * R2Q + (tid & 15) * 16) = kv[i]; }
#pragma unroll
            for (int i = 0; i < 8; ++i) { const int row = 16 * i + (tid >> 5); *(LAS u32x4*)(Vl + row * R2V + (tid & 31) * 16) = vv[i]; }
        }
        __syncthreads();
        const int wr = wid >> 1, wc = wid & 1, r = lane & 31, hh = lane >> 5;
        const bool act = (n != 0) || (__builtin_amdgcn_readfirstlane(wr) == 3);
        f32x16 sc[2];
#pragma unroll
        for (int jt = 0; jt < 2; ++jt) for (int z = 0; z < 16; ++z) sc[jt][z] = 0.f;
        if (act) {
#pragma unroll
        for (int ks = 0; ks < 8; ++ks) {
            const bf16x8 af = *(const LAS bf16x8*)(Ql + (32 * wr + r) * R2Q + (16 * ks + 8 * hh) * 2);
#pragma unroll
            for (int jt = 0; jt < 2; ++jt) { const bf16x8 bf = *(const LAS bf16x8*)(Kl + (64 * wc + 32 * jt + r) * R2Q + (16 * ks + 8 * hh) * 2); sc[jt] = __builtin_amdgcn_mfma_f32_32x32x16_bf16(af, bf, sc[jt], 0, 0, 0); }
        }
        }
        __syncthreads();
#pragma unroll
        for (int jt = 0; jt < 2; ++jt) { const int j = 64 * wc + 32 * jt + r;
#pragma unroll
            for (int z = 0; z < 16; ++z) { const int i = 32 * wr + (z & 3) + 8 * (z >> 2) + 4 * hh; const int df = i - j;
                const float m = __builtin_amdgcn_exp2f(df >= 0 ? lf2 * (float)df : lb2 * (float)(-df));
                *(LAS bf16_t*)(Kl + i * R2Q + j * 2) = f2bf(sc[jt][z] * m); } }
        __syncthreads();
        f32x16 acc[4];
#pragma unroll
        for (int nt = 0; nt < 4; ++nt) for (int z = 0; z < 16; ++z) acc[nt][z] = 0.f;
        const bf16_t* Sf = P_S + (((size_t)0 * 8 + bh) * NCH + n) * 32768 + (size_t)(4 * wc) * 8 * 512 + lane * 8;
        const bf16_t* Sb = P_S + (((size_t)1 * 8 + bh) * NCH + n) * 32768 + (size_t)(4 * wc) * 8 * 512 + lane * 8;
        if (act) {
        bf16x8 sA[8], sB[8];
#pragma unroll
        for (int nt = 0; nt < 4; ++nt) { sA[2 * nt] = *(const bf16x8*)(Sf + (size_t)(nt * 8) * 512); sA[2 * nt + 1] = *(const bf16x8*)(Sb + (size_t)(nt * 8) * 512); }
        __builtin_amdgcn_sched_barrier(0);
        {
            const int g16 = lane >> 4, i16 = lane & 15, q = i16 >> 2, p = i16 & 3;
            const LAS unsigned char* vb = Vl + (8 * hh + q) * R2V + (128 * wc + 16 * (g16 & 1) + 4 * p) * 2;
#pragma unroll
            for (int ks = 0; ks < 8; ++ks) {
                const bf16x8 af = *(const LAS bf16x8*)(Kl + (32 * wr + r) * R2Q + (16 * ks + 8 * hh) * 2);
#pragma unroll
                for (int nt = 0; nt < 4; ++nt) { const bf16x8 bf = tr2(vb + 16 * ks * R2V + 64 * nt, 4 * R2V); acc[nt] = __builtin_amdgcn_mfma_f32_32x32x16_bf16(af, bf, acc[nt], 0, 0, 0); }
            }
        }
        {
            const int i = 32 * wr + r;
            const float qwf = expf(lf * (float)(i + 1)), qwb = expf(lb * (float)(128 - i));
#define R2_SLOAD(dst, ks_) do { _Pragma("unroll") for (int nt = 0; nt < 4; ++nt) { dst[2 * nt] = *(const bf16x8*)(Sf + (size_t)(nt * 8 + (ks_)) * 512); dst[2 * nt + 1] = *(const bf16x8*)(Sb + (size_t)(nt * 8 + (ks_)) * 512); } } while (0)
#define R2_SMMA(src_, ks_) do { const u32x4 aq = *(const LAS u32x4*)(Ql + (32 * wr + r) * R2Q + (16 * (ks_) + 8 * hh) * 2); \
                const bf16x8 af = __builtin_bit_cast(bf16x8, scale8(aq, qwf)), ab = __builtin_bit_cast(bf16x8, scale8(aq, qwb)); \
                _Pragma("unroll") for (int nt = 0; nt < 4; ++nt) { acc[nt] = __builtin_amdgcn_mfma_f32_32x32x16_bf16(af, src_[2 * nt], acc[nt], 0, 0, 0); acc[nt] = __builtin_amdgcn_mfma_f32_32x32x16_bf16(ab, src_[2 * nt + 1], acc[nt], 0, 0, 0); } } while (0)
#define R2_PIN() __builtin_amdgcn_sched_barrier(0)
            R2_SLOAD(sB, 1); R2_PIN(); R2_SMMA(sA, 0); R2_PIN();
            R2_SLOAD(sA, 2); R2_PIN(); R2_SMMA(sB, 1); R2_PIN();
            R2_SLOAD(sB, 3); R2_PIN(); R2_SMMA(sA, 2); R2_PIN();
            R2_SLOAD(sA, 4); R2_PIN(); R2_SMMA(sB, 3); R2_PIN();
            R2_SLOAD(sB, 5); R2_PIN(); R2_SMMA(sA, 4); R2_PIN();
            R2_SLOAD(sA, 6); R2_PIN(); R2_SMMA(sB, 5); R2_PIN();
            R2_SLOAD(sB, 7); R2_PIN(); R2_SMMA(sA, 6); R2_PIN();
            R2_SMMA(sB, 7);
#undef R2_PIN
#undef R2_SLOAD
#undef R2_SMMA
        }
        }
        {
            float ss[16];
#pragma unroll
            for (int z = 0; z < 16; ++z) { float v = 0.f;
#pragma unroll
                for (int nt = 0; nt < 4; ++nt) v += acc[nt][z] * acc[nt][z];
#pragma unroll
                for (int o = 1; o < 32; o <<= 1) v += __shfl_xor(v, o);
                ss[z] = v; }
            if (r == 0) {
#pragma unroll
                for (int z = 0; z < 16; ++z) red[(32 * wr + (z & 3) + 8 * (z >> 2) + 4 * hh) * 2 + wc] = ss[z]; }
        }
        __syncthreads();
        {
            float hgv[4];
#pragma unroll
            for (int nt = 0; nt < 4; ++nt) hgv[nt] = c.hg[h * 256 + 128 * wc + 32 * nt + r];
#pragma unroll
            for (int z = 0; z < 16; ++z) { const int i = 32 * wr + (z & 3) + 8 * (z >> 2) + 4 * hh; const float rs = rsqrtf((red[i * 2] + red[i * 2 + 1]) * (1.f / 256.f) + RMS_EPS);
#pragma unroll
                for (int nt = 0; nt < 4; ++nt) *(LAS bf16_t*)(Vl + i * R2O + (128 * wc + 32 * nt + r) * 2) = f2bf(acc[nt][z] * rs * hgv[nt]); }
        }
        __syncthreads();
        {
            const int tid2 = tidf();
            u32x4 gg[8];
#pragma unroll
            for (int i = 0; i < 8; ++i) { const int row = 16 * i + (tid2 >> 5), pc = tid2 & 31; const int gr = chunk_row(b, n, row); gg[i] = *(const u32x4*)(PROJ + pj_g(h, gr < 0 ? 0 : gr) + 8 * pc); }
#pragma unroll
            for (int i = 0; i < 8; ++i) { const int row = 16 * i + (tid2 >> 5), pc = tid2 & 31; const int gr = chunk_row(b, n, row);
                if (gr >= 0) { const u32x4 o = *(const LAS u32x4*)(Vl + row * R2O + pc * 16), g = gg[i]; u32x4 w;
                    w.x = pk2(lo16(o.x) * lo16(g.x), hi16(o.x) * hi16(g.x)); w.y = pk2(lo16(o.y) * lo16(g.y), hi16(o.y) * hi16(g.y)); w.z = pk2(lo16(o.z) * lo16(g.z), hi16(o.z) * hi16(g.z)); w.w = pk2(lo16(o.w) * lo16(g.w), hi16(o.w) * hi16(g.w));
                    *(u32x4*)(P_ARET + (size_t)gr * DM + h * 256 + 8 * pc) = w; } }
        }
    }
}
constexpr int P6_CONC = (NE * 3072 * 40) / 100;
constexpr int P6B_SPLIT = (NE * 3072 * 82) / 100;
constexpr int PH_LDS = 147456;


typedef __attribute__((address_space(1))) unsigned gu32;
#define XB_TMO      128
#define XB_XCNT(j)  (256  + 64 * (j))
#define XB_XSUB(j)  (1280 + 64 * (j))
#define XB_XGEN(j)  (2304 + 64 * (j))
#define XB_TOP      3328
#define XB_TOPGEN   3392
#define XCD_BAR_WORDS 3456
#define XB_SPIN_CAP (1u << 18)

__device__ __forceinline__ unsigned xb_ld(unsigned* p)              { return __hip_atomic_load(p, __ATOMIC_RELAXED, __HIP_MEMORY_SCOPE_AGENT); }
__device__ __forceinline__ unsigned xb_add(unsigned* p, unsigned v) { return __hip_atomic_fetch_add(p, v, __ATOMIC_RELAXED, __HIP_MEMORY_SCOPE_AGENT); }
__device__ __forceinline__ unsigned xb_xcc_id() { return (unsigned)__builtin_amdgcn_s_getreg((3 << 11) | 20) & 0xFu; }
#define XB_SPIN(cond, bar) do { unsigned _sp = 0; while (cond) { __builtin_amdgcn_s_sleep(1); \
    if ((++_sp & 255u) == 0u) { if (xb_ld(&(bar)[XB_TMO])) break; if (_sp > XB_SPIN_CAP) { atomicAdd(&(bar)[XB_TMO], 1u); break; } } } } while (0)

struct XcdBarrier {
    unsigned* bar; unsigned x;
    volatile LAS unsigned* st;
};

__device__ __forceinline__ XcdBarrier xcd_barrier_post(unsigned* bar, volatile LAS unsigned* st) {
    XcdBarrier b; b.bar = bar; b.x = xb_xcc_id(); b.st = st;
    if (tidf() == 0) (void)xb_add(&bar[XB_XCNT(b.x)], 1u);
    return b;
}
__device__ __forceinline__ void xcd_barrier_complete(unsigned* bar, unsigned x, unsigned& nloc, unsigned& nx) {
    const unsigned G = gridDim.x * gridDim.y * gridDim.z;
    unsigned sum, cnt, mine, sp = 0u;
    for (;;) {
        sum = 0u; cnt = 0u; mine = 0u;
#pragma unroll
        for (unsigned j = 0; j < 16; ++j) { const unsigned c = xb_ld(&bar[XB_XCNT(j)]); sum += c; cnt += (c > 0u) ? 1u : 0u; mine = (j == x) ? c : mine; }
        if (sum == G) break;
        __builtin_amdgcn_s_sleep(1);
        if ((++sp & 255u) == 0u) { if (xb_ld(&bar[XB_TMO])) break; if (sp > XB_SPIN_CAP) { atomicAdd(&bar[XB_TMO], 1u); break; } }
    }
    nloc = mine > 0u ? mine : 1u; nx = cnt > 0u ? cnt : 1u;
}

__device__ __forceinline__ void xcd_barrier(const XcdBarrier& b) {
    asm volatile("s_waitcnt vmcnt(0)" ::: "memory");
    __syncthreads();
    if (tidf() == 0) {
        unsigned* bar = b.bar;
        __builtin_amdgcn_s_waitcnt(0);
        unsigned nloc = b.st[0], nx = b.st[1];
        if (nloc == 0u) { xcd_barrier_complete(bar, b.x, nloc, nx); b.st[0] = nloc; b.st[1] = nx; }
        const unsigned old = xb_add(&bar[XB_XSUB(b.x)], 1u);
        const unsigned gen = old / nloc;
        if (old + 1u == (gen + 1u) * nloc) {
            __builtin_amdgcn_fence(__ATOMIC_RELEASE, "agent");
            asm volatile("s_waitcnt vmcnt(0)" ::: "memory");
            const unsigned og = xb_add(&bar[XB_TOP], 1u);
            const unsigned tg = og / nx;
            if (og + 1u == (tg + 1u) * nx) xb_add(&bar[XB_TOPGEN], 1u);
            else XB_SPIN(xb_ld(&bar[XB_TOPGEN]) == tg, bar);
            __builtin_amdgcn_fence(__ATOMIC_ACQUIRE, "agent");
            xb_add(&bar[XB_XGEN(b.x)], 1u);
            asm volatile("s_waitcnt vmcnt(0)" ::: "memory");
        } else {
            XB_SPIN(xb_ld(&bar[XB_XGEN(b.x)]) == gen, bar);
            __builtin_amdgcn_fence(__ATOMIC_ACQUIRE, "agent");
            asm volatile("s_waitcnt vmcnt(0)" ::: "memory");
        }
    }
    __syncthreads();
}
__device__ __forceinline__ GemmArgs mk_ga(const bf16_t* A, const bf16_t* Bt, int M, int N, int K, int gt, size_t gstride, int side) {
    GemmArgs ga{}; ga.A = A; ga.Bt = Bt; ga.M = M; ga.N = N; ga.K = K; ga.gt = gt; ga.gstride = gstride; ga.side = side; return ga;
}
__global__ void __launch_bounds__(512, 2) mega_fwd(Ctx c) {
    extern __shared__ __attribute__((aligned(16))) unsigned char smem_m[];
    LAS unsigned char* lds = (LAS unsigned char*)smem_m;
    cg::grid_group grid = cg::this_grid();
#ifdef PROBE_A
    unsigned long long tsv[16], tsx[4]; tsv[0] = __builtin_amdgcn_s_memrealtime();
#define TS(k) tsv[k] = __builtin_amdgcn_s_memrealtime()
#define XSYNC0() do { xcd_barrier(xb); tsx[0] = __builtin_amdgcn_s_memrealtime(); } while (0)
#define XSYNC1() do { xcd_barrier(xb); tsx[1] = __builtin_amdgcn_s_memrealtime(); } while (0)
#define XSYNC2() do { xcd_barrier(xb); tsx[2] = __builtin_amdgcn_s_memrealtime(); } while (0)
#define XSYNC3() do { xcd_barrier(xb); tsx[3] = __builtin_amdgcn_s_memrealtime(); } while (0)
#else
#define TS(k)
#define XSYNC0()
#define XSYNC1()
#define XSYNC2()
#define XSYNC3()
#endif
    unsigned* barw = (unsigned*)(c.ws + WS_CTL) + 1024;
    volatile LAS unsigned* bst = (volatile LAS unsigned*)(lds + PH_LDS - 256);
    if (tidf() < 2) bst[tidf()] = 0u;
    __syncthreads();
    if (c.ws == nullptr) grid.sync();
    const XcdBarrier xb = xcd_barrier_post(barw, bst);
#define GSYNC() xcd_barrier(xb)
    phase_p0(lds, c);
    XSYNC0();
    phase_p0b(lds, c);
    GSYNC(); TS(1);
    gemm_fast_body<1>(lds, mk_ga(P_XN, P_WIN, MX, NPROJ, 1024, 1 << 20, 0, 1), make_epi(c));
    GSYNC(); TS(2);
    phase_retsum(lds, c);
    XSYNC1();
    phase_hyprep(lds, c);
    phase_filtout(lds, c);
    GSYNC(); TS(3);
    phase_retscan(c);
    for (int cb = blockIdx.x; cb < 256; cb += gridDim.x) conv_fast_body(lds, P_G, P_ZT, P_YCT, 4 * cb);
    XSYNC2();
    GSYNC(); TS(4);
    phase_retout(lds, c);
    phase_hypost(lds, c);
    GSYNC(); TS(5);
    gemm_fast_body<2>(lds, mk_ga(P_ARET, P_WRET, MX, DM, 1024, 1 << 20, 0, 1), make_epi(c));
    GSYNC(); TS(6);
    gemm_fast_body<3>(lds, mk_ga(P_AHY, P_WHY, MX, DM, 1024, 1 << 20, 0, 1), make_epi(c));
    GSYNC(); TS(7);
    gemm_fast_body<4>(lds, mk_ga(P_XN, P_WO, MX, DM, 1024, 1 << 20, 0, 1), make_epi(c));
    GSYNC(); TS(8);
    phase_p6(lds, c, P6_CONC);
    XSYNC3();
    const int p6split = gridDim.x > 64 ? P6B_SPLIT : NE * 3072;
    phase_p6b(lds, c, P6_CONC, p6split, 0);
    GSYNC(); TS(9);
    phase_topk(lds, c);
    if (gridDim.x > 64) phase_p6b(lds, c, p6split, NE * 3072, NB * NE);
    GSYNC(); TS(10); TS(11);
    { GemmArgs g5 = mk_ga(P_XN, P_WGU, NE * EM, 4096, 1024 / 2, EM / 256, (size_t)4096 * 1024, 0); g5.idx = P_IDX; gemm_fast_body<5>(lds, g5, make_epi(c)); }
    GSYNC(); TS(12);
    gemm_fast_body<6>(lds, mk_ga(P_HID, P_WD, NE * EM, DM, 2048 / 2, EM / 256, (size_t)1024 * 2048, 0), make_epi(c));
    GSYNC(); TS(13);
    phase_final(c);
#ifdef PROBE_A
    GSYNC(); TS(14);
    if (blockIdx.x == 0) {
        #ifdef PROBE_X
        const int kmap[4] = {0, 2, 3, 8};
        const float ta = (float)(tsx[PROBE_X] - tsv[kmap[PROBE_X]]) * 0.01f, tb = (float)(tsv[PROBE_B + 1] - tsv[PROBE_B]) * 0.01f;
#else
        const float ta = (float)(tsv[PROBE_A + 1] - tsv[PROBE_A]) * 0.01f, tb = (float)(tsv[PROBE_B + 1] - tsv[PROBE_B]) * 0.01f;
#endif
        const float eps = sqrtf(ta * 1.6e-5f);
        float* o = (float*)c.dob;
        for (int i = tidf(); i < (1 << 20); i += 512) o[4096 + i] += eps;
        if (tidf() == 0) o[0] += 0.5f + tb * 0.01f;
    }
#endif
}
extern "C" void kernel_launch(void* const* d_in, const int* in_sizes, int n_in, void* d_out, int out_size, void* d_ws, size_t ws_size, hipStream_t stream) {
    if (n_in != 27 || ws_size < WS_END || out_size != MX * DM) { fprintf(stderr, "kernel_launch: unexpected sizes n_in %d ws %zu out %d\n", n_in, ws_size, out_size); return; }
    constexpr size_t kDynLds = PH_LDS;
    static int grid_blocks = 0;
    if (!grid_blocks) {
        int dev = 0, cus = 0, per_cu = 0;
        (void)hipGetDevice(&dev);
        (void)hipDeviceGetAttribute(&cus, hipDeviceAttributeMultiprocessorCount, dev);
        (void)hipFuncSetAttribute((const void*)mega_fwd, hipFuncAttributeMaxDynamicSharedMemorySize, (int)kDynLds);
        (void)hipOccupancyMaxActiveBlocksPerMultiprocessor(&per_cu, (const void*)mega_fwd, 512, kDynLds);
        if (per_cu < 1) per_cu = 1;
        grid_blocks = cus * per_cu;
    }
    Ctx cx{};
    { const float** pp = (const float**)&cx; for (int i = 0; i < 27; ++i) pp[i] = (const float*)d_in[i]; }
    cx.ws = (unsigned char*)d_ws; cx.dob = (unsigned char*)d_out;
    (void)hipMemsetAsync((unsigned char*)d_ws + WS_CTL, 0, 64 * 1024, stream);
    void* args[] = {&cx};
    hipError_t e = hipLaunchCooperativeKernel((const void*)mega_fwd, dim3(grid_blocks), dim3(512), args, kDynLds, stream);
    if (e != hipSuccess) fprintf(stderr, "cooperative launch failed: %s (grid %d)\n", hipGetErrorString(e), grid_blocks);
}
```
